# Optimizing an MI355X kernel written in HIP

```python
import math
import jax
import jax.numpy as jnp
from jax import lax
import numpy as np

D_MODEL = 1024
BATCH = 2
SEQ = 8192
DEPTH = 2

NORM_EPS = 1e-6
PLE_DIM = 256
D_FF = 2816
FFN_HALF = 0.5
BRANCH_WIDTH = D_MODEL // 2
N_BRANCHES = 3
MASK_VALUE = -1e30

ATTN_HEAD_DIM = 64
ATTN_HEADS = BRANCH_WIDTH // ATTN_HEAD_DIM
ATTN_KV_HEADS = ATTN_HEADS // 4
ATTN_GROUP = ATTN_HEADS // ATTN_KV_HEADS
WINDOW = 128
ATTN_BLOCK = 128
ATTN_SCALE = ATTN_HEAD_DIM ** -0.5
ATTN_IN = (ATTN_HEADS + 2 * ATTN_KV_HEADS) * ATTN_HEAD_DIM

RWKV_HEAD_DIM = 64
RWKV_HEADS = BRANCH_WIDTH // RWKV_HEAD_DIM
RWKV_W_RANK = 64
RWKV_A_RANK = 64
RWKV_G_RANK = 128
RWKV_GN_EPS = 64e-5
RWKV_DECAY_SCALE = math.exp(-0.5)
RWKV_WIDTHS = (BRANCH_WIDTH, BRANCH_WIDTH, BRANCH_WIDTH, RWKV_W_RANK, RWKV_A_RANK, RWKV_G_RANK)
RWKV_OFFSETS = tuple(int(o) for o in np.cumsum(RWKV_WIDTHS)[:-1])
RWKV_IN = sum(RWKV_WIDTHS)

HGRN_KEY_DIM = 128
HGRN_HEADS = BRANCH_WIDTH // HGRN_KEY_DIM
HGRN_VAL_DIM = BRANCH_WIDTH // HGRN_HEADS
HGRN_CHUNK = 64
HGRN_IN = 4 * BRANCH_WIDTH

GATE_IN = N_BRANCHES * D_MODEL
GROUP_WIDTHS = (ATTN_IN, RWKV_IN, HGRN_IN, GATE_IN)
GROUP_OFFSETS = tuple(int(o) for o in np.cumsum(GROUP_WIDTHS)[:-1])
IN_WIDTH = sum(GROUP_WIDTHS)

kernel_name = 'hybrid_gated_swa_rwkv7_hgrn2_block'


def rmsnorm(x, g, eps=NORM_EPS):
    xf = x.astype(jnp.float32)
    y = xf * lax.rsqrt(jnp.mean(xf * xf, axis=-1, keepdims=True) + eps)
    return (y * g.astype(jnp.float32)).astype(x.dtype)


def swiglu(x, w_gate, w_up, w_down):
    return (jax.nn.silu(x @ w_gate) * (x @ w_up)) @ w_down


def sliding_window_attention(q, k, v, sinks):
    B, L, _ = q.shape
    nb = L // ATTN_BLOCK
    qb = q.reshape(B, nb, ATTN_BLOCK, ATTN_KV_HEADS, ATTN_GROUP, ATTN_HEAD_DIM)

    def band(t):
        t = t.reshape(B, nb, ATTN_BLOCK, ATTN_KV_HEADS, ATTN_HEAD_DIM)
        prev = jnp.pad(t, ((0, 0), (1, 0), (0, 0), (0, 0), (0, 0)))[:, :-1]
        return jnp.concatenate([prev, t], axis=2)

    kb, vb = band(k), band(v)
    scores = jnp.einsum('bnqhgd,bnkhd->bnhgqk', qb, kb).astype(jnp.float32) * ATTN_SCALE
    qi = jnp.arange(ATTN_BLOCK)[:, None]
    kj = jnp.arange(2 * ATTN_BLOCK)[None, :]
    rel = ATTN_BLOCK + qi - kj
    in_band = (rel >= 0) & (rel < WINDOW)
    not_pad = (jnp.arange(nb)[:, None, None] > 0) | (kj[None] >= ATTN_BLOCK)
    mask = in_band[None] & not_pad
    scores = jnp.where(mask[None, :, None, None], scores, MASK_VALUE)
    sink = sinks.astype(jnp.float32).reshape(ATTN_KV_HEADS, ATTN_GROUP)[None, None, :, :, None, None]
    m = jnp.maximum(jnp.max(scores, axis=-1, keepdims=True), sink)
    pr = jnp.exp(scores - m)
    denom = jnp.sum(pr, axis=-1, keepdims=True) + jnp.exp(sink - m)
    out = jnp.einsum('bnhgqk,bnkhd->bnqhgd', (pr / denom).astype(v.dtype), vb)
    return out.reshape(B, L, ATTN_HEADS * ATTN_HEAD_DIM)


def rwkv7_mix(z, mu, w0, w_up, a0, a_up, g_up, k_k, k_a, r_k, ln_w, ln_b):
    B, L, _ = z.shape
    f32 = jnp.float32
    z = z.astype(f32)
    z_prev = jnp.pad(z, ((0, 0), (1, 0), (0, 0)))[:, :-1]
    z = z + mu * (z_prev - z)
    r, k, v, xw, xa, xg = jnp.split(z, RWKV_OFFSETS, axis=-1)
    d = w0 + jnp.tanh(xw) @ w_up
    decay = jnp.exp(-RWKV_DECAY_SCALE * jax.nn.sigmoid(d))
    a = jax.nn.sigmoid(a0 + xa @ a_up)
    g = jax.nn.sigmoid(xg) @ g_up
    heads = lambda t: t.reshape(B, L, RWKV_HEADS, RWKV_HEAD_DIM)
    kk = heads(k * k_k)
    kk = kk * lax.rsqrt(jnp.maximum(jnp.sum(kk * kk, axis=-1, keepdims=True), 1e-24))
    k = k * (1.0 + (a - 1.0) * k_a)
    r_h, k_h, v_h, a_h, w_h = heads(r), heads(k), heads(v), heads(a), heads(decay)
    b_h = kk * a_h

    def step(S, inp):
        r_t, w_t, k_t, v_t, kk_t, b_t = inp
        sa = jnp.einsum('bhvk,bhk->bhv', S, -kk_t)
        S = S * w_t[:, :, None, :] + sa[..., None] * b_t[:, :, None, :] + v_t[..., None] * k_t[:, :, None, :]
        return S, jnp.einsum('bhvk,bhk->bhv', S, r_t)

    xs = tuple(jnp.moveaxis(t, 1, 0) for t in (r_h, w_h, k_h, v_h, kk, b_h))
    S0 = jnp.zeros((B, RWKV_HEADS, RWKV_HEAD_DIM, RWKV_HEAD_DIM), f32)
    _, y = lax.scan(step, S0, xs)
    y = jnp.moveaxis(y, 0, 1)
    mean = jnp.mean(y, axis=-1, keepdims=True)
    var = jnp.mean(jnp.square(y - mean), axis=-1, keepdims=True)
    y = ((y - mean) * lax.rsqrt(var + RWKV_GN_EPS)).reshape(B, L, BRANCH_WIDTH) * ln_w + ln_b
    bonus = jnp.sum(r_h * k_h * r_k, axis=-1, keepdims=True) * v_h
    y = y + bonus.reshape(B, L, BRANCH_WIDTH)
    return y * g


def hgrn2_mix(z, lb, norm_g):
    B, L, _ = z.shape
    f32 = jnp.float32
    z = z.astype(f32)
    q, f, i, og = jnp.split(z, 4, axis=-1)
    lb = lb.astype(f32)
    forget = lb + (1.0 - lb) * jax.nn.sigmoid(f)
    log_f = jnp.log(forget)
    key = 1.0 - forget
    q = jax.nn.silu(q)
    nc = L // HGRN_CHUNK

    def chunks(t, dim):
        return t.reshape(B, nc, HGRN_CHUNK, HGRN_HEADS, dim).transpose(1, 0, 3, 2, 4)

    xs = (chunks(q, HGRN_KEY_DIM), chunks(key, HGRN_KEY_DIM), chunks(i, HGRN_VAL_DIM), chunks(log_f, HGRN_KEY_DIM))
    causal = jnp.tril(jnp.ones((HGRN_CHUNK, HGRN_CHUNK), bool))[:, :, None]

    def step(S, inp):
        q_c, k_c, v_c, g_c = inp
        b = jnp.cumsum(g_c, axis=-2)
        rel = b[..., :, None, :] - b[..., None, :, :]
        dec = jnp.where(causal, jnp.exp(jnp.where(causal, rel, 0.0)), 0.0)
        attn = jnp.einsum('bhtk,bhsk,bhtsk->bhts', q_c, k_c, dec)
        o = attn @ v_c + jnp.einsum('bhtk,bhkv->bhtv', q_c * jnp.exp(b), S)
        b_last = b[..., -1:, :]
        S = jnp.exp(b_last[..., 0, :])[..., None] * S + jnp.einsum('bhsk,bhsv->bhkv', k_c * jnp.exp(b_last - b), v_c)
        return S, o

    S0 = jnp.zeros((B, HGRN_HEADS, HGRN_KEY_DIM, HGRN_VAL_DIM), f32)
    _, o = lax.scan(step, S0, xs)
    o = o.transpose(1, 0, 3, 2, 4).reshape(B, L, HGRN_HEADS, HGRN_VAL_DIM)
    o = rmsnorm(o, norm_g).reshape(B, L, BRANCH_WIDTH)
    return o * jax.nn.silu(og)


def token_mixer(u, w_in, attn_sinks, rwkv_mu, rwkv_w0, rwkv_w_up, rwkv_a0, rwkv_a_up, rwkv_g_up,
                rwkv_k_k, rwkv_k_a, rwkv_r_k, rwkv_ln_w, rwkv_ln_b, lb, hgrn_norm, w_branch, w_o):
    B, L, _ = u.shape
    z = u @ w_in
    z_attn, z_rwkv, z_hgrn, z_gate = jnp.split(z, GROUP_OFFSETS, axis=-1)
    q_w = ATTN_HEADS * ATTN_HEAD_DIM
    kv_w = ATTN_KV_HEADS * ATTN_HEAD_DIM
    q, k, v = jnp.split(z_attn, [q_w, q_w + kv_w], axis=-1)
    y_a = sliding_window_attention(q, k, v, attn_sinks).astype(jnp.float32)
    y_b = rwkv7_mix(z_rwkv, rwkv_mu, rwkv_w0, rwkv_w_up, rwkv_a0, rwkv_a_up, rwkv_g_up,
                    rwkv_k_k, rwkv_k_a, rwkv_r_k, rwkv_ln_w, rwkv_ln_b)
    y_c = hgrn2_mix(z_hgrn, lb, hgrn_norm)
    ys = jnp.stack([y_a, y_b, y_c], axis=2).astype(u.dtype)
    up = jnp.einsum('blnw,nwd->blnd', ys, w_branch)
    gates = jax.nn.sigmoid(z_gate).reshape(B, L, N_BRANCHES, D_MODEL)
    merged = jnp.sum(gates * up, axis=2)
    return merged @ w_o


def _normal(key, shape, scale):
    return jax.random.normal(key, shape, jnp.float32) * scale


def setup_inputs(seed: int = 0) -> dict:
    key = jax.random.key(seed)
    ks = iter(jax.random.split(key, 40))
    gain = lambda shape: 1.0 + _normal(next(ks), shape, 0.05)
    Dp = DEPTH
    inp = {}
    inp['x'] = _normal(next(ks), (BATCH, SEQ, D_MODEL), 1.0)
    inp['p'] = _normal(next(ks), (DEPTH, BATCH, SEQ, PLE_DIM), 1.0)
    inp['ffn1_norm'] = gain((Dp, D_MODEL))
    inp['ffn1_w_gate'] = _normal(next(ks), (Dp, D_MODEL, D_FF), D_MODEL ** -0.5)
    inp['ffn1_w_up'] = _normal(next(ks), (Dp, D_MODEL, D_FF), D_MODEL ** -0.5)
    inp['ffn1_w_down'] = _normal(next(ks), (Dp, D_FF, D_MODEL), D_FF ** -0.5)
    inp['mix_norm'] = gain((Dp, D_MODEL))
    inp['w_in'] = _normal(next(ks), (Dp, D_MODEL, IN_WIDTH), D_MODEL ** -0.5)
    inp['attn_sinks'] = _normal(next(ks), (Dp, ATTN_HEADS), 0.5)
    inp['rwkv_mu'] = jax.random.uniform(next(ks), (Dp, RWKV_IN), jnp.float32)
    inp['rwkv_w0'] = _normal(next(ks), (Dp, BRANCH_WIDTH), 0.5)
    inp['rwkv_w_up'] = _normal(next(ks), (Dp, RWKV_W_RANK, BRANCH_WIDTH), RWKV_W_RANK ** -0.5)
    inp['rwkv_a0'] = _normal(next(ks), (Dp, BRANCH_WIDTH), 0.1)
    inp['rwkv_a_up'] = _normal(next(ks), (Dp, RWKV_A_RANK, BRANCH_WIDTH), RWKV_A_RANK ** -0.5)
    inp['rwkv_g_up'] = _normal(next(ks), (Dp, RWKV_G_RANK, BRANCH_WIDTH), RWKV_G_RANK ** -0.5)
    inp['rwkv_k_k'] = 0.85 + _normal(next(ks), (Dp, BRANCH_WIDTH), 0.05)
    inp['rwkv_k_a'] = gain((Dp, BRANCH_WIDTH))
    inp['rwkv_r_k'] = _normal(next(ks), (Dp, RWKV_HEADS, RWKV_HEAD_DIM), 0.1)
    inp['rwkv_ln_w'] = gain((Dp, BRANCH_WIDTH))
    inp['rwkv_ln_b'] = _normal(next(ks), (Dp, BRANCH_WIDTH), 0.01)
    inp['hgrn_lb'] = _normal(next(ks), (Dp, HGRN_HEADS * HGRN_KEY_DIM), 1.0)
    inp['hgrn_norm'] = gain((Dp, HGRN_VAL_DIM))
    inp['w_branch'] = _normal(next(ks), (Dp, N_BRANCHES, BRANCH_WIDTH, D_MODEL), BRANCH_WIDTH ** -0.5)
    inp['w_o'] = _normal(next(ks), (Dp, D_MODEL, D_MODEL), D_MODEL ** -0.5)
    inp['ffn2_norm'] = gain((Dp, D_MODEL))
    inp['ffn2_w_gate'] = _normal(next(ks), (Dp, D_MODEL, D_FF), D_MODEL ** -0.5)
    inp['ffn2_w_up'] = _normal(next(ks), (Dp, D_MODEL, D_FF), D_MODEL ** -0.5)
    inp['ffn2_w_down'] = _normal(next(ks), (Dp, D_FF, D_MODEL), D_FF ** -0.5)
    inp['ple_norm'] = gain((Dp, D_MODEL))
    inp['ple_w_gate'] = _normal(next(ks), (Dp, D_MODEL, D_MODEL), D_MODEL ** -0.5)
    inp['ple_w_proj'] = _normal(next(ks), (Dp, PLE_DIM, D_MODEL), PLE_DIM ** -0.5)
    inp['final_norm'] = gain((D_MODEL,))
    return inp


def reference(x, p, ffn1_norm, ffn1_w_gate, ffn1_w_up, ffn1_w_down, mix_norm, w_in, attn_sinks,
              rwkv_mu, rwkv_w0, rwkv_w_up, rwkv_a0, rwkv_a_up, rwkv_g_up, rwkv_k_k, rwkv_k_a, rwkv_r_k,
              rwkv_ln_w, rwkv_ln_b, hgrn_lb, hgrn_norm, w_branch, w_o, ffn2_norm, ffn2_w_gate, ffn2_w_up,
              ffn2_w_down, ple_norm, ple_w_gate, ple_w_proj, final_norm):
    lb_all = jax.nn.softmax(hgrn_lb.astype(jnp.float32), axis=0)
    lb_layers = jnp.clip(jnp.cumsum(lb_all, axis=0) - lb_all[0:1], 0.0, 1.0 - 1e-6)
    for i in range(DEPTH):
        h = rmsnorm(x, ffn1_norm[i])
        x = x + FFN_HALF * swiglu(h, ffn1_w_gate[i], ffn1_w_up[i], ffn1_w_down[i])
        u = rmsnorm(x, mix_norm[i])
        x = x + token_mixer(u, w_in[i], attn_sinks[i], rwkv_mu[i], rwkv_w0[i], rwkv_w_up[i], rwkv_a0[i],
                            rwkv_a_up[i], rwkv_g_up[i], rwkv_k_k[i], rwkv_k_a[i], rwkv_r_k[i], rwkv_ln_w[i],
                            rwkv_ln_b[i], lb_layers[i], hgrn_norm[i], w_branch[i], w_o[i]).astype(x.dtype)
        h = rmsnorm(x, ffn2_norm[i])
        x = x + FFN_HALF * swiglu(h, ffn2_w_gate[i], ffn2_w_up[i], ffn2_w_down[i])
        gate = jax.nn.sigmoid(rmsnorm(x, ple_norm[i]) @ ple_w_gate[i])
        x = x + gate * (p[i] @ ple_w_proj[i])
    return rmsnorm(x, final_norm)
```

```cpp
#include <hip/hip_runtime.h>
#include <cstdio>
#include <cstdint>
namespace pg8 {
#define PG8_LAS __attribute__((address_space(3)))
typedef unsigned short bf16_t;
typedef short bf16x8 __attribute__((ext_vector_type(8)));
typedef float f32x4 __attribute__((ext_vector_type(4)));
typedef unsigned u32x4 __attribute__((ext_vector_type(4)));
constexpr int BM = 256, BK = 64, HALF = 128, HTB = HALF * BK * 2  , STAGE_BYTES = 8 * HTB, NXCD = 8, WGM = 8;

__host__ __device__ __forceinline__ int lds_byte(int r, int c) { const int st = (r >> 4) * 2 + (c >> 5), rr = r & 15, cc = c & 31, ob = rr * 64 + cc * 2; return st * 1024 + (ob ^ (((ob >> 9) & 1) << 5)); }
__host__ __device__ __forceinline__ void stage_rc(int b, int& R, int& C) { const int st = b / 1024, sb = b % 1024, swz = sb ^ (((sb >> 9) & 1) << 5); R = (st >> 1) * 16 + swz / 64; C = (st & 1) * 32 + (swz % 64) / 2; }
__host__ __device__ __forceinline__ int perm32(int rho) { const int n = rho >> 4, i = rho & 15; return 8 * (i >> 2) + 4 * n + (i & 3); }

struct Unit { int pm, pn; };
struct Gemm { const bf16_t* A; const bf16_t* Bt; int M, N, K; };

struct StaticOrder {
    int nM, nN, nwg, G, c;
    __host__ __device__ void init(int M, int N, int G_, int c_) { nM = M / BM; nN = N / BM; nwg = nM * nN; G = G_; c = c_; }
    __host__ __device__ bool next(int i, Unit& u) const {
        const long L = (long)i * G + c; if (L >= nwg) return false;
        int wgid = (int)L; { const int q = nwg / NXCD, r = nwg % NXCD, xcd = wgid % NXCD, off = wgid / NXCD; wgid = (xcd < r ? xcd * (q + 1) : r * (q + 1) + (xcd - r) * q) + off; }
        const int nig = WGM * nN, gid = wgid / nig, fm = gid * WGM, gsz = (nM - fm) < WGM ? (nM - fm) : WGM;
        u.pm = fm + ((wgid % nig) % gsz); u.pn = (wgid % nig) / gsz; return true;
    }
    __device__ __forceinline__ void a_ready(const Unit&) const {}
    __device__ __forceinline__ void done(const Unit&) const {}
};

__device__ __forceinline__ unsigned cvt_pk_bf16(float lo, float hi) { unsigned r; asm volatile("v_cvt_pk_bf16_f32 %0, %1, %2" : "=v"(r) : "v"(lo), "v"(hi)); return r; }
typedef float f32x2 __attribute__((ext_vector_type(2)));
typedef unsigned u32x2 __attribute__((ext_vector_type(2)));
__device__ __forceinline__ float fsigmoid(float x) { return __builtin_amdgcn_rcpf(1.0f + __builtin_amdgcn_exp2f(-1.4426950408889634f * x)); }
__device__ __forceinline__ float fsilu(float x) { return x * fsigmoid(x); }
__device__ __forceinline__ float bf2f(unsigned short b) { return __uint_as_float(((unsigned)b) << 16); }
typedef float f32x2_t __attribute__((ext_vector_type(2))); typedef __bf16 bf16x2_t __attribute__((ext_vector_type(2)));
__device__ __forceinline__ unsigned cvtpk_s(float lo, float hi) { f32x2_t v = {lo, hi}; bf16x2_t b = __builtin_convertvector(v, bf16x2_t); return __builtin_bit_cast(unsigned, b); }
__device__ __forceinline__ u32x4 pack8(const f32x4& a, const f32x4& b) { u32x4 w; w.x = cvtpk_s(a[0], a[1]); w.y = cvtpk_s(a[2], a[3]); w.z = cvtpk_s(b[0], b[1]); w.w = cvtpk_s(b[2], b[3]); return w; }
__device__ __forceinline__ void unpack8(const u32x4& w, f32x4& a, f32x4& b) {
    a[0] = __uint_as_float(w.x << 16); a[1] = __uint_as_float(w.x & 0xffff0000u); a[2] = __uint_as_float(w.y << 16); a[3] = __uint_as_float(w.y & 0xffff0000u);
    b[0] = __uint_as_float(w.z << 16); b[1] = __uint_as_float(w.z & 0xffff0000u); b[2] = __uint_as_float(w.w << 16); b[3] = __uint_as_float(w.w & 0xffff0000u); }
__device__ __forceinline__ float row_rstd(const float* ssp, int r) {
    const f32x4* p = (const f32x4*)(ssp + (size_t)r * 16);
    const f32x4 a = p[0], b = p[1], c = p[2], d = p[3]; const f32x4 s = (a + b) + (c + d);
    return __builtin_amdgcn_rsqf(((s[0] + s[1]) + (s[2] + s[3])) * (1.0f / 1024.0f) + 1e-6f);
}
#define EPI_FENCE() asm volatile("" ::: "memory")
struct EpiSwiglu {
    static constexpr bool PERM = true, AFTER_DRAIN = false;
    bf16_t* H; const float* ssp;
    __device__ __forceinline__ void operator()(const f32x4 (&acc)[2][2][4][2], const Unit& u, int wr, int wc, int fr, int fq) const {
        const int row0 = u.pm * BM + wr * 64 + fr, col0 = u.pn * HALF + wc * 32 + 8 * fq;
#pragma unroll
        for (int ai = 0; ai < 2; ++ai)
#pragma unroll
            for (int m = 0; m < 4; ++m) { const int r = row0 + ai * HALF + m * 16; const float s = row_rstd(ssp, r); f32x4 o[2];
#pragma unroll
                for (int n = 0; n < 2; ++n) { const f32x4 g = acc[ai][0][m][n] * s, up = acc[ai][1][m][n] * s;
#pragma unroll
                    for (int i = 0; i < 4; ++i) o[n][i] = fsilu(g[i]) * up[i]; }
                *(u32x4*)(H + (size_t)r * 2816 + col0) = pack8(o[0], o[1]); EPI_FENCE(); }
    }
};
template <int MODE> struct EpiResid {
    static constexpr bool PERM = true, AFTER_DRAIN = false;
    float* X; bf16_t* XB; float* sso; const float* ssi; const bf16_t* proj; float scale;
    __device__ __forceinline__ void operator()(const f32x4 (&acc)[2][2][4][2], const Unit& u, int wr, int wc, int fr, int fq) const {
        const int row0 = u.pm * BM + wr * 64 + fr, col0 = u.pn * BM + wc * 32 + 8 * fq;
#pragma unroll
        for (int ai = 0; ai < 2; ++ai)
#pragma unroll
            for (int m = 0; m < 4; ++m) { const int r = row0 + ai * HALF + m * 16; float* xp = X + (size_t)r * 1024 + col0; float ss = 0.f;
                float s = 1.0f; if (MODE == 1) s = row_rstd(ssi, r);
#pragma unroll
                for (int bj = 0; bj < 2; ++bj) { f32x4 x0 = *(const f32x4*)(xp + bj * HALF), x1 = *(const f32x4*)(xp + bj * HALF + 4);
                    if (MODE == 0) { x0 = x0 + acc[ai][bj][m][0] * scale; x1 = x1 + acc[ai][bj][m][1] * scale; }
                    else { f32x4 p0, p1; unpack8(*(const u32x4*)(proj + (size_t)r * 1024 + col0 + bj * HALF), p0, p1);
#pragma unroll
                        for (int i = 0; i < 4; ++i) { x0[i] += fsigmoid(acc[ai][bj][m][0][i] * s) * p0[i]; x1[i] += fsigmoid(acc[ai][bj][m][1][i] * s) * p1[i]; } }
                    *(f32x4*)(xp + bj * HALF) = x0; *(f32x4*)(xp + bj * HALF + 4) = x1;
                    *(u32x4*)(XB + (size_t)r * 1024 + col0 + bj * HALF) = pack8(x0, x1);
                    ss += ((x0[0] * x0[0] + x0[1] * x0[1]) + (x0[2] * x0[2] + x0[3] * x0[3])) + ((x1[0] * x1[0] + x1[1] * x1[1]) + (x1[2] * x1[2] + x1[3] * x1[3])); }
                ss += __shfl_xor(ss, 16); ss += __shfl_xor(ss, 32);
                if (fq == 0) sso[(size_t)r * 16 + u.pn * 4 + wc] = ss;
                EPI_FENCE(); }
    }
};
template <int ACT, bool RS, int LD> __device__ __forceinline__ void store_tile(const f32x4 (&acc)[2][2][4][2], bf16_t* base, const float* ssp, const float* cvp, int row0) {
    f32x4 cv[2][2];
#pragma unroll
    for (int bj = 0; bj < 2; ++bj)
#pragma unroll
        for (int n = 0; n < 2; ++n) cv[bj][n] = (ACT >= 3) ? *(const f32x4*)(cvp + bj * HALF + 4 * n) : (f32x4){0.f, 0.f, 0.f, 0.f};
#pragma unroll
    for (int ai = 0; ai < 2; ++ai)
#pragma unroll
        for (int m = 0; m < 4; ++m) { const int r = row0 + ai * HALF + m * 16; float s = 1.0f; if (RS) s = row_rstd(ssp, r);
#pragma unroll
            for (int bj = 0; bj < 2; ++bj) { f32x4 o[2];
#pragma unroll
                for (int n = 0; n < 2; ++n) { const f32x4 z = acc[ai][bj][m][n] * s;
#pragma unroll
                    for (int i = 0; i < 4; ++i) { float v = z[i];
                        if (ACT == 1) v = fsilu(v);
                        else if (ACT == 2) v = fsigmoid(v);
                        else if (ACT == 3) v = (1.0f - cv[bj][n][i]) * fsigmoid(-v);
                        else if (ACT == 4) v = __builtin_amdgcn_exp2f(-0.6065306597126334f * 1.4426950408889634f * fsigmoid(v + cv[bj][n][i]));
                        else if (ACT == 5) v = fsigmoid(v + cv[bj][n][i]);
                        o[n][i] = v; } }
                *(u32x4*)(base + (size_t)r * LD + bj * HALF) = pack8(o[0], o[1]); }
            EPI_FENCE(); }
}
template <int KIND> struct EpiStore {
    static constexpr bool PERM = true, AFTER_DRAIN = false;
    bf16_t* O; const float* ssp; bf16_t* O2; bf16_t* O3; const float* c0; const float* c1;
    __device__ __forceinline__ void operator()(const f32x4 (&acc)[2][2][4][2], const Unit& u, int wr, int wc, int fr, int fq) const {
        const int row0 = u.pm * BM + wr * 64 + fr; const int cl = wc * 32 + 8 * fq;
        if (KIND == 0) store_tile<0, true, 1792>(acc, O + u.pn * BM + cl, ssp, nullptr, row0);
        if (KIND == 1) {
            if (u.pn < 3) store_tile<0, true, 768>(acc, O + u.pn * BM + cl, ssp, nullptr, row0);
            else { const int t = u.pn - 3, kind = t >> 1; bf16_t* b = O2 + t * BM + cl;
                if (kind == 0 || kind == 3) store_tile<1, true, 2048>(acc, b, ssp, nullptr, row0);
                else if (kind == 1) store_tile<3, true, 2048>(acc, b, ssp, c0 + (t & 1) * BM + cl, row0);
                else store_tile<0, true, 2048>(acc, b, ssp, nullptr, row0); } }
        if (KIND == 2) store_tile<2, true, 3072>(acc, O + u.pn * BM + cl, ssp, nullptr, row0);
        if (KIND == 3) {
            if (u.pn < 2) store_tile<4, false, 512>(acc, O + u.pn * BM + cl, nullptr, c0 + u.pn * BM + cl, row0);
            else if (u.pn < 4) store_tile<5, false, 512>(acc, O2 + (u.pn - 2) * BM + cl, nullptr, c1 + (u.pn - 2) * BM + cl, row0);
            else store_tile<0, false, 512>(acc, O3 + (u.pn - 4) * BM + cl, nullptr, nullptr, row0); }
        if (KIND == 4) store_tile<0, false, 1024>(acc, O + u.pn * BM + cl, nullptr, nullptr, row0);
    }
};
template <bool FIRST> struct EpiBranch {
    static constexpr bool PERM = true, AFTER_DRAIN = false;
    bf16_t* Mg; const bf16_t* G; const float* ssp;
    __device__ __forceinline__ void operator()(const f32x4 (&acc)[2][2][4][2], const Unit& u, int wr, int wc, int fr, int fq) const {
        const int row0 = u.pm * BM + wr * 64 + fr, col0 = u.pn * BM + wc * 32 + 8 * fq;
#pragma unroll
        for (int ai = 0; ai < 2; ++ai)
#pragma unroll
            for (int m = 0; m < 4; ++m) { const int r = row0 + ai * HALF + m * 16;
#pragma unroll
                for (int bj = 0; bj < 2; ++bj) { f32x4 g0, g1; unpack8(*(const u32x4*)(G + (size_t)r * 3072 + col0 + bj * HALF), g0, g1);
                    f32x4 o0 = g0 * acc[ai][bj][m][0], o1 = g1 * acc[ai][bj][m][1];
                    bf16_t* mp = Mg + (size_t)r * 1024 + col0 + bj * HALF;
                    if (!FIRST) { f32x4 p0, p1; unpack8(*(const u32x4*)mp, p0, p1); o0 = o0 + p0; o1 = o1 + p1; }
                    *(u32x4*)mp = pack8(o0, o1); }
                EPI_FENCE(); }
    }
};
template <class Epi, class Sched, bool ALIGN_EPI = false, bool SP2 = false>
__device__ __forceinline__ void gemm_phase(PG8_LAS unsigned char* lds, const Gemm g, const Sched& S, const Epi& E) {
    const int tid = threadIdx.x, wid = __builtin_amdgcn_readfirstlane(tid >> 6), lane = tid & 63, wr = wid >> 2, wc = wid & 3, fr = lane & 15, fq = lane >> 4;
    int Kl_ = g.K; asm volatile("" : "+s"(Kl_)); const int K = Kl_, nt = K / BK;
    unsigned voffA[2], voffB[2];
#pragma unroll
    for (int i = 0; i < 2; ++i) { int R, C; stage_rc(tid * 16 + i * 8192, R, C); const int Rb = Epi::PERM ? ((R & ~31) + perm32(R & 31)) : R;
        voffA[i] = (unsigned)(R * K + C) * 2u; voffB[i] = (unsigned)(Rb * K + C) * 2u; }
    const size_t kstep = (size_t)(BK * 2);
    const size_t hstep = (size_t)HALF * K * 2;
    const size_t tstep = 2 * hstep;
    const unsigned ldsw = (unsigned)wid * 1024u;
    const int aoff = lds_byte(wr * 64 + fr, fq * 8), boff = lds_byte(wc * 32 + fr, fq * 8);
#define PG8_SA(b, h) (((b) * 2 + (h)) * HTB)
#define PG8_SB(b, h) ((4 + (b) * 2 + (h)) * HTB)
#define PG8_STAGE(bufoff, gbase, voff) do { _Pragma("unroll") for (int _i = 0; _i < 2; ++_i) \
        __builtin_amdgcn_global_load_lds((const unsigned*)((const char*)(gbase) + (voff)[_i]), (PG8_LAS unsigned*)(lds + (bufoff) + ldsw + _i * 8192), 16, 0, 0); } while (0)
#define PG8_LDA(dst, b, h) do { _Pragma("unroll") for (int m = 0; m < 4; ++m) _Pragma("unroll") for (int k = 0; k < 2; ++k) dst[m][k] = *(const PG8_LAS bf16x8*)(lds + PG8_SA(b, h) + aoff + m * 2048 + k * 1024); } while (0)
#define PG8_LDB(dst, b, h) do { _Pragma("unroll") for (int n = 0; n < 2; ++n) _Pragma("unroll") for (int k = 0; k < 2; ++k) dst[n][k] = *(const PG8_LAS bf16x8*)(lds + PG8_SB(b, h) + boff + n * 2048 + k * 1024); } while (0)
#define PG8_MMA(ai, bj, At, Bt) do { __builtin_amdgcn_s_setprio(1); _Pragma("unroll") for (int m = 0; m < 4; ++m) _Pragma("unroll") for (int n = 0; n < 2; ++n) _Pragma("unroll") for (int k = 0; k < 2; ++k) \
        acc[ai][bj][m][n] = __builtin_amdgcn_mfma_f32_16x16x32_bf16(Bt[n][k], At[m][k], acc[ai][bj][m][n], 0, 0, 0); __builtin_amdgcn_s_setprio(0); } while (0)
#define PG8_WAIT_V(n) asm volatile("s_waitcnt vmcnt(" #n ")" ::: "memory")
#define PG8_WAIT_L(n) asm volatile("s_waitcnt lgkmcnt(" #n ")" ::: "memory")
#define PG8_BAR __builtin_amdgcn_s_barrier()
#define PG8_SCHED __builtin_amdgcn_sched_barrier(0)
    Unit cur, nxt; int ui = 0;
    if (!S.next(0, cur)) return;
    f32x4 acc[2][2][4][2];
#pragma unroll
    for (int a = 0; a < 2; ++a)
#pragma unroll
        for (int b = 0; b < 2; ++b)
#pragma unroll
            for (int m = 0; m < 4; ++m)
#pragma unroll
                for (int n = 0; n < 2; ++n) acc[a][b][m][n] = (f32x4){0.f, 0.f, 0.f, 0.f};
    bf16x8 At[4][2], B0[2][2], B1[2][2];
    const char* cA = (const char*)g.A + (size_t)cur.pm * tstep; const char* cB = (const char*)g.Bt + (size_t)cur.pn * tstep;
    S.a_ready(cur);
    if constexpr (SP2) {
        PG8_STAGE(PG8_SB(0, 0), cB, voffB); PG8_STAGE(PG8_SB(0, 1), cB + hstep, voffB); PG8_STAGE(PG8_SA(0, 0), cA, voffA); PG8_STAGE(PG8_SA(0, 1), cA + hstep, voffA);
        if (wr == 1) PG8_BAR;
        PG8_WAIT_V(2); PG8_BAR;
        PG8_STAGE(PG8_SB(1, 0), cB + kstep, voffB); PG8_STAGE(PG8_SA(1, 0), cA + kstep, voffA); PG8_STAGE(PG8_SB(1, 1), cB + hstep + kstep, voffB);
        PG8_WAIT_V(6); PG8_BAR;
    } else {
        PG8_STAGE(PG8_SB(0, 0), cB, voffB); PG8_STAGE(PG8_SA(0, 0), cA, voffA); PG8_STAGE(PG8_SB(0, 1), cB + hstep, voffB); PG8_STAGE(PG8_SA(0, 1), cA + hstep, voffA);
        if (wr == 1) PG8_BAR;
        PG8_WAIT_V(4); PG8_BAR;
        PG8_STAGE(PG8_SB(1, 0), cB + kstep, voffB); PG8_STAGE(PG8_SA(1, 0), cA + kstep, voffA); PG8_STAGE(PG8_SB(1, 1), cB + hstep + kstep, voffB);
        PG8_WAIT_V(6); PG8_BAR;
    }
    for (;;) {
        const bool has_next = S.next(ui + 1, nxt);
        const char* nA = has_next ? (const char*)g.A + (size_t)nxt.pm * tstep : cA; const char* nB = has_next ? (const char*)g.Bt + (size_t)nxt.pn * tstep : cB;
        for (int t = 0; t < nt; t += 2) {
            const bool last = (t == nt - 2);
            const char* a1 = cA + (size_t)(t + 1) * kstep;
            const char* a2 = last ? nA : cA + (size_t)(t + 2) * kstep; const char* b2 = last ? nB : cB + (size_t)(t + 2) * kstep;
            const char* a3 = a2 + kstep; const char* b3 = b2 + kstep;
            if (last && has_next) S.a_ready(nxt);
            if constexpr (SP2) {
            PG8_LDB(B0, 0, 0); PG8_LDB(B1, 0, 1); PG8_SCHED; PG8_LDA(At, 0, 0); PG8_STAGE(PG8_SA(1, 1), a1 + hstep, voffA);
            PG8_WAIT_V(8); PG8_WAIT_L(0); PG8_BAR; PG8_MMA(0, 0, At, B0); PG8_MMA(0, 1, At, B1); PG8_BAR; PG8_SCHED;
            PG8_LDA(At, 0, 1); PG8_STAGE(PG8_SB(0, 0), b2, voffB); PG8_STAGE(PG8_SB(0, 1), b2 + hstep, voffB); PG8_STAGE(PG8_SA(0, 0), a2, voffA);
            PG8_WAIT_V(8); PG8_WAIT_L(0); PG8_BAR; PG8_MMA(1, 0, At, B0); PG8_MMA(1, 1, At, B1); PG8_BAR; PG8_SCHED;
            PG8_LDB(B0, 1, 0); PG8_LDB(B1, 1, 1); PG8_SCHED; PG8_LDA(At, 1, 0); PG8_STAGE(PG8_SA(0, 1), a2 + hstep, voffA);
            PG8_WAIT_V(8); PG8_WAIT_L(0); PG8_BAR; PG8_MMA(0, 0, At, B0); PG8_MMA(0, 1, At, B1); PG8_BAR; PG8_SCHED;
            PG8_LDA(At, 1, 1); PG8_STAGE(PG8_SB(1, 0), b3, voffB); PG8_STAGE(PG8_SB(1, 1), b3 + hstep, voffB); PG8_STAGE(PG8_SA(1, 0), a3, voffA);
            PG8_WAIT_V(8); PG8_WAIT_L(0); PG8_BAR; PG8_MMA(1, 0, At, B0); PG8_MMA(1, 1, At, B1); PG8_BAR; PG8_SCHED;
            } else {
            PG8_LDB(B0, 0, 0); PG8_SCHED; PG8_LDA(At, 0, 0); PG8_STAGE(PG8_SA(1, 1), a1 + hstep, voffA);
            PG8_WAIT_L(8); PG8_BAR; PG8_WAIT_L(0); PG8_MMA(0, 0, At, B0); PG8_BAR; PG8_SCHED;
            PG8_LDB(B1, 0, 1); PG8_STAGE(PG8_SB(0, 0), b2, voffB);
            PG8_BAR; PG8_WAIT_L(0); PG8_MMA(0, 1, At, B1); PG8_BAR;
            PG8_LDA(At, 0, 1); PG8_STAGE(PG8_SA(0, 0), a2, voffA);
            PG8_BAR; PG8_WAIT_L(0); PG8_MMA(1, 0, At, B0); PG8_BAR; PG8_SCHED;
            PG8_STAGE(PG8_SB(0, 1), b2 + hstep, voffB);
            PG8_WAIT_V(6); PG8_BAR; PG8_MMA(1, 1, At, B1); PG8_BAR;
            PG8_LDB(B0, 1, 0); PG8_SCHED; PG8_LDA(At, 1, 0); PG8_STAGE(PG8_SA(0, 1), a2 + hstep, voffA);
            PG8_WAIT_L(8); PG8_BAR; PG8_WAIT_L(0); PG8_MMA(0, 0, At, B0); PG8_BAR; PG8_SCHED;
            PG8_LDB(B1, 1, 1); PG8_STAGE(PG8_SB(1, 0), b3, voffB);
            PG8_BAR; PG8_WAIT_L(0); PG8_MMA(0, 1, At, B1); PG8_BAR;
            PG8_LDA(At, 1, 1); PG8_STAGE(PG8_SA(1, 0), a3, voffA);
            PG8_BAR; PG8_WAIT_L(0); PG8_MMA(1, 0, At, B0); PG8_BAR; PG8_SCHED;
            PG8_STAGE(PG8_SB(1, 1), b3 + hstep, voffB);
            PG8_WAIT_V(6); PG8_BAR; PG8_MMA(1, 1, At, B1); PG8_BAR;
            }
        }
        if constexpr (ALIGN_EPI) { if (wr == 0) PG8_BAR; }
        if constexpr (!Epi::AFTER_DRAIN) { E(acc, cur, wr, wc, fr, fq); S.done(cur); }
        if (!has_next) break;
#pragma unroll
        for (int a = 0; a < 2; ++a)
#pragma unroll
            for (int b = 0; b < 2; ++b)
#pragma unroll
                for (int m = 0; m < 4; ++m)
#pragma unroll
                    for (int n = 0; n < 2; ++n) acc[a][b][m][n] = (f32x4){0.f, 0.f, 0.f, 0.f};
        cur = nxt; cA = nA; cB = nB; ++ui;
        if constexpr (ALIGN_EPI) { if (wr == 1) PG8_BAR; }
    }
    PG8_WAIT_V(0);
    if constexpr (!ALIGN_EPI) { if (wr == 0) PG8_BAR; }
    PG8_BAR;
    if constexpr (Epi::AFTER_DRAIN) { E.fused(acc, cur, wr, wc, fr, fq, lds, wid, lane); S.done(cur); }
#undef PG8_SA
#undef PG8_SB
#undef PG8_STAGE
#undef PG8_LDA
#undef PG8_LDB
#undef PG8_MMA
#undef PG8_WAIT_V
#undef PG8_WAIT_L
#undef PG8_BAR
#undef PG8_SCHED
}
}
#define GAS __attribute__((address_space(1)))
#define LAS __attribute__((address_space(3)))
typedef unsigned short bf16;
typedef unsigned v4u __attribute__((ext_vector_type(4)));
typedef float f32x4 __attribute__((ext_vector_type(4)));
typedef short bf16x8 __attribute__((ext_vector_type(8)));
typedef GAS unsigned gu32;
typedef GAS unsigned long long gu64;
#define RLX_AGENT __ATOMIC_RELAXED, __HIP_MEMORY_SCOPE_AGENT
#define LDS_WAIT() asm volatile("s_waitcnt lgkmcnt(0)" ::: "memory")
#define VM_WAIT() asm volatile("s_waitcnt vmcnt(0)" ::: "memory")
__device__ __forceinline__ unsigned long long rt() { return __builtin_amdgcn_s_memrealtime(); }
__device__ __forceinline__ unsigned f2bf(float f) { unsigned u = __builtin_bit_cast(unsigned, f); return (u + 0x7fffu + ((u >> 16) & 1u)) >> 16; }
__device__ __forceinline__ unsigned pk2(float lo, float hi) { return f2bf(lo) | (f2bf(hi) << 16); }

#define XB_TMO      128
#define XB_XCNT(j)  (256  + 64 * (j))
#define XB_XSUB(j)  (1280 + 64 * (j))
#define XB_XGEN(j)  (2304 + 64 * (j))
#define XB_TOP      3328
#define XB_TOPGEN   3392
#define XCD_BAR_WORDS 3456
#define XB_SPIN_CAP (1u << 18)

__device__ __forceinline__ unsigned xb_ld(unsigned* p)              { return __hip_atomic_load(p, __ATOMIC_RELAXED, __HIP_MEMORY_SCOPE_AGENT); }
__device__ __forceinline__ unsigned xb_add(unsigned* p, unsigned v) { return __hip_atomic_fetch_add(p, v, __ATOMIC_RELAXED, __HIP_MEMORY_SCOPE_AGENT); }
__device__ __forceinline__ unsigned xb_xcc_id() { return (unsigned)__builtin_amdgcn_s_getreg((3 << 11) | 20) & 0xFu; }
#define XB_SPIN(cond, bar) do { unsigned _sp = 0; while (cond) { __builtin_amdgcn_s_sleep(1); \
    if ((++_sp & 255u) == 0u) { if (xb_ld(&(bar)[XB_TMO])) break; if (_sp > XB_SPIN_CAP) { atomicAdd(&(bar)[XB_TMO], 1u); break; } } } } while (0)

struct XcdBarrier {
    unsigned* bar; unsigned x;
    volatile LAS unsigned* st;
};

__device__ __forceinline__ XcdBarrier xcd_barrier_post(unsigned* bar, volatile LAS unsigned* st) {
    XcdBarrier b; b.bar = bar; b.x = xb_xcc_id(); b.st = st;
    if (threadIdx.x == 0) (void)xb_add(&bar[XB_XCNT(b.x)], 1u);
    return b;
}
__device__ __forceinline__ void xcd_barrier_complete(unsigned* bar, unsigned x, unsigned& nloc, unsigned& nx) {
    const unsigned G = gridDim.x * gridDim.y * gridDim.z;
    unsigned sum, cnt, mine, sp = 0u;
    for (;;) {
        sum = 0u; cnt = 0u; mine = 0u;
#pragma unroll
        for (unsigned j = 0; j < 16; ++j) { const unsigned c = xb_ld(&bar[XB_XCNT(j)]); sum += c; cnt += (c > 0u) ? 1u : 0u; mine = (j == x) ? c : mine; }
        if (sum == G) break;
        __builtin_amdgcn_s_sleep(1);
        if ((++sp & 255u) == 0u) { if (xb_ld(&bar[XB_TMO])) break; if (sp > XB_SPIN_CAP) { atomicAdd(&bar[XB_TMO], 1u); break; } }
    }
    nloc = mine > 0u ? mine : 1u; nx = cnt > 0u ? cnt : 1u;
}

__device__ __forceinline__ void xcd_barrier(const XcdBarrier& b) {
    asm volatile("s_waitcnt vmcnt(0)" ::: "memory");
    __syncthreads();
    if (threadIdx.x == 0) {
        unsigned* bar = b.bar;
        __builtin_amdgcn_s_waitcnt(0);
        unsigned nloc = b.st[0], nx = b.st[1];
        if (nloc == 0u) { xcd_barrier_complete(bar, b.x, nloc, nx); b.st[0] = nloc; b.st[1] = nx; }
        const unsigned old = xb_add(&bar[XB_XSUB(b.x)], 1u);
        const unsigned gen = old / nloc;
        if (old + 1u == (gen + 1u) * nloc) {
            __builtin_amdgcn_fence(__ATOMIC_RELEASE, "agent");
            asm volatile("s_waitcnt vmcnt(0)" ::: "memory");
            const unsigned og = xb_add(&bar[XB_TOP], 1u);
            const unsigned tg = og / nx;
            if (og + 1u == (tg + 1u) * nx) xb_add(&bar[XB_TOPGEN], 1u);
            else XB_SPIN(xb_ld(&bar[XB_TOPGEN]) == tg, bar);
            __builtin_amdgcn_fence(__ATOMIC_ACQUIRE, "agent");
            xb_add(&bar[XB_XGEN(b.x)], 1u);
            asm volatile("s_waitcnt vmcnt(0)" ::: "memory");
        } else {
            XB_SPIN(xb_ld(&bar[XB_XGEN(b.x)]) == gen, bar);
            __builtin_amdgcn_fence(__ATOMIC_ACQUIRE, "agent");
            asm volatile("s_waitcnt vmcnt(0)" ::: "memory");
        }
    }
    __syncthreads();
}
constexpr int NWAVES = 8;
constexpr int BATCH = 2, SEQ = 8192, DM = 1024, M = BATCH * SEQ, FF = 2816, DEPTH = 2;
enum { I_X = 0, I_P, I_F1N, I_F1G, I_F1U, I_F1D, I_MIXN, I_WIN, I_SINK, I_MU, I_W0, I_WUP, I_A0, I_AUP, I_GUP, I_KK, I_KA, I_RK, I_LNW, I_LNB, I_HLB, I_HNORM, I_WBR, I_WO,
       I_F2N, I_F2G, I_F2U, I_F2D, I_PLEN, I_PLEG, I_PLEP, I_FINN, N_IN };
constexpr size_t KiB = 1024, MiB = 1u << 20;
constexpr size_t WS_CTL = 0, CTL_ZERO_BYTES = 64 * KiB;
constexpr size_t WS_SS0 = 1 * MiB, WS_SS1 = 2 * MiB;
constexpr size_t WS_CBON = 3 * MiB;
constexpr size_t WS_LB = 3 * MiB + 512 * KiB;
constexpr size_t WS_W = 4 * MiB;
constexpr size_t W_F1GU = WS_W, W_F1D = W_F1GU + (size_t)5632 * 1024 * 2, W_IN = W_F1D + (size_t)1024 * 2816 * 2, W_LR = W_IN + (size_t)7680 * 1024 * 2,
                 W_BR = W_LR + (size_t)1536 * 256 * 2, W_O = W_BR + (size_t)3 * 1024 * 512 * 2, W_F2GU = W_O + (size_t)1024 * 1024 * 2, W_F2D = W_F2GU + (size_t)5632 * 1024 * 2,
                 W_PG = W_F2D + (size_t)1024 * 2816 * 2, W_PP = W_PG + (size_t)1024 * 1024 * 2, W_END = W_PP + (size_t)1024 * 256 * 2;
constexpr size_t WS_XB = 61 * MiB;
static_assert(W_END <= WS_XB, "weights fit");
constexpr size_t WS_R = 93 * MiB;
constexpr size_t R_H = WS_R;
constexpr size_t R_SIN_V = WS_R, R_SIN_R = WS_R + 16 * MiB, R_SIN_W = WS_R + 32 * MiB, R_SIN_KP = WS_R + 48 * MiB, R_SIN_KK = WS_R + 64 * MiB, R_SIN_B = WS_R + 80 * MiB;
constexpr size_t R_DAG_G = WS_R + 96 * MiB;
constexpr size_t R_ZR = WS_R + 112 * MiB;
constexpr size_t R_AP = WS_R + 168 * MiB;
constexpr size_t R_DAG_W = WS_R + 176 * MiB, R_DAG_A = WS_R + 192 * MiB;
constexpr size_t R_ZA = WS_R + 112 * MiB;
constexpr size_t R_ZH = WS_R + 136 * MiB;
constexpr size_t R_YRAW = WS_R + 200 * MiB;
constexpr size_t R_Y = WS_R + 16 * MiB;
constexpr size_t R_GG = WS_R + 112 * MiB;
constexpr size_t R_MERGED = WS_R + 64 * MiB;
constexpr size_t R_PB = WS_R + 96 * MiB;
constexpr size_t R_PROJ = WS_R + 112 * MiB;
constexpr size_t R_XBALT = WS_R + 144 * MiB;
constexpr size_t WS_SSB = WS_R + 216 * MiB;
constexpr size_t WS_END = WS_SSB + 9 * MiB;
#define SSB(k) (WS_SSB + (size_t)(k) * MiB)
constexpr int CW_BAR = 4096;
constexpr int RING_OFF = 0, RING_BYTES = 131072;
constexpr int LDSCTL_OFF = RING_BYTES, MISC_OFF = LDSCTL_OFF + 320;
constexpr int LDS_BYTES = 147456;
constexpr int N_PHASES = 17 * DEPTH + 1;
#ifndef ENMASK
#define ENMASK 0x3ffff
#endif
#define EN(k) ((ENMASK >> (k)) & 1)
struct Args { const float* in[N_IN]; float* out; unsigned char* ws; int ph_lo, ph_hi; };
typedef const __attribute__((address_space(4))) unsigned char* kargp_t;
#define KP_DECL kargp_t KP_ = (kargp_t)__builtin_amdgcn_kernarg_segment_ptr(); asm volatile("" : "+s"(KP_))
#define INP(i) (*(const float* const __attribute__((address_space(4)))*)(KP_ + 8 * (i)))
typedef unsigned u32x2 __attribute__((ext_vector_type(2)));
__device__ __forceinline__ float bflo(unsigned w) { return __uint_as_float(w << 16); }
__device__ __forceinline__ float bfhi(unsigned w) { return __uint_as_float(w & 0xffff0000u); }
__device__ __forceinline__ float bf1(bf16 b) { return __uint_as_float(((unsigned)b) << 16); }
__device__ __forceinline__ float sigm(float x) { return __builtin_amdgcn_rcpf(1.0f + __builtin_amdgcn_exp2f(-1.4426950408889634f * x)); }
template <int CTRL> __device__ __forceinline__ float dppf(float x) { return __builtin_bit_cast(float, __builtin_amdgcn_mov_dpp(__builtin_bit_cast(int, x), CTRL, 0xf, 0xf, true)); }
__device__ __forceinline__ float xrow16_sum(float x) {
    auto s = __builtin_amdgcn_permlane16_swap(__float_as_uint(x), __float_as_uint(x), false, false);
    x = __uint_as_float(s[0]) + __uint_as_float(s[1]);
    auto t = __builtin_amdgcn_permlane32_swap(__float_as_uint(x), __float_as_uint(x), false, false);
    return __uint_as_float(t[0]) + __uint_as_float(t[1]);
}
__device__ __forceinline__ float wave_allsum(float x) {
    x += dppf<0xB1>(x); x += dppf<0x4E>(x); x += dppf<0x141>(x); x += dppf<0x128>(x); return xrow16_sum(x);
}
__device__ __forceinline__ float wave_allsum_slow(float v) {
#pragma unroll
    for (int o = 1; o < 64; o <<= 1) v += __shfl_xor(v, o);
    return v;
}
__device__ __forceinline__ float wave_allmax_slow(float v) {
#pragma unroll
    for (int o = 1; o < 64; o <<= 1) v = fmaxf(v, __shfl_xor(v, o));
    return v;
}

struct Frame {
    LAS unsigned char* lds;
    volatile LAS unsigned* MISC;
    gu32* ctl;
    int tid, lane, wave;
    int G;
    unsigned char* ws;
    float* x;
};
#define WSP(T, off) ((T*)(F.ws + (off)))

__device__ __forceinline__ int map_row(int map, int n0) {
    if (map == 1) return (n0 >> 7) * 256 + (n0 & 127);
    if (map == 2) return (n0 >> 7) * 256 + 128 + (n0 & 127);
    if (map == 3) return n0 < 768 ? 1792 + n0 : (n0 < 2560 ? n0 - 768 : n0);
    return n0;
}
__device__ __forceinline__ void conv_item(const float* W, const float* g, int K, int N, bf16* WT, int map, LAS float* scr, int item, int lane) {
    const int nblk = N / 32, kb = item / nblk, nb = item % nblk, k0 = 64 * kb, n0 = 32 * nb;
#pragma unroll 8
    for (int i = 0; i < 32; ++i) { const int kk = 2 * i + (lane >> 5); const float sc = g ? g[k0 + kk] : 1.0f; scr[kk * 33 + (lane & 31)] = W[(size_t)(k0 + kk) * N + n0 + (lane & 31)] * sc; }
    LDS_WAIT(); asm volatile("" ::: "memory");
    const int c = lane & 7; const int dr = map_row(map, n0);
#pragma unroll
    for (int j = 0; j < 4; ++j) { const int n = (lane >> 3) + 8 * j; const LAS float* s = scr + (8 * c) * 33 + n;
        v4u o; o.x = pk2(s[0 * 33], s[1 * 33]); o.y = pk2(s[2 * 33], s[3 * 33]); o.z = pk2(s[4 * 33], s[5 * 33]); o.w = pk2(s[6 * 33], s[7 * 33]);
        *(GAS v4u*)(WT + (size_t)(dr + n) * K + k0 + 8 * c) = o; }
    LDS_WAIT(); asm volatile("" ::: "memory");
}
__device__ __forceinline__ void phase_conv(Frame& F, const Args& A, int L) {
    KP_DECL;
    LAS float* scr = (LAS float*)(F.lds + RING_OFF + F.wave * 16384);
    const int gw = blockIdx.x * NWAVES + F.wave, NGW = F.G * NWAVES;
    const float* f1g = INP(I_F1G) + (size_t)L * 1024 * 2816; const float* f1u = INP(I_F1U) + (size_t)L * 1024 * 2816; const float* f1d = INP(I_F1D) + (size_t)L * 2816 * 1024;
    const float* f2g = INP(I_F2G) + (size_t)L * 1024 * 2816; const float* f2u = INP(I_F2U) + (size_t)L * 1024 * 2816; const float* f2d = INP(I_F2D) + (size_t)L * 2816 * 1024;
    const float* win = INP(I_WIN) + (size_t)L * 1024 * 7680; const float* wbr = INP(I_WBR) + (size_t)L * 3 * 512 * 1024; const float* wo = INP(I_WO) + (size_t)L * 1024 * 1024;
    const float* pg = INP(I_PLEG) + (size_t)L * 1024 * 1024; const float* pp = INP(I_PLEP) + (size_t)L * 256 * 1024;
    const float* n1 = INP(I_F1N) + L * 1024; const float* nm = INP(I_MIXN) + L * 1024; const float* n2 = INP(I_F2N) + L * 1024; const float* np = INP(I_PLEN) + L * 1024;
    constexpr int IT_FGU = 16 * 88, IT_FD = 44 * 32, IT_IN = 16 * 240, IT_BR = 8 * 32, IT_SQ = 16 * 32, IT_PP = 4 * 32;
    constexpr int NITEMS = 4 * IT_FGU + 2 * IT_FD + IT_IN + 3 * IT_BR + 2 * IT_SQ + IT_PP;
    for (int it = gw; it < NITEMS; it += NGW) {
        int r = it;
        if (r < IT_FGU) { conv_item(f1g, n1, 1024, 2816, WSP(bf16, W_F1GU), 1, scr, r, F.lane); continue; } r -= IT_FGU;
        if (r < IT_FGU) { conv_item(f1u, n1, 1024, 2816, WSP(bf16, W_F1GU), 2, scr, r, F.lane); continue; } r -= IT_FGU;
        if (r < IT_FD)  { conv_item(f1d, nullptr, 2816, 1024, WSP(bf16, W_F1D), 0, scr, r, F.lane); continue; } r -= IT_FD;
        if (r < IT_IN)  { conv_item(win, nm, 1024, 7680, WSP(bf16, W_IN), 3, scr, r, F.lane); continue; } r -= IT_IN;
        if (r < 3 * IT_BR) { const int b = r / IT_BR; conv_item(wbr + (size_t)b * 512 * 1024, nullptr, 512, 1024, WSP(bf16, W_BR) + (size_t)b * 1024 * 512, 0, scr, r % IT_BR, F.lane); continue; } r -= 3 * IT_BR;
        if (r < IT_SQ)  { conv_item(wo, nullptr, 1024, 1024, WSP(bf16, W_O), 0, scr, r, F.lane); continue; } r -= IT_SQ;
        if (r < IT_FGU) { conv_item(f2g, n2, 1024, 2816, WSP(bf16, W_F2GU), 1, scr, r, F.lane); continue; } r -= IT_FGU;
        if (r < IT_FGU) { conv_item(f2u, n2, 1024, 2816, WSP(bf16, W_F2GU), 2, scr, r, F.lane); continue; } r -= IT_FGU;
        if (r < IT_FD)  { conv_item(f2d, nullptr, 2816, 1024, WSP(bf16, W_F2D), 0, scr, r, F.lane); continue; } r -= IT_FD;
        if (r < IT_SQ)  { conv_item(pg, np, 1024, 1024, WSP(bf16, W_PG), 0, scr, r, F.lane); continue; } r -= IT_SQ;
        conv_item(pp, nullptr, 256, 1024, WSP(bf16, W_PP), 0, scr, r, F.lane);
    }
    const float* wup = INP(I_WUP) + (size_t)L * 64 * 512; const float* aup = INP(I_AUP) + (size_t)L * 64 * 512; const float* gup = INP(I_GUP) + (size_t)L * 128 * 512;
    bf16* wlr = WSP(bf16, W_LR);
    const int gt = blockIdx.x * (NWAVES * 64) + F.tid, NGT = F.G * NWAVES * 64;
    for (int e = gt; e < 1536 * 256; e += NGT) { const int n = e >> 8, k = e & 255; const int grp = n >> 9, c = n & 511; float v = 0.f;
        if (grp == 0) { if (k < 64) v = wup[k * 512 + c]; } else if (grp == 1) { if (k >= 64 && k < 128) v = aup[(k - 64) * 512 + c]; } else { if (k >= 128) v = gup[(k - 128) * 512 + c]; }
        wlr[e] = (bf16)f2bf(v); }
    if (gt < 512) { const float a0 = INP(I_HLB)[gt], a1 = INP(I_HLB)[512 + gt]; const float mx = fmaxf(a0, a1); const float e0 = __expf(a0 - mx), e1 = __expf(a1 - mx);
        float lb = (L == 0) ? 0.f : e1 / (e0 + e1); lb = fminf(fmaxf(lb, 0.f), 1.0f - 1e-6f); WSP(float, WS_LB)[gt] = lb; }
    if (L == 0) {
        const float* xin = INP(I_X); bf16* xb = WSP(bf16, WS_XB); float* ss = WSP(float, SSB(0));
        for (int m = gw; m < M; m += NGW) { const GAS f32x4* xr = (const GAS f32x4*)(xin + (size_t)m * DM) + F.lane; GAS f32x4* xo = (GAS f32x4*)(F.x + (size_t)m * DM) + F.lane;
            GAS unsigned long long* o8 = (GAS unsigned long long*)(xb + (size_t)m * DM) + F.lane; float s = 0.f;
#pragma unroll
            for (int j = 0; j < 4; ++j) { const f32x4 v = xr[64 * j]; xo[64 * j] = v; s += (v.x * v.x + v.y * v.y) + (v.z * v.z + v.w * v.w);
                o8[64 * j] = (unsigned long long)pk2(v.x, v.y) | ((unsigned long long)pk2(v.z, v.w) << 32); }
            s = wave_allsum_slow(s);
            if (F.lane < 16) ss[(size_t)m * 16 + F.lane] = (F.lane == 0) ? s : 0.f; }
    }
}
__device__ __forceinline__ void conv_p(Frame& F, const Args& A, int L) {
    KP_DECL;
    const float* p = INP(I_P) + (size_t)L * M * 256; bf16* pb = WSP(bf16, R_PB);
    const int gt = blockIdx.x * (NWAVES * 64) + F.tid, NGT = F.G * NWAVES * 64;
    for (int e = gt; e < M * 256 / 8; e += NGT) { const f32x4 a = *(const f32x4*)(p + (size_t)e * 8), b = *(const f32x4*)(p + (size_t)e * 8 + 4);
        v4u o; o.x = pk2(a.x, a.y); o.y = pk2(a.z, a.w); o.z = pk2(b.x, b.y); o.w = pk2(b.z, b.w); *(v4u*)(pb + (size_t)e * 8) = o; }
}

__device__ __forceinline__ void phase_rprep1(Frame& F, const Args& A, int L) {
    KP_DECL;
    const bf16* zr = WSP(bf16, R_ZR); bf16* ap = WSP(bf16, R_AP); const float* mu = INP(I_MU) + L * 1792 + 1536;
    const int gt = blockIdx.x * (NWAVES * 64) + F.tid, NGT = F.G * NWAVES * 64;
    for (int e = gt; e < M * 32; e += NGT) { const int row = e >> 5, c0 = (e & 31) * 8; const int tl = row & (SEQ - 1);
        const v4u zc = *(const v4u*)(zr + (size_t)row * 1792 + 1536 + c0); v4u zp = (v4u){0u, 0u, 0u, 0u};
        if (tl != 0) zp = *(const v4u*)(zr + (size_t)(row - 1) * 1792 + 1536 + c0);
        float o[8];
#pragma unroll
        for (int i = 0; i < 4; ++i) { const unsigned wc_ = zc[i], wp_ = zp[i];
            const float c_lo = bflo(wc_), c_hi = bfhi(wc_), p_lo = bflo(wp_), p_hi = bfhi(wp_);
            const float m0 = mu[c0 + 2 * i], m1 = mu[c0 + 2 * i + 1];
            o[2 * i] = c_lo + m0 * (p_lo - c_lo); o[2 * i + 1] = c_hi + m1 * (p_hi - c_hi); }
#pragma unroll
        for (int i = 0; i < 8; ++i) { if (c0 < 64) o[i] = 2.0f * sigm(2.0f * o[i]) - 1.0f; else if (c0 >= 128) o[i] = sigm(o[i]); }
        v4u w; w.x = pk2(o[0], o[1]); w.y = pk2(o[2], o[3]); w.z = pk2(o[4], o[5]); w.w = pk2(o[6], o[7]);
        *(v4u*)(ap + (size_t)row * 256 + c0) = w; }
}
__device__ __forceinline__ void phase_rprep2(Frame& F, const Args& A, int L) {
    KP_DECL;
    const bf16* zr = WSP(bf16, R_ZR); const bf16* dw = WSP(bf16, R_DAG_W); const bf16* da = WSP(bf16, R_DAG_A);
    bf16* sv = WSP(bf16, R_SIN_V); bf16* sr = WSP(bf16, R_SIN_R); bf16* sw = WSP(bf16, R_SIN_W); bf16* skp = WSP(bf16, R_SIN_KP); bf16* skk = WSP(bf16, R_SIN_KK); bf16* sb = WSP(bf16, R_SIN_B);
    float* cbon = WSP(float, WS_CBON);
    const float* mu = INP(I_MU) + L * 1792; const float* k_k = INP(I_KK) + L * 512; const float* k_a = INP(I_KA) + L * 512; const float* r_k = INP(I_RK) + L * 512;
    const int gw = blockIdx.x * NWAVES + F.wave, NGW = F.G * NWAVES;
    for (int it = gw; it < M * 8; it += NGW) { const int row = it >> 3, h = it & 7, ch = h * 64 + F.lane; const int tl = row & (SEQ - 1);
        const bf16* zc = zr + (size_t)row * 1792 + ch; const bf16* zp = zc - 1792;
        const float cr = bf1(zc[0]), ck = bf1(zc[512]), cv = bf1(zc[1024]);
        float pr = 0.f, pk = 0.f, pv = 0.f; if (tl != 0) { pr = bf1(zp[0]); pk = bf1(zp[512]); pv = bf1(zp[1024]); }
        const float r = cr + mu[ch] * (pr - cr), k = ck + mu[512 + ch] * (pk - ck), v = cv + mu[1024 + ch] * (pv - cv);
        const float w = bf1(dw[(size_t)row * 512 + ch]), a = bf1(da[(size_t)row * 512 + ch]);
        float kk = k * k_k[ch]; const float n2 = wave_allsum_slow(kk * kk); kk *= __builtin_amdgcn_rsqf(fmaxf(n2, 1e-24f));
        const float kp = k * (1.0f + (a - 1.0f) * k_a[ch]); const float b = kk * a;
        const float cb = wave_allsum_slow(r * kp * r_k[ch]);
        if (F.lane == 0) cbon[(size_t)row * 8 + h] = cb;
        const size_t o = (size_t)row * 512 + ch;
        sv[o] = (bf16)f2bf(v); sr[o] = (bf16)f2bf(r); sw[o] = (bf16)f2bf(w); skp[o] = (bf16)f2bf(kp); skk[o] = (bf16)f2bf(kk); sb[o] = (bf16)f2bf(b); }
}
__device__ __forceinline__ void scan_rwkv(Frame& F, int rid) {
    const int bh = rid >> 6, vrow = rid & 63, b = bh >> 3, h = bh & 7; const size_t base = (size_t)b * SEQ * 512 + h * 64;
    const bf16* sv = WSP(bf16, R_SIN_V) + base + vrow; const bf16* sr = WSP(bf16, R_SIN_R) + base + F.lane; const bf16* sw = WSP(bf16, R_SIN_W) + base + F.lane;
    const bf16* skp = WSP(bf16, R_SIN_KP) + base + F.lane; const bf16* skk = WSP(bf16, R_SIN_KK) + base + F.lane; const bf16* sb = WSP(bf16, R_SIN_B) + base + F.lane;
    bf16* yo = WSP(bf16, R_YRAW) + base + vrow;
    constexpr int U = 8;
    bf16 nv[U], nr[U], nw[U], nkp[U], nkk[U], nb[U];
#pragma unroll
    for (int j = 0; j < U; ++j) { const size_t o = (size_t)j * 512; nv[j] = sv[o]; nr[j] = sr[o]; nw[j] = sw[o]; nkp[j] = skp[o]; nkk[j] = skk[o]; nb[j] = sb[o]; }
    float S = 0.f, yout = 0.f;
    for (int t0 = 0; t0 < SEQ; t0 += U) {
        bf16 cv[U], cr[U], cw[U], ckp[U], ckk[U], cb[U];
#pragma unroll
        for (int j = 0; j < U; ++j) { cv[j] = nv[j]; cr[j] = nr[j]; cw[j] = nw[j]; ckp[j] = nkp[j]; ckk[j] = nkk[j]; cb[j] = nb[j]; }
        const int tn = (t0 + U < SEQ) ? t0 + U : t0;
#pragma unroll
        for (int j = 0; j < U; ++j) { const size_t o = (size_t)(tn + j) * 512; nv[j] = sv[o]; nr[j] = sr[o]; nw[j] = sw[o]; nkp[j] = skp[o]; nkk[j] = skk[o]; nb[j] = sb[o]; }
#pragma unroll
        for (int j = 0; j < U; ++j) {
            const float kk = bf1(ckk[j]), w = bf1(cw[j]), bb = bf1(cb[j]), kp = bf1(ckp[j]), r = bf1(cr[j]), vv = bf1(cv[j]);
            const float sa = wave_allsum(S * kk);
            const float sw_ = __builtin_fmaf(S, w, vv * kp);
            S = __builtin_fmaf(-sa, bb, sw_);
            const float y = wave_allsum(S * r);
            yout = (F.lane == ((t0 + j) & 63)) ? y : yout;
        }
        if (((t0 + U) & 63) == 0) yo[(size_t)(t0 + U - 64 + F.lane) * 512] = (bf16)f2bf(yout);
    }
}
__device__ __forceinline__ void scan_hgrn(Frame& F, int cid) {
    const int bh = cid >> 7, vcol = cid & 127, b = bh >> 2, h = bh & 3; const size_t base = (size_t)b * SEQ * 2048 + h * 128;
    const unsigned* zq = (const unsigned*)(WSP(bf16, R_ZH) + base) + F.lane; const unsigned* zk = (const unsigned*)(WSP(bf16, R_ZH) + base + 512) + F.lane;
    bf16* zv = WSP(bf16, R_ZH) + base + 1024 + vcol;
    constexpr int U = 8;
    unsigned nq[U], nk[U]; bf16 nv[U];
#pragma unroll
    for (int j = 0; j < U; ++j) { const size_t o = (size_t)j * 1024; nq[j] = zq[o]; nk[j] = zk[o]; nv[j] = zv[(size_t)j * 2048]; }
    float S0 = 0.f, S1 = 0.f, oout = 0.f;
    for (int t0 = 0; t0 < SEQ; t0 += U) {
        unsigned cq[U], ck[U]; bf16 cv[U];
#pragma unroll
        for (int j = 0; j < U; ++j) { cq[j] = nq[j]; ck[j] = nk[j]; cv[j] = nv[j]; }
        const int tn = (t0 + U < SEQ) ? t0 + U : t0;
#pragma unroll
        for (int j = 0; j < U; ++j) { const size_t o = (size_t)(tn + j) * 1024; nq[j] = zq[o]; nk[j] = zk[o]; nv[j] = zv[(size_t)(tn + j) * 2048]; }
#pragma unroll
        for (int j = 0; j < U; ++j) {
            const float q0 = bflo(cq[j]), q1 = bfhi(cq[j]), k0 = bflo(ck[j]), k1 = bfhi(ck[j]), vv = bf1(cv[j]);
            S0 = __builtin_fmaf(1.0f - k0, S0, k0 * vv); S1 = __builtin_fmaf(1.0f - k1, S1, k1 * vv);
            const float o = wave_allsum(__builtin_fmaf(q1, S1, q0 * S0));
            oout = (F.lane == ((t0 + j) & 63)) ? o : oout;
        }
        if (((t0 + U) & 63) == 0) zv[(size_t)(t0 + U - 64 + F.lane) * 2048] = (bf16)f2bf(oout);
    }
}
__device__ __forceinline__ void phase_scan(Frame& F) {
    if (F.wave < 4) { for (int rid = blockIdx.x * 4 + F.wave; rid < 1024; rid += F.G * 4) scan_rwkv(F, rid); }
    else { for (int cid = blockIdx.x * 4 + (F.wave - 4); cid < 1024; cid += F.G * 4) scan_hgrn(F, cid); }
}
__device__ __forceinline__ float dot8(const v4u& a, const v4u& b, float acc) {
#pragma unroll
    for (int i = 0; i < 4; ++i) { acc = __builtin_fmaf(bflo(a[i]), bflo(b[i]), acc); acc = __builtin_fmaf(bfhi(a[i]), bfhi(b[i]), acc); }
    return acc;
}
__device__ __forceinline__ void phase_attn(Frame& F, const Args& A, int L) {
    KP_DECL;
    const bf16* za = WSP(bf16, R_ZA); bf16* y0 = WSP(bf16, R_Y);
    const float* sinks = INP(I_SINK) + L * 8;
    const int gw = blockIdx.x * NWAVES + F.wave, NGW = F.G * NWAVES;
    for (int it = gw; it < M * 2; it += NGW) { const int row = it >> 1, kvh = it & 1; const int tl = row & (SEQ - 1); const int s0 = tl - 127; const size_t rb = (size_t)(row - tl);
        float sc[4][2];
        { const int sA = s0 + F.lane, sB = sA + 64; const bool vA = sA >= 0, vB = sB >= 0;
          const bf16* krA = za + (rb + (size_t)(vA ? sA : 0)) * 768 + 512 + kvh * 64; const bf16* krB = za + (rb + (size_t)(vB ? sB : 0)) * 768 + 512 + kvh * 64;
          const bf16* qr = za + (size_t)row * 768 + kvh * 256;
          float d[4][2];
#pragma unroll
          for (int g = 0; g < 4; ++g) { d[g][0] = 0.f; d[g][1] = 0.f; }
#pragma unroll
          for (int c = 0; c < 8; ++c) { const v4u kA = *(const v4u*)(krA + 8 * c), kB = *(const v4u*)(krB + 8 * c);
#pragma unroll
              for (int g = 0; g < 4; ++g) { const v4u qf = *(const v4u*)(qr + g * 64 + 8 * c); d[g][0] = dot8(qf, kA, d[g][0]); d[g][1] = dot8(qf, kB, d[g][1]); }
              if (c & 1) asm volatile("" ::: "memory"); }
#pragma unroll
          for (int g = 0; g < 4; ++g) { sc[g][0] = vA ? d[g][0] * 0.125f : -1e30f; sc[g][1] = vB ? d[g][1] * 0.125f : -1e30f; } }
        float p[4][2], den[4];
#pragma unroll
        for (int g = 0; g < 4; ++g) { const float sink = sinks[kvh * 4 + g]; float m = wave_allmax_slow(fmaxf(sc[g][0], sc[g][1])); m = fmaxf(m, sink);
            p[g][0] = (sc[g][0] > -1e29f) ? __expf(sc[g][0] - m) : 0.f; p[g][1] = (sc[g][1] > -1e29f) ? __expf(sc[g][1] - m) : 0.f;
            den[g] = wave_allsum_slow(p[g][0] + p[g][1]) + __expf(sink - m); }
        float o[4] = {0.f, 0.f, 0.f, 0.f};
        const bf16* vb = za + rb * 768 + 640 + kvh * 64 + F.lane;
#pragma unroll
        for (int j = 0; j < 2; ++j) {
#pragma unroll 8
            for (int l2 = 0; l2 < 64; ++l2) { const int s = s0 + l2 + 64 * j;
                if (s >= 0) { const float vv = bf1(vb[(size_t)s * 768]);
#pragma unroll
                    for (int g = 0; g < 4; ++g) o[g] = __builtin_fmaf(__shfl(p[g][j], l2), vv, o[g]); } } }
#pragma unroll
        for (int g = 0; g < 4; ++g) y0[(size_t)row * 512 + (kvh * 4 + g) * 64 + F.lane] = (bf16)f2bf(o[g] / den[g]);
    }
}
__device__ __forceinline__ void phase_rpost(Frame& F, const Args& A, int L) {
    KP_DECL;
    const bf16* yr = WSP(bf16, R_YRAW); const bf16* sv = WSP(bf16, R_SIN_V); const bf16* dg = WSP(bf16, R_DAG_G); const float* cbon = WSP(float, WS_CBON);
    bf16* y1 = WSP(bf16, R_Y) + (size_t)M * 512;
    const float* lnw = INP(I_LNW) + L * 512; const float* lnb = INP(I_LNB) + L * 512;
    const int gw = blockIdx.x * NWAVES + F.wave, NGW = F.G * NWAVES;
    for (int it = gw; it < M * 8; it += NGW) { const int row = it >> 3, h = it & 7, ch = h * 64 + F.lane; const size_t o = (size_t)row * 512 + ch;
        const float y = bf1(yr[o]); const float mean = wave_allsum_slow(y) * (1.0f / 64.0f); const float d = y - mean; const float var = wave_allsum_slow(d * d) * (1.0f / 64.0f);
        float yn = d * __builtin_amdgcn_rsqf(var + 64e-5f) * lnw[ch] + lnb[ch];
        yn += cbon[(size_t)row * 8 + h] * bf1(sv[o]);
        yn *= bf1(dg[o]);
        y1[o] = (bf16)f2bf(yn); }
}
__device__ __forceinline__ void phase_hpost(Frame& F, const Args& A, int L) {
    KP_DECL;
    const bf16* zh = WSP(bf16, R_ZH); bf16* y2 = WSP(bf16, R_Y) + (size_t)2 * M * 512; const float* ng = INP(I_HNORM) + L * 128;
    const int gw = blockIdx.x * NWAVES + F.wave, NGW = F.G * NWAVES;
    for (int it = gw; it < M * 4; it += NGW) { const int row = it >> 2, h = it & 3;
        const unsigned ow = *((const unsigned*)(zh + (size_t)row * 2048 + 1024 + h * 128) + F.lane); const unsigned gw_ = *((const unsigned*)(zh + (size_t)row * 2048 + 1536 + h * 128) + F.lane);
        const float o0 = bflo(ow), o1 = bfhi(ow); const float ms = wave_allsum_slow(o0 * o0 + o1 * o1) * (1.0f / 128.0f); const float rs = __builtin_amdgcn_rsqf(ms + 1e-6f);
        const float a = o0 * rs * ng[2 * F.lane] * bflo(gw_), b = o1 * rs * ng[2 * F.lane + 1] * bfhi(gw_);
        *((unsigned*)(y2 + (size_t)row * 512 + h * 128) + F.lane) = pk2(a, b); }
}
__device__ __forceinline__ void phase_final(Frame& F, const Args& A) {
    KP_DECL;
    const float* g = INP(I_FINN);
    const int gw = blockIdx.x * NWAVES + F.wave, NGW = F.G * NWAVES;
    for (int m = gw; m < M; m += NGW) { GAS f32x4* xr = (GAS f32x4*)(F.x + (size_t)m * DM) + F.lane; f32x4 v[4]; float s = 0.f;
#pragma unroll
        for (int j = 0; j < 4; ++j) { v[j] = xr[64 * j]; s += (v[j].x * v[j].x + v[j].y * v[j].y) + (v[j].z * v[j].z + v[j].w * v[j].w); }
        const float rs = __builtin_amdgcn_rsqf(wave_allsum_slow(s) * (1.0f / 1024.0f) + 1e-6f);
#pragma unroll
        for (int j = 0; j < 4; ++j) { const f32x4 gg = *((const f32x4*)g + F.lane + 64 * j); xr[64 * j] = v[j] * rs * gg; } }
}

template <int L> __device__ __forceinline__ void run_layer(Frame& F, const Args& args, const XcdBarrier& bar, int lo, int hi) {
    typedef pg8::bf16_t pb16;
    constexpr int base = 17 * L;
#define IN(k) (lo <= base + (k) && base + (k) < hi && EN(k))
#define SEAM(k) do { if (base + (k) + 1 < hi) xcd_barrier(bar); } while (0)
#define GEMM_RUN(EPI, g, S, E) pg8::gemm_phase<EPI, pg8::StaticOrder, true, true>(F.lds + RING_OFF, g, S, E)
    constexpr size_t SS_IN = SSB(4 * L), SS_A = SSB(4 * L + 1), SS_B = SSB(4 * L + 2), SS_C = SSB(4 * L + 3), SS_OUT = SSB(4 * L + 4);
    if (IN(0)) { phase_conv(F, args, L); SEAM(0); }
    if (IN(1)) { pg8::Gemm g{L == 0 ? WSP(pb16, WS_XB) : WSP(pb16, R_XBALT), WSP(pb16, W_F1GU), M, 5632, 1024}; pg8::StaticOrder S; S.init(M, 5632, F.G, (int)blockIdx.x);
        pg8::EpiSwiglu E{WSP(pb16, R_H), WSP(float, SS_IN)}; GEMM_RUN(pg8::EpiSwiglu, g, S, E); SEAM(1); }
    if (IN(2)) { pg8::Gemm g{WSP(pb16, R_H), WSP(pb16, W_F1D), M, 1024, FF}; pg8::StaticOrder S; S.init(M, 1024, F.G, (int)blockIdx.x);
        pg8::EpiResid<0> E{F.x, WSP(pb16, WS_XB), WSP(float, SS_A), nullptr, nullptr, 0.5f}; GEMM_RUN(pg8::EpiResid<0>, g, S, E); SEAM(2); }
    if (IN(3)) { pg8::Gemm g{WSP(pb16, WS_XB), WSP(pb16, W_IN), M, 1792, 1024}; pg8::StaticOrder S; S.init(M, 1792, F.G, (int)blockIdx.x);
        pg8::EpiStore<0> E{WSP(pb16, R_ZR), WSP(float, SS_A), nullptr, nullptr, nullptr, nullptr}; GEMM_RUN(pg8::EpiStore<0>, g, S, E); SEAM(3); }
    if (IN(4)) { phase_rprep1(F, args, L); SEAM(4); }
    if (IN(5)) { KP_DECL; pg8::Gemm g{WSP(pb16, R_AP), WSP(pb16, W_LR), M, 1536, 256}; pg8::StaticOrder S; S.init(M, 1536, F.G, (int)blockIdx.x);
        pg8::EpiStore<3> E{WSP(pb16, R_DAG_W), nullptr, WSP(pb16, R_DAG_A), WSP(pb16, R_DAG_G), INP(I_W0) + L * 512, INP(I_A0) + L * 512};
        GEMM_RUN(pg8::EpiStore<3>, g, S, E); SEAM(5); }
    if (IN(6)) { phase_rprep2(F, args, L); SEAM(6); }
    if (IN(7)) { pg8::Gemm g{WSP(pb16, WS_XB), WSP(pb16, W_IN) + (size_t)1792 * 1024, M, 2816, 1024}; pg8::StaticOrder S; S.init(M, 2816, F.G, (int)blockIdx.x);
        pg8::EpiStore<1> E{WSP(pb16, R_ZA), WSP(float, SS_A), WSP(pb16, R_ZH), nullptr, WSP(float, WS_LB), nullptr}; GEMM_RUN(pg8::EpiStore<1>, g, S, E); SEAM(7); }
    if (IN(8)) { phase_scan(F); SEAM(8); }
    if (IN(9)) { phase_attn(F, args, L); phase_rpost(F, args, L); phase_hpost(F, args, L); SEAM(9); }
    if (IN(10)) { pg8::Gemm g{WSP(pb16, WS_XB), WSP(pb16, W_IN) + (size_t)4608 * 1024, M, 3072, 1024}; pg8::StaticOrder S; S.init(M, 3072, F.G, (int)blockIdx.x);
        pg8::EpiStore<2> E{WSP(pb16, R_GG), WSP(float, SS_A), nullptr, nullptr, nullptr, nullptr}; GEMM_RUN(pg8::EpiStore<2>, g, S, E); SEAM(10); }
    if (IN(11)) {
        pg8::StaticOrder S; S.init(M, 1024, F.G, (int)blockIdx.x);
        { pg8::Gemm g{WSP(pb16, R_Y), WSP(pb16, W_BR), M, 1024, 512}; pg8::EpiBranch<true> E{WSP(pb16, R_MERGED), WSP(pb16, R_GG), WSP(float, SS_A)}; GEMM_RUN(pg8::EpiBranch<true>, g, S, E); }
        { pg8::Gemm g{WSP(pb16, R_Y) + (size_t)M * 512, WSP(pb16, W_BR) + (size_t)1024 * 512, M, 1024, 512}; pg8::EpiBranch<false> E{WSP(pb16, R_MERGED), WSP(pb16, R_GG) + 1024, WSP(float, SS_A)}; GEMM_RUN(pg8::EpiBranch<false>, g, S, E); }
        { pg8::Gemm g{WSP(pb16, R_Y) + (size_t)2 * M * 512, WSP(pb16, W_BR) + (size_t)2 * 1024 * 512, M, 1024, 512}; pg8::EpiBranch<false> E{WSP(pb16, R_MERGED), WSP(pb16, R_GG) + 2048, WSP(float, SS_A)}; GEMM_RUN(pg8::EpiBranch<false>, g, S, E); }
        SEAM(11); }
    if (IN(12)) { pg8::Gemm g{WSP(pb16, R_MERGED), WSP(pb16, W_O), M, 1024, 1024}; pg8::StaticOrder S; S.init(M, 1024, F.G, (int)blockIdx.x);
        pg8::EpiResid<0> E{F.x, WSP(pb16, WS_XB), WSP(float, SS_B), nullptr, nullptr, 1.0f}; GEMM_RUN(pg8::EpiResid<0>, g, S, E); SEAM(12); }
    if (IN(13)) { conv_p(F, args, L);
        pg8::Gemm g{WSP(pb16, WS_XB), WSP(pb16, W_F2GU), M, 5632, 1024}; pg8::StaticOrder S; S.init(M, 5632, F.G, (int)blockIdx.x);
        pg8::EpiSwiglu E{WSP(pb16, R_H), WSP(float, SS_B)}; GEMM_RUN(pg8::EpiSwiglu, g, S, E); SEAM(13); }
    if (IN(14)) { pg8::Gemm g{WSP(pb16, R_H), WSP(pb16, W_F2D), M, 1024, FF}; pg8::StaticOrder S; S.init(M, 1024, F.G, (int)blockIdx.x);
        pg8::EpiResid<0> E{F.x, WSP(pb16, WS_XB), WSP(float, SS_C), nullptr, nullptr, 0.5f}; GEMM_RUN(pg8::EpiResid<0>, g, S, E); SEAM(14); }
    if (IN(15)) { pg8::Gemm g{WSP(pb16, R_PB), WSP(pb16, W_PP), M, 1024, 256}; pg8::StaticOrder S; S.init(M, 1024, F.G, (int)blockIdx.x);
        pg8::EpiStore<4> E{WSP(pb16, R_PROJ), nullptr, nullptr, nullptr, nullptr, nullptr}; GEMM_RUN(pg8::EpiStore<4>, g, S, E); SEAM(15); }
    if (IN(16)) { pg8::Gemm g{WSP(pb16, WS_XB), WSP(pb16, W_PG), M, 1024, 1024}; pg8::StaticOrder S; S.init(M, 1024, F.G, (int)blockIdx.x);
        pg8::EpiResid<1> E{F.x, WSP(pb16, R_XBALT), WSP(float, SS_OUT), WSP(float, SS_C), WSP(pb16, R_PROJ), 1.0f}; GEMM_RUN(pg8::EpiResid<1>, g, S, E); SEAM(16); }
#undef IN
#undef SEAM
#undef GEMM_RUN
}
__global__ void __launch_bounds__(NWAVES * 64, 2) mk_fwd(Args args) {
    extern __shared__ __attribute__((aligned(16))) unsigned char lds[];
    Frame F;
    F.lds = (LAS unsigned char*)lds;
    F.MISC = (volatile LAS unsigned*)(F.lds + MISC_OFF);
    F.tid = threadIdx.x; F.lane = F.tid & 63; F.wave = __builtin_amdgcn_readfirstlane(F.tid >> 6);
    F.G = gridDim.x;
    F.ws = args.ws; F.x = args.out;
    F.ctl = (gu32*)(args.ws + WS_CTL);
    for (int u = F.tid; u < (LDS_BYTES - LDSCTL_OFF) / 4; u += NWAVES * 64) ((LAS unsigned*)(F.lds + LDSCTL_OFF))[u] = 0u;
    __syncthreads();
    const int lo = args.ph_lo, hi = args.ph_hi;
    const bool multi = (hi - lo) > 1;
    XcdBarrier bar; bar.bar = (unsigned*)(F.ctl + CW_BAR); bar.x = 0; bar.st = nullptr;
    if (multi) bar = xcd_barrier_post((unsigned*)(F.ctl + CW_BAR), F.MISC + 8);
    run_layer<0>(F, args, bar, lo, hi);
    run_layer<1>(F, args, bar, lo, hi);
    if (lo <= N_PHASES - 1 && N_PHASES - 1 < hi && EN(17)) phase_final(F, args);
}

#ifndef MK_PER_PHASE
#define MK_PER_PHASE 0
#endif
extern "C" void kernel_launch(void* const* d_in, const int* in_sizes, int n_in, void* d_out, int out_size, void* d_ws, size_t ws_size, hipStream_t stream) {
    static int grid = 0;
    if (grid == 0) {
        if (n_in != N_IN || in_sizes[0] != M * DM || out_size != M * DM || ws_size < WS_END) { fprintf(stderr, "kernel_launch: unexpected shapes / workspace (n_in %d, ws %zu < %zu)\n", n_in, ws_size, (size_t)WS_END); grid = -1; return; }
        int dev = 0, cus = 0;
        if (hipGetDevice(&dev) != hipSuccess || hipDeviceGetAttribute(&cus, hipDeviceAttributeMultiprocessorCount, dev) != hipSuccess) { grid = -1; return; }
        if (hipFuncSetAttribute((const void*)mk_fwd, hipFuncAttributeMaxDynamicSharedMemorySize, LDS_BYTES) != hipSuccess) { fprintf(stderr, "kernel_launch: hipFuncSetAttribute failed\n"); grid = -1; return; }
        int per_cu = 0;
        if (hipOccupancyMaxActiveBlocksPerMultiprocessor(&per_cu, (const void*)mk_fwd, NWAVES * 64, LDS_BYTES) != hipSuccess || per_cu < 1) fprintf(stderr, "kernel_launch: occupancy query says %d\n", per_cu);
        (void)hipGetLastError();
        grid = cus;
    }
    if (grid < 0) return;
    (void)hipMemsetAsync((char*)d_ws + WS_CTL, 0, CTL_ZERO_BYTES, stream);
    Args a{};
    for (int i = 0; i < N_IN; ++i) a.in[i] = (const float*)d_in[i];
    a.out = (float*)d_out; a.ws = (unsigned char*)d_ws;
#if MK_PER_PHASE
    for (int ph = 0; ph < N_PHASES; ++ph) { a.ph_lo = ph; a.ph_hi = ph + 1; hipLaunchKernelGGL(mk_fwd, dim3(grid), dim3(NWAVES * 64), LDS_BYTES, stream, a); }
#else
    a.ph_lo = 0; a.ph_hi = N_PHASES; hipLaunchKernelGGL(mk_fwd, dim3(grid), dim3(NWAVES * 64), LDS_BYTES, stream, a);
#endif
}
```

```cpp
#include <hip/hip_runtime.h>
#include <cstdio>
#include <cstdint>
namespace pg8 {
#define PG8_LAS __attribute__((address_space(3)))
typedef unsigned short bf16_t;
typedef short bf16x8 __attribute__((ext_vector_type(8)));
typedef float f32x4 __attribute__((ext_vector_type(4)));
typedef unsigned u32x4 __attribute__((ext_vector_type(4)));
constexpr int BM = 256, BK = 64, HALF = 128, HTB = HALF * BK * 2  , STAGE_BYTES = 8 * HTB, NXCD = 8, WGM = 8;
constexpr int RS_LDS_OFF = 8 * 16640;

__host__ __device__ __forceinline__ int lds_byte(int r, int c) { const int st = (r >> 4) * 2 + (c >> 5), rr = r & 15, cc = c & 31, ob = rr * 64 + cc * 2; return st * 1024 + (ob ^ (((ob >> 9) & 1) << 5)); }
__host__ __device__ __forceinline__ void stage_rc(int b, int& R, int& C) { const int st = b / 1024, sb = b % 1024, swz = sb ^ (((sb >> 9) & 1) << 5); R = (st >> 1) * 16 + swz / 64; C = (st & 1) * 32 + (swz % 64) / 2; }
__host__ __device__ __forceinline__ int perm32(int rho) { const int n = rho >> 4, i = rho & 15; return 8 * (i >> 2) + 4 * n + (i & 3); }

struct Unit { int pm, pn; int b = 0; };
struct Gemm { const bf16_t* A; const bf16_t* Bt; int M, N, K; size_t usA = 0, usB = 0; };

struct StaticOrder {
    int nM, nN, nwg, G, c;
    __host__ __device__ void init(int M, int N, int G_, int c_) { nM = M / BM; nN = N / BM; nwg = nM * nN; G = G_; c = c_; }
    __host__ __device__ bool next(int i, Unit& u) const {
        const long L = (long)i * G + c; if (L >= nwg) return false;
        int wgid = (int)L; { const int q = nwg / NXCD, r = nwg % NXCD, xcd = wgid % NXCD, off = wgid / NXCD; wgid = (xcd < r ? xcd * (q + 1) : r * (q + 1) + (xcd - r) * q) + off; }
        const int nig = WGM * nN, gid = wgid / nig, fm = gid * WGM, gsz = (nM - fm) < WGM ? (nM - fm) : WGM;
        u.pm = fm + ((wgid % nig) % gsz); u.pn = (wgid % nig) / gsz; return true;
    }
    __device__ __forceinline__ void a_ready(const Unit&) const {}
    __device__ __forceinline__ void done(const Unit&) const {}
};

struct SplitOrder : StaticOrder {
    int ns;
    __host__ __device__ bool next(int i, Unit& u) const {
        long L;
        if (c < ns) { if (i > 0) return false; L = (long)(nwg - ns) + c; }
        else { L = (long)i * (G - ns) + (c - ns); if (L >= nwg - ns) return false; }
        int wgid = (int)L; { const int q = nwg / NXCD, r = nwg % NXCD, xcd = wgid % NXCD, off = wgid / NXCD; wgid = (xcd < r ? xcd * (q + 1) : r * (q + 1) + (xcd - r) * q) + off; }
        const int nig = WGM * nN, gid = wgid / nig, fm = gid * WGM, gsz = (nM - fm) < WGM ? (nM - fm) : WGM;
        u.pm = fm + ((wgid % nig) % gsz); u.pn = (wgid % nig) / gsz; return true;
    }
};

struct TailOrder : StaticOrder {
    int lo;
    __host__ __device__ bool next(int i, Unit& u) const {
        if (c < lo) return false; const long L = (long)i * (G - lo) + (c - lo); if (L >= nwg) return false;
        int wgid = (int)L; { const int q = nwg / NXCD, r = nwg % NXCD, xcd = wgid % NXCD, off = wgid / NXCD; wgid = (xcd < r ? xcd * (q + 1) : r * (q + 1) + (xcd - r) * q) + off; }
        const int nig = WGM * nN, gid = wgid / nig, fm = gid * WGM, gsz = (nM - fm) < WGM ? (nM - fm) : WGM;
        u.pm = fm + ((wgid % nig) % gsz); u.pn = (wgid % nig) / gsz; return true;
    }
};

__device__ __forceinline__ unsigned cvt_pk_bf16(float lo, float hi) { unsigned r; asm volatile("v_cvt_pk_bf16_f32 %0, %1, %2" : "=v"(r) : "v"(lo), "v"(hi)); return r; }
typedef float f32x2 __attribute__((ext_vector_type(2)));
typedef unsigned u32x2 __attribute__((ext_vector_type(2)));
__device__ __forceinline__ float fsigmoid(float x) { return __builtin_amdgcn_rcpf(1.0f + __builtin_amdgcn_exp2f(-1.4426950408889634f * x)); }
__device__ __forceinline__ float fsilu(float x) { return x * fsigmoid(x); }
__device__ __forceinline__ float bf2f(unsigned short b) { return __uint_as_float(((unsigned)b) << 16); }
typedef float f32x2_t __attribute__((ext_vector_type(2))); typedef __bf16 bf16x2_t __attribute__((ext_vector_type(2)));
__device__ __forceinline__ unsigned cvtpk_s(float lo, float hi) { f32x2_t v = {lo, hi}; bf16x2_t b = __builtin_convertvector(v, bf16x2_t); return __builtin_bit_cast(unsigned, b); }
__device__ __forceinline__ u32x4 pack8(const f32x4& a, const f32x4& b) { u32x4 w; w.x = cvtpk_s(a[0], a[1]); w.y = cvtpk_s(a[2], a[3]); w.z = cvtpk_s(b[0], b[1]); w.w = cvtpk_s(b[2], b[3]); return w; }
__device__ __forceinline__ void unpack8(const u32x4& w, f32x4& a, f32x4& b) {
    a[0] = __uint_as_float(w.x << 16); a[1] = __uint_as_float(w.x & 0xffff0000u); a[2] = __uint_as_float(w.y << 16); a[3] = __uint_as_float(w.y & 0xffff0000u);
    b[0] = __uint_as_float(w.z << 16); b[1] = __uint_as_float(w.z & 0xffff0000u); b[2] = __uint_as_float(w.w << 16); b[3] = __uint_as_float(w.w & 0xffff0000u); }
__device__ __forceinline__ float row_rstd(const float* ssp, int r) {
    const f32x4* p = (const f32x4*)(ssp + (size_t)r * 16);
    const f32x4 a = p[0], b = p[1], c = p[2], d = p[3]; const f32x4 s = (a + b) + (c + d);
    return __builtin_amdgcn_rsqf(((s[0] + s[1]) + (s[2] + s[3])) * (1.0f / 1024.0f) + 1e-6f);
}
#define EPI_FENCE() asm volatile("" ::: "memory")
typedef __amdgpu_buffer_rsrc_t rsrc_t;
__device__ __forceinline__ rsrc_t mk_rsrc(const void* p) { return __builtin_amdgcn_make_buffer_rsrc((void*)p, (short)0, 0x7fffffff, 0x00020000); }
__device__ __forceinline__ float xq_sum(float x) {
    auto s = __builtin_amdgcn_permlane16_swap(__float_as_uint(x), __float_as_uint(x), false, false); x = __uint_as_float(s[0]) + __uint_as_float(s[1]);
    auto t = __builtin_amdgcn_permlane32_swap(__float_as_uint(x), __float_as_uint(x), false, false); return __uint_as_float(t[0]) + __uint_as_float(t[1]);
}
__device__ __forceinline__ void rstd8_issue(const float* ssp, int row0, int fq, f32x4 (&p)[2][4]) {
#pragma unroll
    for (int ai = 0; ai < 2; ++ai)
#pragma unroll
        for (int m = 0; m < 4; ++m) p[ai][m] = *(const f32x4*)(ssp + (size_t)(row0 + ai * HALF + m * 16) * 16 + 4 * fq);
}
__device__ __forceinline__ void rstd8_reduce(const f32x4 (&p)[2][4], float (&rs)[2][4]) {
#pragma unroll
    for (int ai = 0; ai < 2; ++ai)
#pragma unroll
        for (int m = 0; m < 4; ++m) { const float q = (p[ai][m][0] + p[ai][m][1]) + (p[ai][m][2] + p[ai][m][3]); rs[ai][m] = __builtin_amdgcn_rsqf(xq_sum(q) * (1.0f / 1024.0f) + 1e-6f); }
}
struct EpiSwiglu {
    static constexpr bool PERM = true, AFTER_DRAIN = false, CHAIN = false, RS = true;
    bf16_t* H; const float* ssp;
    __device__ __forceinline__ const float* rs_ptr() const { return ssp; }
    __device__ __forceinline__ void operator()(const f32x4 (&acc)[2][2][4][2], const Unit& u, int wr, int wc, int fr, int fq, const float (&rs8)[2][4]) const {
        const int row0 = u.pm * BM + wr * 64 + fr, col0 = u.pn * HALF + wc * 32 + 8 * fq;
#pragma unroll
        for (int ai = 0; ai < 2; ++ai)
#pragma unroll
            for (int m = 0; m < 4; ++m) { const int r = row0 + ai * HALF + m * 16; const float s = rs8[ai][m]; f32x4 o[2];
#pragma unroll
                for (int n = 0; n < 2; ++n) { const f32x4 g = acc[ai][0][m][n] * s, up = acc[ai][1][m][n] * s;
#pragma unroll
                    for (int i = 0; i < 4; ++i) o[n][i] = fsilu(g[i]) * up[i]; }
                *(u32x4*)(H + (size_t)r * 2816 + col0) = pack8(o[0], o[1]); EPI_FENCE(); }
    }
};
template <int MODE> struct EpiResid {
    static constexpr bool PERM = true, AFTER_DRAIN = false, CHAIN = false, RS = (MODE == 1);
    bf16_t* XB; float* sso; const float* ssi; const bf16_t* proj; float scale; const bf16_t* XBin;
    __device__ __forceinline__ const float* rs_ptr() const { return ssi; }
    static constexpr int NB = (MODE == 0) ? 8 : 2;
    __device__ __forceinline__ void operator()(const f32x4 (&acc)[2][2][4][2], const Unit& u, int wr, int wc, int fr, int fq, const float (&rs8)[2][4]) const {
        const rsrc_t rx = mk_rsrc(XBin), rp = mk_rsrc(MODE == 1 ? (const void*)proj : (const void*)XBin), ro = mk_rsrc(XB);
        const unsigned voff = (unsigned)(fr * 1024 + 8 * fq) * 2u;
        const unsigned sbase = (unsigned)((u.pm * BM + wr * 64) * 1024 + u.pn * BM + wc * 32) * 2u;
        const int row0 = u.pm * BM + wr * 64 + fr;
#pragma unroll
        for (int gp = 0; gp < 8 / NB; ++gp) {
            u32x4 xv[NB][2]; u32x4 pv[NB][2];
#pragma unroll
            for (int mm = 0; mm < NB; ++mm) { const int g = NB * gp + mm, ai = g >> 2, m = g & 3;
#pragma unroll
                for (int bj = 0; bj < 2; ++bj) { const unsigned so = sbase + (unsigned)((ai * HALF + m * 16) * 1024 + bj * HALF) * 2u;
                    xv[mm][bj] = __builtin_amdgcn_raw_buffer_load_b128(rx, voff + so, 0, 0);
                    if (MODE == 1) pv[mm][bj] = __builtin_amdgcn_raw_buffer_load_b128(rp, voff + so, 0, 0); } }
#pragma unroll
            for (int mm = 0; mm < NB; ++mm) { const int g = NB * gp + mm, ai = g >> 2, m = g & 3; const int r = row0 + ai * HALF + m * 16; float ss = 0.f;
                float s = 1.0f; if (MODE == 1) s = rs8[ai][m];
#pragma unroll
                for (int bj = 0; bj < 2; ++bj) { const unsigned so = sbase + (unsigned)((ai * HALF + m * 16) * 1024 + bj * HALF) * 2u; f32x4 x0, x1; unpack8(xv[mm][bj], x0, x1);
                    if (MODE == 0) { x0 = x0 + acc[ai][bj][m][0] * scale; x1 = x1 + acc[ai][bj][m][1] * scale; }
                    else { f32x4 p0, p1; unpack8(pv[mm][bj], p0, p1);
#pragma unroll
                        for (int i = 0; i < 4; ++i) { x0[i] += fsigmoid(acc[ai][bj][m][0][i] * s) * p0[i]; x1[i] += fsigmoid(acc[ai][bj][m][1][i] * s) * p1[i]; } }
                    __builtin_amdgcn_raw_buffer_store_b128(pack8(x0, x1), ro, voff + so, 0, 0);
                    ss += ((x0[0] * x0[0] + x0[1] * x0[1]) + (x0[2] * x0[2] + x0[3] * x0[3])) + ((x1[0] * x1[0] + x1[1] * x1[1]) + (x1[2] * x1[2] + x1[3] * x1[3])); }
                ss = xq_sum(ss);
                if (fq == 0) sso[(size_t)r * 16 + u.pn * 4 + wc] = ss; }
            EPI_FENCE(); }
    }
};
template <int ACT, bool RS, int LD> __device__ __forceinline__ void store_tile(const f32x4 (&acc)[2][2][4][2], bf16_t* base, const float (&rs8)[2][4], const float* cvp, int row0, int fq) {
    f32x4 cv[2][2];
#pragma unroll
    for (int bj = 0; bj < 2; ++bj)
#pragma unroll
        for (int n = 0; n < 2; ++n) cv[bj][n] = (ACT >= 3) ? *(const f32x4*)(cvp + bj * HALF + 4 * n) : (f32x4){0.f, 0.f, 0.f, 0.f};
#pragma unroll
    for (int ai = 0; ai < 2; ++ai)
#pragma unroll
        for (int m = 0; m < 4; ++m) { const int r = row0 + ai * HALF + m * 16; float s = 1.0f; if (RS) s = rs8[ai][m];
#pragma unroll
            for (int bj = 0; bj < 2; ++bj) { f32x4 o[2];
#pragma unroll
                for (int n = 0; n < 2; ++n) { const f32x4 z = acc[ai][bj][m][n] * s;
#pragma unroll
                    for (int i = 0; i < 4; ++i) { float v = z[i];
                        if (ACT == 1) v = fsilu(v);
                        else if (ACT == 2) v = fsigmoid(v);
                        else if (ACT == 3) v = (1.0f - cv[bj][n][i]) * fsigmoid(-v);
                        else if (ACT == 4) v = __builtin_amdgcn_exp2f(-0.6065306597126334f * 1.4426950408889634f * fsigmoid(v + cv[bj][n][i]));
                        else if (ACT == 5) v = fsigmoid(v + cv[bj][n][i]);
                        o[n][i] = v; } }
                *(u32x4*)(base + (size_t)r * LD + bj * HALF) = pack8(o[0], o[1]); }
            EPI_FENCE(); }
}
template <int KIND> struct EpiStore {
    static constexpr bool PERM = true, AFTER_DRAIN = false, CHAIN = false, RS = (KIND <= 2);
    bf16_t* O; const float* ssp; bf16_t* O2; bf16_t* O3; const float* c0; const float* c1;
    __device__ __forceinline__ const float* rs_ptr() const { return ssp; }
    __device__ __forceinline__ void operator()(const f32x4 (&acc)[2][2][4][2], const Unit& u, int wr, int wc, int fr, int fq, const float (&rs8)[2][4]) const {
        const int row0 = u.pm * BM + wr * 64 + fr; const int cl = wc * 32 + 8 * fq;
        if (KIND == 0) store_tile<0, true, 1792>(acc, O + u.pn * BM + cl, rs8, nullptr, row0, fq);
        if (KIND == 1) {
            if (u.pn < 3) store_tile<0, true, 768>(acc, O + u.pn * BM + cl, rs8, nullptr, row0, fq);
            else { const int t = u.pn - 3, kind = t >> 1; bf16_t* b = O2 + t * BM + cl;
                if (kind == 0 || kind == 3) store_tile<1, true, 2048>(acc, b, rs8, nullptr, row0, fq);
                else if (kind == 1) store_tile<3, true, 2048>(acc, b, rs8, c0 + (t & 1) * BM + cl, row0, fq);
                else store_tile<0, true, 2048>(acc, b, rs8, nullptr, row0, fq); } }
        if (KIND == 2) store_tile<2, true, 3072>(acc, O + u.pn * BM + cl, rs8, nullptr, row0, fq);
        if (KIND == 3) {
            if (u.pn < 2) store_tile<4, false, 512>(acc, O + u.pn * BM + cl, rs8, c0 + u.pn * BM + cl, row0, fq);
            else if (u.pn < 4) store_tile<5, false, 512>(acc, O2 + (u.pn - 2) * BM + cl, rs8, c1 + (u.pn - 2) * BM + cl, row0, fq);
            else store_tile<0, false, 512>(acc, O3 + (u.pn - 4) * BM + cl, rs8, nullptr, row0, fq); }
        if (KIND == 4) store_tile<0, false, 1024>(acc, O + u.pn * BM + cl, rs8, nullptr, row0, fq);
    }
};
template <bool FIRST> struct EpiBranch {
    static constexpr bool PERM = true, AFTER_DRAIN = false, CHAIN = false, RS = false;
    bf16_t* Mg; const bf16_t* G; const float* ssp;
    __device__ __forceinline__ const float* rs_ptr() const { return nullptr; }
    __device__ __forceinline__ void operator()(const f32x4 (&acc)[2][2][4][2], const Unit& u, int wr, int wc, int fr, int fq, const float (&rs8)[2][4]) const {
        const int row0 = u.pm * BM + wr * 64 + fr, col0 = u.pn * BM + wc * 32 + 8 * fq;
#pragma unroll
        for (int ai = 0; ai < 2; ++ai)
#pragma unroll
            for (int m = 0; m < 4; ++m) { const int r = row0 + ai * HALF + m * 16;
#pragma unroll
                for (int bj = 0; bj < 2; ++bj) { f32x4 g0, g1; unpack8(*(const u32x4*)(G + (size_t)r * 3072 + col0 + bj * HALF), g0, g1);
                    f32x4 o0 = g0 * acc[ai][bj][m][0], o1 = g1 * acc[ai][bj][m][1];
                    bf16_t* mp = Mg + (size_t)r * 1024 + col0 + bj * HALF;
                    if (!FIRST) { f32x4 p0, p1; unpack8(*(const u32x4*)mp, p0, p1); o0 = o0 + p0; o1 = o1 + p1; }
                    *(u32x4*)mp = pack8(o0, o1); }
                EPI_FENCE(); }
    }
};
struct EpiBranchChain {
    static constexpr bool PERM = true, AFTER_DRAIN = false, CHAIN = true, RS = false;
    bf16_t* Mg; const bf16_t* G;
    __device__ __forceinline__ const float* rs_ptr() const { return nullptr; }
    __device__ __forceinline__ void operator()(f32x4 (&acc)[2][2][4][2], const Unit& u, int wr, int wc, int fr, int fq, const float (&rs8)[2][4]) const {
        const int row0 = u.pm * BM + wr * 64 + fr, col0 = u.pn * BM + wc * 32 + 8 * fq; const int b = u.b;
#pragma unroll
        for (int ai = 0; ai < 2; ++ai)
#pragma unroll
            for (int m = 0; m < 4; ++m) { const int r = row0 + ai * HALF + m * 16;
#pragma unroll
                for (int bj = 0; bj < 2; ++bj) { const bf16_t* gp = G + (size_t)r * 3072 + b * 1024 + col0 + bj * HALF; f32x4 g0, g1; unpack8(*(const u32x4*)gp, g0, g1);
                    if (b < 2) { f32x4 h0, h1; unpack8(*(const u32x4*)(gp + 1024), h0, h1);
#pragma unroll
                        for (int i = 0; i < 4; ++i) { g0[i] *= __builtin_amdgcn_rcpf(h0[i]); g1[i] *= __builtin_amdgcn_rcpf(h1[i]); }
                        acc[ai][bj][m][0] = acc[ai][bj][m][0] * g0; acc[ai][bj][m][1] = acc[ai][bj][m][1] * g1; }
                    else { const f32x4 o0 = g0 * acc[ai][bj][m][0], o1 = g1 * acc[ai][bj][m][1]; *(u32x4*)(Mg + (size_t)r * 1024 + col0 + bj * HALF) = pack8(o0, o1); } }
                if (m & 1) EPI_FENCE(); }
    }
};
struct ChainOrder : StaticOrder {
    __host__ __device__ bool next(int i, Unit& u) const { if (i >= 3) return false; if (!StaticOrder::next(0, u)) return false; u.b = i; return true; }
};
template <class Epi, class Sched, bool ALIGN_EPI = false, bool SP2 = false>
__device__ __forceinline__ void gemm_phase(PG8_LAS unsigned char* lds, const Gemm g, const Sched& S, const Epi& E) {
    const int tid = threadIdx.x, wid = __builtin_amdgcn_readfirstlane(tid >> 6), lane = tid & 63, wr = wid >> 2, wc = wid & 3, fr = lane & 15, fq = lane >> 4;
    int Kl_ = g.K; asm volatile("" : "+s"(Kl_)); const int K = Kl_, nt = K / BK;
    unsigned voffA[2], voffB[2];
#pragma unroll
    for (int i = 0; i < 2; ++i) { int R, C; stage_rc(tid * 16 + i * 8192, R, C); const int Rb = Epi::PERM ? ((R & ~31) + perm32(R & 31)) : R;
        voffA[i] = (unsigned)(R * K + C) * 2u; voffB[i] = (unsigned)(Rb * K + C) * 2u; }
    const size_t kstep = (size_t)(BK * 2);
    const size_t hstep = (size_t)HALF * K * 2;
    const size_t tstep = 2 * hstep;
    const unsigned ldsw = (unsigned)wid * 1024u;
    const int aoff = lds_byte(wr * 64 + fr, fq * 8), boff = lds_byte(wc * 32 + fr, fq * 8);
#define PG8_SA(b, h) (((b) * 2 + (h)) * HTB)
#define PG8_SB(b, h) ((4 + (b) * 2 + (h)) * HTB)
#define PG8_STAGE(bufoff, gbase, voff) do { _Pragma("unroll") for (int _i = 0; _i < 2; ++_i) \
        __builtin_amdgcn_global_load_lds((const unsigned*)((const char*)(gbase) + (voff)[_i]), (PG8_LAS unsigned*)(lds + (bufoff) + ldsw + _i * 8192), 16, 0, 0); } while (0)
#define PG8_LDA(dst, b, h) do { _Pragma("unroll") for (int m = 0; m < 4; ++m) _Pragma("unroll") for (int k = 0; k < 2; ++k) dst[m][k] = *(const PG8_LAS bf16x8*)(lds + PG8_SA(b, h) + aoff + m * 2048 + k * 1024); } while (0)
#define PG8_LDB(dst, b, h) do { _Pragma("unroll") for (int n = 0; n < 2; ++n) _Pragma("unroll") for (int k = 0; k < 2; ++k) dst[n][k] = *(const PG8_LAS bf16x8*)(lds + PG8_SB(b, h) + boff + n * 2048 + k * 1024); } while (0)
#define PG8_MMA(ai, bj, At, Bt) do { __builtin_amdgcn_s_setprio(1); _Pragma("unroll") for (int m = 0; m < 4; ++m) _Pragma("unroll") for (int n = 0; n < 2; ++n) _Pragma("unroll") for (int k = 0; k < 2; ++k) \
        acc[ai][bj][m][n] = __builtin_amdgcn_mfma_f32_16x16x32_bf16(Bt[n][k], At[m][k], acc[ai][bj][m][n], 0, 0, 0); __builtin_amdgcn_s_setprio(0); } while (0)
#define PG8_WAIT_V(n) asm volatile("s_waitcnt vmcnt(" #n ")" ::: "memory")
#define PG8_WAIT_L(n) asm volatile("s_waitcnt lgkmcnt(" #n ")" ::: "memory")
#define PG8_BAR __builtin_amdgcn_s_barrier()
#define PG8_SCHED __builtin_amdgcn_sched_barrier(0)
    Unit cur, nxt; int ui = 0;
    if (!S.next(0, cur)) return;
    f32x4 acc[2][2][4][2];
#pragma unroll
    for (int a = 0; a < 2; ++a)
#pragma unroll
        for (int b = 0; b < 2; ++b)
#pragma unroll
            for (int m = 0; m < 4; ++m)
#pragma unroll
                for (int n = 0; n < 2; ++n) acc[a][b][m][n] = (f32x4){0.f, 0.f, 0.f, 0.f};
    bf16x8 At[4][2], B0[2][2], B1[2][2];
    const char* cA = (const char*)g.A + (size_t)cur.pm * tstep + (size_t)cur.b * g.usA * 2; const char* cB = (const char*)g.Bt + (size_t)cur.pn * tstep + (size_t)cur.b * g.usB * 2;
    S.a_ready(cur);
    PG8_LAS float* RSL = (PG8_LAS float*)(lds + RS_LDS_OFF);
    if constexpr (Epi::RS) { f32x4 p0_[2];
#pragma unroll
        for (int ai = 0; ai < 2; ++ai) p0_[ai] = *(const f32x4*)(E.rs_ptr() + (size_t)(cur.pm * BM + ai * HALF + wr * 64 + wc * 16 + fr) * 16 + 4 * fq);
#pragma unroll
        for (int ai = 0; ai < 2; ++ai) { const float q_ = (p0_[ai][0] + p0_[ai][1]) + (p0_[ai][2] + p0_[ai][3]); const float r_ = __builtin_amdgcn_rsqf(xq_sum(q_) * (1.0f / 1024.0f) + 1e-6f);
            if (fq == 0) RSL[ai * HALF + wr * 64 + wc * 16 + fr] = r_; } }
    if constexpr (SP2) {
        PG8_STAGE(PG8_SB(0, 0), cB, voffB); PG8_STAGE(PG8_SB(0, 1), cB + hstep, voffB); PG8_STAGE(PG8_SA(0, 0), cA, voffA); PG8_STAGE(PG8_SA(0, 1), cA + hstep, voffA);
        if (wr == 1) PG8_BAR;
        PG8_WAIT_V(2); PG8_BAR;
        PG8_STAGE(PG8_SB(1, 0), cB + kstep, voffB); PG8_STAGE(PG8_SA(1, 0), cA + kstep, voffA); PG8_STAGE(PG8_SB(1, 1), cB + hstep + kstep, voffB);
        PG8_WAIT_V(6); PG8_BAR;
    } else {
        PG8_STAGE(PG8_SB(0, 0), cB, voffB); PG8_STAGE(PG8_SA(0, 0), cA, voffA); PG8_STAGE(PG8_SB(0, 1), cB + hstep, voffB); PG8_STAGE(PG8_SA(0, 1), cA + hstep, voffA);
        if (wr == 1) PG8_BAR;
        PG8_WAIT_V(4); PG8_BAR;
        PG8_STAGE(PG8_SB(1, 0), cB + kstep, voffB); PG8_STAGE(PG8_SA(1, 0), cA + kstep, voffA); PG8_STAGE(PG8_SB(1, 1), cB + hstep + kstep, voffB);
        PG8_WAIT_V(6); PG8_BAR;
    }
    for (;;) {
        const bool has_next = S.next(ui + 1, nxt);
        const char* nA = has_next ? (const char*)g.A + (size_t)nxt.pm * tstep + (size_t)nxt.b * g.usA * 2 : cA; const char* nB = has_next ? (const char*)g.Bt + (size_t)nxt.pn * tstep + (size_t)nxt.b * g.usB * 2 : cB;
        for (int t = 0; t < nt; t += 2) {
            const bool last = (t == nt - 2);
            const char* a1 = cA + (size_t)(t + 1) * kstep;
            const char* a2 = last ? nA : cA + (size_t)(t + 2) * kstep; const char* b2 = last ? nB : cB + (size_t)(t + 2) * kstep;
            const char* a3 = a2 + kstep; const char* b3 = b2 + kstep;
            if (last && has_next) S.a_ready(nxt);
            if constexpr (SP2) {
            PG8_LDB(B0, 0, 0); PG8_LDB(B1, 0, 1); PG8_SCHED; PG8_LDA(At, 0, 0); PG8_STAGE(PG8_SA(1, 1), a1 + hstep, voffA);
            PG8_WAIT_V(8); PG8_WAIT_L(0); PG8_BAR; PG8_MMA(0, 0, At, B0); PG8_MMA(0, 1, At, B1); PG8_BAR; PG8_SCHED;
            PG8_LDA(At, 0, 1); PG8_STAGE(PG8_SB(0, 0), b2, voffB); PG8_STAGE(PG8_SB(0, 1), b2 + hstep, voffB); PG8_STAGE(PG8_SA(0, 0), a2, voffA);
            PG8_WAIT_V(8); PG8_WAIT_L(0); PG8_BAR; PG8_MMA(1, 0, At, B0); PG8_MMA(1, 1, At, B1); PG8_BAR; PG8_SCHED;
            PG8_LDB(B0, 1, 0); PG8_LDB(B1, 1, 1); PG8_SCHED; PG8_LDA(At, 1, 0); PG8_STAGE(PG8_SA(0, 1), a2 + hstep, voffA);
            PG8_WAIT_V(8); PG8_WAIT_L(0); PG8_BAR; PG8_MMA(0, 0, At, B0); PG8_MMA(0, 1, At, B1); PG8_BAR; PG8_SCHED;
            PG8_LDA(At, 1, 1); PG8_STAGE(PG8_SB(1, 0), b3, voffB); PG8_STAGE(PG8_SB(1, 1), b3 + hstep, voffB); PG8_STAGE(PG8_SA(1, 0), a3, voffA);
            PG8_WAIT_V(8); PG8_WAIT_L(0); PG8_BAR; PG8_MMA(1, 0, At, B0); PG8_MMA(1, 1, At, B1); PG8_BAR; PG8_SCHED;
            } else {
            PG8_LDB(B0, 0, 0); PG8_SCHED; PG8_LDA(At, 0, 0); PG8_STAGE(PG8_SA(1, 1), a1 + hstep, voffA);
            PG8_WAIT_L(8); PG8_BAR; PG8_WAIT_L(0); PG8_MMA(0, 0, At, B0); PG8_BAR; PG8_SCHED;
            PG8_LDB(B1, 0, 1); PG8_STAGE(PG8_SB(0, 0), b2, voffB);
            PG8_BAR; PG8_WAIT_L(0); PG8_MMA(0, 1, At, B1); PG8_BAR;
            PG8_LDA(At, 0, 1); PG8_STAGE(PG8_SA(0, 0), a2, voffA);
            PG8_BAR; PG8_WAIT_L(0); PG8_MMA(1, 0, At, B0); PG8_BAR; PG8_SCHED;
            PG8_STAGE(PG8_SB(0, 1), b2 + hstep, voffB);
            PG8_WAIT_V(6); PG8_BAR; PG8_MMA(1, 1, At, B1); PG8_BAR;
            PG8_LDB(B0, 1, 0); PG8_SCHED; PG8_LDA(At, 1, 0); PG8_STAGE(PG8_SA(0, 1), a2 + hstep, voffA);
            PG8_WAIT_L(8); PG8_BAR; PG8_WAIT_L(0); PG8_MMA(0, 0, At, B0); PG8_BAR; PG8_SCHED;
            PG8_LDB(B1, 1, 1); PG8_STAGE(PG8_SB(1, 0), b3, voffB);
            PG8_BAR; PG8_WAIT_L(0); PG8_MMA(0, 1, At, B1); PG8_BAR;
            PG8_LDA(At, 1, 1); PG8_STAGE(PG8_SA(1, 0), a3, voffA);
            PG8_BAR; PG8_WAIT_L(0); PG8_MMA(1, 0, At, B0); PG8_BAR; PG8_SCHED;
            PG8_STAGE(PG8_SB(1, 1), b3 + hstep, voffB);
            PG8_WAIT_V(6); PG8_BAR; PG8_MMA(1, 1, At, B1); PG8_BAR;
            }
        }
        if constexpr (ALIGN_EPI) { if (wr == 0) PG8_BAR; }
        if constexpr (!Epi::AFTER_DRAIN) {
            float rsv[2][4];
            if constexpr (Epi::RS) { const PG8_LAS float* rb_ = RSL + (ui & 1) * 256 + wr * 64 + fr;
#pragma unroll
                for (int ai = 0; ai < 2; ++ai)
#pragma unroll
                    for (int m = 0; m < 4; ++m) rsv[ai][m] = rb_[ai * HALF + m * 16];
                f32x4 pn_[2];
                if (has_next) {
#pragma unroll
                    for (int ai = 0; ai < 2; ++ai) pn_[ai] = *(const f32x4*)(E.rs_ptr() + (size_t)(nxt.pm * BM + ai * HALF + wr * 64 + wc * 16 + fr) * 16 + 4 * fq); }
                E(acc, cur, wr, wc, fr, fq, rsv);
                if (has_next) {
#pragma unroll
                    for (int ai = 0; ai < 2; ++ai) { const float q_ = (pn_[ai][0] + pn_[ai][1]) + (pn_[ai][2] + pn_[ai][3]); const float r_ = __builtin_amdgcn_rsqf(xq_sum(q_) * (1.0f / 1024.0f) + 1e-6f);
                        if (fq == 0) RSL[((ui + 1) & 1) * 256 + ai * HALF + wr * 64 + wc * 16 + fr] = r_; } } }
            else { for (int ai = 0; ai < 2; ++ai) for (int m = 0; m < 4; ++m) rsv[ai][m] = 1.0f; E(acc, cur, wr, wc, fr, fq, rsv); }
            S.done(cur); }
        if (!has_next) break;
        if constexpr (!Epi::CHAIN)
#pragma unroll
        for (int a = 0; a < 2; ++a)
#pragma unroll
            for (int b = 0; b < 2; ++b)
#pragma unroll
                for (int m = 0; m < 4; ++m)
#pragma unroll
                    for (int n = 0; n < 2; ++n) acc[a][b][m][n] = (f32x4){0.f, 0.f, 0.f, 0.f};
        cur = nxt; cA = nA; cB = nB; ++ui;
        if constexpr (ALIGN_EPI) { if (wr == 1) PG8_BAR; }
    }
    PG8_WAIT_V(0);
    if constexpr (!ALIGN_EPI) { if (wr == 0) PG8_BAR; }
    PG8_BAR;
    if constexpr (Epi::AFTER_DRAIN) { E.fused(acc, cur, wr, wc, fr, fq, lds, wid, lane); S.done(cur); }
#undef PG8_SA
#undef PG8_SB
#undef PG8_STAGE
#undef PG8_LDA
#undef PG8_LDB
#undef PG8_MMA
#undef PG8_WAIT_V
#undef PG8_WAIT_L
#undef PG8_BAR
#undef PG8_SCHED
}
}
#define GAS __attribute__((address_space(1)))
#define LAS __attribute__((address_space(3)))
typedef unsigned short bf16;
typedef unsigned v4u __attribute__((ext_vector_type(4)));
typedef float f32x4 __attribute__((ext_vector_type(4)));
typedef short bf16x8 __attribute__((ext_vector_type(8)));
typedef GAS unsigned gu32;
typedef GAS unsigned long long gu64;
#define RLX_AGENT __ATOMIC_RELAXED, __HIP_MEMORY_SCOPE_AGENT
#define LDS_WAIT() asm volatile("s_waitcnt lgkmcnt(0)" ::: "memory")
#define VM_WAIT() asm volatile("s_waitcnt vmcnt(0)" ::: "memory")
__device__ __forceinline__ unsigned long long rt() { return __builtin_amdgcn_s_memrealtime(); }
__device__ __forceinline__ unsigned f2bf(float f) { unsigned u = __builtin_bit_cast(unsigned, f); return (u + 0x7fffu + ((u >> 16) & 1u)) >> 16; }
__device__ __forceinline__ unsigned pk2(float lo, float hi) { return f2bf(lo) | (f2bf(hi) << 16); }

#define XB_TMO      128
#define XB_XCNT(j)  (256  + 64 * (j))
#define XB_XSUB(j)  (1280 + 64 * (j))
#define XB_XGEN(j)  (2304 + 64 * (j))
#define XB_TOP      3328
#define XB_TOPGEN   3392
#define XCD_BAR_WORDS 3456
#define XB_SPIN_CAP (1u << 18)

__device__ __forceinline__ unsigned xb_ld(unsigned* p)              { return __hip_atomic_load(p, __ATOMIC_RELAXED, __HIP_MEMORY_SCOPE_AGENT); }
__device__ __forceinline__ unsigned xb_add(unsigned* p, unsigned v) { return __hip_atomic_fetch_add(p, v, __ATOMIC_RELAXED, __HIP_MEMORY_SCOPE_AGENT); }
__device__ __forceinline__ unsigned xb_xcc_id() { return (unsigned)__builtin_amdgcn_s_getreg((3 << 11) | 20) & 0xFu; }
#define XB_SPIN(cond, bar) do { unsigned _sp = 0; while (cond) { __builtin_amdgcn_s_sleep(1); \
    if ((++_sp & 255u) == 0u) { if (xb_ld(&(bar)[XB_TMO])) break; if (_sp > XB_SPIN_CAP) { atomicAdd(&(bar)[XB_TMO], 1u); break; } } } } while (0)

struct XcdBarrier {
    unsigned* bar; unsigned x;
    volatile LAS unsigned* st;
};

__device__ __forceinline__ XcdBarrier xcd_barrier_post(unsigned* bar, volatile LAS unsigned* st) {
    XcdBarrier b; b.bar = bar; b.x = xb_xcc_id(); b.st = st;
    if (threadIdx.x == 0) (void)xb_add(&bar[XB_XCNT(b.x)], 1u);
    return b;
}
__device__ __forceinline__ void xcd_barrier_complete(unsigned* bar, unsigned x, unsigned& nloc, unsigned& nx) {
    const unsigned G = gridDim.x * gridDim.y * gridDim.z;
    unsigned sum, cnt, mine, sp = 0u;
    for (;;) {
        sum = 0u; cnt = 0u; mine = 0u;
#pragma unroll
        for (unsigned j = 0; j < 16; ++j) { const unsigned c = xb_ld(&bar[XB_XCNT(j)]); sum += c; cnt += (c > 0u) ? 1u : 0u; mine = (j == x) ? c : mine; }
        if (sum == G) break;
        __builtin_amdgcn_s_sleep(1);
        if ((++sp & 255u) == 0u) { if (xb_ld(&bar[XB_TMO])) break; if (sp > XB_SPIN_CAP) { atomicAdd(&bar[XB_TMO], 1u); break; } }
    }
    nloc = mine > 0u ? mine : 1u; nx = cnt > 0u ? cnt : 1u;
}

__device__ __forceinline__ void xcd_barrier(const XcdBarrier& b) {
    asm volatile("s_waitcnt vmcnt(0)" ::: "memory");
    __syncthreads();
    if (threadIdx.x == 0) {
        unsigned* bar = b.bar;
        __builtin_amdgcn_s_waitcnt(0);
        unsigned nloc = b.st[0], nx = b.st[1];
        if (nloc == 0u) { xcd_barrier_complete(bar, b.x, nloc, nx); b.st[0] = nloc; b.st[1] = nx; }
        const unsigned old = xb_add(&bar[XB_XSUB(b.x)], 1u);
        const unsigned gen = old / nloc;
        if (old + 1u == (gen + 1u) * nloc) {
            __builtin_amdgcn_fence(__ATOMIC_RELEASE, "agent");
            asm volatile("s_waitcnt vmcnt(0)" ::: "memory");
            __builtin_amdgcn_fence(__ATOMIC_ACQUIRE, "agent");
            const unsigned og = xb_add(&bar[XB_TOP], 1u);
            const unsigned tg = og / nx;
            if (og + 1u == (tg + 1u) * nx) xb_add(&bar[XB_TOPGEN], 1u);
            else XB_SPIN(xb_ld(&bar[XB_TOPGEN]) == tg, bar);
            xb_add(&bar[XB_XGEN(b.x)], 1u);
            asm volatile("s_waitcnt vmcnt(0)" ::: "memory");
        } else {
            __builtin_amdgcn_fence(__ATOMIC_ACQUIRE, "agent");
            XB_SPIN(xb_ld(&bar[XB_XGEN(b.x)]) == gen, bar);
            asm volatile("s_waitcnt vmcnt(0)" ::: "memory");
        }
    }
    __syncthreads();
}
constexpr int NWAVES = 8;
constexpr int BATCH = 2, SEQ = 8192, DM = 1024, M = BATCH * SEQ, FF = 2816, DEPTH = 2;
enum { I_X = 0, I_P, I_F1N, I_F1G, I_F1U, I_F1D, I_MIXN, I_WIN, I_SINK, I_MU, I_W0, I_WUP, I_A0, I_AUP, I_GUP, I_KK, I_KA, I_RK, I_LNW, I_LNB, I_HLB, I_HNORM, I_WBR, I_WO,
       I_F2N, I_F2G, I_F2U, I_F2D, I_PLEN, I_PLEG, I_PLEP, I_FINN, N_IN };
constexpr size_t KiB = 1024, MiB = 1u << 20;
constexpr size_t WS_CTL = 0, CTL_ZERO_BYTES = 64 * KiB;
constexpr size_t WS_SS0 = 1 * MiB, WS_SS1 = 2 * MiB;
constexpr size_t WS_CBON = 3 * MiB;
constexpr size_t WS_LB = 3 * MiB + 512 * KiB;
constexpr size_t WS_W = 4 * MiB;
constexpr size_t W_F1GU = WS_W, W_F1D = W_F1GU + (size_t)5632 * 1024 * 2, W_IN = W_F1D + (size_t)1024 * 2816 * 2, W_LR = W_IN + (size_t)7680 * 1024 * 2,
                 W_BR = W_LR + (size_t)1536 * 256 * 2, W_O = W_BR + (size_t)3 * 1024 * 512 * 2, W_F2GU = W_O + (size_t)1024 * 1024 * 2, W_F2D = W_F2GU + (size_t)5632 * 1024 * 2,
                 W_PG = W_F2D + (size_t)1024 * 2816 * 2, W_PP = W_PG + (size_t)1024 * 1024 * 2, W_END = W_PP + (size_t)1024 * 256 * 2;
constexpr size_t WS_XB = 61 * MiB;
static_assert(W_END <= WS_XB, "weights fit");
constexpr size_t WS_R = 93 * MiB;
constexpr size_t R_H = WS_R;
constexpr size_t R_SIN_V = WS_R, R_SIN_R = WS_R + 16 * MiB, R_SIN_W = WS_R + 32 * MiB, R_SIN_KP = WS_R + 48 * MiB, R_SIN_KK = WS_R + 64 * MiB, R_SIN_B = WS_R + 80 * MiB;
constexpr size_t R_CV = WS_R, R_CG = WS_R + 16 * MiB, R_CH = WS_R + 32 * MiB, R_CDT = WS_R + 64 * MiB, R_CQT = WS_R + 80 * MiB, R_CS = WS_R + 200 * MiB;
constexpr size_t R_DAG_G = WS_R + 96 * MiB;
constexpr size_t R_ZR = WS_R + 112 * MiB;
constexpr size_t R_AP = WS_R + 168 * MiB;
constexpr size_t R_DAG_W = WS_R + 176 * MiB, R_DAG_A = WS_R + 192 * MiB;
constexpr size_t R_ZA = WS_R + 112 * MiB;
constexpr size_t R_YRAW = WS_R + 200 * MiB;
constexpr size_t R_Y = WS_R + 16 * MiB;
constexpr size_t R_GG = WS_R + 112 * MiB;
constexpr size_t R_MERGED = WS_R + 64 * MiB;
constexpr size_t R_PB = WS_R + 96 * MiB;
constexpr size_t R_PROJ = WS_R + 112 * MiB;
constexpr size_t R_XBALT = WS_R + 144 * MiB;
constexpr size_t R_HST = WS_R + 216 * MiB;
constexpr size_t WS_HD = 3 * MiB + 576 * KiB;
constexpr size_t WS_END = WS_R + 224 * MiB;
constexpr int CW_GRP = 512;
constexpr int CW_MISMATCH = 1100;
constexpr int CW_BAR = 4096;
constexpr int RING_OFF = 0, RING_BYTES = 131072;
constexpr int LDSCTL_OFF = 143360, MISC_OFF = LDSCTL_OFF + 320;
constexpr int LDS_BYTES = 147456;
constexpr int N_PHASES = 17 * DEPTH + 1;
#ifndef ENMASK
#define ENMASK 0x3ffff
#endif
#define EN(k) ((ENMASK >> (k)) & 1)
struct Args { const float* in[N_IN]; float* out; unsigned char* ws; int ph_lo, ph_hi; };
typedef const __attribute__((address_space(4))) unsigned char* kargp_t;
#define KP_DECL kargp_t KP_ = (kargp_t)__builtin_amdgcn_kernarg_segment_ptr(); asm volatile("" : "+s"(KP_))
#define INP(i) (*(const float* const __attribute__((address_space(4)))*)(KP_ + 8 * (i)))
typedef unsigned u32x2 __attribute__((ext_vector_type(2)));
__device__ __forceinline__ float bflo(unsigned w) { return __uint_as_float(w << 16); }
__device__ __forceinline__ float bfhi(unsigned w) { return __uint_as_float(w & 0xffff0000u); }
__device__ __forceinline__ float bf1(bf16 b) { return __uint_as_float(((unsigned)b) << 16); }
__device__ __forceinline__ float sigm(float x) { return __builtin_amdgcn_rcpf(1.0f + __builtin_amdgcn_exp2f(-1.4426950408889634f * x)); }
template <int CTRL> __device__ __forceinline__ float dppf(float x) { return __builtin_bit_cast(float, __builtin_amdgcn_mov_dpp(__builtin_bit_cast(int, x), CTRL, 0xf, 0xf, true)); }
__device__ __forceinline__ float xrow16_sum(float x) {
    auto s = __builtin_amdgcn_permlane16_swap(__float_as_uint(x), __float_as_uint(x), false, false);
    x = __uint_as_float(s[0]) + __uint_as_float(s[1]);
    auto t = __builtin_amdgcn_permlane32_swap(__float_as_uint(x), __float_as_uint(x), false, false);
    return __uint_as_float(t[0]) + __uint_as_float(t[1]);
}
__device__ __forceinline__ float wave_allsum(float x) {
    x += dppf<0xB1>(x); x += dppf<0x4E>(x); x += dppf<0x141>(x); x += dppf<0x128>(x); return xrow16_sum(x);
}
__device__ __forceinline__ float wave_allsum_slow(float v) {
#pragma unroll
    for (int o = 1; o < 64; o <<= 1) v += __shfl_xor(v, o);
    return v;
}
__device__ __forceinline__ float wave_allmax_slow(float v) {
#pragma unroll
    for (int o = 1; o < 64; o <<= 1) v = fmaxf(v, __shfl_xor(v, o));
    return v;
}

__device__ __forceinline__ void grp_barrier(unsigned* cnt, unsigned ng, volatile LAS unsigned* genp, unsigned* bar) {
    asm volatile("s_waitcnt vmcnt(0)" ::: "memory");
    __syncthreads();
    if (threadIdx.x == 0) {
        __builtin_amdgcn_s_waitcnt(0);
        const unsigned g = genp[0];
        __builtin_amdgcn_fence(__ATOMIC_ACQUIRE, "agent");
        (void)xb_add(cnt, 1u);
        const unsigned target = (g + 1u) * ng;
        XB_SPIN(xb_ld(cnt) < target, bar);
        genp[0] = g + 1u;
        asm volatile("s_waitcnt vmcnt(0)" ::: "memory");
    }
    __syncthreads();
}

struct Frame {
    LAS unsigned char* lds;
    volatile LAS unsigned* MISC;
    gu32* ctl;
    int tid, lane, wave;
    int G;
    unsigned char* ws;
    float* x;
};
#define WSP(T, off) ((T*)(F.ws + (off)))

__device__ __forceinline__ int map_row(int map, int n0) {
    if (map == 1) return (n0 >> 7) * 256 + (n0 & 127);
    if (map == 2) return (n0 >> 7) * 256 + 128 + (n0 & 127);
    if (map == 3) return n0 < 768 ? 1792 + n0 : (n0 < 2560 ? n0 - 768 : n0);
    return n0;
}
struct CJob { const float* W; const float* g; int K, N; bf16* WT; int map, item; };
__device__ __forceinline__ void conv_load(const CJob& j, int lane, f32x4 (&v)[16], float (&sc)[16]) {
    const int nblk = j.N / 64, kb = j.item / nblk, nb = j.item % nblk, k0 = 64 * kb, n0 = 64 * nb; const int nq = (lane & 15) * 4;
#pragma unroll
    for (int i = 0; i < 16; ++i) { const int kk = 4 * i + (lane >> 4); sc[i] = j.g ? j.g[k0 + kk] : 1.0f; v[i] = __builtin_nontemporal_load((const f32x4*)(j.W + (size_t)(k0 + kk) * j.N + n0 + nq)); }
}
__device__ __forceinline__ void conv_to_lds(int lane, const f32x4 (&v)[16], const float (&sc)[16], LAS float* scr) {
    const int nq = (lane & 15) * 4;
#pragma unroll
    for (int i = 0; i < 16; ++i) { const int kk = 4 * i + (lane >> 4); LAS float* d = scr + kk * 65 + nq; d[0] = v[i].x * sc[i]; d[1] = v[i].y * sc[i]; d[2] = v[i].z * sc[i]; d[3] = v[i].w * sc[i]; }
}
__device__ __forceinline__ void conv_store(const CJob& j, int lane, const LAS float* scr) {
    const int nblk = j.N / 64, kb = j.item / nblk, nb = j.item % nblk, k0 = 64 * kb, n0 = 64 * nb; const int c = lane & 7; const int dr = map_row(j.map, n0);
#pragma unroll
    for (int q = 0; q < 8; ++q) { const int n = (lane >> 3) + 8 * q; const LAS float* s = scr + (8 * c) * 65 + n;
        v4u o; o.x = pk2(s[0 * 65], s[1 * 65]); o.y = pk2(s[2 * 65], s[3 * 65]); o.z = pk2(s[4 * 65], s[5 * 65]); o.w = pk2(s[6 * 65], s[7 * 65]);
        *(GAS v4u*)(j.WT + (size_t)(dr + n) * j.K + k0 + 8 * c) = o; }
}
template <int PART> __device__ __forceinline__ void phase_conv(Frame& F, const Args& A, int L) {
    KP_DECL;
    LAS float* scr = (LAS float*)(F.lds + RING_OFF + F.wave * 16640);
    const int gw = blockIdx.x * NWAVES + F.wave, NGW = F.G * NWAVES;
    const float* f1g = INP(I_F1G) + (size_t)L * 1024 * 2816; const float* f1u = INP(I_F1U) + (size_t)L * 1024 * 2816; const float* f1d = INP(I_F1D) + (size_t)L * 2816 * 1024;
    const float* f2g = INP(I_F2G) + (size_t)L * 1024 * 2816; const float* f2u = INP(I_F2U) + (size_t)L * 1024 * 2816; const float* f2d = INP(I_F2D) + (size_t)L * 2816 * 1024;
    const float* win = INP(I_WIN) + (size_t)L * 1024 * 7680; const float* wbr = INP(I_WBR) + (size_t)L * 3 * 512 * 1024; const float* wo = INP(I_WO) + (size_t)L * 1024 * 1024;
    const float* pg = INP(I_PLEG) + (size_t)L * 1024 * 1024; const float* pp = INP(I_PLEP) + (size_t)L * 256 * 1024;
    const float* n1 = INP(I_F1N) + L * 1024; const float* nm = INP(I_MIXN) + L * 1024; const float* n2 = INP(I_F2N) + L * 1024; const float* np = INP(I_PLEN) + L * 1024;
    constexpr int IT_FGU = 16 * 44, IT_FD = 44 * 16, IT_IN = 16 * 120, IT_BR = 8 * 16, IT_SQ = 16 * 16, IT_PP = 4 * 16;
    constexpr int NITEMS = 4 * IT_FGU + 2 * IT_FD + IT_IN + 3 * IT_BR + 2 * IT_SQ + IT_PP;
#define CONV_DECODE(it_, J) do { int r = (it_); \
        if (r < IT_FGU) { J = CJob{f1g, n1, 1024, 2816, WSP(bf16, W_F1GU), 1, r}; break; } r -= IT_FGU; \
        if (r < IT_FGU) { J = CJob{f1u, n1, 1024, 2816, WSP(bf16, W_F1GU), 2, r}; break; } r -= IT_FGU; \
        if (r < IT_FD)  { J = CJob{f1d, nullptr, 2816, 1024, WSP(bf16, W_F1D), 0, r}; break; } r -= IT_FD; \
        if (r < IT_IN)  { J = CJob{win, nm, 1024, 7680, WSP(bf16, W_IN), 3, r}; break; } r -= IT_IN; \
        if (r < 3 * IT_BR) { const int b_ = r / IT_BR; J = CJob{wbr + (size_t)b_ * 512 * 1024, nullptr, 512, 1024, WSP(bf16, W_BR) + (size_t)b_ * 1024 * 512, 0, r % IT_BR}; break; } r -= 3 * IT_BR; \
        if (r < IT_SQ)  { J = CJob{wo, nullptr, 1024, 1024, WSP(bf16, W_O), 0, r}; break; } r -= IT_SQ; \
        if (r < IT_FGU) { J = CJob{f2g, n2, 1024, 2816, WSP(bf16, W_F2GU), 1, r}; break; } r -= IT_FGU; \
        if (r < IT_FGU) { J = CJob{f2u, n2, 1024, 2816, WSP(bf16, W_F2GU), 2, r}; break; } r -= IT_FGU; \
        if (r < IT_FD)  { J = CJob{f2d, nullptr, 2816, 1024, WSP(bf16, W_F2D), 0, r}; break; } r -= IT_FD; \
        if (r < IT_SQ)  { J = CJob{pg, np, 1024, 1024, WSP(bf16, W_PG), 0, r}; break; } r -= IT_SQ; \
        J = CJob{pp, nullptr, 256, 1024, WSP(bf16, W_PP), 0, r}; } while (0)
    constexpr int NA = 2 * IT_FGU + IT_FD + IT_IN;
    const int first = (PART == 0) ? gw : NA + ((int)blockIdx.x - F.G / 2) * NWAVES + F.wave, stride = (PART == 0) ? NGW : (F.G - F.G / 2) * NWAVES, hi_ = (PART == 0) ? NA : NITEMS;
    { CJob cur{}, nxt{}; f32x4 v[16]; float scv[16];
      if (first < hi_) { CONV_DECODE(first, cur); conv_load(cur, F.lane, v, scv); }
      for (int it = first; it < hi_; it += stride) {
          conv_to_lds(F.lane, v, scv, scr);
          const bool has = it + stride < hi_;
          if (has) { CONV_DECODE(it + stride, nxt); conv_load(nxt, F.lane, v, scv); }
          LDS_WAIT(); asm volatile("" ::: "memory");
          conv_store(cur, F.lane, scr);
          LDS_WAIT(); asm volatile("" ::: "memory");
          cur = nxt; } }
#undef CONV_DECODE
    if (PART != 0) return;
    const float* wup = INP(I_WUP) + (size_t)L * 64 * 512; const float* aup = INP(I_AUP) + (size_t)L * 64 * 512; const float* gup = INP(I_GUP) + (size_t)L * 128 * 512;
    bf16* wlr = WSP(bf16, W_LR);
    const int gt = blockIdx.x * (NWAVES * 64) + F.tid, NGT = F.G * NWAVES * 64;
    for (int e = gt; e < 1536 * 256; e += NGT) { const int n = e >> 8, k = e & 255; const int grp = n >> 9, c = n & 511; float v = 0.f;
        if (grp == 0) { if (k < 64) v = wup[k * 512 + c]; } else if (grp == 1) { if (k >= 64 && k < 128) v = aup[(k - 64) * 512 + c]; } else { if (k >= 128) v = gup[(k - 128) * 512 + c]; }
        wlr[e] = (bf16)f2bf(v); }
    if (gt < 512) { const float a0 = INP(I_HLB)[gt], a1 = INP(I_HLB)[512 + gt]; const float mx = fmaxf(a0, a1); const float e0 = __expf(a0 - mx), e1 = __expf(a1 - mx);
        float lb = (L == 0) ? 0.f : e1 / (e0 + e1); lb = fminf(fmaxf(lb, 0.f), 1.0f - 1e-6f); WSP(float, WS_LB)[gt] = lb; }
    if (L == 0) {
        const float* xin = INP(I_X); bf16* xb = WSP(bf16, WS_XB); float* ss = WSP(float, WS_SS0);
        for (int m0 = gw; m0 < M; m0 += 2 * NGW) {
            f32x4 v[2][4];
#pragma unroll
            for (int k = 0; k < 2; ++k) { const int m = (m0 + k * NGW < M) ? m0 + k * NGW : m0; const GAS f32x4* xr = (const GAS f32x4*)(xin + (size_t)m * DM) + F.lane;
#pragma unroll
                for (int j = 0; j < 4; ++j) v[k][j] = __builtin_nontemporal_load((const f32x4*)(xr + 64 * j)); }
#pragma unroll
            for (int k = 0; k < 2; ++k) { const int m = m0 + k * NGW; if (m >= M) break;
                GAS unsigned long long* o8 = (GAS unsigned long long*)(xb + (size_t)m * DM) + F.lane; float s = 0.f;
#pragma unroll
                for (int j = 0; j < 4; ++j) { const f32x4 vv = v[k][j]; s += (vv.x * vv.x + vv.y * vv.y) + (vv.z * vv.z + vv.w * vv.w);
                    o8[64 * j] = (unsigned long long)pk2(vv.x, vv.y) | ((unsigned long long)pk2(vv.z, vv.w) << 32); }
                s = wave_allsum_slow(s);
                if (F.lane < 16) ss[(size_t)m * 16 + F.lane] = (F.lane == 0) ? s : 0.f; } }
    }
}
__device__ __forceinline__ void conv_p(Frame& F, const Args& A, int L) {
    KP_DECL;
    const float* p = INP(I_P) + (size_t)L * M * 256; bf16* pb = WSP(bf16, R_PB);
    const int gt = blockIdx.x * (NWAVES * 64) + F.tid, NGT = F.G * NWAVES * 64;
    for (int e0 = gt; e0 < M * 256 / 8; e0 += 4 * NGT) {
        f32x4 a[4], b[4];
#pragma unroll
        for (int k = 0; k < 4; ++k) { const int e = e0 + k * NGT; if (e < M * 256 / 8) { a[k] = __builtin_nontemporal_load((const f32x4*)(p + (size_t)e * 8)); b[k] = __builtin_nontemporal_load((const f32x4*)(p + (size_t)e * 8 + 4)); } }
#pragma unroll
        for (int k = 0; k < 4; ++k) { const int e = e0 + k * NGT; if (e < M * 256 / 8) {
            v4u o; o.x = pk2(a[k].x, a[k].y); o.y = pk2(a[k].z, a[k].w); o.z = pk2(b[k].x, b[k].y); o.w = pk2(b[k].z, b[k].w); *(v4u*)(pb + (size_t)e * 8) = o; } } }
}

__device__ __forceinline__ void phase_rprep1(Frame& F, const Args& A, int L) {
    KP_DECL;
    const bf16* zr = WSP(bf16, R_ZR); bf16* ap = WSP(bf16, R_AP); const float* mu = INP(I_MU) + L * 1792 + 1536;
    const int gt = blockIdx.x * (NWAVES * 64) + F.tid, NGT = F.G * NWAVES * 64;
    for (int e = gt; e < M * 32; e += NGT) { const int row = e >> 5, c0 = (e & 31) * 8; const int tl = row & (SEQ - 1);
        const v4u zc = *(const v4u*)(zr + (size_t)row * 1792 + 1536 + c0); v4u zp = (v4u){0u, 0u, 0u, 0u};
        if (tl != 0) zp = *(const v4u*)(zr + (size_t)(row - 1) * 1792 + 1536 + c0);
        float o[8];
#pragma unroll
        for (int i = 0; i < 4; ++i) { const unsigned wc_ = zc[i], wp_ = zp[i];
            const float c_lo = bflo(wc_), c_hi = bfhi(wc_), p_lo = bflo(wp_), p_hi = bfhi(wp_);
            const float m0 = mu[c0 + 2 * i], m1 = mu[c0 + 2 * i + 1];
            o[2 * i] = c_lo + m0 * (p_lo - c_lo); o[2 * i + 1] = c_hi + m1 * (p_hi - c_hi); }
#pragma unroll
        for (int i = 0; i < 8; ++i) { if (c0 < 64) o[i] = 2.0f * sigm(2.0f * o[i]) - 1.0f; else if (c0 >= 128) o[i] = sigm(o[i]); }
        v4u w; w.x = pk2(o[0], o[1]); w.y = pk2(o[2], o[3]); w.z = pk2(o[4], o[5]); w.w = pk2(o[6], o[7]);
        *(v4u*)(ap + (size_t)row * 256 + c0) = w; }
}
typedef float f32x16 __attribute__((ext_vector_type(16)));
__device__ __forceinline__ unsigned cvtpk(float lo, float hi) { return pg8::cvtpk_s(lo, hi); }
constexpr int LDP = 72;
__device__ __forceinline__ f32x4 mm16_k64(const LAS bf16* X, const LAS bf16* YT, int m0, int n0, int lane, f32x4 acc) {
    const int r = lane & 15, g = lane >> 4;
#pragma unroll
    for (int ks = 0; ks < 2; ++ks) { const bf16x8 a = *(const LAS bf16x8*)(X + (m0 + r) * LDP + ks * 32 + 8 * g); const bf16x8 b = *(const LAS bf16x8*)(YT + (n0 + r) * LDP + ks * 32 + 8 * g);
        acc = __builtin_amdgcn_mfma_f32_16x16x32_bf16(a, b, acc, 0, 0, 0); }
    return acc;
}
constexpr int RC_MAT = 64 * LDP * 2;
constexpr int RC_BH = 0, RC_KH = RC_MAT, RC_PC = 2 * RC_MAT, RC_RC = 3 * RC_MAT, RC_PT = 4 * RC_MAT, RC_AKP = 5 * RC_MAT, RC_RT = 6 * RC_MAT, RC_VT = 7 * RC_MAT;
constexpr int RC_XR = 8 * RC_MAT;
constexpr int RC_TI = 10 * RC_MAT;
constexpr int RC_ABP = 11 * RC_MAT;
constexpr int RC_TT = RC_ABP + 16384;
constexpr int RC_PS = RC_TT + 16384;
constexpr int RC_GC = RC_PS + 4096;
constexpr int RC_PAR = RC_GC + 256;
constexpr int RC_END = RC_PAR + 6 * 64 * 4;
static_assert(RC_END <= LDSCTL_OFF, "rwkv pre-pass LDS");
constexpr int RC_ZT = RC_PC;
constexpr int RC_KBT = RC_BH;
__device__ __forceinline__ float shx(float v, int m) { return __shfl_xor(v, m); }
__device__ __forceinline__ float sum8(float v) { v += dppf<0xB1>(v); v += dppf<0x4E>(v); v += dppf<0x141>(v); return v; }
__device__ __forceinline__ float sum16(float v) { v = sum8(v); v += dppf<0x128>(v); return v; }
__device__ __forceinline__ void phase_rchunk_pre(Frame& F, const Args& A, int L) {
    KP_DECL;
    const bf16* zr = WSP(bf16, R_ZR); const bf16* dw = WSP(bf16, R_DAG_W); const bf16* da = WSP(bf16, R_DAG_A);
    const float* mu = INP(I_MU) + L * 1792; const float* k_k = INP(I_KK) + L * 512; const float* k_a = INP(I_KA) + L * 512; const float* r_k = INP(I_RK) + L * 512;
    float* cbon = WSP(float, WS_CBON); bf16* gV = WSP(bf16, R_CV);
    LAS unsigned char* lds = F.lds;
    const int t = F.tid >> 3, cg = F.tid & 7, c0 = cg * 8;
    v4u n_cr, n_ck, n_cv, n_pr, n_pk, n_pv, n_ww, n_aa;
#define RPRE_LOAD(it_) do { const int bh_ = (it_) >> 7, ck2_ = (it_) & 127; const int row_ = (bh_ >> 3) * SEQ + ck2_ * 64 + t, ch_ = (bh_ & 7) * 64 + c0; const bf16* zc_ = zr + (size_t)row_ * 1792 + ch_; \
        n_cr = *(const v4u*)zc_; n_ck = *(const v4u*)(zc_ + 512); n_cv = *(const v4u*)(zc_ + 1024); n_pr = (v4u){0u,0u,0u,0u}; n_pk = n_pr; n_pv = n_pr; \
        if (ck2_ * 64 + t != 0) { n_pr = *(const v4u*)(zc_ - 1792); n_pk = *(const v4u*)(zc_ - 1792 + 512); n_pv = *(const v4u*)(zc_ - 1792 + 1024); } \
        n_ww = *(const v4u*)(dw + (size_t)row_ * 512 + ch_); n_aa = *(const v4u*)(da + (size_t)row_ * 512 + ch_); } while (0)
#define RPRE_ITEM(s_) (((((s_) >> 3) >> 7) * 8 + ((s_) & 7)) * 128 + (((s_) >> 3) & 127))
    if ((int)blockIdx.x < 2048) RPRE_LOAD(RPRE_ITEM((int)blockIdx.x));
    int h_par = -1; LAS float* PAR = (LAS float*)(lds + RC_PAR);
    for (int slot = blockIdx.x; slot < 2048; slot += F.G) { const int item = RPRE_ITEM(slot);
        const int bh = item >> 7, ck = item & 127, b = bh >> 3, h = bh & 7; const int row = b * SEQ + ck * 64 + t, ch = h * 64 + c0;
        if (h != h_par) { h_par = h;
            if (F.tid < 384) { const int a_ = F.tid >> 6, c_ = F.tid & 63; PAR[F.tid] = (a_ < 3) ? mu[a_ * 512 + h * 64 + c_] : (a_ == 3 ? k_k[h * 64 + c_] : (a_ == 4 ? k_a[h * 64 + c_] : r_k[h * 64 + c_])); }
            __syncthreads(); }
        float r_[8], kp_[8], kk_[8], bb_[8], lw_[8];
        { float v_[8]; const v4u cr = n_cr, ck_ = n_ck, cv = n_cv, pr = n_pr, pk = n_pk, pv = n_pv, ww = n_ww, aa = n_aa;
          float ssq = 0.f, cb = 0.f;
#pragma unroll
          for (int i = 0; i < 8; ++i) { const int q = i >> 1; const bool hi = i & 1;
              const float crf = hi ? bfhi(cr[q]) : bflo(cr[q]), ckf = hi ? bfhi(ck_[q]) : bflo(ck_[q]), cvf = hi ? bfhi(cv[q]) : bflo(cv[q]);
              const float prf = hi ? bfhi(pr[q]) : bflo(pr[q]), pkf = hi ? bfhi(pk[q]) : bflo(pk[q]), pvf = hi ? bfhi(pv[q]) : bflo(pv[q]);
              const float w = hi ? bfhi(ww[q]) : bflo(ww[q]), a = hi ? bfhi(aa[q]) : bflo(aa[q]);
              const float r = crf + PAR[c0 + i] * (prf - crf), k = ckf + PAR[64 + c0 + i] * (pkf - ckf), v = cvf + PAR[128 + c0 + i] * (pvf - cvf);
              const float kk = k * PAR[192 + c0 + i]; ssq += kk * kk; const float kp = k * (1.0f + (a - 1.0f) * PAR[256 + c0 + i]);
              r_[i] = r; kp_[i] = kp; kk_[i] = kk; bb_[i] = a; v_[i] = v; lw_[i] = __logf(w); cb += r * kp * PAR[320 + c0 + i]; }
          ssq = sum8(ssq); cb = sum8(cb);
          const float inv = __builtin_amdgcn_rsqf(fmaxf(ssq, 1e-24f));
#pragma unroll
          for (int i = 0; i < 8; ++i) { kk_[i] *= inv; bb_[i] *= kk_[i]; }
          if (cg == 0) cbon[(size_t)row * 8 + h] = cb;
          if (slot + F.G < 2048) RPRE_LOAD(RPRE_ITEM(slot + F.G));
          v4u vo; vo.x = pk2(v_[0], v_[1]); vo.y = pk2(v_[2], v_[3]); vo.z = pk2(v_[4], v_[5]); vo.w = pk2(v_[6], v_[7]); *(v4u*)(gV + (size_t)row * 512 + ch) = vo;
          { LAS bf16* VT = (LAS bf16*)(lds + RC_VT);
#pragma unroll
            for (int i = 0; i < 8; ++i) VT[(c0 + i) * LDP + t] = (bf16)f2bf(v_[i]); } }
        { LAS float* LW = (LAS float*)(lds + RC_ABP);
#pragma unroll
          for (int i = 0; i < 8; ++i) LW[t * 64 + c0 + i] = lw_[i];
          __syncthreads();
          { const int cc = F.tid & 63, sg = F.tid >> 6; float loc[8]; float run = 0.f;
            LAS float* SG = (LAS float*)(lds + RC_PS);
#pragma unroll
            for (int e = 0; e < 8; ++e) { run += LW[(8 * sg + e) * 64 + cc]; loc[e] = run; }
            SG[sg * 64 + cc] = run;
            __syncthreads();
            float pre = 0.f;
#pragma unroll
            for (int q = 0; q < 8; ++q) { const float tv = SG[q * 64 + cc]; if (q < sg) pre += tv; }
#pragma unroll
            for (int e = 0; e < 8; ++e) LW[(8 * sg + e) * 64 + cc] = pre + loc[e]; }
          __syncthreads();
          LAS bf16* Bh = (LAS bf16*)(lds + RC_BH); LAS bf16* Kh = (LAS bf16*)(lds + RC_KH); LAS bf16* Pc = (LAS bf16*)(lds + RC_PC); LAS bf16* Rc = (LAS bf16*)(lds + RC_RC);
          LAS bf16* PT = (LAS bf16*)(lds + RC_PT); LAS bf16* Rt = (LAS bf16*)(lds + RC_RT); LAS bf16* BhT = (LAS bf16*)(lds + RC_XR); LAS float* GC = (LAS float*)(lds + RC_GC);
          float bh_[8], kh_[8], pc_[8], rc_[8], rt_[8];
#pragma unroll
          for (int i = 0; i < 8; ++i) { const float Lt = LW[t * 64 + c0 + i], Lp = (t == 0) ? 0.f : LW[(t - 1) * 64 + c0 + i], LC = LW[63 * 64 + c0 + i];
              const float e1 = __expf(LC - Lt); bh_[i] = bb_[i] * e1; kh_[i] = kp_[i] * e1; pc_[i] = kk_[i] * __expf(Lp - LC); rc_[i] = r_[i] * __expf(Lt - LC); rt_[i] = r_[i] * __expf(Lt);
              PT[(c0 + i) * LDP + t] = (bf16)f2bf(kk_[i] * __expf(Lp)); BhT[(c0 + i) * LDP + t] = (bf16)f2bf(bh_[i]); if (t == 63) GC[c0 + i] = __expf(LC); }
          v4u o; o.x = pk2(bh_[0], bh_[1]); o.y = pk2(bh_[2], bh_[3]); o.z = pk2(bh_[4], bh_[5]); o.w = pk2(bh_[6], bh_[7]); *(LAS v4u*)(Bh + t * LDP + c0) = o;
          o.x = pk2(kh_[0], kh_[1]); o.y = pk2(kh_[2], kh_[3]); o.z = pk2(kh_[4], kh_[5]); o.w = pk2(kh_[6], kh_[7]); *(LAS v4u*)(Kh + t * LDP + c0) = o;
          o.x = pk2(pc_[0], pc_[1]); o.y = pk2(pc_[2], pc_[3]); o.z = pk2(pc_[4], pc_[5]); o.w = pk2(pc_[6], pc_[7]); *(LAS v4u*)(Pc + t * LDP + c0) = o;
          o.x = pk2(rc_[0], rc_[1]); o.y = pk2(rc_[2], rc_[3]); o.z = pk2(rc_[4], rc_[5]); o.w = pk2(rc_[6], rc_[7]); *(LAS v4u*)(Rc + t * LDP + c0) = o;
          o.x = pk2(rt_[0], rt_[1]); o.y = pk2(rt_[2], rt_[3]); o.z = pk2(rt_[4], rt_[5]); o.w = pk2(rt_[6], rt_[7]); *(LAS v4u*)(Rt + t * LDP + c0) = o;
          __syncthreads(); }
        f32x4 akr[4];
        { const int r16 = F.lane & 15, g4 = F.lane >> 4; const int xsel = F.wave >> 2, m0 = (F.wave & 3) * 16;
          const LAS bf16* X = (const LAS bf16*)(lds + (xsel ? RC_KH : RC_BH)) + (m0 + r16) * LDP + 8 * g4;
          const bf16x8 xa0 = *(const LAS bf16x8*)X, xa1 = *(const LAS bf16x8*)(X + 32);
          f32x4 acc[2][4];
#pragma unroll
          for (int ys = 0; ys < 2; ++ys)
#pragma unroll
              for (int nt = 0; nt < 4; ++nt) { const LAS bf16* Y = (const LAS bf16*)(lds + (ys ? RC_RC : RC_PC)) + (16 * nt + r16) * LDP + 8 * g4;
                  const bf16x8 b0 = *(const LAS bf16x8*)Y, b1 = *(const LAS bf16x8*)(Y + 32);
                  acc[ys][nt] = __builtin_amdgcn_mfma_f32_16x16x32_bf16(xa0, b0, (f32x4){0.f, 0.f, 0.f, 0.f}, 0, 0, 0); acc[ys][nt] = __builtin_amdgcn_mfma_f32_16x16x32_bf16(xa1, b1, acc[ys][nt], 0, 0, 0); }
#pragma unroll
          for (int nt = 0; nt < 4; ++nt) { const int tt = 16 * nt + r16; const int i0 = m0 + 4 * g4; float v0[4], v1[4];
#pragma unroll
              for (int rg = 0; rg < 4; ++rg) { v0[rg] = (i0 + rg < tt) ? acc[0][nt][rg] : 0.f; v1[rg] = (i0 + rg <= tt) ? acc[1][nt][rg] : 0.f; }
              if (xsel == 0) {
#pragma unroll
                  for (int rg = 0; rg < 4; ++rg) ((LAS float*)(lds + RC_ABP))[(i0 + rg) * 64 + tt] = v0[rg];
                  u32x2 o; o.x = pk2(v1[0], v1[1]); o.y = pk2(v1[2], v1[3]); *(LAS u32x2*)((LAS bf16*)(lds + RC_XR) + (64 + tt) * LDP + i0) = o; }
              else {
#pragma unroll
                  for (int rg = 0; rg < 4; ++rg) ((LAS bf16*)(lds + RC_AKP))[(i0 + rg) * LDP + tt] = (bf16)f2bf(v0[rg]);
                  akr[nt] = (f32x4){v1[0], v1[1], v1[2], v1[3]}; } }
          __syncthreads(); }
        { const LAS float* AB = (const LAS float*)(lds + RC_ABP); LAS float* TT = (LAS float*)(lds + RC_TT); LAS float* PS = (LAS float*)(lds + RC_PS);
          if (F.tid < 64) { const int a = F.tid >> 4, e = F.tid & 15; const LAS float* Aa = AB + (16 * a) * 64 + 16 * a; float x[16];
#pragma unroll
              for (int r = 15; r >= 0; --r) { float acc = (r == e) ? 1.0f : 0.f;
#pragma unroll
                  for (int j = r + 1; j < 16; ++j) acc = __builtin_fmaf(-Aa[r * 64 + j], x[j], acc);
                  x[r] = acc; }
#pragma unroll
              for (int r = 0; r < 16; ++r) TT[(16 * a + r) * 64 + 16 * a + e] = x[r]; }
          __syncthreads();
#pragma unroll 1
          for (int d = 1; d < 4; ++d) { const int nel = (4 - d) * 256;
              for (int el = F.tid; el < nel; el += NWAVES * 64) { const int a = el >> 8, r = (el >> 4) & 15, c = el & 15, b = a + d; float acc = 0.f;
                  for (int cc = a + 1; cc <= b; ++cc) { const LAS float* ar = AB + (16 * a + r) * 64 + 16 * cc; const LAS float* tc = TT + (16 * cc) * 64 + 16 * b + c;
#pragma unroll
                      for (int j = 0; j < 16; ++j) acc = __builtin_fmaf(ar[j], tc[j * 64], acc); }
                  PS[el] = acc; }
              __syncthreads();
              for (int el = F.tid; el < nel; el += NWAVES * 64) { const int a = el >> 8, r = (el >> 4) & 15, c = el & 15, b = a + d; float acc = 0.f; const LAS float* dr = TT + (16 * a + r) * 64 + 16 * a; const LAS float* sc = PS + (a << 8) + c;
#pragma unroll
                  for (int j = 0; j < 16; ++j) acc = __builtin_fmaf(-dr[j], sc[j * 16], acc);
                  TT[(16 * a + r) * 64 + 16 * b + c] = acc; }
              __syncthreads(); }
          { LAS bf16* TI = (LAS bf16*)(lds + RC_TI); float o[8];
#pragma unroll
            for (int i = 0; i < 8; ++i) o[i] = ((c0 + i) >> 4) >= (t >> 4) ? TT[t * 64 + c0 + i] : 0.f;
            v4u w; w.x = pk2(o[0], o[1]); w.y = pk2(o[2], o[3]); w.z = pk2(o[4], o[5]); w.w = pk2(o[6], o[7]); *(LAS v4u*)(TI + t * LDP + c0) = w; }
          __syncthreads();
          { const int r16 = F.lane & 15, g4 = F.lane >> 4; const int m0 = (F.wave & 3) * 16, cb0 = (F.wave >> 2) * 64;
            const LAS bf16* X = (const LAS bf16*)(lds + RC_TI) + (m0 + r16) * LDP + 8 * g4; const bf16x8 xa0 = *(const LAS bf16x8*)X, xa1 = *(const LAS bf16x8*)(X + 32);
            f32x4 zc[4];
#pragma unroll
            for (int nt = 0; nt < 4; ++nt) { const LAS bf16* Y = (const LAS bf16*)(lds + RC_XR) + (cb0 + 16 * nt + r16) * LDP + 8 * g4; const bf16x8 b0 = *(const LAS bf16x8*)Y, b1 = *(const LAS bf16x8*)(Y + 32);
                zc[nt] = __builtin_amdgcn_mfma_f32_16x16x32_bf16(xa0, b0, (f32x4){0.f, 0.f, 0.f, 0.f}, 0, 0, 0); zc[nt] = __builtin_amdgcn_mfma_f32_16x16x32_bf16(xa1, b1, zc[nt], 0, 0, 0); }
#pragma unroll
            for (int nt = 0; nt < 4; ++nt) { u32x2 o; o.x = pk2(zc[nt][0], zc[nt][1]); o.y = pk2(zc[nt][2], zc[nt][3]); *(LAS u32x2*)((LAS bf16*)(lds + RC_ZT) + (cb0 + 16 * nt + r16) * LDP + m0 + 4 * g4) = o; } } }
        __syncthreads();
        { const int r16 = F.lane & 15, g4 = F.lane >> 4; const int xsel = F.wave >> 2, m0 = (F.wave & 3) * 16, mm = m0 + 4 * g4;
          bf16* gG = WSP(bf16, R_CG) + (size_t)item * 4096; bf16* gQ = WSP(bf16, R_CQT) + (size_t)item * 4096; bf16* gD = WSP(bf16, R_CDT) + (size_t)item * 4096;
          const LAS float* GC = (const LAS float*)(lds + RC_GC);
          const LAS bf16* X = (const LAS bf16*)(lds + (xsel ? RC_AKP : RC_PT)) + (m0 + r16) * LDP + 8 * g4;
          const bf16x8 xa0 = *(const LAS bf16x8*)X, xa1 = *(const LAS bf16x8*)(X + 32);
          f32x4 acc[2][4];
#pragma unroll
          for (int ys = 0; ys < 2; ++ys)
#pragma unroll
              for (int nt = 0; nt < 4; ++nt) { const LAS bf16* Y = (const LAS bf16*)(lds + RC_ZT) + (64 * ys + 16 * nt + r16) * LDP + 8 * g4;
                  const bf16x8 b0 = *(const LAS bf16x8*)Y, b1 = *(const LAS bf16x8*)(Y + 32);
                  acc[ys][nt] = __builtin_amdgcn_mfma_f32_16x16x32_bf16(xa0, b0, (f32x4){0.f, 0.f, 0.f, 0.f}, 0, 0, 0); acc[ys][nt] = __builtin_amdgcn_mfma_f32_16x16x32_bf16(xa1, b1, acc[ys][nt], 0, 0, 0); }
#pragma unroll
          for (int nt = 0; nt < 4; ++nt) { const int nn = 16 * nt + r16;
              if (xsel == 0) {
                  { const int i2 = nn >> 5, rr = nn & 31, kt = mm >> 5, sx_ = (mm >> 4) & 1, qq = mm & 15, hh = (qq >> 2) & 1, jj0 = (qq >> 3) << 2;
                    float gv[4];
#pragma unroll
                    for (int rg = 0; rg < 4; ++rg) gv[rg] = ((mm + rg) == nn ? GC[nn] : 0.f) - acc[0][nt][rg];
                    u32x2 o; o.x = pk2(gv[0], gv[1]); o.y = pk2(gv[2], gv[3]); *(u32x2*)(gG + ((((i2 * 2 + kt) * 2 + sx_) * 64 + rr + 32 * hh) * 8 + jj0)) = o; }
                  { const LAS bf16* Rt = (const LAS bf16*)(lds + RC_RT); const u32x2 rv = *(const LAS u32x2*)(Rt + nn * LDP + mm);
                    u32x2 o; o.x = pk2(bflo(rv.x) - acc[1][nt][0], bfhi(rv.x) - acc[1][nt][1]); o.y = pk2(bflo(rv.y) - acc[1][nt][2], bfhi(rv.y) - acc[1][nt][3]); *(u32x2*)(gQ + nn * 64 + mm) = o; }
              } else {
                  { const LAS bf16* Kh = (const LAS bf16*)(lds + RC_KH); float kv[4];
#pragma unroll
                    for (int rg = 0; rg < 4; ++rg) kv[rg] = bf1(Kh[(mm + rg) * LDP + nn]) - acc[0][nt][rg];
                    u32x2 o; o.x = pk2(kv[0], kv[1]); o.y = pk2(kv[2], kv[3]); *(LAS u32x2*)((LAS bf16*)(lds + RC_KBT) + nn * LDP + mm) = o; }
                  { float dv[4];
#pragma unroll
                    for (int rg = 0; rg < 4; ++rg) dv[rg] = akr[nt][rg] - acc[1][nt][rg];
                    u32x2 o; o.x = pk2(dv[0], dv[1]); o.y = pk2(dv[2], dv[3]); *(u32x2*)(gD + nn * 64 + mm) = o; } } }
          __syncthreads();
          bf16* gH = WSP(bf16, R_CH) + (size_t)item * 4096;
#pragma unroll
          for (int q = 0; q < 2; ++q) { const int id = F.wave * 2 + q, m0 = (id >> 2) * 16, n0 = (id & 3) * 16;
              const f32x4 acc = mm16_k64((const LAS bf16*)(lds + RC_VT), (const LAS bf16*)(lds + RC_KBT), m0, n0, F.lane, (f32x4){0.f, 0.f, 0.f, 0.f});
              const int kq = n0 + r16, vv = m0 + 4 * g4;
              const int i2 = kq >> 5, kl = kq & 31, rg16 = (kl & 3) | ((kl >> 3) << 2), hh = (kl >> 2) & 1, j2 = vv >> 5;
              bf16* hq_ = gH + j2 * 2048 + ((vv & 31) + 32 * hh) * 32 + i2 * 16 + rg16;
#pragma unroll
              for (int rg = 0; rg < 4; ++rg) hq_[32 * rg] = (bf16)f2bf(acc[rg]); }
          __syncthreads(); }
    }
}
__device__ __forceinline__ void rchunk_seq(Frame& F, int wid) {
    const int bh = wid >> 1, j = wid & 1; const int r32 = F.lane & 31, hh = F.lane >> 5;
    const bf16* gG = WSP(bf16, R_CG) + (size_t)bh * 128 * 4096; const bf16* gH = WSP(bf16, R_CH) + (size_t)bh * 128 * 4096 + j * 2048 + F.lane * 32; bf16* gS = WSP(bf16, R_CS) + (size_t)bh * 128 * 4096;
    f32x16 x0, x1;
#pragma unroll
    for (int i = 0; i < 16; ++i) { x0[i] = 0.f; x1[i] = 0.f; }
    bf16x8 gA[8], gB[8]; v4u hA[4], hB[4];
#define RS_LOAD(G_, H_, cc) do { const int c_ = ((cc) < 128) ? (cc) : 127; _Pragma("unroll") for (int q = 0; q < 8; ++q) G_[q] = *(const bf16x8*)(gG + (size_t)c_ * 4096 + (q * 64 + F.lane) * 8); \
        _Pragma("unroll") for (int q = 0; q < 4; ++q) H_[q] = *(const v4u*)(gH + (size_t)c_ * 4096 + 8 * q); } while (0)
#define RS_STEP(G_, H_, cc) do { \
        f32x16 h0, h1; \
        _Pragma("unroll") for (int q = 0; q < 4; ++q) { h0[2 * q] = bflo(H_[0][q]); h0[2 * q + 1] = bfhi(H_[0][q]); h0[8 + 2 * q] = bflo(H_[1][q]); h0[8 + 2 * q + 1] = bfhi(H_[1][q]); \
                                                         h1[2 * q] = bflo(H_[2][q]); h1[2 * q + 1] = bfhi(H_[2][q]); h1[8 + 2 * q] = bflo(H_[3][q]); h1[8 + 2 * q + 1] = bfhi(H_[3][q]); } \
        unsigned xb0[8], xb1[8]; \
        _Pragma("unroll") for (int q = 0; q < 8; ++q) { xb0[q] = cvtpk(x0[2 * q], x0[2 * q + 1]); xb1[q] = cvtpk(x1[2 * q], x1[2 * q + 1]); } \
        { bf16* sp = gS + (size_t)(cc) * 4096 + (32 * j + r32) * 64 + 8 * hh;     \
          _Pragma("unroll") for (int mq = 0; mq < 2; ++mq) { \
              { auto s0 = __builtin_amdgcn_permlane32_swap(xb0[4 * mq], xb0[4 * mq + 2], false, false); auto s1 = __builtin_amdgcn_permlane32_swap(xb0[4 * mq + 1], xb0[4 * mq + 3], false, false); \
                v4u o; o.x = s0[0]; o.y = s1[0]; o.z = s0[1]; o.w = s1[1]; *(v4u*)(sp + 16 * mq) = o; } \
              { auto s0 = __builtin_amdgcn_permlane32_swap(xb1[4 * mq], xb1[4 * mq + 2], false, false); auto s1 = __builtin_amdgcn_permlane32_swap(xb1[4 * mq + 1], xb1[4 * mq + 3], false, false); \
                v4u o; o.x = s0[0]; o.y = s1[0]; o.z = s0[1]; o.w = s1[1]; *(v4u*)(sp + 32 + 16 * mq) = o; } } } \
        const bf16x8 b00 = __builtin_bit_cast(bf16x8, (v4u){xb0[0], xb0[1], xb0[2], xb0[3]}), b01 = __builtin_bit_cast(bf16x8, (v4u){xb0[4], xb0[5], xb0[6], xb0[7]}); \
        const bf16x8 b10 = __builtin_bit_cast(bf16x8, (v4u){xb1[0], xb1[1], xb1[2], xb1[3]}), b11 = __builtin_bit_cast(bf16x8, (v4u){xb1[4], xb1[5], xb1[6], xb1[7]}); \
        h0 = __builtin_amdgcn_mfma_f32_32x32x16_bf16(G_[0], b00, h0, 0, 0, 0); h1 = __builtin_amdgcn_mfma_f32_32x32x16_bf16(G_[4], b00, h1, 0, 0, 0); \
        h0 = __builtin_amdgcn_mfma_f32_32x32x16_bf16(G_[1], b01, h0, 0, 0, 0); h1 = __builtin_amdgcn_mfma_f32_32x32x16_bf16(G_[5], b01, h1, 0, 0, 0); \
        h0 = __builtin_amdgcn_mfma_f32_32x32x16_bf16(G_[2], b10, h0, 0, 0, 0); h1 = __builtin_amdgcn_mfma_f32_32x32x16_bf16(G_[6], b10, h1, 0, 0, 0); \
        h0 = __builtin_amdgcn_mfma_f32_32x32x16_bf16(G_[3], b11, h0, 0, 0, 0); h1 = __builtin_amdgcn_mfma_f32_32x32x16_bf16(G_[7], b11, h1, 0, 0, 0); \
        x0 = h0; x1 = h1; RS_LOAD(G_, H_, (cc) + 2); } while (0)
    RS_LOAD(gA, hA, 0); RS_LOAD(gB, hB, 1);
    for (int c = 0; c < 128; c += 2) { RS_STEP(gA, hA, c); RS_STEP(gB, hB, c + 1); }
#undef RS_LOAD
#undef RS_STEP
}
constexpr int RO_SX = 0, RO_QT = RC_MAT, RO_DT = 2 * RC_MAT, RO_VT = 3 * RC_MAT, RO_Y = 4 * RC_MAT, RO_HALF = RO_Y + 64 * 68 * 4;
constexpr int RO_PAR = 2 * RO_HALF;
static_assert(RO_PAR + 4096 <= LDSCTL_OFF, "rwkv output pass LDS (parameters)");
static_assert(2 * RO_HALF <= LDSCTL_OFF, "rwkv output pass LDS");
__device__ __forceinline__ void phase_rchunk_out(Frame& F, const Args& A, int L) {
    KP_DECL;
    const float* lnw = INP(I_LNW) + L * 512; const float* lnb = INP(I_LNB) + L * 512;
    const bf16* gV = WSP(bf16, R_CV); const bf16* dg = WSP(bf16, R_DAG_G); const float* cbon = WSP(float, WS_CBON); bf16* y1 = WSP(bf16, R_Y) + (size_t)M * 512;
    const int half = F.tid >> 8, ht = F.tid & 255, t = ht >> 2, c0 = (ht & 3) * 16, hw = F.wave & 3;
    LAS unsigned char* lds = F.lds + half * RO_HALF;
    { LAS float* PAR = (LAS float*)(F.lds + RO_PAR); const int pt = F.wave * 64 + (int)__builtin_amdgcn_mbcnt_hi(~0u, __builtin_amdgcn_mbcnt_lo(~0u, 0u));
      PAR[pt] = lnw[pt]; PAR[512 + pt] = lnb[pt]; }
    const LAS float* PW = (const LAS float*)(F.lds + RO_PAR); const LAS float* PB = PW + 512;
    v4u n_sx[2], n_qt[2], n_dt[2], n_vv[2], n_gg[2]; float n_cb;
#define ROUT_LOAD(it_) do { const int bh_ = (it_) >> 7, ck_ = (it_) & 127; const int row_ = (bh_ >> 3) * SEQ + ck_ * 64 + t; \
        _Pragma("unroll") for (int e = 0; e < 2; ++e) { n_sx[e] = __builtin_nontemporal_load((const v4u*)(WSP(bf16, R_CS) + (size_t)(it_) * 4096 + t * 64 + c0 + 8 * e)); n_qt[e] = __builtin_nontemporal_load((const v4u*)(WSP(bf16, R_CQT) + (size_t)(it_) * 4096 + t * 64 + c0 + 8 * e)); \
            n_dt[e] = __builtin_nontemporal_load((const v4u*)(WSP(bf16, R_CDT) + (size_t)(it_) * 4096 + t * 64 + c0 + 8 * e)); n_vv[e] = __builtin_nontemporal_load((const v4u*)(gV + (size_t)row_ * 512 + (bh_ & 7) * 64 + c0 + 8 * e)); n_gg[e] = __builtin_nontemporal_load((const v4u*)(dg + (size_t)row_ * 512 + (bh_ & 7) * 64 + c0 + 8 * e)); } \
        n_cb = cbon[(size_t)row_ * 8 + (bh_ & 7)]; } while (0)
    const int it0 = (int)blockIdx.x + half * F.G;
    if (it0 < 2048) ROUT_LOAD(it0);
    for (int base = blockIdx.x; base < 2048; base += 2 * F.G) {
        const int item = base + half * F.G; const bool valid = item < 2048;
        const int bh = item >> 7, ck = item & 127, b = bh >> 3, h = bh & 7; const int row = b * SEQ + ck * 64 + t, ch = h * 64 + c0;
        v4u vv[2], gv[2]; float cb = 0.f;
        if (valid) { cb = n_cb;
#pragma unroll
            for (int e = 0; e < 2; ++e) { vv[e] = n_vv[e]; gv[e] = n_gg[e];
                *(LAS v4u*)((LAS bf16*)(lds + RO_SX) + t * LDP + c0 + 8 * e) = n_sx[e]; *(LAS v4u*)((LAS bf16*)(lds + RO_QT) + t * LDP + c0 + 8 * e) = n_qt[e]; *(LAS v4u*)((LAS bf16*)(lds + RO_DT) + t * LDP + c0 + 8 * e) = n_dt[e];
                LAS bf16* VT = (LAS bf16*)(lds + RO_VT);
#pragma unroll
                for (int i = 0; i < 4; ++i) { VT[(c0 + 8 * e + 2 * i) * LDP + t] = (bf16)(vv[e][i] & 0xffffu); VT[(c0 + 8 * e + 2 * i + 1) * LDP + t] = (bf16)(vv[e][i] >> 16); } }
            if (item + 2 * F.G < 2048) ROUT_LOAD(item + 2 * F.G); }
        __syncthreads();
        if (valid) { const int r16 = F.lane & 15, g4 = F.lane >> 4, m0 = 16 * hw; LAS float* YL = (LAS float*)(lds + RO_Y);
            const LAS bf16* X1 = (const LAS bf16*)(lds + RO_SX) + (m0 + r16) * LDP + 8 * g4; const LAS bf16* X2 = (const LAS bf16*)(lds + RO_VT) + (m0 + r16) * LDP + 8 * g4;
            const bf16x8 a0 = *(const LAS bf16x8*)X1, a1 = *(const LAS bf16x8*)(X1 + 32), a2 = *(const LAS bf16x8*)X2, a3 = *(const LAS bf16x8*)(X2 + 32);
            f32x4 acc[4];
#pragma unroll
            for (int q = 0; q < 4; ++q) { const LAS bf16* Y1 = (const LAS bf16*)(lds + RO_QT) + (16 * q + r16) * LDP + 8 * g4; const LAS bf16* Y2 = (const LAS bf16*)(lds + RO_DT) + (16 * q + r16) * LDP + 8 * g4;
                acc[q] = __builtin_amdgcn_mfma_f32_16x16x32_bf16(a0, *(const LAS bf16x8*)Y1, (f32x4){0.f, 0.f, 0.f, 0.f}, 0, 0, 0); acc[q] = __builtin_amdgcn_mfma_f32_16x16x32_bf16(a1, *(const LAS bf16x8*)(Y1 + 32), acc[q], 0, 0, 0);
                acc[q] = __builtin_amdgcn_mfma_f32_16x16x32_bf16(a2, *(const LAS bf16x8*)Y2, acc[q], 0, 0, 0); acc[q] = __builtin_amdgcn_mfma_f32_16x16x32_bf16(a3, *(const LAS bf16x8*)(Y2 + 32), acc[q], 0, 0, 0); }
#pragma unroll
            for (int q = 0; q < 4; ++q) *(LAS f32x4*)(YL + (16 * q + r16) * 68 + m0 + 4 * g4) = acc[q]; }
        __syncthreads();
        if (valid) { const LAS float* YL = (const LAS float*)(lds + RO_Y) + t * 68 + c0; float y[16], s_ = 0.f;
#pragma unroll
            for (int i = 0; i < 16; ++i) { y[i] = YL[i]; s_ += y[i]; }
            s_ += dppf<0xB1>(s_); s_ += dppf<0x4E>(s_); const float mean = s_ * (1.0f / 64.0f); float q2 = 0.f;
#pragma unroll
            for (int i = 0; i < 16; ++i) { y[i] -= mean; q2 += y[i] * y[i]; }
            q2 += dppf<0xB1>(q2); q2 += dppf<0x4E>(q2); const float rstd = __builtin_amdgcn_rsqf(q2 * (1.0f / 64.0f) + 64e-5f);
#pragma unroll
            for (int e = 0; e < 2; ++e) { const v4u gg = gv[e]; float o[8];
#pragma unroll
                for (int i = 0; i < 8; ++i) { const int q = i >> 1; const bool hi = i & 1; const float vf = hi ? bfhi(vv[e][q]) : bflo(vv[e][q]), gf = hi ? bfhi(gg[q]) : bflo(gg[q]);
                    o[i] = (y[8 * e + i] * rstd * PW[ch + 8 * e + i] + PB[ch + 8 * e + i] + cb * vf) * gf; }
                v4u w; w.x = pk2(o[0], o[1]); w.y = pk2(o[2], o[3]); w.z = pk2(o[4], o[5]); w.w = pk2(o[6], o[7]); *(v4u*)(y1 + (size_t)row * 512 + ch + 8 * e) = w; } }
        __syncthreads();
    }
#undef ROUT_LOAD
}
template <int KS, int LDX, int LDY> __device__ __forceinline__ f32x4 mm16(const LAS bf16* X, const LAS bf16* YT, int m0, int n0, int lane, f32x4 acc) {
    const int r = lane & 15, g = lane >> 4;
#pragma unroll
    for (int ks = 0; ks < KS; ++ks) { const bf16x8 a = *(const LAS bf16x8*)(X + (m0 + r) * LDX + ks * 32 + 8 * g); const bf16x8 b = *(const LAS bf16x8*)(YT + (n0 + r) * LDY + ks * 32 + 8 * g);
        acc = __builtin_amdgcn_mfma_f32_16x16x32_bf16(a, b, acc, 0, 0, 0); }
    return acc;
}
__device__ __forceinline__ float hg_lf(float key) { return fmaxf(__logf(fmaxf(1.0f - key, 1e-30f)), -30.0f); }
constexpr int H1_LD = 136;
constexpr int H1_KT = 0, H1_VT = 128 * H1_LD * 2, H1_SEG = 2 * 128 * H1_LD * 2, H1_END = H1_SEG + 4 * 128 * 4;
__device__ __forceinline__ void phase_h1(Frame& F, int first, int stride) {
    const bf16* zh = (const bf16*)F.x; bf16* Hg = WSP(bf16, R_HST); float* Dg = WSP(float, WS_HD);
    LAS unsigned char* lds = F.lds; LAS bf16* KT = (LAS bf16*)(lds + H1_KT); LAS bf16* VT = (LAS bf16*)(lds + H1_VT); LAS float* SEG = (LAS float*)(lds + H1_SEG);
    const int k = F.tid & 127, seg = F.tid >> 7; const int r16 = F.lane & 15, g4 = F.lane >> 4;
    for (int item = first; item < 256; item += stride) { const int bh = item >> 5, m = item & 31, b = bh >> 2, h = bh & 3; const size_t row0 = (size_t)b * SEQ + m * 256;
        f32x4 acc[8];
#pragma unroll
        for (int nt = 0; nt < 8; ++nt) acc[nt] = (f32x4){0.f, 0.f, 0.f, 0.f};
        float carry = 0.f;
#pragma unroll 1
        for (int half = 1; half >= 0; --half) { const size_t rb = row0 + 128 * half;
            float key[32], lf[32]; float tot = 0.f;
#pragma unroll
            for (int j = 0; j < 32; ++j) { key[j] = bf1(zh[(rb + 32 * seg + j) * 2048 + 512 + h * 128 + k]); lf[j] = hg_lf(key[j]); tot += lf[j]; }
            SEG[seg * 128 + k] = tot;
            { const int s = F.tid >> 2, part = F.tid & 3; const bf16* vp = zh + (rb + s) * 2048 + 1024 + h * 128 + part * 32;
#pragma unroll
              for (int c = 0; c < 4; ++c) { const v4u vv = *(const v4u*)(vp + 8 * c);
#pragma unroll
                  for (int i = 0; i < 4; ++i) { VT[(part * 32 + 8 * c + 2 * i) * H1_LD + s] = (bf16)(vv[i] & 0xffffu); VT[(part * 32 + 8 * c + 2 * i + 1) * H1_LD + s] = (bf16)(vv[i] >> 16); } } }
            __syncthreads();
            float off = carry, all = 0.f;
#pragma unroll
            for (int sg = 0; sg < 4; ++sg) { const float tt = SEG[sg * 128 + k]; all += tt; if (sg > seg) off += tt; }
            carry += all;
            float e = off;
#pragma unroll
            for (int j = 31; j >= 0; --j) { KT[k * H1_LD + 32 * seg + j] = (bf16)f2bf(key[j] * __expf(e)); e += lf[j]; }
            __syncthreads();
#pragma unroll
            for (int nt = 0; nt < 8; ++nt) acc[nt] = mm16<4, H1_LD, H1_LD>(KT, VT, 16 * F.wave, 16 * nt, F.lane, acc[nt]);
            __syncthreads(); }
        if (F.tid < 128) Dg[(size_t)item * 128 + k] = __expf(carry);
        bf16* hp = Hg + (size_t)item * 16384;
#pragma unroll
        for (int nt = 0; nt < 8; ++nt) { u32x2 o; o.x = pk2(acc[nt][0], acc[nt][1]); o.y = pk2(acc[nt][2], acc[nt][3]); *(u32x2*)(hp + (16 * nt + r16) * 128 + 16 * F.wave + 4 * g4) = o; }
    }
}
__device__ __forceinline__ void phase_h2(Frame& F) {
    bf16* Hg = WSP(bf16, R_HST); const float* Dg = WSP(float, WS_HD);
    const int gt = blockIdx.x * (NWAVES * 64) + F.tid, NGT = F.G * NWAVES * 64;
    for (int idx = gt; idx < 8 * 16384; idx += NGT) { const int bh = idx >> 14, e = idx & 16383; float s = 0.f;
#pragma unroll 4
        for (int m = 0; m < 32; ++m) { const size_t o = ((size_t)(bh * 32 + m) << 14) + e; const float hv = bf1(Hg[o]); Hg[o] = (bf16)f2bf(s); s = __builtin_fmaf(Dg[(bh * 32 + m) * 128 + (e & 127)], s, hv); } }
}
constexpr int H3_LDK = 136, H3_LDS = 40;
constexpr int H3_QC = 0, H3_KH = H3_QC + 32 * H3_LDK * 2, H3_KHT = H3_KH + 32 * H3_LDK * 2, H3_VT = H3_KHT + 128 * H3_LDS * 2, H3_ST = H3_VT + 128 * H3_LDS * 2, H3_AL = H3_ST + 128 * H3_LDK * 2,
              H3_OL = H3_AL + 32 * H3_LDS * 2, H3_SEG = H3_OL + 32 * 132 * 4, H3_DD = H3_SEG + 4 * 128 * 4, H3_END = H3_DD + 128 * 4;
static_assert(H3_END <= LDSCTL_OFF && H1_END <= LDSCTL_OFF, "hgrn LDS");
__device__ __forceinline__ void phase_h3(Frame& F, const Args& A, int L) {
    KP_DECL;
    const bf16* zh = (const bf16*)F.x; const bf16* Hg = WSP(bf16, R_HST); bf16* y2 = WSP(bf16, R_Y) + (size_t)2 * M * 512; const float* ng = INP(I_HNORM) + L * 128;
    LAS unsigned char* lds = F.lds; LAS bf16* QC = (LAS bf16*)(lds + H3_QC); LAS bf16* KH = (LAS bf16*)(lds + H3_KH); LAS bf16* KHT = (LAS bf16*)(lds + H3_KHT); LAS bf16* VT = (LAS bf16*)(lds + H3_VT);
    LAS bf16* ST = (LAS bf16*)(lds + H3_ST); LAS bf16* AL = (LAS bf16*)(lds + H3_AL); LAS float* OL = (LAS float*)(lds + H3_OL); LAS float* SEG = (LAS float*)(lds + H3_SEG); LAS float* DD = (LAS float*)(lds + H3_DD);
    const int k = F.tid & 127, seg = F.tid >> 7; const int r16 = F.lane & 15, g4 = F.lane >> 4;
    float ngv[8];
#pragma unroll
    for (int i = 0; i < 8; ++i) ngv[i] = ng[(F.tid & 15) * 8 + i];
    for (int item = blockIdx.x; item < 256; item += F.G) { const int bh = item >> 5, m = item & 31, b = bh >> 2, h = bh & 3; const size_t row0 = (size_t)b * SEQ + m * 256;
        f32x4 acc[8];
        { const bf16* hp = Hg + (size_t)item * 16384;
#pragma unroll
          for (int nt = 0; nt < 8; ++nt) { const u32x2 w = *(const u32x2*)(hp + (16 * nt + r16) * 128 + 16 * F.wave + 4 * g4); acc[nt] = (f32x4){bflo(w.x), bfhi(w.x), bflo(w.y), bfhi(w.y)}; } }
        bf16 nq[8], nk[8]; v4u nvv, ngg;
#define H3_LOAD(cc) do { const size_t rb_ = row0 + 32 * (cc); _Pragma("unroll") for (int j = 0; j < 8; ++j) { const bf16* zp = zh + (rb_ + 8 * seg + j) * 2048 + h * 128 + k; nq[j] = __builtin_nontemporal_load(zp); nk[j] = __builtin_nontemporal_load(zp + 512); } \
            nvv = __builtin_nontemporal_load((const v4u*)(zh + (rb_ + (F.tid >> 4)) * 2048 + 1024 + h * 128 + (F.tid & 15) * 8)); ngg = __builtin_nontemporal_load((const v4u*)(zh + (rb_ + (F.tid >> 4)) * 2048 + 1536 + h * 128 + (F.tid & 15) * 8)); } while (0)
        H3_LOAD(0);
#pragma unroll 1
        for (int c = 0; c < 8; ++c) { const size_t rb = row0 + 32 * c;
            float key[8], qv[8], bcs[8]; float run = 0.f;
#pragma unroll
            for (int j = 0; j < 8; ++j) { qv[j] = bf1(nq[j]); key[j] = bf1(nk[j]); run += hg_lf(key[j]); bcs[j] = run; }
            const v4u vv = nvv, gg = ngg;
            if (c < 7) H3_LOAD(c + 1);
            SEG[seg * 128 + k] = run;
            { const int s = F.tid >> 4, part = F.tid & 15;
#pragma unroll
              for (int i = 0; i < 4; ++i) { VT[(part * 8 + 2 * i) * H3_LDS + s] = (bf16)(vv[i] & 0xffffu); VT[(part * 8 + 2 * i + 1) * H3_LDS + s] = (bf16)(vv[i] >> 16); } }
            __syncthreads();
            float pre = 0.f, all = 0.f;
#pragma unroll
            for (int sg = 0; sg < 4; ++sg) { const float tt = SEG[sg * 128 + k]; all += tt; if (sg < seg) pre += tt; }
#pragma unroll
            for (int j = 0; j < 8; ++j) { const float bt = pre + bcs[j]; const int t = 8 * seg + j;
                QC[t * H3_LDK + k] = (bf16)f2bf(qv[j] * __expf(bt - all)); const bf16 kh = (bf16)f2bf(key[j] * __expf(all - bt)); KH[t * H3_LDK + k] = kh; KHT[k * H3_LDS + t] = kh; }
            if (seg == 0) DD[k] = __expf(all);
            __syncthreads();
            { const f32x4 dv = *(const LAS f32x4*)(DD + 16 * F.wave + 4 * g4);
#pragma unroll
              for (int nt = 0; nt < 8; ++nt) { acc[nt] = acc[nt] * dv; u32x2 o; o.x = pk2(acc[nt][0], acc[nt][1]); o.y = pk2(acc[nt][2], acc[nt][3]); *(LAS u32x2*)(ST + (16 * nt + r16) * H3_LDK + 16 * F.wave + 4 * g4) = o; } }
            if (F.wave < 4) { const int m0 = (F.wave >> 1) * 16, n0 = (F.wave & 1) * 16; const f32x4 a = mm16<4, H3_LDK, H3_LDK>(QC, KH, m0, n0, F.lane, (f32x4){0.f, 0.f, 0.f, 0.f});
#pragma unroll
                for (int rg = 0; rg < 4; ++rg) { const int t = m0 + 4 * g4 + rg, s = n0 + r16; AL[t * H3_LDS + s] = (bf16)f2bf(s <= t ? a[rg] : 0.f); } }
            __syncthreads();
#pragma unroll
            for (int q = 0; q < 2; ++q) { const int id = 2 * F.wave + q, m0 = (id >> 3) * 16, n0 = (id & 7) * 16;
                f32x4 o = mm16<4, H3_LDK, H3_LDK>(QC, ST, m0, n0, F.lane, (f32x4){0.f, 0.f, 0.f, 0.f}); o = mm16<1, H3_LDS, H3_LDS>(AL, VT, m0, n0, F.lane, o);
#pragma unroll
                for (int rg = 0; rg < 4; ++rg) OL[(m0 + 4 * g4 + rg) * 132 + n0 + r16] = o[rg]; }
#pragma unroll
            for (int nt = 0; nt < 8; ++nt) acc[nt] = mm16<1, H3_LDS, H3_LDS>(KHT, VT, 16 * F.wave, 16 * nt, F.lane, acc[nt]);
            __syncthreads();
            { const int t = F.tid >> 4, part = F.tid & 15; const LAS float* op = OL + t * 132 + part * 8; float o[8], ss = 0.f;
#pragma unroll
              for (int i = 0; i < 8; ++i) { o[i] = op[i]; ss += o[i] * o[i]; }
              ss = sum16(ss);
              const float rs = __builtin_amdgcn_rsqf(ss * (1.0f / 128.0f) + 1e-6f); const size_t row = rb + t;
              float y[8];
#pragma unroll
              for (int i = 0; i < 8; ++i) { const int q = i >> 1; const float gf = (i & 1) ? bfhi(gg[q]) : bflo(gg[q]); y[i] = o[i] * rs * ngv[i] * gf; }
              v4u w; w.x = pk2(y[0], y[1]); w.y = pk2(y[2], y[3]); w.z = pk2(y[4], y[5]); w.w = pk2(y[6], y[7]); *(v4u*)(y2 + row * 512 + h * 128 + part * 8) = w; }
        }
        __syncthreads();
    }
}
constexpr int AT_KLD = 72, AT_VLD = 260, AT_K = 0, AT_VT = 256 * AT_KLD * 2, AT_END = AT_VT + 64 * AT_VLD * 2;
static_assert(AT_END <= LDSCTL_OFF, "attention LDS");
__device__ __forceinline__ void phase_attn_mfma(Frame& F, const Args& A, int L) {
    KP_DECL;
    const bf16* za = WSP(bf16, R_ZA); bf16* y0 = WSP(bf16, R_Y); const float* sinks = INP(I_SINK) + L * 8;
    LAS bf16* KI = (LAS bf16*)(F.lds + AT_K); LAS bf16* VT = (LAS bf16*)(F.lds + AT_VT);
    const int c32 = F.lane & 31, hh = F.lane >> 5;
    for (int item = blockIdx.x; item < 256; item += F.G) { const int b = item >> 7, kvh = (item >> 6) & 1, n = item & 63; const int rowq0 = b * SEQ + n * 128, rowk0 = rowq0 - 128;
        { const int key = F.tid >> 1, half = F.tid & 1; const bool valid = (n > 0) || key >= 128; const bf16* src = za + (size_t)(rowk0 + key) * 768 + kvh * 64 + half * 32;
#pragma unroll
          for (int c = 0; c < 4; ++c) { v4u kk = (v4u){0u, 0u, 0u, 0u}, vv = kk; if (valid) { kk = *(const v4u*)(src + 512 + 8 * c); vv = *(const v4u*)(src + 640 + 8 * c); }
              *(LAS v4u*)(KI + key * AT_KLD + half * 32 + 8 * c) = kk;
#pragma unroll
              for (int i = 0; i < 4; ++i) { VT[(half * 32 + 8 * c + 2 * i) * AT_VLD + key] = (bf16)(vv[i] & 0xffffu); VT[(half * 32 + 8 * c + 2 * i + 1) * AT_VLD + key] = (bf16)(vv[i] >> 16); } } }
        __syncthreads();
#pragma unroll 1
        for (int rep = 0; rep < 2; ++rep) { const int id = F.wave * 2 + rep, g = id >> 2, u = id & 3, hq = kvh * 4 + g; const int qrow = rowq0 + 32 * u + c32, qi = 32 * u + c32;
            bf16x8 qf[4];
#pragma unroll
            for (int s = 0; s < 4; ++s) qf[s] = *(const bf16x8*)(za + (size_t)qrow * 768 + hq * 64 + 16 * s + 8 * hh);
            f32x16 st[5];
#pragma unroll
            for (int j = 0; j < 5; ++j) { f32x16 acc;
#pragma unroll
                for (int i = 0; i < 16; ++i) acc[i] = 0.f;
#pragma unroll
                for (int s = 0; s < 4; ++s) { const bf16x8 a = *(const LAS bf16x8*)(KI + (32 * (u + j) + c32) * AT_KLD + 16 * s + 8 * hh); acc = __builtin_amdgcn_mfma_f32_32x32x16_bf16(a, qf[s], acc, 0, 0, 0); }
                st[j] = acc; }
            const float sink = sinks[hq]; float mx = sink;
#pragma unroll
            for (int j = 0; j < 5; ++j)
#pragma unroll
                for (int rg = 0; rg < 16; ++rg) { const int kj = 32 * (u + j) + (rg & 3) + 8 * (rg >> 2) + 4 * hh; const bool ok = (kj > qi) && (kj <= qi + 128) && (n > 0 || kj >= 128);
                    const float v = ok ? st[j][rg] * 0.125f : -1e30f; st[j][rg] = v; mx = fmaxf(mx, v); }
            mx = fmaxf(mx, __shfl_xor(mx, 32));
            float sum = 0.f;
#pragma unroll
            for (int j = 0; j < 5; ++j)
#pragma unroll
                for (int rg = 0; rg < 16; ++rg) { const float p = __expf(st[j][rg] - mx); st[j][rg] = p; sum += p; }
            sum += __shfl_xor(sum, 32);
            const float inv = 1.0f / (sum + __expf(sink - mx));
            f32x16 o0, o1;
#pragma unroll
            for (int i = 0; i < 16; ++i) { o0[i] = 0.f; o1[i] = 0.f; }
#pragma unroll
            for (int j = 0; j < 5; ++j)
#pragma unroll
                for (int s = 0; s < 2; ++s) { v4u pw; pw.x = pg8::cvtpk_s(st[j][8 * s], st[j][8 * s + 1]); pw.y = pg8::cvtpk_s(st[j][8 * s + 2], st[j][8 * s + 3]); pw.z = pg8::cvtpk_s(st[j][8 * s + 4], st[j][8 * s + 5]); pw.w = pg8::cvtpk_s(st[j][8 * s + 6], st[j][8 * s + 7]);
                    const bf16x8 pb = __builtin_bit_cast(bf16x8, pw); const int k0 = 32 * (u + j) + 16 * s + 4 * hh;
                    { const u32x2 lo = *(const LAS u32x2*)(VT + c32 * AT_VLD + k0), hi = *(const LAS u32x2*)(VT + c32 * AT_VLD + k0 + 8); const bf16x8 va = __builtin_bit_cast(bf16x8, (v4u){lo.x, lo.y, hi.x, hi.y});
                      o0 = __builtin_amdgcn_mfma_f32_32x32x16_bf16(va, pb, o0, 0, 0, 0); }
                    { const u32x2 lo = *(const LAS u32x2*)(VT + (32 + c32) * AT_VLD + k0), hi = *(const LAS u32x2*)(VT + (32 + c32) * AT_VLD + k0 + 8); const bf16x8 va = __builtin_bit_cast(bf16x8, (v4u){lo.x, lo.y, hi.x, hi.y});
                      o1 = __builtin_amdgcn_mfma_f32_32x32x16_bf16(va, pb, o1, 0, 0, 0); } }
            bf16* yp = y0 + (size_t)qrow * 512 + hq * 64 + 4 * hh;
#pragma unroll
            for (int q4 = 0; q4 < 4; ++q4) { u32x2 w; w.x = pk2(o0[4 * q4] * inv, o0[4 * q4 + 1] * inv); w.y = pk2(o0[4 * q4 + 2] * inv, o0[4 * q4 + 3] * inv); *(u32x2*)(yp + 8 * q4) = w;
                w.x = pk2(o1[4 * q4] * inv, o1[4 * q4 + 1] * inv); w.y = pk2(o1[4 * q4 + 2] * inv, o1[4 * q4 + 3] * inv); *(u32x2*)(yp + 32 + 8 * q4) = w; }
        }
        __syncthreads();
    }
}
__device__ __forceinline__ void phase_final(Frame& F, const Args& A) {
    KP_DECL;
    const float* g = INP(I_FINN); const bf16* xb = WSP(bf16, R_XBALT); const float* ss = WSP(float, WS_SS0);
    const int gw = blockIdx.x * NWAVES + F.wave, NGW = F.G * NWAVES;
    const int lane_ = (int)__builtin_amdgcn_mbcnt_hi(~0u, __builtin_amdgcn_mbcnt_lo(~0u, 0u));
    f32x4 gg[2][2];
#pragma unroll
    for (int j = 0; j < 2; ++j) { gg[j][0] = *(const f32x4*)(g + j * 512 + lane_ * 8); gg[j][1] = *(const f32x4*)(g + j * 512 + lane_ * 8 + 4); }
    for (int m0 = gw; m0 < M; m0 += 4 * NGW) {
        const int mr = m0 + (lane_ >> 4) * NGW; const float pq = (mr < M) ? ss[(size_t)mr * 16 + (lane_ & 15)] : 1.0f;
        v4u w[4][2];
#pragma unroll
        for (int k = 0; k < 4; ++k) { const int m = (m0 + k * NGW < M) ? m0 + k * NGW : m0;
#pragma unroll
            for (int j = 0; j < 2; ++j) w[k][j] = __builtin_nontemporal_load((const v4u*)(xb + (size_t)m * DM + j * 512 + lane_ * 8)); }
        const float rsl = __builtin_amdgcn_rsqf(sum16(pq) * (1.0f / 1024.0f) + 1e-6f);
#pragma unroll
        for (int k = 0; k < 4; ++k) { const int m = m0 + k * NGW; if (m >= M) break; const float rs = __shfl(rsl, 16 * k);
#pragma unroll
            for (int j = 0; j < 2; ++j) { const v4u ww = w[k][j]; f32x4 o0, o1;
                o0.x = bflo(ww.x) * rs; o0.y = bfhi(ww.x) * rs; o0.z = bflo(ww.y) * rs; o0.w = bfhi(ww.y) * rs; o1.x = bflo(ww.z) * rs; o1.y = bfhi(ww.z) * rs; o1.z = bflo(ww.w) * rs; o1.w = bfhi(ww.w) * rs;
                float* op = F.x + (size_t)m * DM + j * 512 + lane_ * 8; *(f32x4*)op = o0 * gg[j][0]; *(f32x4*)(op + 4) = o1 * gg[j][1]; } } }
}

template <int L> __device__ __forceinline__ void run_layer(Frame& F, const Args& args, const XcdBarrier& bar, int lo, int hi) {
    typedef pg8::bf16_t pb16;
    constexpr int base = 17 * L;
#define IN(k) (lo <= base + (k) && base + (k) < hi && EN(k))
#define SEAM(k) do { if (base + (k) + 1 < hi) xcd_barrier(bar); } while (0)
#define GSEAM(k) do { if (base + (k) + 1 < hi) { if (F.MISC[10]) grp_barrier((unsigned*)(F.ctl + CW_GRP + 64 * (blockIdx.x & 7u)), (unsigned)(F.G - (int)(blockIdx.x & 7u) + 7) / 8u, F.MISC + 11, (unsigned*)(F.ctl + CW_BAR)); \
                                             else xcd_barrier(bar); } } while (0)
#define GEMM_RUN(EPI, g, S, E) pg8::gemm_phase<EPI, pg8::StaticOrder, true, true>(F.lds + RING_OFF, g, S, E)
    constexpr size_t SS_IN = WS_SS0, SS_A = WS_SS1, SS_B = WS_SS0, SS_C = WS_SS1, SS_OUT = WS_SS0;
    if (IN(0)) { phase_conv<0>(F, args, L); SEAM(0);
        if (L == 0 && base + 1 < hi) { if (F.tid == 0) F.MISC[10] = (xb_ld((unsigned*)(F.ctl + CW_MISMATCH)) == 0u && (F.G & 7) == 0) ? 1u : 0u; __syncthreads(); } }
    if (IN(1)) { pg8::Gemm g{L == 0 ? WSP(pb16, WS_XB) : WSP(pb16, R_XBALT), WSP(pb16, W_F1GU), M, 5632, 1024}; pg8::StaticOrder S; S.init(M, 5632, F.G, (int)blockIdx.x);
        pg8::EpiSwiglu E{WSP(pb16, R_H), WSP(float, SS_IN)}; GEMM_RUN(pg8::EpiSwiglu, g, S, E);
        if ((int)blockIdx.x >= F.G / 2) phase_conv<1>(F, args, L);
        GSEAM(1); }
    if (IN(2)) { KP_DECL; pg8::Gemm g{WSP(pb16, R_H), WSP(pb16, W_F1D), M, 1024, FF}; pg8::StaticOrder S; S.init(M, 1024, F.G, (int)blockIdx.x);
        pg8::EpiResid<0> E{WSP(pb16, WS_XB), WSP(float, SS_A), nullptr, nullptr, 0.5f, L == 0 ? WSP(pb16, WS_XB) : WSP(pb16, R_XBALT)}; GEMM_RUN(pg8::EpiResid<0>, g, S, E);
        if (L == 0) GSEAM(2); else SEAM(2); }
    if (IN(3)) { pg8::Gemm g{WSP(pb16, WS_XB), WSP(pb16, W_IN), M, 1792, 1024}; pg8::StaticOrder S; S.init(M, 1792, F.G, (int)blockIdx.x);
        pg8::EpiStore<0> E{WSP(pb16, R_ZR), WSP(float, SS_A), nullptr, nullptr, nullptr, nullptr}; GEMM_RUN(pg8::EpiStore<0>, g, S, E); SEAM(3); }
    if (IN(4)) { phase_rprep1(F, args, L); SEAM(4); }
    if (IN(5)) { KP_DECL; pg8::Gemm g{WSP(pb16, R_AP), WSP(pb16, W_LR), M, 1536, 256}; pg8::StaticOrder S; S.init(M, 1536, F.G, (int)blockIdx.x);
        pg8::EpiStore<3> E{WSP(pb16, R_DAG_W), nullptr, WSP(pb16, R_DAG_A), WSP(pb16, R_DAG_G), INP(I_W0) + L * 512, INP(I_A0) + L * 512};
        GEMM_RUN(pg8::EpiStore<3>, g, S, E); SEAM(5); }
    if (IN(6)) { phase_rchunk_pre(F, args, L); SEAM(6); }
    if (IN(7)) {
        if (blockIdx.x < 32 && F.wave == 0) rchunk_seq(F, blockIdx.x);
        pg8::Gemm g{WSP(pb16, WS_XB), WSP(pb16, W_IN) + (size_t)1792 * 1024, M, 2816, 1024}; pg8::SplitOrder S; S.init(M, 2816, F.G, (int)blockIdx.x); S.ns = 32;
        pg8::EpiStore<1> E{WSP(pb16, R_ZA), WSP(float, SS_A), (pb16*)F.x, nullptr, WSP(float, WS_LB), nullptr};
        pg8::gemm_phase<pg8::EpiStore<1>, pg8::SplitOrder, true, true>(F.lds + RING_OFF, g, S, E); SEAM(7); }
    if (IN(8)) { phase_h1(F, blockIdx.x, F.G); phase_attn_mfma(F, args, L); phase_rchunk_out(F, args, L); SEAM(8); }
    if (IN(9)) { phase_h2(F); xcd_barrier(bar); phase_h3(F, args, L); SEAM(9); }
    if (IN(10)) { pg8::Gemm g{WSP(pb16, WS_XB), WSP(pb16, W_IN) + (size_t)4608 * 1024, M, 3072, 1024}; pg8::StaticOrder S; S.init(M, 3072, F.G, (int)blockIdx.x);
        pg8::EpiStore<2> E{WSP(pb16, R_GG), WSP(float, SS_A), nullptr, nullptr, nullptr, nullptr}; GEMM_RUN(pg8::EpiStore<2>, g, S, E); GSEAM(10); }
    if (IN(11)) { pg8::Gemm g{WSP(pb16, R_Y), WSP(pb16, W_BR), M, 1024, 512, (size_t)M * 512, (size_t)1024 * 512}; pg8::ChainOrder S; S.init(M, 1024, F.G, (int)blockIdx.x);
        pg8::EpiBranchChain E{WSP(pb16, R_MERGED), WSP(pb16, R_GG)}; pg8::gemm_phase<pg8::EpiBranchChain, pg8::ChainOrder, true, true>(F.lds + RING_OFF, g, S, E); GSEAM(11); }
    if (IN(12)) { conv_p(F, args, L); pg8::Gemm g{WSP(pb16, R_MERGED), WSP(pb16, W_O), M, 1024, 1024}; pg8::StaticOrder S; S.init(M, 1024, F.G, (int)blockIdx.x);
        pg8::EpiResid<0> E{WSP(pb16, WS_XB), WSP(float, SS_B), nullptr, nullptr, 1.0f, WSP(pb16, WS_XB)}; GEMM_RUN(pg8::EpiResid<0>, g, S, E); SEAM(12); }
    if (IN(13)) {
        { pg8::Gemm g{WSP(pb16, WS_XB), WSP(pb16, W_F2GU), M, 5632, 1024}; pg8::StaticOrder S; S.init(M, 5632, F.G, (int)blockIdx.x);
          pg8::EpiSwiglu E{WSP(pb16, R_H), WSP(float, SS_B)}; GEMM_RUN(pg8::EpiSwiglu, g, S, E); }
        { pg8::Gemm g{WSP(pb16, R_PB), WSP(pb16, W_PP), M, 1024, 256}; pg8::TailOrder S; S.init(M, 1024, F.G, (int)blockIdx.x); S.lo = F.G / 2;
          pg8::EpiStore<4> E{WSP(pb16, R_PROJ), nullptr, nullptr, nullptr, nullptr, nullptr}; pg8::gemm_phase<pg8::EpiStore<4>, pg8::TailOrder, true, true>(F.lds + RING_OFF, g, S, E); }
        GSEAM(13); }
    if (IN(14)) { pg8::Gemm g{WSP(pb16, R_H), WSP(pb16, W_F2D), M, 1024, FF}; pg8::StaticOrder S; S.init(M, 1024, F.G, (int)blockIdx.x);
        pg8::EpiResid<0> E{WSP(pb16, WS_XB), WSP(float, SS_C), nullptr, nullptr, 0.5f, WSP(pb16, WS_XB)}; GEMM_RUN(pg8::EpiResid<0>, g, S, E); GSEAM(14); }
    if (IN(16)) { pg8::Gemm g{WSP(pb16, WS_XB), WSP(pb16, W_PG), M, 1024, 1024}; pg8::StaticOrder S; S.init(M, 1024, F.G, (int)blockIdx.x);
        pg8::EpiResid<1> E{WSP(pb16, R_XBALT), WSP(float, SS_OUT), WSP(float, SS_C), WSP(pb16, R_PROJ), 1.0f, WSP(pb16, WS_XB)}; GEMM_RUN(pg8::EpiResid<1>, g, S, E);
        if (L != 0) SEAM(16); }
#undef IN
#undef SEAM
#undef GEMM_RUN
}
__global__ void __launch_bounds__(NWAVES * 64, 2) mk_fwd(Args args) {
    extern __shared__ __attribute__((aligned(16))) unsigned char lds[];
    Frame F;
    F.lds = (LAS unsigned char*)lds;
    F.MISC = (volatile LAS unsigned*)(F.lds + MISC_OFF);
    F.tid = threadIdx.x; F.lane = F.tid & 63; F.wave = __builtin_amdgcn_readfirstlane(F.tid >> 6);
    F.G = gridDim.x;
    F.ws = args.ws; F.x = args.out;
    F.ctl = (gu32*)(args.ws + WS_CTL);
    for (int u = F.tid; u < (LDS_BYTES - LDSCTL_OFF) / 4; u += NWAVES * 64) ((LAS unsigned*)(F.lds + LDSCTL_OFF))[u] = 0u;
    __syncthreads();
    const int lo = args.ph_lo, hi = args.ph_hi;
    const bool multi = (hi - lo) > 1;
    XcdBarrier bar; bar.bar = (unsigned*)(F.ctl + CW_BAR); bar.x = 0; bar.st = nullptr;
    if (multi) { bar = xcd_barrier_post((unsigned*)(F.ctl + CW_BAR), F.MISC + 8);
        if (F.tid == 0 && xb_xcc_id() != (blockIdx.x & 7u)) (void)__hip_atomic_fetch_or((unsigned*)(F.ctl + CW_MISMATCH), 1u, __ATOMIC_RELAXED, __HIP_MEMORY_SCOPE_AGENT); }
    run_layer<0>(F, args, bar, lo, hi);
    run_layer<1>(F, args, bar, lo, hi);
    if (lo <= N_PHASES - 1 && N_PHASES - 1 < hi && EN(17)) phase_final(F, args);
}

#ifndef MK_PER_PHASE
#define MK_PER_PHASE 0
#endif
extern "C" void kernel_launch(void* const* d_in, const int* in_sizes, int n_in, void* d_out, int out_size, void* d_ws, size_t ws_size, hipStream_t stream) {
    static int grid = 0;
    if (grid == 0) {
        if (n_in != N_IN || in_sizes[0] != M * DM || out_size != M * DM || ws_size < WS_END) { fprintf(stderr, "kernel_launch: unexpected shapes / workspace (n_in %d, ws %zu < %zu)\n", n_in, ws_size, (size_t)WS_END); grid = -1; return; }
        int dev = 0, cus = 0;
        if (hipGetDevice(&dev) != hipSuccess || hipDeviceGetAttribute(&cus, hipDeviceAttributeMultiprocessorCount, dev) != hipSuccess) { grid = -1; return; }
        if (hipFuncSetAttribute((const void*)mk_fwd, hipFuncAttributeMaxDynamicSharedMemorySize, LDS_BYTES) != hipSuccess) { fprintf(stderr, "kernel_launch: hipFuncSetAttribute failed\n"); grid = -1; return; }
        int per_cu = 0;
        if (hipOccupancyMaxActiveBlocksPerMultiprocessor(&per_cu, (const void*)mk_fwd, NWAVES * 64, LDS_BYTES) != hipSuccess || per_cu < 1) fprintf(stderr, "kernel_launch: occupancy query says %d\n", per_cu);
        (void)hipGetLastError();
        grid = cus;
    }
    if (grid < 0) return;
    (void)hipMemsetAsync((char*)d_ws + WS_CTL, 0, CTL_ZERO_BYTES, stream);
    Args a{};
    for (int i = 0; i < N_IN; ++i) a.in[i] = (const float*)d_in[i];
    a.out = (float*)d_out; a.ws = (unsigned char*)d_ws;
#if MK_PER_PHASE
    for (int ph = 0; ph < N_PHASES; ++ph) { a.ph_lo = ph; a.ph_hi = ph + 1; hipLaunchKernelGGL(mk_fwd, dim3(grid), dim3(NWAVES * 64), LDS_BYTES, stream, a); }
#else
    a.ph_lo = 0; a.ph_hi = N_PHASES; hipLaunchKernelGGL(mk_fwd, dim3(grid), dim3(NWAVES * 64), LDS_BYTES, stream, a);
#endif
}
```

```cpp
#include <hip/hip_runtime.h>
#include <cstdio>
#include <cstdint>
namespace pg8 {
#define PG8_LAS __attribute__((address_space(3)))
typedef unsigned short bf16_t;
typedef short bf16x8 __attribute__((ext_vector_type(8)));
typedef float f32x4 __attribute__((ext_vector_type(4)));
typedef unsigned u32x4 __attribute__((ext_vector_type(4)));
constexpr int BM = 256, BK = 64, HALF = 128, HTB = HALF * BK * 2  , STAGE_BYTES = 8 * HTB, NXCD = 8, WGM = 8;
constexpr int RS_LDS_OFF = 8 * 16640;

__host__ __device__ __forceinline__ int lds_byte(int r, int c) { const int st = (r >> 4) * 2 + (c >> 5), rr = r & 15, cc = c & 31, ob = rr * 64 + cc * 2; return st * 1024 + (ob ^ (((ob >> 9) & 1) << 5)); }
__host__ __device__ __forceinline__ void stage_rc(int b, int& R, int& C) { const int st = b / 1024, sb = b % 1024, swz = sb ^ (((sb >> 9) & 1) << 5); R = (st >> 1) * 16 + swz / 64; C = (st & 1) * 32 + (swz % 64) / 2; }
__host__ __device__ __forceinline__ int perm32(int rho) { const int n = rho >> 4, i = rho & 15; return 8 * (i >> 2) + 4 * n + (i & 3); }

struct Unit { int pm, pn; int b = 0; };
struct Gemm { const bf16_t* A; const bf16_t* Bt; int M, N, K; size_t usA = 0, usB = 0; };

struct StaticOrder {
    int nM, nN, nwg, G, c;
    __host__ __device__ void init(int M, int N, int G_, int c_) { nM = M / BM; nN = N / BM; nwg = nM * nN; G = G_; c = c_; }
    __host__ __device__ bool next(int i, Unit& u) const {
        const long L = (long)i * G + c; if (L >= nwg) return false;
        int wgid = (int)L; { const int q = nwg / NXCD, r = nwg % NXCD, xcd = wgid % NXCD, off = wgid / NXCD; wgid = (xcd < r ? xcd * (q + 1) : r * (q + 1) + (xcd - r) * q) + off; }
        const int nig = WGM * nN, gid = wgid / nig, fm = gid * WGM, gsz = (nM - fm) < WGM ? (nM - fm) : WGM;
        u.pm = fm + ((wgid % nig) % gsz); u.pn = (wgid % nig) / gsz; return true;
    }
    __device__ __forceinline__ void a_ready(const Unit&) const {}
    __device__ __forceinline__ void done(const Unit&) const {}
};

struct SplitOrder : StaticOrder {
    int ns;
    __host__ __device__ bool next(int i, Unit& u) const {
        long L;
        if (c < ns) { if (i > 0) return false; L = (long)(nwg - ns) + c; }
        else { L = (long)i * (G - ns) + (c - ns); if (L >= nwg - ns) return false; }
        int wgid = (int)L; { const int q = nwg / NXCD, r = nwg % NXCD, xcd = wgid % NXCD, off = wgid / NXCD; wgid = (xcd < r ? xcd * (q + 1) : r * (q + 1) + (xcd - r) * q) + off; }
        const int nig = WGM * nN, gid = wgid / nig, fm = gid * WGM, gsz = (nM - fm) < WGM ? (nM - fm) : WGM;
        u.pm = fm + ((wgid % nig) % gsz); u.pn = (wgid % nig) / gsz; return true;
    }
};

struct TailOrder : StaticOrder {
    int lo;
    __host__ __device__ bool next(int i, Unit& u) const {
        if (c < lo) return false; const long L = (long)i * (G - lo) + (c - lo); if (L >= nwg) return false;
        int wgid = (int)L; { const int q = nwg / NXCD, r = nwg % NXCD, xcd = wgid % NXCD, off = wgid / NXCD; wgid = (xcd < r ? xcd * (q + 1) : r * (q + 1) + (xcd - r) * q) + off; }
        const int nig = WGM * nN, gid = wgid / nig, fm = gid * WGM, gsz = (nM - fm) < WGM ? (nM - fm) : WGM;
        u.pm = fm + ((wgid % nig) % gsz); u.pn = (wgid % nig) / gsz; return true;
    }
};

__device__ __forceinline__ unsigned cvt_pk_bf16(float lo, float hi) { unsigned r; asm volatile("v_cvt_pk_bf16_f32 %0, %1, %2" : "=v"(r) : "v"(lo), "v"(hi)); return r; }
typedef float f32x2 __attribute__((ext_vector_type(2)));
typedef unsigned u32x2 __attribute__((ext_vector_type(2)));
__device__ __forceinline__ float fsigmoid(float x) { return __builtin_amdgcn_rcpf(1.0f + __builtin_amdgcn_exp2f(-1.4426950408889634f * x)); }
__device__ __forceinline__ float fsilu(float x) { return x * fsigmoid(x); }
__device__ __forceinline__ float bf2f(unsigned short b) { return __uint_as_float(((unsigned)b) << 16); }
typedef float f32x2_t __attribute__((ext_vector_type(2))); typedef __bf16 bf16x2_t __attribute__((ext_vector_type(2)));
__device__ __forceinline__ unsigned cvtpk_s(float lo, float hi) { f32x2_t v = {lo, hi}; bf16x2_t b = __builtin_convertvector(v, bf16x2_t); return __builtin_bit_cast(unsigned, b); }
__device__ __forceinline__ u32x4 pack8(const f32x4& a, const f32x4& b) { u32x4 w; w.x = cvtpk_s(a[0], a[1]); w.y = cvtpk_s(a[2], a[3]); w.z = cvtpk_s(b[0], b[1]); w.w = cvtpk_s(b[2], b[3]); return w; }
__device__ __forceinline__ void unpack8(const u32x4& w, f32x4& a, f32x4& b) {
    a[0] = __uint_as_float(w.x << 16); a[1] = __uint_as_float(w.x & 0xffff0000u); a[2] = __uint_as_float(w.y << 16); a[3] = __uint_as_float(w.y & 0xffff0000u);
    b[0] = __uint_as_float(w.z << 16); b[1] = __uint_as_float(w.z & 0xffff0000u); b[2] = __uint_as_float(w.w << 16); b[3] = __uint_as_float(w.w & 0xffff0000u); }
__device__ __forceinline__ float row_rstd(const float* ssp, int r) {
    const f32x4* p = (const f32x4*)(ssp + (size_t)r * 16);
    const f32x4 a = p[0], b = p[1], c = p[2], d = p[3]; const f32x4 s = (a + b) + (c + d);
    return __builtin_amdgcn_rsqf(((s[0] + s[1]) + (s[2] + s[3])) * (1.0f / 1024.0f) + 1e-6f);
}
#define EPI_FENCE() asm volatile("" ::: "memory")
typedef __amdgpu_buffer_rsrc_t rsrc_t;
__device__ __forceinline__ rsrc_t mk_rsrc(const void* p) { return __builtin_amdgcn_make_buffer_rsrc((void*)p, (short)0, 0x7fffffff, 0x00020000); }
__device__ __forceinline__ float xq_sum(float x) {
    auto s = __builtin_amdgcn_permlane16_swap(__float_as_uint(x), __float_as_uint(x), false, false); x = __uint_as_float(s[0]) + __uint_as_float(s[1]);
    auto t = __builtin_amdgcn_permlane32_swap(__float_as_uint(x), __float_as_uint(x), false, false); return __uint_as_float(t[0]) + __uint_as_float(t[1]);
}
__device__ __forceinline__ void rstd8_issue(const float* ssp, int row0, int fq, f32x4 (&p)[2][4]) {
#pragma unroll
    for (int ai = 0; ai < 2; ++ai)
#pragma unroll
        for (int m = 0; m < 4; ++m) p[ai][m] = *(const f32x4*)(ssp + (size_t)(row0 + ai * HALF + m * 16) * 16 + 4 * fq);
}
__device__ __forceinline__ void rstd8_reduce(const f32x4 (&p)[2][4], float (&rs)[2][4]) {
#pragma unroll
    for (int ai = 0; ai < 2; ++ai)
#pragma unroll
        for (int m = 0; m < 4; ++m) { const float q = (p[ai][m][0] + p[ai][m][1]) + (p[ai][m][2] + p[ai][m][3]); rs[ai][m] = __builtin_amdgcn_rsqf(xq_sum(q) * (1.0f / 1024.0f) + 1e-6f); }
}
struct EpiSwiglu {
    static constexpr bool PERM = true, AFTER_DRAIN = false, CHAIN = false, RS = true;
    bf16_t* H; const float* ssp;
    __device__ __forceinline__ const float* rs_ptr() const { return ssp; }
    __device__ __forceinline__ void operator()(const f32x4 (&acc)[2][2][4][2], const Unit& u, int wr, int wc, int fr, int fq, const float (&rs8)[2][4]) const {
        const int row0 = u.pm * BM + wr * 64 + fr, col0 = u.pn * HALF + wc * 32 + 8 * fq;
#pragma unroll
        for (int ai = 0; ai < 2; ++ai)
#pragma unroll
            for (int m = 0; m < 4; ++m) { const int r = row0 + ai * HALF + m * 16; const float s = rs8[ai][m]; f32x4 o[2];
#pragma unroll
                for (int n = 0; n < 2; ++n) { const f32x4 g = acc[ai][0][m][n] * s, up = acc[ai][1][m][n] * s;
#pragma unroll
                    for (int i = 0; i < 4; ++i) o[n][i] = fsilu(g[i]) * up[i]; }
                *(u32x4*)(H + (size_t)r * 2816 + col0) = pack8(o[0], o[1]); EPI_FENCE(); }
    }
};
template <int MODE> struct EpiResid {
    static constexpr bool PERM = true, AFTER_DRAIN = false, CHAIN = false, RS = (MODE == 1);
    bf16_t* XB; float* sso; const float* ssi; const bf16_t* proj; float scale; const bf16_t* XBin;
    __device__ __forceinline__ const float* rs_ptr() const { return ssi; }
    static constexpr int NB = (MODE == 0) ? 8 : 2;
    __device__ __forceinline__ void operator()(const f32x4 (&acc)[2][2][4][2], const Unit& u, int wr, int wc, int fr, int fq, const float (&rs8)[2][4]) const {
        const rsrc_t rx = mk_rsrc(XBin), rp = mk_rsrc(MODE == 1 ? (const void*)proj : (const void*)XBin), ro = mk_rsrc(XB);
        const unsigned voff = (unsigned)(fr * 1024 + 8 * fq) * 2u;
        const unsigned sbase = (unsigned)((u.pm * BM + wr * 64) * 1024 + u.pn * BM + wc * 32) * 2u;
        const int row0 = u.pm * BM + wr * 64 + fr;
#pragma unroll
        for (int gp = 0; gp < 8 / NB; ++gp) {
            u32x4 xv[NB][2]; u32x4 pv[NB][2];
#pragma unroll
            for (int mm = 0; mm < NB; ++mm) { const int g = NB * gp + mm, ai = g >> 2, m = g & 3;
#pragma unroll
                for (int bj = 0; bj < 2; ++bj) { const unsigned so = sbase + (unsigned)((ai * HALF + m * 16) * 1024 + bj * HALF) * 2u;
                    xv[mm][bj] = __builtin_amdgcn_raw_buffer_load_b128(rx, voff + so, 0, 0);
                    if (MODE == 1) pv[mm][bj] = __builtin_amdgcn_raw_buffer_load_b128(rp, voff + so, 0, 0); } }
#pragma unroll
            for (int mm = 0; mm < NB; ++mm) { const int g = NB * gp + mm, ai = g >> 2, m = g & 3; const int r = row0 + ai * HALF + m * 16; float ss = 0.f;
                float s = 1.0f; if (MODE == 1) s = rs8[ai][m];
#pragma unroll
                for (int bj = 0; bj < 2; ++bj) { const unsigned so = sbase + (unsigned)((ai * HALF + m * 16) * 1024 + bj * HALF) * 2u; f32x4 x0, x1; unpack8(xv[mm][bj], x0, x1);
                    if (MODE == 0) { x0 = x0 + acc[ai][bj][m][0] * scale; x1 = x1 + acc[ai][bj][m][1] * scale; }
                    else { f32x4 p0, p1; unpack8(pv[mm][bj], p0, p1);
#pragma unroll
                        for (int i = 0; i < 4; ++i) { x0[i] += fsigmoid(acc[ai][bj][m][0][i] * s) * p0[i]; x1[i] += fsigmoid(acc[ai][bj][m][1][i] * s) * p1[i]; } }
                    __builtin_amdgcn_raw_buffer_store_b128(pack8(x0, x1), ro, voff + so, 0, 0);
                    ss += ((x0[0] * x0[0] + x0[1] * x0[1]) + (x0[2] * x0[2] + x0[3] * x0[3])) + ((x1[0] * x1[0] + x1[1] * x1[1]) + (x1[2] * x1[2] + x1[3] * x1[3])); }
                ss = xq_sum(ss);
                if (fq == 0) sso[(size_t)r * 16 + u.pn * 4 + wc] = ss; }
            EPI_FENCE(); }
    }
};
template <int ACT, bool RS, int LD> __device__ __forceinline__ void store_tile(const f32x4 (&acc)[2][2][4][2], bf16_t* base, const float (&rs8)[2][4], const float* cvp, int row0, int fq) {
    f32x4 cv[2][2];
#pragma unroll
    for (int bj = 0; bj < 2; ++bj)
#pragma unroll
        for (int n = 0; n < 2; ++n) cv[bj][n] = (ACT >= 3) ? *(const f32x4*)(cvp + bj * HALF + 4 * n) : (f32x4){0.f, 0.f, 0.f, 0.f};
#pragma unroll
    for (int ai = 0; ai < 2; ++ai)
#pragma unroll
        for (int m = 0; m < 4; ++m) { const int r = row0 + ai * HALF + m * 16; float s = 1.0f; if (RS) s = rs8[ai][m];
#pragma unroll
            for (int bj = 0; bj < 2; ++bj) { f32x4 o[2];
#pragma unroll
                for (int n = 0; n < 2; ++n) { const f32x4 z = acc[ai][bj][m][n] * s;
#pragma unroll
                    for (int i = 0; i < 4; ++i) { float v = z[i];
                        if (ACT == 1) v = fsilu(v);
                        else if (ACT == 2) v = fsigmoid(v);
                        else if (ACT == 3) v = (1.0f - cv[bj][n][i]) * fsigmoid(-v);
                        else if (ACT == 4) v = __builtin_amdgcn_exp2f(-0.6065306597126334f * 1.4426950408889634f * fsigmoid(v + cv[bj][n][i]));
                        else if (ACT == 5) v = fsigmoid(v + cv[bj][n][i]);
                        o[n][i] = v; } }
                *(u32x4*)(base + (size_t)r * LD + bj * HALF) = pack8(o[0], o[1]); }
            EPI_FENCE(); }
}
template <int KIND> struct EpiStore {
    static constexpr bool PERM = true, AFTER_DRAIN = false, CHAIN = false, RS = (KIND <= 2);
    bf16_t* O; const float* ssp; bf16_t* O2; bf16_t* O3; const float* c0; const float* c1;
    __device__ __forceinline__ const float* rs_ptr() const { return ssp; }
    __device__ __forceinline__ void operator()(const f32x4 (&acc)[2][2][4][2], const Unit& u, int wr, int wc, int fr, int fq, const float (&rs8)[2][4]) const {
        const int row0 = u.pm * BM + wr * 64 + fr; const int cl = wc * 32 + 8 * fq;
        if (KIND == 0) store_tile<0, true, 1792>(acc, O + u.pn * BM + cl, rs8, nullptr, row0, fq);
        if (KIND == 1) {
            if (u.pn < 3) store_tile<0, true, 768>(acc, O + u.pn * BM + cl, rs8, nullptr, row0, fq);
            else { const int t = u.pn - 3, kind = t >> 1; bf16_t* b = O2 + t * BM + cl;
                if (kind == 0 || kind == 3) store_tile<1, true, 2048>(acc, b, rs8, nullptr, row0, fq);
                else if (kind == 1) store_tile<3, true, 2048>(acc, b, rs8, c0 + (t & 1) * BM + cl, row0, fq);
                else store_tile<0, true, 2048>(acc, b, rs8, nullptr, row0, fq); } }
        if (KIND == 2) store_tile<2, true, 3072>(acc, O + u.pn * BM + cl, rs8, nullptr, row0, fq);
        if (KIND == 3) {
            if (u.pn < 2) store_tile<4, false, 512>(acc, O + u.pn * BM + cl, rs8, c0 + u.pn * BM + cl, row0, fq);
            else if (u.pn < 4) store_tile<5, false, 512>(acc, O2 + (u.pn - 2) * BM + cl, rs8, c1 + (u.pn - 2) * BM + cl, row0, fq);
            else store_tile<0, false, 512>(acc, O3 + (u.pn - 4) * BM + cl, rs8, nullptr, row0, fq); }
        if (KIND == 4) store_tile<0, false, 1024>(acc, O + u.pn * BM + cl, rs8, nullptr, row0, fq);
    }
};
template <bool FIRST> struct EpiBranch {
    static constexpr bool PERM = true, AFTER_DRAIN = false, CHAIN = false, RS = false;
    bf16_t* Mg; const bf16_t* G; const float* ssp;
    __device__ __forceinline__ const float* rs_ptr() const { return nullptr; }
    __device__ __forceinline__ void operator()(const f32x4 (&acc)[2][2][4][2], const Unit& u, int wr, int wc, int fr, int fq, const float (&rs8)[2][4]) const {
        const int row0 = u.pm * BM + wr * 64 + fr, col0 = u.pn * BM + wc * 32 + 8 * fq;
#pragma unroll
        for (int ai = 0; ai < 2; ++ai)
#pragma unroll
            for (int m = 0; m < 4; ++m) { const int r = row0 + ai * HALF + m * 16;
#pragma unroll
                for (int bj = 0; bj < 2; ++bj) { f32x4 g0, g1; unpack8(*(const u32x4*)(G + (size_t)r * 3072 + col0 + bj * HALF), g0, g1);
                    f32x4 o0 = g0 * acc[ai][bj][m][0], o1 = g1 * acc[ai][bj][m][1];
                    bf16_t* mp = Mg + (size_t)r * 1024 + col0 + bj * HALF;
                    if (!FIRST) { f32x4 p0, p1; unpack8(*(const u32x4*)mp, p0, p1); o0 = o0 + p0; o1 = o1 + p1; }
                    *(u32x4*)mp = pack8(o0, o1); }
                EPI_FENCE(); }
    }
};
struct EpiBranchChain {
    static constexpr bool PERM = true, AFTER_DRAIN = false, CHAIN = true, RS = false;
    bf16_t* Mg; const bf16_t* G;
    __device__ __forceinline__ const float* rs_ptr() const { return nullptr; }
    __device__ __forceinline__ void operator()(f32x4 (&acc)[2][2][4][2], const Unit& u, int wr, int wc, int fr, int fq, const float (&rs8)[2][4]) const {
        const int b = u.b; const rsrc_t rg = mk_rsrc(G), rm = mk_rsrc(Mg);
        const unsigned vg = (unsigned)(fr * 3072 + 8 * fq) * 2u + (unsigned)((u.pm * BM + wr * 64) * 3072 + b * 1024 + u.pn * BM + wc * 32) * 2u;
        const unsigned vm = (unsigned)(fr * 1024 + 8 * fq) * 2u + (unsigned)((u.pm * BM + wr * 64) * 1024 + u.pn * BM + wc * 32) * 2u;
        if (b < 2) {
#pragma unroll
            for (int ai = 0; ai < 2; ++ai) { u32x4 gv[4][2], hv[4][2];
#pragma unroll
                for (int m = 0; m < 4; ++m)
#pragma unroll
                    for (int bj = 0; bj < 2; ++bj) { const unsigned o = vg + (unsigned)((ai * HALF + m * 16) * 3072 + bj * HALF) * 2u;
                        gv[m][bj] = __builtin_amdgcn_raw_buffer_load_b128(rg, o, 0, 0); hv[m][bj] = __builtin_amdgcn_raw_buffer_load_b128(rg, o + 2048u, 0, 0); }
#pragma unroll
                for (int m = 0; m < 4; ++m)
#pragma unroll
                    for (int bj = 0; bj < 2; ++bj) { f32x4 g0, g1, h0, h1; unpack8(gv[m][bj], g0, g1); unpack8(hv[m][bj], h0, h1);
#pragma unroll
                        for (int i = 0; i < 4; ++i) { g0[i] *= __builtin_amdgcn_rcpf(h0[i]); g1[i] *= __builtin_amdgcn_rcpf(h1[i]); }
                        acc[ai][bj][m][0] = acc[ai][bj][m][0] * g0; acc[ai][bj][m][1] = acc[ai][bj][m][1] * g1; }
                EPI_FENCE(); }
        } else { u32x4 gv[2][4][2];
#pragma unroll
            for (int ai = 0; ai < 2; ++ai)
#pragma unroll
                for (int m = 0; m < 4; ++m)
#pragma unroll
                    for (int bj = 0; bj < 2; ++bj) gv[ai][m][bj] = __builtin_amdgcn_raw_buffer_load_b128(rg, vg + (unsigned)((ai * HALF + m * 16) * 3072 + bj * HALF) * 2u, 0, 0);
#pragma unroll
            for (int ai = 0; ai < 2; ++ai)
#pragma unroll
                for (int m = 0; m < 4; ++m)
#pragma unroll
                    for (int bj = 0; bj < 2; ++bj) { f32x4 g0, g1; unpack8(gv[ai][m][bj], g0, g1); const f32x4 o0 = g0 * acc[ai][bj][m][0], o1 = g1 * acc[ai][bj][m][1];
                        __builtin_amdgcn_raw_buffer_store_b128(pack8(o0, o1), rm, vm + (unsigned)((ai * HALF + m * 16) * 1024 + bj * HALF) * 2u, 0, 0); }
            EPI_FENCE(); }
    }
};
struct ChainOrder : StaticOrder {
    __host__ __device__ bool next(int i, Unit& u) const { if (i >= 3) return false; if (!StaticOrder::next(0, u)) return false; u.b = i; return true; }
};
template <class Epi, class Sched, bool ALIGN_EPI = false, bool SP2 = false>
__device__ __forceinline__ void gemm_phase(PG8_LAS unsigned char* lds, const Gemm g, const Sched& S, const Epi& E) {
    const int tid = threadIdx.x, wid = __builtin_amdgcn_readfirstlane(tid >> 6), lane = tid & 63, wr = wid >> 2, wc = wid & 3, fr = lane & 15, fq = lane >> 4;
    int Kl_ = g.K; asm volatile("" : "+s"(Kl_)); const int K = Kl_, nt = K / BK;
    unsigned voffA[2], voffB[2];
#pragma unroll
    for (int i = 0; i < 2; ++i) { int R, C; stage_rc(tid * 16 + i * 8192, R, C); const int Rb = Epi::PERM ? ((R & ~31) + perm32(R & 31)) : R;
        voffA[i] = (unsigned)(R * K + C) * 2u; voffB[i] = (unsigned)(Rb * K + C) * 2u; }
    const size_t kstep = (size_t)(BK * 2);
    const size_t hstep = (size_t)HALF * K * 2;
    const size_t tstep = 2 * hstep;
    const unsigned ldsw = (unsigned)wid * 1024u;
    const int aoff = lds_byte(wr * 64 + fr, fq * 8), boff = lds_byte(wc * 32 + fr, fq * 8);
#define PG8_SA(b, h) (((b) * 2 + (h)) * HTB)
#define PG8_SB(b, h) ((4 + (b) * 2 + (h)) * HTB)
#define PG8_STAGE(bufoff, gbase, voff) do { _Pragma("unroll") for (int _i = 0; _i < 2; ++_i) \
        __builtin_amdgcn_global_load_lds((const unsigned*)((const char*)(gbase) + (voff)[_i]), (PG8_LAS unsigned*)(lds + (bufoff) + ldsw + _i * 8192), 16, 0, 0); } while (0)
#define PG8_LDA(dst, b, h) do { _Pragma("unroll") for (int m = 0; m < 4; ++m) _Pragma("unroll") for (int k = 0; k < 2; ++k) dst[m][k] = *(const PG8_LAS bf16x8*)(lds + PG8_SA(b, h) + aoff + m * 2048 + k * 1024); } while (0)
#define PG8_LDB(dst, b, h) do { _Pragma("unroll") for (int n = 0; n < 2; ++n) _Pragma("unroll") for (int k = 0; k < 2; ++k) dst[n][k] = *(const PG8_LAS bf16x8*)(lds + PG8_SB(b, h) + boff + n * 2048 + k * 1024); } while (0)
#define PG8_MMA(ai, bj, At, Bt) do { __builtin_amdgcn_s_setprio(1); _Pragma("unroll") for (int m = 0; m < 4; ++m) _Pragma("unroll") for (int n = 0; n < 2; ++n) _Pragma("unroll") for (int k = 0; k < 2; ++k) \
        acc[ai][bj][m][n] = __builtin_amdgcn_mfma_f32_16x16x32_bf16(Bt[n][k], At[m][k], acc[ai][bj][m][n], 0, 0, 0); __builtin_amdgcn_s_setprio(0); } while (0)
#define PG8_WAIT_V(n) asm volatile("s_waitcnt vmcnt(" #n ")" ::: "memory")
#define PG8_WAIT_L(n) asm volatile("s_waitcnt lgkmcnt(" #n ")" ::: "memory")
#define PG8_BAR __builtin_amdgcn_s_barrier()
#define PG8_SCHED __builtin_amdgcn_sched_barrier(0)
    Unit cur, nxt; int ui = 0;
    if (!S.next(0, cur)) return;
    f32x4 acc[2][2][4][2];
#pragma unroll
    for (int a = 0; a < 2; ++a)
#pragma unroll
        for (int b = 0; b < 2; ++b)
#pragma unroll
            for (int m = 0; m < 4; ++m)
#pragma unroll
                for (int n = 0; n < 2; ++n) acc[a][b][m][n] = (f32x4){0.f, 0.f, 0.f, 0.f};
    bf16x8 At[4][2], B0[2][2], B1[2][2];
    const char* cA = (const char*)g.A + (size_t)cur.pm * tstep + (size_t)cur.b * g.usA * 2; const char* cB = (const char*)g.Bt + (size_t)cur.pn * tstep + (size_t)cur.b * g.usB * 2;
    S.a_ready(cur);
    PG8_LAS float* RSL = (PG8_LAS float*)(lds + RS_LDS_OFF);
    if constexpr (Epi::RS) { f32x4 p0_[2];
#pragma unroll
        for (int ai = 0; ai < 2; ++ai) p0_[ai] = *(const f32x4*)(E.rs_ptr() + (size_t)(cur.pm * BM + ai * HALF + wr * 64 + wc * 16 + fr) * 16 + 4 * fq);
#pragma unroll
        for (int ai = 0; ai < 2; ++ai) { const float q_ = (p0_[ai][0] + p0_[ai][1]) + (p0_[ai][2] + p0_[ai][3]); const float r_ = __builtin_amdgcn_rsqf(xq_sum(q_) * (1.0f / 1024.0f) + 1e-6f);
            if (fq == 0) RSL[ai * HALF + wr * 64 + wc * 16 + fr] = r_; } }
    if constexpr (SP2) {
        PG8_STAGE(PG8_SB(0, 0), cB, voffB); PG8_STAGE(PG8_SB(0, 1), cB + hstep, voffB); PG8_STAGE(PG8_SA(0, 0), cA, voffA); PG8_STAGE(PG8_SA(0, 1), cA + hstep, voffA);
        if (wr == 1) PG8_BAR;
        PG8_WAIT_V(2); PG8_BAR;
        PG8_STAGE(PG8_SB(1, 0), cB + kstep, voffB); PG8_STAGE(PG8_SA(1, 0), cA + kstep, voffA); PG8_STAGE(PG8_SB(1, 1), cB + hstep + kstep, voffB);
        PG8_WAIT_V(6); PG8_BAR;
    } else {
        PG8_STAGE(PG8_SB(0, 0), cB, voffB); PG8_STAGE(PG8_SA(0, 0), cA, voffA); PG8_STAGE(PG8_SB(0, 1), cB + hstep, voffB); PG8_STAGE(PG8_SA(0, 1), cA + hstep, voffA);
        if (wr == 1) PG8_BAR;
        PG8_WAIT_V(4); PG8_BAR;
        PG8_STAGE(PG8_SB(1, 0), cB + kstep, voffB); PG8_STAGE(PG8_SA(1, 0), cA + kstep, voffA); PG8_STAGE(PG8_SB(1, 1), cB + hstep + kstep, voffB);
        PG8_WAIT_V(6); PG8_BAR;
    }
    for (;;) {
        const bool has_next = S.next(ui + 1, nxt);
        const char* nA = has_next ? (const char*)g.A + (size_t)nxt.pm * tstep + (size_t)nxt.b * g.usA * 2 : cA; const char* nB = has_next ? (const char*)g.Bt + (size_t)nxt.pn * tstep + (size_t)nxt.b * g.usB * 2 : cB;
        for (int t = 0; t < nt; t += 2) {
            const bool last = (t == nt - 2);
            const char* a1 = cA + (size_t)(t + 1) * kstep;
            const char* a2 = last ? nA : cA + (size_t)(t + 2) * kstep; const char* b2 = last ? nB : cB + (size_t)(t + 2) * kstep;
            const char* a3 = a2 + kstep; const char* b3 = b2 + kstep;
            if (last && has_next) S.a_ready(nxt);
            if constexpr (SP2) {
            PG8_LDB(B0, 0, 0); PG8_LDB(B1, 0, 1); PG8_SCHED; PG8_LDA(At, 0, 0); PG8_STAGE(PG8_SA(1, 1), a1 + hstep, voffA);
            PG8_WAIT_V(8); PG8_WAIT_L(0); PG8_BAR; PG8_MMA(0, 0, At, B0); PG8_MMA(0, 1, At, B1); PG8_BAR; PG8_SCHED;
            PG8_LDA(At, 0, 1); PG8_STAGE(PG8_SB(0, 0), b2, voffB); PG8_STAGE(PG8_SB(0, 1), b2 + hstep, voffB); PG8_STAGE(PG8_SA(0, 0), a2, voffA);
            PG8_WAIT_V(8); PG8_WAIT_L(0); PG8_BAR; PG8_MMA(1, 0, At, B0); PG8_MMA(1, 1, At, B1); PG8_BAR; PG8_SCHED;
            PG8_LDB(B0, 1, 0); PG8_LDB(B1, 1, 1); PG8_SCHED; PG8_LDA(At, 1, 0); PG8_STAGE(PG8_SA(0, 1), a2 + hstep, voffA);
            PG8_WAIT_V(8); PG8_WAIT_L(0); PG8_BAR; PG8_MMA(0, 0, At, B0); PG8_MMA(0, 1, At, B1); PG8_BAR; PG8_SCHED;
            PG8_LDA(At, 1, 1); PG8_STAGE(PG8_SB(1, 0), b3, voffB); PG8_STAGE(PG8_SB(1, 1), b3 + hstep, voffB); PG8_STAGE(PG8_SA(1, 0), a3, voffA);
            PG8_WAIT_V(8); PG8_WAIT_L(0); PG8_BAR; PG8_MMA(1, 0, At, B0); PG8_MMA(1, 1, At, B1); PG8_BAR; PG8_SCHED;
            } else {
            PG8_LDB(B0, 0, 0); PG8_SCHED; PG8_LDA(At, 0, 0); PG8_STAGE(PG8_SA(1, 1), a1 + hstep, voffA);
            PG8_WAIT_L(8); PG8_BAR; PG8_WAIT_L(0); PG8_MMA(0, 0, At, B0); PG8_BAR; PG8_SCHED;
            PG8_LDB(B1, 0, 1); PG8_STAGE(PG8_SB(0, 0), b2, voffB);
            PG8_BAR; PG8_WAIT_L(0); PG8_MMA(0, 1, At, B1); PG8_BAR;
            PG8_LDA(At, 0, 1); PG8_STAGE(PG8_SA(0, 0), a2, voffA);
            PG8_BAR; PG8_WAIT_L(0); PG8_MMA(1, 0, At, B0); PG8_BAR; PG8_SCHED;
            PG8_STAGE(PG8_SB(0, 1), b2 + hstep, voffB);
            PG8_WAIT_V(6); PG8_BAR; PG8_MMA(1, 1, At, B1); PG8_BAR;
            PG8_LDB(B0, 1, 0); PG8_SCHED; PG8_LDA(At, 1, 0); PG8_STAGE(PG8_SA(0, 1), a2 + hstep, voffA);
            PG8_WAIT_L(8); PG8_BAR; PG8_WAIT_L(0); PG8_MMA(0, 0, At, B0); PG8_BAR; PG8_SCHED;
            PG8_LDB(B1, 1, 1); PG8_STAGE(PG8_SB(1, 0), b3, voffB);
            PG8_BAR; PG8_WAIT_L(0); PG8_MMA(0, 1, At, B1); PG8_BAR;
            PG8_LDA(At, 1, 1); PG8_STAGE(PG8_SA(1, 0), a3, voffA);
            PG8_BAR; PG8_WAIT_L(0); PG8_MMA(1, 0, At, B0); PG8_BAR; PG8_SCHED;
            PG8_STAGE(PG8_SB(1, 1), b3 + hstep, voffB);
            PG8_WAIT_V(6); PG8_BAR; PG8_MMA(1, 1, At, B1); PG8_BAR;
            }
        }
        if constexpr (ALIGN_EPI) { if (wr == 0) PG8_BAR; }
        if constexpr (!Epi::AFTER_DRAIN) {
            float rsv[2][4];
            if constexpr (Epi::RS) { const PG8_LAS float* rb_ = RSL + (ui & 1) * 256 + wr * 64 + fr;
#pragma unroll
                for (int ai = 0; ai < 2; ++ai)
#pragma unroll
                    for (int m = 0; m < 4; ++m) rsv[ai][m] = rb_[ai * HALF + m * 16];
                f32x4 pn_[2];
                if (has_next) {
#pragma unroll
                    for (int ai = 0; ai < 2; ++ai) pn_[ai] = *(const f32x4*)(E.rs_ptr() + (size_t)(nxt.pm * BM + ai * HALF + wr * 64 + wc * 16 + fr) * 16 + 4 * fq); }
                E(acc, cur, wr, wc, fr, fq, rsv);
                if (has_next) {
#pragma unroll
                    for (int ai = 0; ai < 2; ++ai) { const float q_ = (pn_[ai][0] + pn_[ai][1]) + (pn_[ai][2] + pn_[ai][3]); const float r_ = __builtin_amdgcn_rsqf(xq_sum(q_) * (1.0f / 1024.0f) + 1e-6f);
                        if (fq == 0) RSL[((ui + 1) & 1) * 256 + ai * HALF + wr * 64 + wc * 16 + fr] = r_; } } }
            else { for (int ai = 0; ai < 2; ++ai) for (int m = 0; m < 4; ++m) rsv[ai][m] = 1.0f; E(acc, cur, wr, wc, fr, fq, rsv); }
            S.done(cur); }
        if (!has_next) break;
        if constexpr (!Epi::CHAIN)
#pragma unroll
        for (int a = 0; a < 2; ++a)
#pragma unroll
            for (int b = 0; b < 2; ++b)
#pragma unroll
                for (int m = 0; m < 4; ++m)
#pragma unroll
                    for (int n = 0; n < 2; ++n) acc[a][b][m][n] = (f32x4){0.f, 0.f, 0.f, 0.f};
        cur = nxt; cA = nA; cB = nB; ++ui;
        if constexpr (ALIGN_EPI) { if (wr == 1) PG8_BAR; }
    }
    PG8_WAIT_V(0);
    if constexpr (!ALIGN_EPI) { if (wr == 0) PG8_BAR; }
    PG8_BAR;
    if constexpr (Epi::AFTER_DRAIN) { E.fused(acc, cur, wr, wc, fr, fq, lds, wid, lane); S.done(cur); }
#undef PG8_SA
#undef PG8_SB
#undef PG8_STAGE
#undef PG8_LDA
#undef PG8_LDB
#undef PG8_MMA
#undef PG8_WAIT_V
#undef PG8_WAIT_L
#undef PG8_BAR
#undef PG8_SCHED
}
}
#define GAS __attribute__((address_space(1)))
#define LAS __attribute__((address_space(3)))
typedef unsigned short bf16;
typedef unsigned v4u __attribute__((ext_vector_type(4)));
typedef float f32x4 __attribute__((ext_vector_type(4)));
typedef short bf16x8 __attribute__((ext_vector_type(8)));
typedef GAS unsigned gu32;
typedef GAS unsigned long long gu64;
#define RLX_AGENT __ATOMIC_RELAXED, __HIP_MEMORY_SCOPE_AGENT
#define LDS_WAIT() asm volatile("s_waitcnt lgkmcnt(0)" ::: "memory")
#define VM_WAIT() asm volatile("s_waitcnt vmcnt(0)" ::: "memory")
__device__ __forceinline__ unsigned long long rt() { return __builtin_amdgcn_s_memrealtime(); }
__device__ __forceinline__ unsigned f2bf(float f) { unsigned u = __builtin_bit_cast(unsigned, f); return (u + 0x7fffu + ((u >> 16) & 1u)) >> 16; }
__device__ __forceinline__ unsigned pk2(float lo, float hi) { return f2bf(lo) | (f2bf(hi) << 16); }

#define XB_TMO      128
#define XB_XCNT(j)  (256  + 64 * (j))
#define XB_XSUB(j)  (1280 + 64 * (j))
#define XB_XGEN(j)  (2304 + 64 * (j))
#define XB_TOP      3328
#define XB_TOPGEN   3392
#define XCD_BAR_WORDS 3456
#define XB_SPIN_CAP (1u << 18)

__device__ __forceinline__ unsigned xb_ld(unsigned* p)              { return __hip_atomic_load(p, __ATOMIC_RELAXED, __HIP_MEMORY_SCOPE_AGENT); }
__device__ __forceinline__ unsigned xb_add(unsigned* p, unsigned v) { return __hip_atomic_fetch_add(p, v, __ATOMIC_RELAXED, __HIP_MEMORY_SCOPE_AGENT); }
__device__ __forceinline__ unsigned xb_xcc_id() { return (unsigned)__builtin_amdgcn_s_getreg((3 << 11) | 20) & 0xFu; }
#define XB_SPIN(cond, bar) do { unsigned _sp = 0; while (cond) { __builtin_amdgcn_s_sleep(1); \
    if ((++_sp & 255u) == 0u) { if (xb_ld(&(bar)[XB_TMO])) break; if (_sp > XB_SPIN_CAP) { atomicAdd(&(bar)[XB_TMO], 1u); break; } } } } while (0)

struct XcdBarrier {
    unsigned* bar; unsigned x;
    volatile LAS unsigned* st;
};

__device__ __forceinline__ XcdBarrier xcd_barrier_post(unsigned* bar, volatile LAS unsigned* st) {
    XcdBarrier b; b.bar = bar; b.x = xb_xcc_id(); b.st = st;
    if (threadIdx.x == 0) (void)xb_add(&bar[XB_XCNT(b.x)], 1u);
    return b;
}
__device__ __forceinline__ void xcd_barrier_complete(unsigned* bar, unsigned x, unsigned& nloc, unsigned& nx) {
    const unsigned G = gridDim.x * gridDim.y * gridDim.z;
    unsigned sum, cnt, mine, sp = 0u;
    for (;;) {
        sum = 0u; cnt = 0u; mine = 0u;
#pragma unroll
        for (unsigned j = 0; j < 16; ++j) { const unsigned c = xb_ld(&bar[XB_XCNT(j)]); sum += c; cnt += (c > 0u) ? 1u : 0u; mine = (j == x) ? c : mine; }
        if (sum == G) break;
        __builtin_amdgcn_s_sleep(1);
        if ((++sp & 255u) == 0u) { if (xb_ld(&bar[XB_TMO])) break; if (sp > XB_SPIN_CAP) { atomicAdd(&bar[XB_TMO], 1u); break; } }
    }
    nloc = mine > 0u ? mine : 1u; nx = cnt > 0u ? cnt : 1u;
}

__device__ __forceinline__ void xcd_barrier(const XcdBarrier& b) {
    asm volatile("s_waitcnt vmcnt(0)" ::: "memory");
    __syncthreads();
    if (threadIdx.x == 0) {
        unsigned* bar = b.bar;
        __builtin_amdgcn_s_waitcnt(0);
        unsigned nloc = b.st[0], nx = b.st[1];
        if (nloc == 0u) { xcd_barrier_complete(bar, b.x, nloc, nx); b.st[0] = nloc; b.st[1] = nx; }
        const unsigned old = xb_add(&bar[XB_XSUB(b.x)], 1u);
        const unsigned gen = old / nloc;
        if (old + 1u == (gen + 1u) * nloc) {
            __builtin_amdgcn_fence(__ATOMIC_RELEASE, "agent");
            asm volatile("s_waitcnt vmcnt(0)" ::: "memory");
            __builtin_amdgcn_fence(__ATOMIC_ACQUIRE, "agent");
            const unsigned og = xb_add(&bar[XB_TOP], 1u);
            const unsigned tg = og / nx;
            if (og + 1u == (tg + 1u) * nx) xb_add(&bar[XB_TOPGEN], 1u);
            else XB_SPIN(xb_ld(&bar[XB_TOPGEN]) == tg, bar);
            xb_add(&bar[XB_XGEN(b.x)], 1u);
            asm volatile("s_waitcnt vmcnt(0)" ::: "memory");
        } else {
            __builtin_amdgcn_fence(__ATOMIC_ACQUIRE, "agent");
            XB_SPIN(xb_ld(&bar[XB_XGEN(b.x)]) == gen, bar);
            asm volatile("s_waitcnt vmcnt(0)" ::: "memory");
        }
    }
    __syncthreads();
}
constexpr int NWAVES = 8;
constexpr int BATCH = 2, SEQ = 8192, DM = 1024, M = BATCH * SEQ, FF = 2816, DEPTH = 2;
enum { I_X = 0, I_P, I_F1N, I_F1G, I_F1U, I_F1D, I_MIXN, I_WIN, I_SINK, I_MU, I_W0, I_WUP, I_A0, I_AUP, I_GUP, I_KK, I_KA, I_RK, I_LNW, I_LNB, I_HLB, I_HNORM, I_WBR, I_WO,
       I_F2N, I_F2G, I_F2U, I_F2D, I_PLEN, I_PLEG, I_PLEP, I_FINN, N_IN };
constexpr size_t KiB = 1024, MiB = 1u << 20;
constexpr size_t WS_CTL = 0, CTL_ZERO_BYTES = 64 * KiB;
constexpr size_t WS_SS0 = 1 * MiB, WS_SS1 = 2 * MiB;
constexpr size_t WS_CBON = 3 * MiB;
constexpr size_t WS_LB = 3 * MiB + 512 * KiB;
constexpr size_t WS_W = 4 * MiB;
constexpr size_t W_F1GU = WS_W, W_F1D = W_F1GU + (size_t)5632 * 1024 * 2, W_IN = W_F1D + (size_t)1024 * 2816 * 2, W_LR = W_IN + (size_t)7680 * 1024 * 2,
                 W_BR = W_LR + (size_t)1536 * 256 * 2, W_O = W_BR + (size_t)3 * 1024 * 512 * 2, W_F2GU = W_O + (size_t)1024 * 1024 * 2, W_F2D = W_F2GU + (size_t)5632 * 1024 * 2,
                 W_PG = W_F2D + (size_t)1024 * 2816 * 2, W_PP = W_PG + (size_t)1024 * 1024 * 2, W_END = W_PP + (size_t)1024 * 256 * 2;
constexpr size_t WS_XB = 61 * MiB;
static_assert(W_END <= WS_XB, "weights fit");
constexpr size_t WS_R = 93 * MiB;
constexpr size_t R_H = WS_R;
constexpr size_t R_SIN_V = WS_R, R_SIN_R = WS_R + 16 * MiB, R_SIN_W = WS_R + 32 * MiB, R_SIN_KP = WS_R + 48 * MiB, R_SIN_KK = WS_R + 64 * MiB, R_SIN_B = WS_R + 80 * MiB;
constexpr size_t R_CV = WS_R, R_CG = WS_R + 16 * MiB, R_CH = WS_R + 32 * MiB, R_CDT = WS_R + 64 * MiB, R_CQT = WS_R + 80 * MiB, R_CS = WS_R + 200 * MiB;
constexpr size_t R_DAG_G = WS_R + 96 * MiB;
constexpr size_t R_ZR = WS_R + 112 * MiB;
constexpr size_t R_AP = WS_R + 168 * MiB;
constexpr size_t R_DAG_W = WS_R + 176 * MiB, R_DAG_A = WS_R + 192 * MiB;
constexpr size_t R_ZA = WS_R + 112 * MiB;
constexpr size_t R_YRAW = WS_R + 200 * MiB;
constexpr size_t R_Y = WS_R + 16 * MiB;
constexpr size_t R_GG = WS_R + 112 * MiB;
constexpr size_t R_MERGED = WS_R + 64 * MiB;
constexpr size_t R_PB = WS_R + 96 * MiB;
constexpr size_t R_PROJ = WS_R + 112 * MiB;
constexpr size_t R_XBALT = WS_R + 144 * MiB;
constexpr size_t R_HST = WS_R + 216 * MiB;
constexpr size_t WS_HD = 3 * MiB + 576 * KiB;
constexpr size_t WS_END = WS_R + 224 * MiB;
constexpr int CW_BAR = 4096;
constexpr int RING_OFF = 0, RING_BYTES = 131072;
constexpr int LDSCTL_OFF = 143360, MISC_OFF = LDSCTL_OFF + 320;
constexpr int LDS_BYTES = 147456;
constexpr int N_PHASES = 17 * DEPTH + 1;
#ifndef ENMASK
#define ENMASK 0x3ffff
#endif
#define EN(k) ((ENMASK >> (k)) & 1)
struct Args { const float* in[N_IN]; float* out; unsigned char* ws; int ph_lo, ph_hi; };
typedef const __attribute__((address_space(4))) unsigned char* kargp_t;
#define KP_DECL kargp_t KP_ = (kargp_t)__builtin_amdgcn_kernarg_segment_ptr(); asm volatile("" : "+s"(KP_))
#define INP(i) (*(const float* const __attribute__((address_space(4)))*)(KP_ + 8 * (i)))
typedef unsigned u32x2 __attribute__((ext_vector_type(2)));
__device__ __forceinline__ float bflo(unsigned w) { return __uint_as_float(w << 16); }
__device__ __forceinline__ float bfhi(unsigned w) { return __uint_as_float(w & 0xffff0000u); }
__device__ __forceinline__ float bf1(bf16 b) { return __uint_as_float(((unsigned)b) << 16); }
__device__ __forceinline__ float sigm(float x) { return __builtin_amdgcn_rcpf(1.0f + __builtin_amdgcn_exp2f(-1.4426950408889634f * x)); }
template <int CTRL> __device__ __forceinline__ float dppf(float x) { return __builtin_bit_cast(float, __builtin_amdgcn_mov_dpp(__builtin_bit_cast(int, x), CTRL, 0xf, 0xf, true)); }
__device__ __forceinline__ float xrow16_sum(float x) {
    auto s = __builtin_amdgcn_permlane16_swap(__float_as_uint(x), __float_as_uint(x), false, false);
    x = __uint_as_float(s[0]) + __uint_as_float(s[1]);
    auto t = __builtin_amdgcn_permlane32_swap(__float_as_uint(x), __float_as_uint(x), false, false);
    return __uint_as_float(t[0]) + __uint_as_float(t[1]);
}
__device__ __forceinline__ float wave_allsum(float x) {
    x += dppf<0xB1>(x); x += dppf<0x4E>(x); x += dppf<0x141>(x); x += dppf<0x128>(x); return xrow16_sum(x);
}
__device__ __forceinline__ float wave_allsum_slow(float v) {
#pragma unroll
    for (int o = 1; o < 64; o <<= 1) v += __shfl_xor(v, o);
    return v;
}
__device__ __forceinline__ float wave_allmax_slow(float v) {
#pragma unroll
    for (int o = 1; o < 64; o <<= 1) v = fmaxf(v, __shfl_xor(v, o));
    return v;
}

struct Frame {
    LAS unsigned char* lds;
    volatile LAS unsigned* MISC;
    gu32* ctl;
    int tid, lane, wave;
    int G;
    unsigned char* ws;
    float* x;
};
#define WSP(T, off) ((T*)(F.ws + (off)))

__device__ __forceinline__ int map_row(int map, int n0) {
    if (map == 1) return (n0 >> 7) * 256 + (n0 & 127);
    if (map == 2) return (n0 >> 7) * 256 + 128 + (n0 & 127);
    if (map == 3) return n0 < 768 ? 1792 + n0 : (n0 < 2560 ? n0 - 768 : n0);
    return n0;
}
struct CJob { const float* W; const float* g; int K, N; bf16* WT; int map, item; };
__device__ __forceinline__ void conv_load(const CJob& j, int lane, f32x4 (&v)[16], float (&sc)[16]) {
    const int nblk = j.N / 64, kb = j.item / nblk, nb = j.item % nblk, k0 = 64 * kb, n0 = 64 * nb; const int nq = (lane & 15) * 4;
#pragma unroll
    for (int i = 0; i < 16; ++i) { const int kk = 4 * i + (lane >> 4); sc[i] = j.g ? j.g[k0 + kk] : 1.0f; v[i] = __builtin_nontemporal_load((const f32x4*)(j.W + (size_t)(k0 + kk) * j.N + n0 + nq)); }
}
__device__ __forceinline__ void conv_to_lds(int lane, const f32x4 (&v)[16], const float (&sc)[16], LAS float* scr) {
    const int nq = (lane & 15) * 4;
#pragma unroll
    for (int i = 0; i < 16; ++i) { const int kk = 4 * i + (lane >> 4); LAS float* d = scr + kk * 65 + nq; d[0] = v[i].x * sc[i]; d[1] = v[i].y * sc[i]; d[2] = v[i].z * sc[i]; d[3] = v[i].w * sc[i]; }
}
__device__ __forceinline__ void conv_store(const CJob& j, int lane, const LAS float* scr) {
    const int nblk = j.N / 64, kb = j.item / nblk, nb = j.item % nblk, k0 = 64 * kb, n0 = 64 * nb; const int c = lane & 7; const int dr = map_row(j.map, n0);
#pragma unroll
    for (int q = 0; q < 8; ++q) { const int n = (lane >> 3) + 8 * q; const LAS float* s = scr + (8 * c) * 65 + n;
        v4u o; o.x = pk2(s[0 * 65], s[1 * 65]); o.y = pk2(s[2 * 65], s[3 * 65]); o.z = pk2(s[4 * 65], s[5 * 65]); o.w = pk2(s[6 * 65], s[7 * 65]);
        *(GAS v4u*)(j.WT + (size_t)(dr + n) * j.K + k0 + 8 * c) = o; }
}
template <int PART> __device__ __forceinline__ void phase_conv(Frame& F, const Args& A, int L) {
    KP_DECL;
    LAS float* scr = (LAS float*)(F.lds + RING_OFF + F.wave * 16640);
    const int gw = blockIdx.x * NWAVES + F.wave, NGW = F.G * NWAVES;
    const float* f1g = INP(I_F1G) + (size_t)L * 1024 * 2816; const float* f1u = INP(I_F1U) + (size_t)L * 1024 * 2816; const float* f1d = INP(I_F1D) + (size_t)L * 2816 * 1024;
    const float* f2g = INP(I_F2G) + (size_t)L * 1024 * 2816; const float* f2u = INP(I_F2U) + (size_t)L * 1024 * 2816; const float* f2d = INP(I_F2D) + (size_t)L * 2816 * 1024;
    const float* win = INP(I_WIN) + (size_t)L * 1024 * 7680; const float* wbr = INP(I_WBR) + (size_t)L * 3 * 512 * 1024; const float* wo = INP(I_WO) + (size_t)L * 1024 * 1024;
    const float* pg = INP(I_PLEG) + (size_t)L * 1024 * 1024; const float* pp = INP(I_PLEP) + (size_t)L * 256 * 1024;
    const float* n1 = INP(I_F1N) + L * 1024; const float* nm = INP(I_MIXN) + L * 1024; const float* n2 = INP(I_F2N) + L * 1024; const float* np = INP(I_PLEN) + L * 1024;
    constexpr int IT_FGU = 16 * 44, IT_FD = 44 * 16, IT_IN = 16 * 120, IT_BR = 8 * 16, IT_SQ = 16 * 16, IT_PP = 4 * 16;
    constexpr int NITEMS = 4 * IT_FGU + 2 * IT_FD + IT_IN + 3 * IT_BR + 2 * IT_SQ + IT_PP;
#define CONV_DECODE(it_, J) do { int r = (it_); \
        if (r < IT_FGU) { J = CJob{f1g, n1, 1024, 2816, WSP(bf16, W_F1GU), 1, r}; break; } r -= IT_FGU; \
        if (r < IT_FGU) { J = CJob{f1u, n1, 1024, 2816, WSP(bf16, W_F1GU), 2, r}; break; } r -= IT_FGU; \
        if (r < IT_FD)  { J = CJob{f1d, nullptr, 2816, 1024, WSP(bf16, W_F1D), 0, r}; break; } r -= IT_FD; \
        if (r < IT_IN)  { J = CJob{win, nm, 1024, 7680, WSP(bf16, W_IN), 3, r}; break; } r -= IT_IN; \
        if (r < 3 * IT_BR) { const int b_ = r / IT_BR; J = CJob{wbr + (size_t)b_ * 512 * 1024, nullptr, 512, 1024, WSP(bf16, W_BR) + (size_t)b_ * 1024 * 512, 0, r % IT_BR}; break; } r -= 3 * IT_BR; \
        if (r < IT_SQ)  { J = CJob{wo, nullptr, 1024, 1024, WSP(bf16, W_O), 0, r}; break; } r -= IT_SQ; \
        if (r < IT_FGU) { J = CJob{f2g, n2, 1024, 2816, WSP(bf16, W_F2GU), 1, r}; break; } r -= IT_FGU; \
        if (r < IT_FGU) { J = CJob{f2u, n2, 1024, 2816, WSP(bf16, W_F2GU), 2, r}; break; } r -= IT_FGU; \
        if (r < IT_FD)  { J = CJob{f2d, nullptr, 2816, 1024, WSP(bf16, W_F2D), 0, r}; break; } r -= IT_FD; \
        if (r < IT_SQ)  { J = CJob{pg, np, 1024, 1024, WSP(bf16, W_PG), 0, r}; break; } r -= IT_SQ; \
        J = CJob{pp, nullptr, 256, 1024, WSP(bf16, W_PP), 0, r}; } while (0)
    constexpr int NA = 2 * IT_FGU + IT_FD + IT_IN;
    const int first = (PART == 0) ? gw : NA + ((int)blockIdx.x - F.G / 2) * NWAVES + F.wave, stride = (PART == 0) ? NGW : (F.G - F.G / 2) * NWAVES, hi_ = (PART == 0) ? NA : NITEMS;
    { CJob cur{}, nxt{}; f32x4 v[16]; float scv[16];
      if (first < hi_) { CONV_DECODE(first, cur); conv_load(cur, F.lane, v, scv); }
      for (int it = first; it < hi_; it += stride) {
          conv_to_lds(F.lane, v, scv, scr);
          const bool has = it + stride < hi_;
          if (has) { CONV_DECODE(it + stride, nxt); conv_load(nxt, F.lane, v, scv); }
          LDS_WAIT(); asm volatile("" ::: "memory");
          conv_store(cur, F.lane, scr);
          LDS_WAIT(); asm volatile("" ::: "memory");
          cur = nxt; } }
#undef CONV_DECODE
    if (PART != 0) return;
    const float* wup = INP(I_WUP) + (size_t)L * 64 * 512; const float* aup = INP(I_AUP) + (size_t)L * 64 * 512; const float* gup = INP(I_GUP) + (size_t)L * 128 * 512;
    bf16* wlr = WSP(bf16, W_LR);
    const int gt = blockIdx.x * (NWAVES * 64) + F.tid, NGT = F.G * NWAVES * 64;
    for (int e = gt; e < 1536 * 256; e += NGT) { const int n = e >> 8, k = e & 255; const int grp = n >> 9, c = n & 511; float v = 0.f;
        if (grp == 0) { if (k < 64) v = wup[k * 512 + c]; } else if (grp == 1) { if (k >= 64 && k < 128) v = aup[(k - 64) * 512 + c]; } else { if (k >= 128) v = gup[(k - 128) * 512 + c]; }
        wlr[e] = (bf16)f2bf(v); }
    if (gt < 512) { const float a0 = INP(I_HLB)[gt], a1 = INP(I_HLB)[512 + gt]; const float mx = fmaxf(a0, a1); const float e0 = __expf(a0 - mx), e1 = __expf(a1 - mx);
        float lb = (L == 0) ? 0.f : e1 / (e0 + e1); lb = fminf(fmaxf(lb, 0.f), 1.0f - 1e-6f); WSP(float, WS_LB)[gt] = lb; }
    if (L == 0) {
        const float* xin = INP(I_X); bf16* xb = WSP(bf16, WS_XB); float* ss = WSP(float, WS_SS0);
        for (int m0 = gw; m0 < M; m0 += 2 * NGW) {
            f32x4 v[2][4];
#pragma unroll
            for (int k = 0; k < 2; ++k) { const int m = (m0 + k * NGW < M) ? m0 + k * NGW : m0; const GAS f32x4* xr = (const GAS f32x4*)(xin + (size_t)m * DM) + F.lane;
#pragma unroll
                for (int j = 0; j < 4; ++j) v[k][j] = __builtin_nontemporal_load((const f32x4*)(xr + 64 * j)); }
#pragma unroll
            for (int k = 0; k < 2; ++k) { const int m = m0 + k * NGW; if (m >= M) break;
                GAS unsigned long long* o8 = (GAS unsigned long long*)(xb + (size_t)m * DM) + F.lane; float s = 0.f;
#pragma unroll
                for (int j = 0; j < 4; ++j) { const f32x4 vv = v[k][j]; s += (vv.x * vv.x + vv.y * vv.y) + (vv.z * vv.z + vv.w * vv.w);
                    o8[64 * j] = (unsigned long long)pk2(vv.x, vv.y) | ((unsigned long long)pk2(vv.z, vv.w) << 32); }
                s = wave_allsum_slow(s);
                if (F.lane < 16) ss[(size_t)m * 16 + F.lane] = (F.lane == 0) ? s : 0.f; } }
    }
}
__device__ __forceinline__ void conv_p(Frame& F, const Args& A, int L) {
    KP_DECL;
    const float* p = INP(I_P) + (size_t)L * M * 256; bf16* pb = WSP(bf16, R_PB);
    const int gt = blockIdx.x * (NWAVES * 64) + F.tid, NGT = F.G * NWAVES * 64;
    for (int e0 = gt; e0 < M * 256 / 8; e0 += 4 * NGT) {
        f32x4 a[4], b[4];
#pragma unroll
        for (int k = 0; k < 4; ++k) { const int e = e0 + k * NGT; if (e < M * 256 / 8) { a[k] = __builtin_nontemporal_load((const f32x4*)(p + (size_t)e * 8)); b[k] = __builtin_nontemporal_load((const f32x4*)(p + (size_t)e * 8 + 4)); } }
#pragma unroll
        for (int k = 0; k < 4; ++k) { const int e = e0 + k * NGT; if (e < M * 256 / 8) {
            v4u o; o.x = pk2(a[k].x, a[k].y); o.y = pk2(a[k].z, a[k].w); o.z = pk2(b[k].x, b[k].y); o.w = pk2(b[k].z, b[k].w); *(v4u*)(pb + (size_t)e * 8) = o; } } }
}

__device__ __forceinline__ void phase_rprep1(Frame& F, const Args& A, int L) {
    KP_DECL;
    const bf16* zr = WSP(bf16, R_ZR); bf16* ap = WSP(bf16, R_AP); const float* mu = INP(I_MU) + L * 1792 + 1536;
    const int gt = blockIdx.x * (NWAVES * 64) + F.tid, NGT = F.G * NWAVES * 64;
    for (int e = gt; e < M * 32; e += NGT) { const int row = e >> 5, c0 = (e & 31) * 8; const int tl = row & (SEQ - 1);
        const v4u zc = *(const v4u*)(zr + (size_t)row * 1792 + 1536 + c0); v4u zp = (v4u){0u, 0u, 0u, 0u};
        if (tl != 0) zp = *(const v4u*)(zr + (size_t)(row - 1) * 1792 + 1536 + c0);
        float o[8];
#pragma unroll
        for (int i = 0; i < 4; ++i) { const unsigned wc_ = zc[i], wp_ = zp[i];
            const float c_lo = bflo(wc_), c_hi = bfhi(wc_), p_lo = bflo(wp_), p_hi = bfhi(wp_);
            const float m0 = mu[c0 + 2 * i], m1 = mu[c0 + 2 * i + 1];
            o[2 * i] = c_lo + m0 * (p_lo - c_lo); o[2 * i + 1] = c_hi + m1 * (p_hi - c_hi); }
#pragma unroll
        for (int i = 0; i < 8; ++i) { if (c0 < 64) o[i] = 2.0f * sigm(2.0f * o[i]) - 1.0f; else if (c0 >= 128) o[i] = sigm(o[i]); }
        v4u w; w.x = pk2(o[0], o[1]); w.y = pk2(o[2], o[3]); w.z = pk2(o[4], o[5]); w.w = pk2(o[6], o[7]);
        *(v4u*)(ap + (size_t)row * 256 + c0) = w; }
}
typedef float f32x16 __attribute__((ext_vector_type(16)));
__device__ __forceinline__ unsigned cvtpk(float lo, float hi) { return pg8::cvtpk_s(lo, hi); }
constexpr int LDP = 72;
__device__ __forceinline__ f32x4 mm16_k64(const LAS bf16* X, const LAS bf16* YT, int m0, int n0, int lane, f32x4 acc) {
    const int r = lane & 15, g = lane >> 4;
#pragma unroll
    for (int ks = 0; ks < 2; ++ks) { const bf16x8 a = *(const LAS bf16x8*)(X + (m0 + r) * LDP + ks * 32 + 8 * g); const bf16x8 b = *(const LAS bf16x8*)(YT + (n0 + r) * LDP + ks * 32 + 8 * g);
        acc = __builtin_amdgcn_mfma_f32_16x16x32_bf16(a, b, acc, 0, 0, 0); }
    return acc;
}
constexpr int RC_MAT = 64 * LDP * 2;
constexpr int RC_BH = 0, RC_KH = RC_MAT, RC_PC = 2 * RC_MAT, RC_RC = 3 * RC_MAT, RC_PT = 4 * RC_MAT, RC_AKP = 5 * RC_MAT, RC_RT = 6 * RC_MAT, RC_VT = 7 * RC_MAT;
constexpr int RC_XR = 8 * RC_MAT;
constexpr int RC_TI = 10 * RC_MAT;
constexpr int RC_ABP = 11 * RC_MAT;
constexpr int RC_TT = RC_ABP + 16384;
constexpr int RC_PS = RC_TT + 16384;
constexpr int RC_GC = RC_PS + 4096;
constexpr int RC_PAR = RC_GC + 256;
constexpr int RC_END = RC_PAR + 6 * 64 * 4;
static_assert(RC_END <= LDSCTL_OFF, "rwkv pre-pass LDS");
constexpr int RC_ZT = RC_PC;
constexpr int RC_KBT = RC_BH;
__device__ __forceinline__ float shx(float v, int m) { return __shfl_xor(v, m); }
__device__ __forceinline__ float sum8(float v) { v += dppf<0xB1>(v); v += dppf<0x4E>(v); v += dppf<0x141>(v); return v; }
__device__ __forceinline__ float sum16(float v) { v = sum8(v); v += dppf<0x128>(v); return v; }
__device__ __forceinline__ void phase_rchunk_pre(Frame& F, const Args& A, int L) {
    KP_DECL;
    const bf16* zr = WSP(bf16, R_ZR); const bf16* dw = WSP(bf16, R_DAG_W); const bf16* da = WSP(bf16, R_DAG_A);
    const float* mu = INP(I_MU) + L * 1792; const float* k_k = INP(I_KK) + L * 512; const float* k_a = INP(I_KA) + L * 512; const float* r_k = INP(I_RK) + L * 512;
    float* cbon = WSP(float, WS_CBON); bf16* gV = WSP(bf16, R_CV);
    LAS unsigned char* lds = F.lds;
    const int t = F.tid >> 3, cg = F.tid & 7, c0 = cg * 8;
    v4u n_cr, n_ck, n_cv, n_pr, n_pk, n_pv, n_ww, n_aa;
#define RPRE_LOAD(it_) do { const int bh_ = (it_) >> 7, ck2_ = (it_) & 127; const int row_ = (bh_ >> 3) * SEQ + ck2_ * 64 + t, ch_ = (bh_ & 7) * 64 + c0; const bf16* zc_ = zr + (size_t)row_ * 1792 + ch_; \
        n_cr = *(const v4u*)zc_; n_ck = *(const v4u*)(zc_ + 512); n_cv = *(const v4u*)(zc_ + 1024); n_pr = (v4u){0u,0u,0u,0u}; n_pk = n_pr; n_pv = n_pr; \
        if (ck2_ * 64 + t != 0) { n_pr = *(const v4u*)(zc_ - 1792); n_pk = *(const v4u*)(zc_ - 1792 + 512); n_pv = *(const v4u*)(zc_ - 1792 + 1024); } \
        n_ww = *(const v4u*)(dw + (size_t)row_ * 512 + ch_); n_aa = *(const v4u*)(da + (size_t)row_ * 512 + ch_); } while (0)
#define RPRE_ITEM(s_) (((((s_) >> 3) >> 7) * 8 + ((s_) & 7)) * 128 + (((s_) >> 3) & 127))
    if ((int)blockIdx.x < 2048) RPRE_LOAD(RPRE_ITEM((int)blockIdx.x));
    int h_par = -1; LAS float* PAR = (LAS float*)(lds + RC_PAR);
    for (int slot = blockIdx.x; slot < 2048; slot += F.G) { const int item = RPRE_ITEM(slot);
        const int bh = item >> 7, ck = item & 127, b = bh >> 3, h = bh & 7; const int row = b * SEQ + ck * 64 + t, ch = h * 64 + c0;
        if (h != h_par) { h_par = h;
            if (F.tid < 384) { const int a_ = F.tid >> 6, c_ = F.tid & 63; PAR[F.tid] = (a_ < 3) ? mu[a_ * 512 + h * 64 + c_] : (a_ == 3 ? k_k[h * 64 + c_] : (a_ == 4 ? k_a[h * 64 + c_] : r_k[h * 64 + c_])); }
            __syncthreads(); }
        float r_[8], kp_[8], kk_[8], bb_[8], lw_[8];
        { float v_[8]; const v4u cr = n_cr, ck_ = n_ck, cv = n_cv, pr = n_pr, pk = n_pk, pv = n_pv, ww = n_ww, aa = n_aa;
          float ssq = 0.f, cb = 0.f;
#pragma unroll
          for (int i = 0; i < 8; ++i) { const int q = i >> 1; const bool hi = i & 1;
              const float crf = hi ? bfhi(cr[q]) : bflo(cr[q]), ckf = hi ? bfhi(ck_[q]) : bflo(ck_[q]), cvf = hi ? bfhi(cv[q]) : bflo(cv[q]);
              const float prf = hi ? bfhi(pr[q]) : bflo(pr[q]), pkf = hi ? bfhi(pk[q]) : bflo(pk[q]), pvf = hi ? bfhi(pv[q]) : bflo(pv[q]);
              const float w = hi ? bfhi(ww[q]) : bflo(ww[q]), a = hi ? bfhi(aa[q]) : bflo(aa[q]);
              const float r = crf + PAR[c0 + i] * (prf - crf), k = ckf + PAR[64 + c0 + i] * (pkf - ckf), v = cvf + PAR[128 + c0 + i] * (pvf - cvf);
              const float kk = k * PAR[192 + c0 + i]; ssq += kk * kk; const float kp = k * (1.0f + (a - 1.0f) * PAR[256 + c0 + i]);
              r_[i] = r; kp_[i] = kp; kk_[i] = kk; bb_[i] = a; v_[i] = v; lw_[i] = __logf(w); cb += r * kp * PAR[320 + c0 + i]; }
          ssq = sum8(ssq); cb = sum8(cb);
          const float inv = __builtin_amdgcn_rsqf(fmaxf(ssq, 1e-24f));
#pragma unroll
          for (int i = 0; i < 8; ++i) { kk_[i] *= inv; bb_[i] *= kk_[i]; }
          if (cg == 0) cbon[(size_t)row * 8 + h] = cb;
          if (slot + F.G < 2048) RPRE_LOAD(RPRE_ITEM(slot + F.G));
          v4u vo; vo.x = pk2(v_[0], v_[1]); vo.y = pk2(v_[2], v_[3]); vo.z = pk2(v_[4], v_[5]); vo.w = pk2(v_[6], v_[7]); *(v4u*)(gV + (size_t)row * 512 + ch) = vo;
          { LAS bf16* VT = (LAS bf16*)(lds + RC_VT);
#pragma unroll
            for (int i = 0; i < 8; ++i) VT[(c0 + i) * LDP + t] = (bf16)f2bf(v_[i]); } }
        { LAS float* LW = (LAS float*)(lds + RC_ABP);
#pragma unroll
          for (int i = 0; i < 8; ++i) LW[t * 64 + c0 + i] = lw_[i];
          __syncthreads();
          { const int cc = F.tid & 63, sg = F.tid >> 6; float loc[8]; float run = 0.f;
            LAS float* SG = (LAS float*)(lds + RC_PS);
#pragma unroll
            for (int e = 0; e < 8; ++e) { run += LW[(8 * sg + e) * 64 + cc]; loc[e] = run; }
            SG[sg * 64 + cc] = run;
            __syncthreads();
            float pre = 0.f;
#pragma unroll
            for (int q = 0; q < 8; ++q) { const float tv = SG[q * 64 + cc]; if (q < sg) pre += tv; }
#pragma unroll
            for (int e = 0; e < 8; ++e) LW[(8 * sg + e) * 64 + cc] = pre + loc[e]; }
          __syncthreads();
          LAS bf16* Bh = (LAS bf16*)(lds + RC_BH); LAS bf16* Kh = (LAS bf16*)(lds + RC_KH); LAS bf16* Pc = (LAS bf16*)(lds + RC_PC); LAS bf16* Rc = (LAS bf16*)(lds + RC_RC);
          LAS bf16* PT = (LAS bf16*)(lds + RC_PT); LAS bf16* Rt = (LAS bf16*)(lds + RC_RT); LAS bf16* BhT = (LAS bf16*)(lds + RC_XR); LAS float* GC = (LAS float*)(lds + RC_GC);
          float bh_[8], kh_[8], pc_[8], rc_[8], rt_[8];
#pragma unroll
          for (int i = 0; i < 8; ++i) { const float Lt = LW[t * 64 + c0 + i], Lp = (t == 0) ? 0.f : LW[(t - 1) * 64 + c0 + i], LC = LW[63 * 64 + c0 + i];
              const float e1 = __expf(LC - Lt); bh_[i] = bb_[i] * e1; kh_[i] = kp_[i] * e1; pc_[i] = kk_[i] * __expf(Lp - LC); rc_[i] = r_[i] * __expf(Lt - LC); rt_[i] = r_[i] * __expf(Lt);
              PT[(c0 + i) * LDP + t] = (bf16)f2bf(kk_[i] * __expf(Lp)); BhT[(c0 + i) * LDP + t] = (bf16)f2bf(bh_[i]); if (t == 63) GC[c0 + i] = __expf(LC); }
          v4u o; o.x = pk2(bh_[0], bh_[1]); o.y = pk2(bh_[2], bh_[3]); o.z = pk2(bh_[4], bh_[5]); o.w = pk2(bh_[6], bh_[7]); *(LAS v4u*)(Bh + t * LDP + c0) = o;
          o.x = pk2(kh_[0], kh_[1]); o.y = pk2(kh_[2], kh_[3]); o.z = pk2(kh_[4], kh_[5]); o.w = pk2(kh_[6], kh_[7]); *(LAS v4u*)(Kh + t * LDP + c0) = o;
          o.x = pk2(pc_[0], pc_[1]); o.y = pk2(pc_[2], pc_[3]); o.z = pk2(pc_[4], pc_[5]); o.w = pk2(pc_[6], pc_[7]); *(LAS v4u*)(Pc + t * LDP + c0) = o;
          o.x = pk2(rc_[0], rc_[1]); o.y = pk2(rc_[2], rc_[3]); o.z = pk2(rc_[4], rc_[5]); o.w = pk2(rc_[6], rc_[7]); *(LAS v4u*)(Rc + t * LDP + c0) = o;
          o.x = pk2(rt_[0], rt_[1]); o.y = pk2(rt_[2], rt_[3]); o.z = pk2(rt_[4], rt_[5]); o.w = pk2(rt_[6], rt_[7]); *(LAS v4u*)(Rt + t * LDP + c0) = o;
          __syncthreads(); }
        f32x4 akr[4];
        { const int r16 = F.lane & 15, g4 = F.lane >> 4; const int xsel = F.wave >> 2, m0 = (F.wave & 3) * 16;
          const LAS bf16* X = (const LAS bf16*)(lds + (xsel ? RC_KH : RC_BH)) + (m0 + r16) * LDP + 8 * g4;
          const bf16x8 xa0 = *(const LAS bf16x8*)X, xa1 = *(const LAS bf16x8*)(X + 32);
          f32x4 acc[2][4];
#pragma unroll
          for (int ys = 0; ys < 2; ++ys)
#pragma unroll
              for (int nt = 0; nt < 4; ++nt) { const LAS bf16* Y = (const LAS bf16*)(lds + (ys ? RC_RC : RC_PC)) + (16 * nt + r16) * LDP + 8 * g4;
                  const bf16x8 b0 = *(const LAS bf16x8*)Y, b1 = *(const LAS bf16x8*)(Y + 32);
                  acc[ys][nt] = __builtin_amdgcn_mfma_f32_16x16x32_bf16(xa0, b0, (f32x4){0.f, 0.f, 0.f, 0.f}, 0, 0, 0); acc[ys][nt] = __builtin_amdgcn_mfma_f32_16x16x32_bf16(xa1, b1, acc[ys][nt], 0, 0, 0); }
#pragma unroll
          for (int nt = 0; nt < 4; ++nt) { const int tt = 16 * nt + r16; const int i0 = m0 + 4 * g4; float v0[4], v1[4];
#pragma unroll
              for (int rg = 0; rg < 4; ++rg) { v0[rg] = (i0 + rg < tt) ? acc[0][nt][rg] : 0.f; v1[rg] = (i0 + rg <= tt) ? acc[1][nt][rg] : 0.f; }
              if (xsel == 0) {
#pragma unroll
                  for (int rg = 0; rg < 4; ++rg) ((LAS float*)(lds + RC_ABP))[(i0 + rg) * 64 + tt] = v0[rg];
                  u32x2 o; o.x = pk2(v1[0], v1[1]); o.y = pk2(v1[2], v1[3]); *(LAS u32x2*)((LAS bf16*)(lds + RC_XR) + (64 + tt) * LDP + i0) = o; }
              else {
#pragma unroll
                  for (int rg = 0; rg < 4; ++rg) ((LAS bf16*)(lds + RC_AKP))[(i0 + rg) * LDP + tt] = (bf16)f2bf(v0[rg]);
                  akr[nt] = (f32x4){v1[0], v1[1], v1[2], v1[3]}; } }
          __syncthreads(); }
        { const LAS float* AB = (const LAS float*)(lds + RC_ABP); LAS float* TT = (LAS float*)(lds + RC_TT); LAS float* PS = (LAS float*)(lds + RC_PS);
          if (F.tid < 64) { const int a = F.tid >> 4, e = F.tid & 15; const LAS float* Aa = AB + (16 * a) * 64 + 16 * a; float x[16];
#pragma unroll
              for (int r = 15; r >= 0; --r) { float acc = (r == e) ? 1.0f : 0.f;
#pragma unroll
                  for (int j = r + 1; j < 16; ++j) acc = __builtin_fmaf(-Aa[r * 64 + j], x[j], acc);
                  x[r] = acc; }
#pragma unroll
              for (int r = 0; r < 16; ++r) TT[(16 * a + r) * 64 + 16 * a + e] = x[r]; }
          __syncthreads();
#pragma unroll 1
          for (int d = 1; d < 4; ++d) { const int nel = (4 - d) * 256;
              for (int el = F.tid; el < nel; el += NWAVES * 64) { const int a = el >> 8, r = (el >> 4) & 15, c = el & 15, b = a + d; float acc = 0.f;
                  for (int cc = a + 1; cc <= b; ++cc) { const LAS float* ar = AB + (16 * a + r) * 64 + 16 * cc; const LAS float* tc = TT + (16 * cc) * 64 + 16 * b + c;
#pragma unroll
                      for (int j = 0; j < 16; ++j) acc = __builtin_fmaf(ar[j], tc[j * 64], acc); }
                  PS[el] = acc; }
              __syncthreads();
              for (int el = F.tid; el < nel; el += NWAVES * 64) { const int a = el >> 8, r = (el >> 4) & 15, c = el & 15, b = a + d; float acc = 0.f; const LAS float* dr = TT + (16 * a + r) * 64 + 16 * a; const LAS float* sc = PS + (a << 8) + c;
#pragma unroll
                  for (int j = 0; j < 16; ++j) acc = __builtin_fmaf(-dr[j], sc[j * 16], acc);
                  TT[(16 * a + r) * 64 + 16 * b + c] = acc; }
              __syncthreads(); }
          { LAS bf16* TI = (LAS bf16*)(lds + RC_TI); float o[8];
#pragma unroll
            for (int i = 0; i < 8; ++i) o[i] = ((c0 + i) >> 4) >= (t >> 4) ? TT[t * 64 + c0 + i] : 0.f;
            v4u w; w.x = pk2(o[0], o[1]); w.y = pk2(o[2], o[3]); w.z = pk2(o[4], o[5]); w.w = pk2(o[6], o[7]); *(LAS v4u*)(TI + t * LDP + c0) = w; }
          __syncthreads();
          { const int r16 = F.lane & 15, g4 = F.lane >> 4; const int m0 = (F.wave & 3) * 16, cb0 = (F.wave >> 2) * 64;
            const LAS bf16* X = (const LAS bf16*)(lds + RC_TI) + (m0 + r16) * LDP + 8 * g4; const bf16x8 xa0 = *(const LAS bf16x8*)X, xa1 = *(const LAS bf16x8*)(X + 32);
            f32x4 zc[4];
#pragma unroll
            for (int nt = 0; nt < 4; ++nt) { const LAS bf16* Y = (const LAS bf16*)(lds + RC_XR) + (cb0 + 16 * nt + r16) * LDP + 8 * g4; const bf16x8 b0 = *(const LAS bf16x8*)Y, b1 = *(const LAS bf16x8*)(Y + 32);
                zc[nt] = __builtin_amdgcn_mfma_f32_16x16x32_bf16(xa0, b0, (f32x4){0.f, 0.f, 0.f, 0.f}, 0, 0, 0); zc[nt] = __builtin_amdgcn_mfma_f32_16x16x32_bf16(xa1, b1, zc[nt], 0, 0, 0); }
#pragma unroll
            for (int nt = 0; nt < 4; ++nt) { u32x2 o; o.x = pk2(zc[nt][0], zc[nt][1]); o.y = pk2(zc[nt][2], zc[nt][3]); *(LAS u32x2*)((LAS bf16*)(lds + RC_ZT) + (cb0 + 16 * nt + r16) * LDP + m0 + 4 * g4) = o; } } }
        __syncthreads();
        { const int r16 = F.lane & 15, g4 = F.lane >> 4; const int xsel = F.wave >> 2, m0 = (F.wave & 3) * 16, mm = m0 + 4 * g4;
          bf16* gG = WSP(bf16, R_CG) + (size_t)item * 4096; bf16* gQ = WSP(bf16, R_CQT) + (size_t)item * 4096; bf16* gD = WSP(bf16, R_CDT) + (size_t)item * 4096;
          const LAS float* GC = (const LAS float*)(lds + RC_GC);
          const LAS bf16* X = (const LAS bf16*)(lds + (xsel ? RC_AKP : RC_PT)) + (m0 + r16) * LDP + 8 * g4;
          const bf16x8 xa0 = *(const LAS bf16x8*)X, xa1 = *(const LAS bf16x8*)(X + 32);
          f32x4 acc[2][4];
#pragma unroll
          for (int ys = 0; ys < 2; ++ys)
#pragma unroll
              for (int nt = 0; nt < 4; ++nt) { const LAS bf16* Y = (const LAS bf16*)(lds + RC_ZT) + (64 * ys + 16 * nt + r16) * LDP + 8 * g4;
                  const bf16x8 b0 = *(const LAS bf16x8*)Y, b1 = *(const LAS bf16x8*)(Y + 32);
                  acc[ys][nt] = __builtin_amdgcn_mfma_f32_16x16x32_bf16(xa0, b0, (f32x4){0.f, 0.f, 0.f, 0.f}, 0, 0, 0); acc[ys][nt] = __builtin_amdgcn_mfma_f32_16x16x32_bf16(xa1, b1, acc[ys][nt], 0, 0, 0); }
#pragma unroll
          for (int nt = 0; nt < 4; ++nt) { const int nn = 16 * nt + r16;
              if (xsel == 0) {
                  { const int i2 = nn >> 5, rr = nn & 31, kt = mm >> 5, sx_ = (mm >> 4) & 1, qq = mm & 15, hh = (qq >> 2) & 1, jj0 = (qq >> 3) << 2;
                    float gv[4];
#pragma unroll
                    for (int rg = 0; rg < 4; ++rg) gv[rg] = ((mm + rg) == nn ? GC[nn] : 0.f) - acc[0][nt][rg];
                    u32x2 o; o.x = pk2(gv[0], gv[1]); o.y = pk2(gv[2], gv[3]); *(u32x2*)(gG + ((((i2 * 2 + kt) * 2 + sx_) * 64 + rr + 32 * hh) * 8 + jj0)) = o; }
                  { const LAS bf16* Rt = (const LAS bf16*)(lds + RC_RT); const u32x2 rv = *(const LAS u32x2*)(Rt + nn * LDP + mm);
                    u32x2 o; o.x = pk2(bflo(rv.x) - acc[1][nt][0], bfhi(rv.x) - acc[1][nt][1]); o.y = pk2(bflo(rv.y) - acc[1][nt][2], bfhi(rv.y) - acc[1][nt][3]); *(u32x2*)(gQ + nn * 64 + mm) = o; }
              } else {
                  { const LAS bf16* Kh = (const LAS bf16*)(lds + RC_KH); float kv[4];
#pragma unroll
                    for (int rg = 0; rg < 4; ++rg) kv[rg] = bf1(Kh[(mm + rg) * LDP + nn]) - acc[0][nt][rg];
                    u32x2 o; o.x = pk2(kv[0], kv[1]); o.y = pk2(kv[2], kv[3]); *(LAS u32x2*)((LAS bf16*)(lds + RC_KBT) + nn * LDP + mm) = o; }
                  { float dv[4];
#pragma unroll
                    for (int rg = 0; rg < 4; ++rg) dv[rg] = akr[nt][rg] - acc[1][nt][rg];
                    u32x2 o; o.x = pk2(dv[0], dv[1]); o.y = pk2(dv[2], dv[3]); *(u32x2*)(gD + nn * 64 + mm) = o; } } }
          __syncthreads();
          bf16* gH = WSP(bf16, R_CH) + (size_t)item * 4096;
#pragma unroll
          for (int q = 0; q < 2; ++q) { const int id = F.wave * 2 + q, m0 = (id >> 2) * 16, n0 = (id & 3) * 16;
              const f32x4 acc = mm16_k64((const LAS bf16*)(lds + RC_VT), (const LAS bf16*)(lds + RC_KBT), m0, n0, F.lane, (f32x4){0.f, 0.f, 0.f, 0.f});
              const int kq = n0 + r16, vv = m0 + 4 * g4;
              const int i2 = kq >> 5, kl = kq & 31, rg16 = (kl & 3) | ((kl >> 3) << 2), hh = (kl >> 2) & 1, j2 = vv >> 5;
              bf16* hq_ = gH + j2 * 2048 + ((vv & 31) + 32 * hh) * 32 + i2 * 16 + rg16;
#pragma unroll
              for (int rg = 0; rg < 4; ++rg) hq_[32 * rg] = (bf16)f2bf(acc[rg]); }
          __syncthreads(); }
    }
}
__device__ __forceinline__ void rchunk_seq(Frame& F, int wid) {
    const int bh = wid >> 1, j = wid & 1; const int r32 = F.lane & 31, hh = F.lane >> 5;
    const bf16* gG = WSP(bf16, R_CG) + (size_t)bh * 128 * 4096; const bf16* gH = WSP(bf16, R_CH) + (size_t)bh * 128 * 4096 + j * 2048 + F.lane * 32; bf16* gS = WSP(bf16, R_CS) + (size_t)bh * 128 * 4096;
    f32x16 x0, x1;
#pragma unroll
    for (int i = 0; i < 16; ++i) { x0[i] = 0.f; x1[i] = 0.f; }
    bf16x8 gA[8], gB[8]; v4u hA[4], hB[4];
#define RS_LOAD(G_, H_, cc) do { const int c_ = ((cc) < 128) ? (cc) : 127; _Pragma("unroll") for (int q = 0; q < 8; ++q) G_[q] = *(const bf16x8*)(gG + (size_t)c_ * 4096 + (q * 64 + F.lane) * 8); \
        _Pragma("unroll") for (int q = 0; q < 4; ++q) H_[q] = *(const v4u*)(gH + (size_t)c_ * 4096 + 8 * q); } while (0)
#define RS_STEP(G_, H_, cc) do { \
        f32x16 h0, h1; \
        _Pragma("unroll") for (int q = 0; q < 4; ++q) { h0[2 * q] = bflo(H_[0][q]); h0[2 * q + 1] = bfhi(H_[0][q]); h0[8 + 2 * q] = bflo(H_[1][q]); h0[8 + 2 * q + 1] = bfhi(H_[1][q]); \
                                                         h1[2 * q] = bflo(H_[2][q]); h1[2 * q + 1] = bfhi(H_[2][q]); h1[8 + 2 * q] = bflo(H_[3][q]); h1[8 + 2 * q + 1] = bfhi(H_[3][q]); } \
        unsigned xb0[8], xb1[8]; \
        _Pragma("unroll") for (int q = 0; q < 8; ++q) { xb0[q] = cvtpk(x0[2 * q], x0[2 * q + 1]); xb1[q] = cvtpk(x1[2 * q], x1[2 * q + 1]); } \
        { bf16* sp = gS + (size_t)(cc) * 4096 + (32 * j + r32) * 64 + 8 * hh;     \
          _Pragma("unroll") for (int mq = 0; mq < 2; ++mq) { \
              { auto s0 = __builtin_amdgcn_permlane32_swap(xb0[4 * mq], xb0[4 * mq + 2], false, false); auto s1 = __builtin_amdgcn_permlane32_swap(xb0[4 * mq + 1], xb0[4 * mq + 3], false, false); \
                v4u o; o.x = s0[0]; o.y = s1[0]; o.z = s0[1]; o.w = s1[1]; *(v4u*)(sp + 16 * mq) = o; } \
              { auto s0 = __builtin_amdgcn_permlane32_swap(xb1[4 * mq], xb1[4 * mq + 2], false, false); auto s1 = __builtin_amdgcn_permlane32_swap(xb1[4 * mq + 1], xb1[4 * mq + 3], false, false); \
                v4u o; o.x = s0[0]; o.y = s1[0]; o.z = s0[1]; o.w = s1[1]; *(v4u*)(sp + 32 + 16 * mq) = o; } } } \
        const bf16x8 b00 = __builtin_bit_cast(bf16x8, (v4u){xb0[0], xb0[1], xb0[2], xb0[3]}), b01 = __builtin_bit_cast(bf16x8, (v4u){xb0[4], xb0[5], xb0[6], xb0[7]}); \
        const bf16x8 b10 = __builtin_bit_cast(bf16x8, (v4u){xb1[0], xb1[1], xb1[2], xb1[3]}), b11 = __builtin_bit_cast(bf16x8, (v4u){xb1[4], xb1[5], xb1[6], xb1[7]}); \
        h0 = __builtin_amdgcn_mfma_f32_32x32x16_bf16(G_[0], b00, h0, 0, 0, 0); h1 = __builtin_amdgcn_mfma_f32_32x32x16_bf16(G_[4], b00, h1, 0, 0, 0); \
        h0 = __builtin_amdgcn_mfma_f32_32x32x16_bf16(G_[1], b01, h0, 0, 0, 0); h1 = __builtin_amdgcn_mfma_f32_32x32x16_bf16(G_[5], b01, h1, 0, 0, 0); \
        h0 = __builtin_amdgcn_mfma_f32_32x32x16_bf16(G_[2], b10, h0, 0, 0, 0); h1 = __builtin_amdgcn_mfma_f32_32x32x16_bf16(G_[6], b10, h1, 0, 0, 0); \
        h0 = __builtin_amdgcn_mfma_f32_32x32x16_bf16(G_[3], b11, h0, 0, 0, 0); h1 = __builtin_amdgcn_mfma_f32_32x32x16_bf16(G_[7], b11, h1, 0, 0, 0); \
        x0 = h0; x1 = h1; RS_LOAD(G_, H_, (cc) + 2); } while (0)
    RS_LOAD(gA, hA, 0); RS_LOAD(gB, hB, 1);
    for (int c = 0; c < 128; c += 2) { RS_STEP(gA, hA, c); RS_STEP(gB, hB, c + 1); }
#undef RS_LOAD
#undef RS_STEP
}
constexpr int RO_SX = 0, RO_QT = RC_MAT, RO_DT = 2 * RC_MAT, RO_VT = 3 * RC_MAT, RO_Y = 4 * RC_MAT, RO_HALF = RO_Y + 64 * 68 * 4;
constexpr int RO_PAR = 2 * RO_HALF;
static_assert(RO_PAR + 4096 <= LDSCTL_OFF, "rwkv output pass LDS (parameters)");
static_assert(2 * RO_HALF <= LDSCTL_OFF, "rwkv output pass LDS");
__device__ __forceinline__ void phase_rchunk_out(Frame& F, const Args& A, int L) {
    KP_DECL;
    const float* lnw = INP(I_LNW) + L * 512; const float* lnb = INP(I_LNB) + L * 512;
    const bf16* gV = WSP(bf16, R_CV); const bf16* dg = WSP(bf16, R_DAG_G); const float* cbon = WSP(float, WS_CBON); bf16* y1 = WSP(bf16, R_Y) + (size_t)M * 512;
    const int half = F.tid >> 8, ht = F.tid & 255, t = ht >> 2, c0 = (ht & 3) * 16, hw = F.wave & 3;
    LAS unsigned char* lds = F.lds + half * RO_HALF;
    { LAS float* PAR = (LAS float*)(F.lds + RO_PAR); const int pt = F.wave * 64 + (int)__builtin_amdgcn_mbcnt_hi(~0u, __builtin_amdgcn_mbcnt_lo(~0u, 0u));
      PAR[pt] = lnw[pt]; PAR[512 + pt] = lnb[pt]; }
    const LAS float* PW = (const LAS float*)(F.lds + RO_PAR); const LAS float* PB = PW + 512;
    v4u n_sx[2], n_qt[2], n_dt[2], n_vv[2], n_gg[2]; float n_cb;
#define ROUT_LOAD(it_) do { const int bh_ = (it_) >> 7, ck_ = (it_) & 127; const int row_ = (bh_ >> 3) * SEQ + ck_ * 64 + t; \
        _Pragma("unroll") for (int e = 0; e < 2; ++e) { n_sx[e] = __builtin_nontemporal_load((const v4u*)(WSP(bf16, R_CS) + (size_t)(it_) * 4096 + t * 64 + c0 + 8 * e)); n_qt[e] = __builtin_nontemporal_load((const v4u*)(WSP(bf16, R_CQT) + (size_t)(it_) * 4096 + t * 64 + c0 + 8 * e)); \
            n_dt[e] = __builtin_nontemporal_load((const v4u*)(WSP(bf16, R_CDT) + (size_t)(it_) * 4096 + t * 64 + c0 + 8 * e)); n_vv[e] = __builtin_nontemporal_load((const v4u*)(gV + (size_t)row_ * 512 + (bh_ & 7) * 64 + c0 + 8 * e)); n_gg[e] = __builtin_nontemporal_load((const v4u*)(dg + (size_t)row_ * 512 + (bh_ & 7) * 64 + c0 + 8 * e)); } \
        n_cb = cbon[(size_t)row_ * 8 + (bh_ & 7)]; } while (0)
    const int it0 = (int)blockIdx.x + half * F.G;
    if (it0 < 2048) ROUT_LOAD(it0);
    for (int base = blockIdx.x; base < 2048; base += 2 * F.G) {
        const int item = base + half * F.G; const bool valid = item < 2048;
        const int bh = item >> 7, ck = item & 127, b = bh >> 3, h = bh & 7; const int row = b * SEQ + ck * 64 + t, ch = h * 64 + c0;
        v4u vv[2], gv[2]; float cb = 0.f;
        if (valid) { cb = n_cb;
#pragma unroll
            for (int e = 0; e < 2; ++e) { vv[e] = n_vv[e]; gv[e] = n_gg[e];
                *(LAS v4u*)((LAS bf16*)(lds + RO_SX) + t * LDP + c0 + 8 * e) = n_sx[e]; *(LAS v4u*)((LAS bf16*)(lds + RO_QT) + t * LDP + c0 + 8 * e) = n_qt[e]; *(LAS v4u*)((LAS bf16*)(lds + RO_DT) + t * LDP + c0 + 8 * e) = n_dt[e];
                LAS bf16* VT = (LAS bf16*)(lds + RO_VT);
#pragma unroll
                for (int i = 0; i < 4; ++i) { VT[(c0 + 8 * e + 2 * i) * LDP + t] = (bf16)(vv[e][i] & 0xffffu); VT[(c0 + 8 * e + 2 * i + 1) * LDP + t] = (bf16)(vv[e][i] >> 16); } }
            if (item + 2 * F.G < 2048) ROUT_LOAD(item + 2 * F.G); }
        __syncthreads();
        if (valid) { const int r16 = F.lane & 15, g4 = F.lane >> 4, m0 = 16 * hw; LAS float* YL = (LAS float*)(lds + RO_Y);
            const LAS bf16* X1 = (const LAS bf16*)(lds + RO_SX) + (m0 + r16) * LDP + 8 * g4; const LAS bf16* X2 = (const LAS bf16*)(lds + RO_VT) + (m0 + r16) * LDP + 8 * g4;
            const bf16x8 a0 = *(const LAS bf16x8*)X1, a1 = *(const LAS bf16x8*)(X1 + 32), a2 = *(const LAS bf16x8*)X2, a3 = *(const LAS bf16x8*)(X2 + 32);
            f32x4 acc[4];
#pragma unroll
            for (int q = 0; q < 4; ++q) { const LAS bf16* Y1 = (const LAS bf16*)(lds + RO_QT) + (16 * q + r16) * LDP + 8 * g4; const LAS bf16* Y2 = (const LAS bf16*)(lds + RO_DT) + (16 * q + r16) * LDP + 8 * g4;
                acc[q] = __builtin_amdgcn_mfma_f32_16x16x32_bf16(a0, *(const LAS bf16x8*)Y1, (f32x4){0.f, 0.f, 0.f, 0.f}, 0, 0, 0); acc[q] = __builtin_amdgcn_mfma_f32_16x16x32_bf16(a1, *(const LAS bf16x8*)(Y1 + 32), acc[q], 0, 0, 0);
                acc[q] = __builtin_amdgcn_mfma_f32_16x16x32_bf16(a2, *(const LAS bf16x8*)Y2, acc[q], 0, 0, 0); acc[q] = __builtin_amdgcn_mfma_f32_16x16x32_bf16(a3, *(const LAS bf16x8*)(Y2 + 32), acc[q], 0, 0, 0); }
#pragma unroll
            for (int q = 0; q < 4; ++q) *(LAS f32x4*)(YL + (16 * q + r16) * 68 + m0 + 4 * g4) = acc[q]; }
        __syncthreads();
        if (valid) { const LAS float* YL = (const LAS float*)(lds + RO_Y) + t * 68 + c0; float y[16], s_ = 0.f;
#pragma unroll
            for (int i = 0; i < 16; ++i) { y[i] = YL[i]; s_ += y[i]; }
            s_ += dppf<0xB1>(s_); s_ += dppf<0x4E>(s_); const float mean = s_ * (1.0f / 64.0f); float q2 = 0.f;
#pragma unroll
            for (int i = 0; i < 16; ++i) { y[i] -= mean; q2 += y[i] * y[i]; }
            q2 += dppf<0xB1>(q2); q2 += dppf<0x4E>(q2); const float rstd = __builtin_amdgcn_rsqf(q2 * (1.0f / 64.0f) + 64e-5f);
#pragma unroll
            for (int e = 0; e < 2; ++e) { const v4u gg = gv[e]; float o[8];
#pragma unroll
                for (int i = 0; i < 8; ++i) { const int q = i >> 1; const bool hi = i & 1; const float vf = hi ? bfhi(vv[e][q]) : bflo(vv[e][q]), gf = hi ? bfhi(gg[q]) : bflo(gg[q]);
                    o[i] = (y[8 * e + i] * rstd * PW[ch + 8 * e + i] + PB[ch + 8 * e + i] + cb * vf) * gf; }
                v4u w; w.x = pk2(o[0], o[1]); w.y = pk2(o[2], o[3]); w.z = pk2(o[4], o[5]); w.w = pk2(o[6], o[7]); *(v4u*)(y1 + (size_t)row * 512 + ch + 8 * e) = w; } }
        __syncthreads();
    }
#undef ROUT_LOAD
}
template <int KS, int LDX, int LDY> __device__ __forceinline__ f32x4 mm16(const LAS bf16* X, const LAS bf16* YT, int m0, int n0, int lane, f32x4 acc) {
    const int r = lane & 15, g = lane >> 4;
#pragma unroll
    for (int ks = 0; ks < KS; ++ks) { const bf16x8 a = *(const LAS bf16x8*)(X + (m0 + r) * LDX + ks * 32 + 8 * g); const bf16x8 b = *(const LAS bf16x8*)(YT + (n0 + r) * LDY + ks * 32 + 8 * g);
        acc = __builtin_amdgcn_mfma_f32_16x16x32_bf16(a, b, acc, 0, 0, 0); }
    return acc;
}
__device__ __forceinline__ float hg_lf(float key) { return fmaxf(__logf(fmaxf(1.0f - key, 1e-30f)), -30.0f); }
constexpr int H1_LD = 136;
constexpr int H1_KT = 0, H1_VT = 128 * H1_LD * 2, H1_SEG = 2 * 128 * H1_LD * 2, H1_END = H1_SEG + 4 * 128 * 4;
__device__ __forceinline__ void phase_h1(Frame& F, int first, int stride) {
    const bf16* zh = (const bf16*)F.x; bf16* Hg = WSP(bf16, R_HST); float* Dg = WSP(float, WS_HD);
    LAS unsigned char* lds = F.lds; LAS bf16* KT = (LAS bf16*)(lds + H1_KT); LAS bf16* VT = (LAS bf16*)(lds + H1_VT); LAS float* SEG = (LAS float*)(lds + H1_SEG);
    const int k = F.tid & 127, seg = F.tid >> 7; const int r16 = F.lane & 15, g4 = F.lane >> 4;
    for (int item = first; item < 256; item += stride) { const int bh = item >> 5, m = item & 31, b = bh >> 2, h = bh & 3; const size_t row0 = (size_t)b * SEQ + m * 256;
        f32x4 acc[8];
#pragma unroll
        for (int nt = 0; nt < 8; ++nt) acc[nt] = (f32x4){0.f, 0.f, 0.f, 0.f};
        float carry = 0.f;
#pragma unroll 1
        for (int half = 1; half >= 0; --half) { const size_t rb = row0 + 128 * half;
            float key[32], lf[32]; float tot = 0.f;
#pragma unroll
            for (int j = 0; j < 32; ++j) { key[j] = bf1(zh[(rb + 32 * seg + j) * 2048 + 512 + h * 128 + k]); lf[j] = hg_lf(key[j]); tot += lf[j]; }
            SEG[seg * 128 + k] = tot;
            { const int s = F.tid >> 2, part = F.tid & 3; const bf16* vp = zh + (rb + s) * 2048 + 1024 + h * 128 + part * 32;
#pragma unroll
              for (int c = 0; c < 4; ++c) { const v4u vv = *(const v4u*)(vp + 8 * c);
#pragma unroll
                  for (int i = 0; i < 4; ++i) { VT[(part * 32 + 8 * c + 2 * i) * H1_LD + s] = (bf16)(vv[i] & 0xffffu); VT[(part * 32 + 8 * c + 2 * i + 1) * H1_LD + s] = (bf16)(vv[i] >> 16); } } }
            __syncthreads();
            float off = carry, all = 0.f;
#pragma unroll
            for (int sg = 0; sg < 4; ++sg) { const float tt = SEG[sg * 128 + k]; all += tt; if (sg > seg) off += tt; }
            carry += all;
            float e = off;
#pragma unroll
            for (int j = 31; j >= 0; --j) { KT[k * H1_LD + 32 * seg + j] = (bf16)f2bf(key[j] * __expf(e)); e += lf[j]; }
            __syncthreads();
#pragma unroll
            for (int nt = 0; nt < 8; ++nt) acc[nt] = mm16<4, H1_LD, H1_LD>(KT, VT, 16 * F.wave, 16 * nt, F.lane, acc[nt]);
            __syncthreads(); }
        if (F.tid < 128) Dg[(size_t)item * 128 + k] = __expf(carry);
        bf16* hp = Hg + (size_t)item * 16384;
#pragma unroll
        for (int nt = 0; nt < 8; ++nt) { u32x2 o; o.x = pk2(acc[nt][0], acc[nt][1]); o.y = pk2(acc[nt][2], acc[nt][3]); *(u32x2*)(hp + (16 * nt + r16) * 128 + 16 * F.wave + 4 * g4) = o; }
    }
}
__device__ __forceinline__ void phase_h2(Frame& F) {
    bf16* Hg = WSP(bf16, R_HST); const float* Dg = WSP(float, WS_HD);
    const int gt = blockIdx.x * (NWAVES * 64) + F.tid, NGT = F.G * NWAVES * 64;
    for (int idx = gt; idx < 8 * 16384; idx += NGT) { const int bh = idx >> 14, e = idx & 16383; float s = 0.f;
#pragma unroll 4
        for (int m = 0; m < 32; ++m) { const size_t o = ((size_t)(bh * 32 + m) << 14) + e; const float hv = bf1(Hg[o]); Hg[o] = (bf16)f2bf(s); s = __builtin_fmaf(Dg[(bh * 32 + m) * 128 + (e & 127)], s, hv); } }
}
constexpr int H3_LDK = 136, H3_LDS = 40;
constexpr int H3_QC = 0, H3_KH = H3_QC + 32 * H3_LDK * 2, H3_KHT = H3_KH + 32 * H3_LDK * 2, H3_VT = H3_KHT + 128 * H3_LDS * 2, H3_ST = H3_VT + 128 * H3_LDS * 2, H3_AL = H3_ST + 128 * H3_LDK * 2,
              H3_OL = H3_AL + 32 * H3_LDS * 2, H3_SEG = H3_OL + 32 * 132 * 4, H3_DD = H3_SEG + 4 * 128 * 4, H3_END = H3_DD + 128 * 4;
static_assert(H3_END <= LDSCTL_OFF && H1_END <= LDSCTL_OFF, "hgrn LDS");
__device__ __forceinline__ void phase_h3(Frame& F, const Args& A, int L) {
    KP_DECL;
    const bf16* zh = (const bf16*)F.x; const bf16* Hg = WSP(bf16, R_HST); bf16* y2 = WSP(bf16, R_Y) + (size_t)2 * M * 512; const float* ng = INP(I_HNORM) + L * 128;
    LAS unsigned char* lds = F.lds; LAS bf16* QC = (LAS bf16*)(lds + H3_QC); LAS bf16* KH = (LAS bf16*)(lds + H3_KH); LAS bf16* KHT = (LAS bf16*)(lds + H3_KHT); LAS bf16* VT = (LAS bf16*)(lds + H3_VT);
    LAS bf16* ST = (LAS bf16*)(lds + H3_ST); LAS bf16* AL = (LAS bf16*)(lds + H3_AL); LAS float* OL = (LAS float*)(lds + H3_OL); LAS float* SEG = (LAS float*)(lds + H3_SEG); LAS float* DD = (LAS float*)(lds + H3_DD);
    const int k = F.tid & 127, seg = F.tid >> 7; const int r16 = F.lane & 15, g4 = F.lane >> 4;
    float ngv[8];
#pragma unroll
    for (int i = 0; i < 8; ++i) ngv[i] = ng[(F.tid & 15) * 8 + i];
    for (int item = blockIdx.x; item < 256; item += F.G) { const int bh = item >> 5, m = item & 31, b = bh >> 2, h = bh & 3; const size_t row0 = (size_t)b * SEQ + m * 256;
        f32x4 acc[8];
        { const bf16* hp = Hg + (size_t)item * 16384;
#pragma unroll
          for (int nt = 0; nt < 8; ++nt) { const u32x2 w = *(const u32x2*)(hp + (16 * nt + r16) * 128 + 16 * F.wave + 4 * g4); acc[nt] = (f32x4){bflo(w.x), bfhi(w.x), bflo(w.y), bfhi(w.y)}; } }
        bf16 nq[8], nk[8]; v4u nvv, ngg;
#define H3_LOAD(cc) do { const size_t rb_ = row0 + 32 * (cc); _Pragma("unroll") for (int j = 0; j < 8; ++j) { const bf16* zp = zh + (rb_ + 8 * seg + j) * 2048 + h * 128 + k; nq[j] = __builtin_nontemporal_load(zp); nk[j] = __builtin_nontemporal_load(zp + 512); } \
            nvv = __builtin_nontemporal_load((const v4u*)(zh + (rb_ + (F.tid >> 4)) * 2048 + 1024 + h * 128 + (F.tid & 15) * 8)); ngg = __builtin_nontemporal_load((const v4u*)(zh + (rb_ + (F.tid >> 4)) * 2048 + 1536 + h * 128 + (F.tid & 15) * 8)); } while (0)
        H3_LOAD(0);
#pragma unroll 1
        for (int c = 0; c < 8; ++c) { const size_t rb = row0 + 32 * c;
            float key[8], qv[8], bcs[8]; float run = 0.f;
#pragma unroll
            for (int j = 0; j < 8; ++j) { qv[j] = bf1(nq[j]); key[j] = bf1(nk[j]); run += hg_lf(key[j]); bcs[j] = run; }
            const v4u vv = nvv, gg = ngg;
            if (c < 7) H3_LOAD(c + 1);
            SEG[seg * 128 + k] = run;
            { const int s = F.tid >> 4, part = F.tid & 15;
#pragma unroll
              for (int i = 0; i < 4; ++i) { VT[(part * 8 + 2 * i) * H3_LDS + s] = (bf16)(vv[i] & 0xffffu); VT[(part * 8 + 2 * i + 1) * H3_LDS + s] = (bf16)(vv[i] >> 16); } }
            __syncthreads();
            float pre = 0.f, all = 0.f;
#pragma unroll
            for (int sg = 0; sg < 4; ++sg) { const float tt = SEG[sg * 128 + k]; all += tt; if (sg < seg) pre += tt; }
#pragma unroll
            for (int j = 0; j < 8; ++j) { const float bt = pre + bcs[j]; const int t = 8 * seg + j;
                QC[t * H3_LDK + k] = (bf16)f2bf(qv[j] * __expf(bt - all)); const bf16 kh = (bf16)f2bf(key[j] * __expf(all - bt)); KH[t * H3_LDK + k] = kh; KHT[k * H3_LDS + t] = kh; }
            if (seg == 0) DD[k] = __expf(all);
            __syncthreads();
            { const f32x4 dv = *(const LAS f32x4*)(DD + 16 * F.wave + 4 * g4);
#pragma unroll
              for (int nt = 0; nt < 8; ++nt) { acc[nt] = acc[nt] * dv; u32x2 o; o.x = pk2(acc[nt][0], acc[nt][1]); o.y = pk2(acc[nt][2], acc[nt][3]); *(LAS u32x2*)(ST + (16 * nt + r16) * H3_LDK + 16 * F.wave + 4 * g4) = o; } }
            if (F.wave < 4) { const int m0 = (F.wave >> 1) * 16, n0 = (F.wave & 1) * 16; const f32x4 a = mm16<4, H3_LDK, H3_LDK>(QC, KH, m0, n0, F.lane, (f32x4){0.f, 0.f, 0.f, 0.f});
#pragma unroll
                for (int rg = 0; rg < 4; ++rg) { const int t = m0 + 4 * g4 + rg, s = n0 + r16; AL[t * H3_LDS + s] = (bf16)f2bf(s <= t ? a[rg] : 0.f); } }
            __syncthreads();
#pragma unroll
            for (int q = 0; q < 2; ++q) { const int id = 2 * F.wave + q, m0 = (id >> 3) * 16, n0 = (id & 7) * 16;
                f32x4 o = mm16<4, H3_LDK, H3_LDK>(QC, ST, m0, n0, F.lane, (f32x4){0.f, 0.f, 0.f, 0.f}); o = mm16<1, H3_LDS, H3_LDS>(AL, VT, m0, n0, F.lane, o);
#pragma unroll
                for (int rg = 0; rg < 4; ++rg) OL[(m0 + 4 * g4 + rg) * 132 + n0 + r16] = o[rg]; }
#pragma unroll
            for (int nt = 0; nt < 8; ++nt) acc[nt] = mm16<1, H3_LDS, H3_LDS>(KHT, VT, 16 * F.wave, 16 * nt, F.lane, acc[nt]);
            __syncthreads();
            { const int t = F.tid >> 4, part = F.tid & 15; const LAS float* op = OL + t * 132 + part * 8; float o[8], ss = 0.f;
#pragma unroll
              for (int i = 0; i < 8; ++i) { o[i] = op[i]; ss += o[i] * o[i]; }
              ss = sum16(ss);
              const float rs = __builtin_amdgcn_rsqf(ss * (1.0f / 128.0f) + 1e-6f); const size_t row = rb + t;
              float y[8];
#pragma unroll
              for (int i = 0; i < 8; ++i) { const int q = i >> 1; const float gf = (i & 1) ? bfhi(gg[q]) : bflo(gg[q]); y[i] = o[i] * rs * ngv[i] * gf; }
              v4u w; w.x = pk2(y[0], y[1]); w.y = pk2(y[2], y[3]); w.z = pk2(y[4], y[5]); w.w = pk2(y[6], y[7]); *(v4u*)(y2 + row * 512 + h * 128 + part * 8) = w; }
        }
        __syncthreads();
    }
}
constexpr int AT_KLD = 72, AT_VLD = 260, AT_K = 0, AT_VT = 256 * AT_KLD * 2, AT_END = AT_VT + 64 * AT_VLD * 2;
static_assert(AT_END <= LDSCTL_OFF, "attention LDS");
__device__ __forceinline__ void phase_attn_mfma(Frame& F, const Args& A, int L) {
    KP_DECL;
    const bf16* za = WSP(bf16, R_ZA); bf16* y0 = WSP(bf16, R_Y); const float* sinks = INP(I_SINK) + L * 8;
    LAS bf16* KI = (LAS bf16*)(F.lds + AT_K); LAS bf16* VT = (LAS bf16*)(F.lds + AT_VT);
    const int c32 = F.lane & 31, hh = F.lane >> 5;
    for (int item = blockIdx.x; item < 256; item += F.G) { const int b = item >> 7, kvh = (item >> 6) & 1, n = item & 63; const int rowq0 = b * SEQ + n * 128, rowk0 = rowq0 - 128;
        { const int key = F.tid >> 1, half = F.tid & 1; const bool valid = (n > 0) || key >= 128; const bf16* src = za + (size_t)(rowk0 + key) * 768 + kvh * 64 + half * 32;
#pragma unroll
          for (int c = 0; c < 4; ++c) { v4u kk = (v4u){0u, 0u, 0u, 0u}, vv = kk; if (valid) { kk = *(const v4u*)(src + 512 + 8 * c); vv = *(const v4u*)(src + 640 + 8 * c); }
              *(LAS v4u*)(KI + key * AT_KLD + half * 32 + 8 * c) = kk;
#pragma unroll
              for (int i = 0; i < 4; ++i) { VT[(half * 32 + 8 * c + 2 * i) * AT_VLD + key] = (bf16)(vv[i] & 0xffffu); VT[(half * 32 + 8 * c + 2 * i + 1) * AT_VLD + key] = (bf16)(vv[i] >> 16); } } }
        __syncthreads();
#pragma unroll 1
        for (int rep = 0; rep < 2; ++rep) { const int id = F.wave * 2 + rep, g = id >> 2, u = id & 3, hq = kvh * 4 + g; const int qrow = rowq0 + 32 * u + c32, qi = 32 * u + c32;
            bf16x8 qf[4];
#pragma unroll
            for (int s = 0; s < 4; ++s) qf[s] = *(const bf16x8*)(za + (size_t)qrow * 768 + hq * 64 + 16 * s + 8 * hh);
            f32x16 st[5];
#pragma unroll
            for (int j = 0; j < 5; ++j) { f32x16 acc;
#pragma unroll
                for (int i = 0; i < 16; ++i) acc[i] = 0.f;
#pragma unroll
                for (int s = 0; s < 4; ++s) { const bf16x8 a = *(const LAS bf16x8*)(KI + (32 * (u + j) + c32) * AT_KLD + 16 * s + 8 * hh); acc = __builtin_amdgcn_mfma_f32_32x32x16_bf16(a, qf[s], acc, 0, 0, 0); }
                st[j] = acc; }
            const float sink = sinks[hq]; float mx = sink;
#pragma unroll
            for (int j = 0; j < 5; ++j)
#pragma unroll
                for (int rg = 0; rg < 16; ++rg) { const int kj = 32 * (u + j) + (rg & 3) + 8 * (rg >> 2) + 4 * hh; const bool ok = (kj > qi) && (kj <= qi + 128) && (n > 0 || kj >= 128);
                    const float v = ok ? st[j][rg] * 0.125f : -1e30f; st[j][rg] = v; mx = fmaxf(mx, v); }
            mx = fmaxf(mx, __shfl_xor(mx, 32));
            float sum = 0.f;
#pragma unroll
            for (int j = 0; j < 5; ++j)
#pragma unroll
                for (int rg = 0; rg < 16; ++rg) { const float p = __expf(st[j][rg] - mx); st[j][rg] = p; sum += p; }
            sum += __shfl_xor(sum, 32);
            const float inv = 1.0f / (sum + __expf(sink - mx));
            f32x16 o0, o1;
#pragma unroll
            for (int i = 0; i < 16; ++i) { o0[i] = 0.f; o1[i] = 0.f; }
#pragma unroll
            for (int j = 0; j < 5; ++j)
#pragma unroll
                for (int s = 0; s < 2; ++s) { v4u pw; pw.x = pg8::cvtpk_s(st[j][8 * s], st[j][8 * s + 1]); pw.y = pg8::cvtpk_s(st[j][8 * s + 2], st[j][8 * s + 3]); pw.z = pg8::cvtpk_s(st[j][8 * s + 4], st[j][8 * s + 5]); pw.w = pg8::cvtpk_s(st[j][8 * s + 6], st[j][8 * s + 7]);
                    const bf16x8 pb = __builtin_bit_cast(bf16x8, pw); const int k0 = 32 * (u + j) + 16 * s + 4 * hh;
                    { const u32x2 lo = *(const LAS u32x2*)(VT + c32 * AT_VLD + k0), hi = *(const LAS u32x2*)(VT + c32 * AT_VLD + k0 + 8); const bf16x8 va = __builtin_bit_cast(bf16x8, (v4u){lo.x, lo.y, hi.x, hi.y});
                      o0 = __builtin_amdgcn_mfma_f32_32x32x16_bf16(va, pb, o0, 0, 0, 0); }
                    { const u32x2 lo = *(const LAS u32x2*)(VT + (32 + c32) * AT_VLD + k0), hi = *(const LAS u32x2*)(VT + (32 + c32) * AT_VLD + k0 + 8); const bf16x8 va = __builtin_bit_cast(bf16x8, (v4u){lo.x, lo.y, hi.x, hi.y});
                      o1 = __builtin_amdgcn_mfma_f32_32x32x16_bf16(va, pb, o1, 0, 0, 0); } }
            bf16* yp = y0 + (size_t)qrow * 512 + hq * 64 + 4 * hh;
#pragma unroll
            for (int q4 = 0; q4 < 4; ++q4) { u32x2 w; w.x = pk2(o0[4 * q4] * inv, o0[4 * q4 + 1] * inv); w.y = pk2(o0[4 * q4 + 2] * inv, o0[4 * q4 + 3] * inv); *(u32x2*)(yp + 8 * q4) = w;
                w.x = pk2(o1[4 * q4] * inv, o1[4 * q4 + 1] * inv); w.y = pk2(o1[4 * q4 + 2] * inv, o1[4 * q4 + 3] * inv); *(u32x2*)(yp + 32 + 8 * q4) = w; }
        }
        __syncthreads();
    }
}
__device__ __forceinline__ void phase_final(Frame& F, const Args& A) {
    KP_DECL;
    const float* g = INP(I_FINN); const bf16* xb = WSP(bf16, R_XBALT); const float* ss = WSP(float, WS_SS0);
    const int gw = blockIdx.x * NWAVES + F.wave, NGW = F.G * NWAVES;
    const int lane_ = (int)__builtin_amdgcn_mbcnt_hi(~0u, __builtin_amdgcn_mbcnt_lo(~0u, 0u));
    f32x4 gg[2][2];
#pragma unroll
    for (int j = 0; j < 2; ++j) { gg[j][0] = *(const f32x4*)(g + j * 512 + lane_ * 8); gg[j][1] = *(const f32x4*)(g + j * 512 + lane_ * 8 + 4); }
    for (int m0 = gw; m0 < M; m0 += 4 * NGW) {
        const int mr = m0 + (lane_ >> 4) * NGW; const float pq = (mr < M) ? ss[(size_t)mr * 16 + (lane_ & 15)] : 1.0f;
        v4u w[4][2];
#pragma unroll
        for (int k = 0; k < 4; ++k) { const int m = (m0 + k * NGW < M) ? m0 + k * NGW : m0;
#pragma unroll
            for (int j = 0; j < 2; ++j) w[k][j] = __builtin_nontemporal_load((const v4u*)(xb + (size_t)m * DM + j * 512 + lane_ * 8)); }
        const float rsl = __builtin_amdgcn_rsqf(sum16(pq) * (1.0f / 1024.0f) + 1e-6f);
#pragma unroll
        for (int k = 0; k < 4; ++k) { const int m = m0 + k * NGW; if (m >= M) break; const float rs = __shfl(rsl, 16 * k);
#pragma unroll
            for (int j = 0; j < 2; ++j) { const v4u ww = w[k][j]; f32x4 o0, o1;
                o0.x = bflo(ww.x) * rs; o0.y = bfhi(ww.x) * rs; o0.z = bflo(ww.y) * rs; o0.w = bfhi(ww.y) * rs; o1.x = bflo(ww.z) * rs; o1.y = bfhi(ww.z) * rs; o1.z = bflo(ww.w) * rs; o1.w = bfhi(ww.w) * rs;
                float* op = F.x + (size_t)m * DM + j * 512 + lane_ * 8; *(f32x4*)op = o0 * gg[j][0]; *(f32x4*)(op + 4) = o1 * gg[j][1]; } } }
}

template <int L> __device__ __forceinline__ void run_layer(Frame& F, const Args& args, const XcdBarrier& bar, int lo, int hi) {
    typedef pg8::bf16_t pb16;
    constexpr int base = 17 * L;
#define IN(k) (lo <= base + (k) && base + (k) < hi && EN(k))
#define SEAM(k) do { if (base + (k) + 1 < hi) xcd_barrier(bar); } while (0)
#define GEMM_RUN(EPI, g, S, E) pg8::gemm_phase<EPI, pg8::StaticOrder, true, true>(F.lds + RING_OFF, g, S, E)
    constexpr size_t SS_IN = WS_SS0, SS_A = WS_SS1, SS_B = WS_SS0, SS_C = WS_SS1, SS_OUT = WS_SS0;
    if (IN(0)) { phase_conv<0>(F, args, L); SEAM(0); }
    if (IN(1)) { pg8::Gemm g{L == 0 ? WSP(pb16, WS_XB) : WSP(pb16, R_XBALT), WSP(pb16, W_F1GU), M, 5632, 1024}; pg8::StaticOrder S; S.init(M, 5632, F.G, (int)blockIdx.x);
        pg8::EpiSwiglu E{WSP(pb16, R_H), WSP(float, SS_IN)}; GEMM_RUN(pg8::EpiSwiglu, g, S, E);
        if ((int)blockIdx.x >= F.G / 2) phase_conv<1>(F, args, L);
        SEAM(1); }
    if (IN(2)) { KP_DECL; pg8::Gemm g{WSP(pb16, R_H), WSP(pb16, W_F1D), M, 1024, FF}; pg8::StaticOrder S; S.init(M, 1024, F.G, (int)blockIdx.x);
        pg8::EpiResid<0> E{WSP(pb16, WS_XB), WSP(float, SS_A), nullptr, nullptr, 0.5f, L == 0 ? WSP(pb16, WS_XB) : WSP(pb16, R_XBALT)}; GEMM_RUN(pg8::EpiResid<0>, g, S, E); SEAM(2); }
    if (IN(3)) { pg8::Gemm g{WSP(pb16, WS_XB), WSP(pb16, W_IN), M, 1792, 1024}; pg8::StaticOrder S; S.init(M, 1792, F.G, (int)blockIdx.x);
        pg8::EpiStore<0> E{WSP(pb16, R_ZR), WSP(float, SS_A), nullptr, nullptr, nullptr, nullptr}; GEMM_RUN(pg8::EpiStore<0>, g, S, E); SEAM(3); }
    if (IN(4)) { phase_rprep1(F, args, L); SEAM(4); }
    if (IN(5)) { KP_DECL; pg8::Gemm g{WSP(pb16, R_AP), WSP(pb16, W_LR), M, 1536, 256}; pg8::StaticOrder S; S.init(M, 1536, F.G, (int)blockIdx.x);
        pg8::EpiStore<3> E{WSP(pb16, R_DAG_W), nullptr, WSP(pb16, R_DAG_A), WSP(pb16, R_DAG_G), INP(I_W0) + L * 512, INP(I_A0) + L * 512};
        GEMM_RUN(pg8::EpiStore<3>, g, S, E); SEAM(5); }
    if (IN(6)) { phase_rchunk_pre(F, args, L); SEAM(6); }
    if (IN(7)) {
        if (blockIdx.x < 32 && F.wave == 0) rchunk_seq(F, blockIdx.x);
        pg8::Gemm g{WSP(pb16, WS_XB), WSP(pb16, W_IN) + (size_t)1792 * 1024, M, 2816, 1024}; pg8::SplitOrder S; S.init(M, 2816, F.G, (int)blockIdx.x); S.ns = 32;
        pg8::EpiStore<1> E{WSP(pb16, R_ZA), WSP(float, SS_A), (pb16*)F.x, nullptr, WSP(float, WS_LB), nullptr};
        pg8::gemm_phase<pg8::EpiStore<1>, pg8::SplitOrder, true, true>(F.lds + RING_OFF, g, S, E); SEAM(7); }
    if (IN(8)) { phase_h1(F, blockIdx.x, F.G); phase_attn_mfma(F, args, L); phase_rchunk_out(F, args, L); SEAM(8); }
    if (IN(9)) { phase_h2(F); xcd_barrier(bar); phase_h3(F, args, L); }
    if (IN(10)) { pg8::Gemm g{WSP(pb16, WS_XB), WSP(pb16, W_IN) + (size_t)4608 * 1024, M, 3072, 1024}; pg8::StaticOrder S; S.init(M, 3072, F.G, (int)blockIdx.x);
        pg8::EpiStore<2> E{WSP(pb16, R_GG), WSP(float, SS_A), nullptr, nullptr, nullptr, nullptr}; GEMM_RUN(pg8::EpiStore<2>, g, S, E); SEAM(10); }
    if (IN(11)) { pg8::Gemm g{WSP(pb16, R_Y), WSP(pb16, W_BR), M, 1024, 512, (size_t)M * 512, (size_t)1024 * 512}; pg8::ChainOrder S; S.init(M, 1024, F.G, (int)blockIdx.x);
        pg8::EpiBranchChain E{WSP(pb16, R_MERGED), WSP(pb16, R_GG)}; pg8::gemm_phase<pg8::EpiBranchChain, pg8::ChainOrder, true, true>(F.lds + RING_OFF, g, S, E); SEAM(11); }
    if (IN(12)) { conv_p(F, args, L); pg8::Gemm g{WSP(pb16, R_MERGED), WSP(pb16, W_O), M, 1024, 1024}; pg8::StaticOrder S; S.init(M, 1024, F.G, (int)blockIdx.x);
        pg8::EpiResid<0> E{WSP(pb16, WS_XB), WSP(float, SS_B), nullptr, nullptr, 1.0f, WSP(pb16, WS_XB)}; GEMM_RUN(pg8::EpiResid<0>, g, S, E); SEAM(12); }
    if (IN(13)) {
        { pg8::Gemm g{WSP(pb16, WS_XB), WSP(pb16, W_F2GU), M, 5632, 1024}; pg8::StaticOrder S; S.init(M, 5632, F.G, (int)blockIdx.x);
          pg8::EpiSwiglu E{WSP(pb16, R_H), WSP(float, SS_B)}; GEMM_RUN(pg8::EpiSwiglu, g, S, E); }
        { pg8::Gemm g{WSP(pb16, R_PB), WSP(pb16, W_PP), M, 1024, 256}; pg8::TailOrder S; S.init(M, 1024, F.G, (int)blockIdx.x); S.lo = F.G / 2;
          pg8::EpiStore<4> E{WSP(pb16, R_PROJ), nullptr, nullptr, nullptr, nullptr, nullptr}; pg8::gemm_phase<pg8::EpiStore<4>, pg8::TailOrder, true, true>(F.lds + RING_OFF, g, S, E); }
        SEAM(13); }
    if (IN(14)) { pg8::Gemm g{WSP(pb16, R_H), WSP(pb16, W_F2D), M, 1024, FF}; pg8::StaticOrder S; S.init(M, 1024, F.G, (int)blockIdx.x);
        pg8::EpiResid<0> E{WSP(pb16, WS_XB), WSP(float, SS_C), nullptr, nullptr, 0.5f, WSP(pb16, WS_XB)}; GEMM_RUN(pg8::EpiResid<0>, g, S, E); SEAM(14); }
    if (IN(16)) { pg8::Gemm g{WSP(pb16, WS_XB), WSP(pb16, W_PG), M, 1024, 1024}; pg8::StaticOrder S; S.init(M, 1024, F.G, (int)blockIdx.x);
        pg8::EpiResid<1> E{WSP(pb16, R_XBALT), WSP(float, SS_OUT), WSP(float, SS_C), WSP(pb16, R_PROJ), 1.0f, WSP(pb16, WS_XB)}; GEMM_RUN(pg8::EpiResid<1>, g, S, E);
        if (L != 0) SEAM(16); }
#undef IN
#undef SEAM
#undef GEMM_RUN
}
__global__ void __launch_bounds__(NWAVES * 64, 2) mk_fwd(Args args) {
    extern __shared__ __attribute__((aligned(16))) unsigned char lds[];
    Frame F;
    F.lds = (LAS unsigned char*)lds;
    F.MISC = (volatile LAS unsigned*)(F.lds + MISC_OFF);
    F.tid = threadIdx.x; F.lane = F.tid & 63; F.wave = __builtin_amdgcn_readfirstlane(F.tid >> 6);
    F.G = gridDim.x;
    F.ws = args.ws; F.x = args.out;
    F.ctl = (gu32*)(args.ws + WS_CTL);
    for (int u = F.tid; u < (LDS_BYTES - LDSCTL_OFF) / 4; u += NWAVES * 64) ((LAS unsigned*)(F.lds + LDSCTL_OFF))[u] = 0u;
    __syncthreads();
    const int lo = args.ph_lo, hi = args.ph_hi;
    const bool multi = (hi - lo) > 1;
    XcdBarrier bar; bar.bar = (unsigned*)(F.ctl + CW_BAR); bar.x = 0; bar.st = nullptr;
    if (multi) bar = xcd_barrier_post((unsigned*)(F.ctl + CW_BAR), F.MISC + 8);
    run_layer<0>(F, args, bar, lo, hi);
    run_layer<1>(F, args, bar, lo, hi);
    if (lo <= N_PHASES - 1 && N_PHASES - 1 < hi && EN(17)) phase_final(F, args);
}

#ifndef MK_PER_PHASE
#define MK_PER_PHASE 0
#endif
extern "C" void kernel_launch(void* const* d_in, const int* in_sizes, int n_in, void* d_out, int out_size, void* d_ws, size_t ws_size, hipStream_t stream) {
    static int grid = 0;
    if (grid == 0) {
        if (n_in != N_IN || in_sizes[0] != M * DM || out_size != M * DM || ws_size < WS_END) { fprintf(stderr, "kernel_launch: unexpected shapes / workspace (n_in %d, ws %zu < %zu)\n", n_in, ws_size, (size_t)WS_END); grid = -1; return; }
        int dev = 0, cus = 0;
        if (hipGetDevice(&dev) != hipSuccess || hipDeviceGetAttribute(&cus, hipDeviceAttributeMultiprocessorCount, dev) != hipSuccess) { grid = -1; return; }
        if (hipFuncSetAttribute((const void*)mk_fwd, hipFuncAttributeMaxDynamicSharedMemorySize, LDS_BYTES) != hipSuccess) { fprintf(stderr, "kernel_launch: hipFuncSetAttribute failed\n"); grid = -1; return; }
        int per_cu = 0;
        if (hipOccupancyMaxActiveBlocksPerMultiprocessor(&per_cu, (const void*)mk_fwd, NWAVES * 64, LDS_BYTES) != hipSuccess || per_cu < 1) fprintf(stderr, "kernel_launch: occupancy query says %d\n", per_cu);
        (void)hipGetLastError();
        grid = cus;
    }
    if (grid < 0) return;
    (void)hipMemsetAsync((char*)d_ws + WS_CTL, 0, CTL_ZERO_BYTES, stream);
    Args a{};
    for (int i = 0; i < N_IN; ++i) a.in[i] = (const float*)d_in[i];
    a.out = (float*)d_out; a.ws = (unsigned char*)d_ws;
#if MK_PER_PHASE
    for (int ph = 0; ph < N_PHASES; ++ph) { a.ph_lo = ph; a.ph_hi = ph + 1; hipLaunchKernelGGL(mk_fwd, dim3(grid), dim3(NWAVES * 64), LDS_BYTES, stream, a); }
#else
    a.ph_lo = 0; a.ph_hi = N_PHASES; hipLaunchKernelGGL(mk_fwd, dim3(grid), dim3(NWAVES * 64), LDS_BYTES, stream, a);
#endif
}
```

```cpp
#include <hip/hip_runtime.h>
#include <cstdio>
#include <cstdint>
namespace pg8 {
#define PG8_LAS __attribute__((address_space(3)))
typedef unsigned short bf16_t;
typedef short bf16x8 __attribute__((ext_vector_type(8)));
typedef float f32x4 __attribute__((ext_vector_type(4)));
typedef unsigned u32x4 __attribute__((ext_vector_type(4)));
constexpr int BM = 256, BK = 64, HALF = 128, HTB = HALF * BK * 2  , STAGE_BYTES = 8 * HTB, NXCD = 8, WGM = 8;
constexpr int RS_LDS_OFF = 8 * 16640;

__host__ __device__ __forceinline__ int lds_byte(int r, int c) { const int st = (r >> 4) * 2 + (c >> 5), rr = r & 15, cc = c & 31, ob = rr * 64 + cc * 2; return st * 1024 + (ob ^ (((ob >> 9) & 1) << 5)); }
__host__ __device__ __forceinline__ void stage_rc(int b, int& R, int& C) { const int st = b / 1024, sb = b % 1024, swz = sb ^ (((sb >> 9) & 1) << 5); R = (st >> 1) * 16 + swz / 64; C = (st & 1) * 32 + (swz % 64) / 2; }
__host__ __device__ __forceinline__ int perm32(int rho) { const int n = rho >> 4, i = rho & 15; return 8 * (i >> 2) + 4 * n + (i & 3); }

struct Unit { int pm, pn; int b = 0; };
struct Gemm { const bf16_t* A; const bf16_t* Bt; int M, N, K; size_t usA = 0, usB = 0; };

struct StaticOrder {
    int nM, nN, nwg, G, c;
    __host__ __device__ void init(int M, int N, int G_, int c_) { nM = M / BM; nN = N / BM; nwg = nM * nN; G = G_; c = c_; }
    __host__ __device__ bool next(int i, Unit& u) const {
        const long L = (long)i * G + c; if (L >= nwg) return false;
        int wgid = (int)L; { const int q = nwg / NXCD, r = nwg % NXCD, xcd = wgid % NXCD, off = wgid / NXCD; wgid = (xcd < r ? xcd * (q + 1) : r * (q + 1) + (xcd - r) * q) + off; }
        const int nig = WGM * nN, gid = wgid / nig, fm = gid * WGM, gsz = (nM - fm) < WGM ? (nM - fm) : WGM;
        u.pm = fm + ((wgid % nig) % gsz); u.pn = (wgid % nig) / gsz; return true;
    }
    __device__ __forceinline__ void a_ready(const Unit&) const {}
    __device__ __forceinline__ void done(const Unit&) const {}
};

struct SplitOrder : StaticOrder {
    int ns;
    __host__ __device__ bool next(int i, Unit& u) const {
        long L;
        if (c < ns) { if (i > 0) return false; L = (long)(nwg - ns) + c; }
        else { L = (long)i * (G - ns) + (c - ns); if (L >= nwg - ns) return false; }
        int wgid = (int)L; { const int q = nwg / NXCD, r = nwg % NXCD, xcd = wgid % NXCD, off = wgid / NXCD; wgid = (xcd < r ? xcd * (q + 1) : r * (q + 1) + (xcd - r) * q) + off; }
        const int nig = WGM * nN, gid = wgid / nig, fm = gid * WGM, gsz = (nM - fm) < WGM ? (nM - fm) : WGM;
        u.pm = fm + ((wgid % nig) % gsz); u.pn = (wgid % nig) / gsz; return true;
    }
};

struct TailOrder : StaticOrder {
    int lo;
    __host__ __device__ bool next(int i, Unit& u) const {
        if (c < lo) return false; const long L = (long)i * (G - lo) + (c - lo); if (L >= nwg) return false;
        int wgid = (int)L; { const int q = nwg / NXCD, r = nwg % NXCD, xcd = wgid % NXCD, off = wgid / NXCD; wgid = (xcd < r ? xcd * (q + 1) : r * (q + 1) + (xcd - r) * q) + off; }
        const int nig = WGM * nN, gid = wgid / nig, fm = gid * WGM, gsz = (nM - fm) < WGM ? (nM - fm) : WGM;
        u.pm = fm + ((wgid % nig) % gsz); u.pn = (wgid % nig) / gsz; return true;
    }
};

__device__ __forceinline__ unsigned cvt_pk_bf16(float lo, float hi) { unsigned r; asm volatile("v_cvt_pk_bf16_f32 %0, %1, %2" : "=v"(r) : "v"(lo), "v"(hi)); return r; }
typedef float f32x2 __attribute__((ext_vector_type(2)));
typedef unsigned u32x2 __attribute__((ext_vector_type(2)));
__device__ __forceinline__ float fsigmoid(float x) { return __builtin_amdgcn_rcpf(1.0f + __builtin_amdgcn_exp2f(-1.4426950408889634f * x)); }
__device__ __forceinline__ float fsilu(float x) { return x * fsigmoid(x); }
__device__ __forceinline__ float bf2f(unsigned short b) { return __uint_as_float(((unsigned)b) << 16); }
typedef float f32x2_t __attribute__((ext_vector_type(2))); typedef __bf16 bf16x2_t __attribute__((ext_vector_type(2)));
__device__ __forceinline__ unsigned cvtpk_s(float lo, float hi) { f32x2_t v = {lo, hi}; bf16x2_t b = __builtin_convertvector(v, bf16x2_t); return __builtin_bit_cast(unsigned, b); }
__device__ __forceinline__ u32x4 pack8(const f32x4& a, const f32x4& b) { u32x4 w; w.x = cvtpk_s(a[0], a[1]); w.y = cvtpk_s(a[2], a[3]); w.z = cvtpk_s(b[0], b[1]); w.w = cvtpk_s(b[2], b[3]); return w; }
__device__ __forceinline__ void unpack8(const u32x4& w, f32x4& a, f32x4& b) {
    a[0] = __uint_as_float(w.x << 16); a[1] = __uint_as_float(w.x & 0xffff0000u); a[2] = __uint_as_float(w.y << 16); a[3] = __uint_as_float(w.y & 0xffff0000u);
    b[0] = __uint_as_float(w.z << 16); b[1] = __uint_as_float(w.z & 0xffff0000u); b[2] = __uint_as_float(w.w << 16); b[3] = __uint_as_float(w.w & 0xffff0000u); }
__device__ __forceinline__ float row_rstd(const float* ssp, int r) {
    const f32x4* p = (const f32x4*)(ssp + (size_t)r * 16);
    const f32x4 a = p[0], b = p[1], c = p[2], d = p[3]; const f32x4 s = (a + b) + (c + d);
    return __builtin_amdgcn_rsqf(((s[0] + s[1]) + (s[2] + s[3])) * (1.0f / 1024.0f) + 1e-6f);
}
#define EPI_FENCE() asm volatile("" ::: "memory")
typedef __amdgpu_buffer_rsrc_t rsrc_t;
__device__ __forceinline__ rsrc_t mk_rsrc(const void* p) { return __builtin_amdgcn_make_buffer_rsrc((void*)p, (short)0, 0x7fffffff, 0x00020000); }
__device__ __forceinline__ float xq_sum(float x) {
    auto s = __builtin_amdgcn_permlane16_swap(__float_as_uint(x), __float_as_uint(x), false, false); x = __uint_as_float(s[0]) + __uint_as_float(s[1]);
    auto t = __builtin_amdgcn_permlane32_swap(__float_as_uint(x), __float_as_uint(x), false, false); return __uint_as_float(t[0]) + __uint_as_float(t[1]);
}
__device__ __forceinline__ void rstd8_issue(const float* ssp, int row0, int fq, f32x4 (&p)[2][4]) {
#pragma unroll
    for (int ai = 0; ai < 2; ++ai)
#pragma unroll
        for (int m = 0; m < 4; ++m) p[ai][m] = *(const f32x4*)(ssp + (size_t)(row0 + ai * HALF + m * 16) * 16 + 4 * fq);
}
__device__ __forceinline__ void rstd8_reduce(const f32x4 (&p)[2][4], float (&rs)[2][4]) {
#pragma unroll
    for (int ai = 0; ai < 2; ++ai)
#pragma unroll
        for (int m = 0; m < 4; ++m) { const float q = (p[ai][m][0] + p[ai][m][1]) + (p[ai][m][2] + p[ai][m][3]); rs[ai][m] = __builtin_amdgcn_rsqf(xq_sum(q) * (1.0f / 1024.0f) + 1e-6f); }
}
struct EpiSwiglu {
    static constexpr bool PERM = true, AFTER_DRAIN = false, CHAIN = false, RS = true;
    bf16_t* H; const float* ssp;
    __device__ __forceinline__ const float* rs_ptr() const { return ssp; }
    __device__ __forceinline__ void operator()(const f32x4 (&acc)[2][2][4][2], const Unit& u, int wr, int wc, int fr, int fq, const float (&rs8)[2][4]) const {
        const int row0 = u.pm * BM + wr * 64 + fr, col0 = u.pn * HALF + wc * 32 + 8 * fq;
#pragma unroll
        for (int ai = 0; ai < 2; ++ai)
#pragma unroll
            for (int m = 0; m < 4; ++m) { const int r = row0 + ai * HALF + m * 16; const float s = rs8[ai][m]; f32x4 o[2];
                const float sn = -1.4426950408889634f * s, s2 = s * s;
#pragma unroll
                for (int n = 0; n < 2; ++n) { const f32x4 gu = acc[ai][0][m][n] * acc[ai][1][m][n], t = acc[ai][0][m][n] * sn;
#pragma unroll
                    for (int i = 0; i < 4; ++i) o[n][i] = gu[i] * (s2 * __builtin_amdgcn_rcpf(1.0f + __builtin_amdgcn_exp2f(t[i]))); }
                *(u32x4*)(H + (size_t)r * 2816 + col0) = pack8(o[0], o[1]); EPI_FENCE(); }
    }
};
template <int MODE> struct EpiResid {
    static constexpr bool PERM = true, AFTER_DRAIN = false, CHAIN = false, RS = (MODE == 1);
    bf16_t* XB; float* sso; const float* ssi; const bf16_t* proj; float scale; const bf16_t* XBin;
    __device__ __forceinline__ const float* rs_ptr() const { return ssi; }
    static constexpr int NB = (MODE == 0) ? 8 : 2;
    __device__ __forceinline__ void operator()(const f32x4 (&acc)[2][2][4][2], const Unit& u, int wr, int wc, int fr, int fq, const float (&rs8)[2][4]) const {
        const rsrc_t rx = mk_rsrc(XBin), rp = mk_rsrc(MODE == 1 ? (const void*)proj : (const void*)XBin), ro = mk_rsrc(XB);
        const unsigned voff = (unsigned)(fr * 1024 + 8 * fq) * 2u;
        const unsigned sbase = (unsigned)((u.pm * BM + wr * 64) * 1024 + u.pn * BM + wc * 32) * 2u;
        const int row0 = u.pm * BM + wr * 64 + fr;
#pragma unroll
        for (int gp = 0; gp < 8 / NB; ++gp) {
            u32x4 xv[NB][2]; u32x4 pv[NB][2];
#pragma unroll
            for (int mm = 0; mm < NB; ++mm) { const int g = NB * gp + mm, ai = g >> 2, m = g & 3;
#pragma unroll
                for (int bj = 0; bj < 2; ++bj) { const unsigned so = sbase + (unsigned)((ai * HALF + m * 16) * 1024 + bj * HALF) * 2u;
                    xv[mm][bj] = __builtin_amdgcn_raw_buffer_load_b128(rx, voff + so, 0, 0);
                    if (MODE == 1) pv[mm][bj] = __builtin_amdgcn_raw_buffer_load_b128(rp, voff + so, 0, 0); } }
#pragma unroll
            for (int mm = 0; mm < NB; ++mm) { const int g = NB * gp + mm, ai = g >> 2, m = g & 3; const int r = row0 + ai * HALF + m * 16; float ss = 0.f;
                float s = 1.0f; if (MODE == 1) s = rs8[ai][m];
#pragma unroll
                for (int bj = 0; bj < 2; ++bj) { const unsigned so = sbase + (unsigned)((ai * HALF + m * 16) * 1024 + bj * HALF) * 2u; f32x4 x0, x1; unpack8(xv[mm][bj], x0, x1);
                    if (MODE == 0) { x0 = x0 + acc[ai][bj][m][0] * scale; x1 = x1 + acc[ai][bj][m][1] * scale; }
                    else { f32x4 p0, p1; unpack8(pv[mm][bj], p0, p1);
#pragma unroll
                        for (int i = 0; i < 4; ++i) { x0[i] += fsigmoid(acc[ai][bj][m][0][i] * s) * p0[i]; x1[i] += fsigmoid(acc[ai][bj][m][1][i] * s) * p1[i]; } }
                    __builtin_amdgcn_raw_buffer_store_b128(pack8(x0, x1), ro, voff + so, 0, 0);
                    ss += ((x0[0] * x0[0] + x0[1] * x0[1]) + (x0[2] * x0[2] + x0[3] * x0[3])) + ((x1[0] * x1[0] + x1[1] * x1[1]) + (x1[2] * x1[2] + x1[3] * x1[3])); }
                ss = xq_sum(ss);
                if (fq == 0) sso[(size_t)r * 16 + u.pn * 4 + wc] = ss; }
            EPI_FENCE(); }
    }
};
template <int ACT, bool RS, int LD> __device__ __forceinline__ void store_tile(const f32x4 (&acc)[2][2][4][2], bf16_t* base, const float (&rs8)[2][4], const float* cvp, int row0, int fq) {
    f32x4 cv[2][2];
#pragma unroll
    for (int bj = 0; bj < 2; ++bj)
#pragma unroll
        for (int n = 0; n < 2; ++n) cv[bj][n] = (ACT >= 3) ? *(const f32x4*)(cvp + bj * HALF + 4 * n) : (f32x4){0.f, 0.f, 0.f, 0.f};
#pragma unroll
    for (int ai = 0; ai < 2; ++ai)
#pragma unroll
        for (int m = 0; m < 4; ++m) { const int r = row0 + ai * HALF + m * 16; float s = 1.0f; if (RS) s = rs8[ai][m];
#pragma unroll
            for (int bj = 0; bj < 2; ++bj) { f32x4 o[2];
#pragma unroll
                for (int n = 0; n < 2; ++n) { const f32x4 z = acc[ai][bj][m][n] * ((ACT == 2) ? -1.4426950408889634f * s : s);
#pragma unroll
                    for (int i = 0; i < 4; ++i) { float v = z[i];
                        if (ACT == 1) v = fsilu(v);
                        else if (ACT == 2) v = __builtin_amdgcn_rcpf(1.0f + __builtin_amdgcn_exp2f(v));
                        else if (ACT == 3) v = (1.0f - cv[bj][n][i]) * fsigmoid(-v);
                        else if (ACT == 4) v = __builtin_amdgcn_exp2f(-0.6065306597126334f * 1.4426950408889634f * fsigmoid(v + cv[bj][n][i]));
                        else if (ACT == 5) v = fsigmoid(v + cv[bj][n][i]);
                        o[n][i] = v; } }
                *(u32x4*)(base + (size_t)r * LD + bj * HALF) = pack8(o[0], o[1]); }
            EPI_FENCE(); }
}
template <int KIND> struct EpiStore {
    static constexpr bool PERM = true, AFTER_DRAIN = false, CHAIN = false, RS = (KIND <= 2);
    bf16_t* O; const float* ssp; bf16_t* O2; bf16_t* O3; const float* c0; const float* c1;
    __device__ __forceinline__ const float* rs_ptr() const { return ssp; }
    __device__ __forceinline__ void operator()(const f32x4 (&acc)[2][2][4][2], const Unit& u, int wr, int wc, int fr, int fq, const float (&rs8)[2][4]) const {
        const int row0 = u.pm * BM + wr * 64 + fr; const int cl = wc * 32 + 8 * fq;
        if (KIND == 0) store_tile<0, true, 1792>(acc, O + u.pn * BM + cl, rs8, nullptr, row0, fq);
        if (KIND == 1) {
            if (u.pn < 3) store_tile<0, true, 768>(acc, O + u.pn * BM + cl, rs8, nullptr, row0, fq);
            else { const int t = u.pn - 3, kind = t >> 1; bf16_t* b = O2 + t * BM + cl;
                if (kind == 0 || kind == 3) store_tile<1, true, 2048>(acc, b, rs8, nullptr, row0, fq);
                else if (kind == 1) store_tile<3, true, 2048>(acc, b, rs8, c0 + (t & 1) * BM + cl, row0, fq);
                else store_tile<0, true, 2048>(acc, b, rs8, nullptr, row0, fq); } }
        if (KIND == 2) store_tile<2, true, 3072>(acc, O + u.pn * BM + cl, rs8, nullptr, row0, fq);
        if (KIND == 3) {
            if (u.pn < 2) store_tile<4, false, 512>(acc, O + u.pn * BM + cl, rs8, c0 + u.pn * BM + cl, row0, fq);
            else if (u.pn < 4) store_tile<5, false, 512>(acc, O2 + (u.pn - 2) * BM + cl, rs8, c1 + (u.pn - 2) * BM + cl, row0, fq);
            else store_tile<0, false, 512>(acc, O3 + (u.pn - 4) * BM + cl, rs8, nullptr, row0, fq); }
        if (KIND == 4) store_tile<0, false, 1024>(acc, O + u.pn * BM + cl, rs8, nullptr, row0, fq);
    }
};
template <bool FIRST> struct EpiBranch {
    static constexpr bool PERM = true, AFTER_DRAIN = false, CHAIN = false, RS = false;
    bf16_t* Mg; const bf16_t* G; const float* ssp;
    __device__ __forceinline__ const float* rs_ptr() const { return nullptr; }
    __device__ __forceinline__ void operator()(const f32x4 (&acc)[2][2][4][2], const Unit& u, int wr, int wc, int fr, int fq, const float (&rs8)[2][4]) const {
        const int row0 = u.pm * BM + wr * 64 + fr, col0 = u.pn * BM + wc * 32 + 8 * fq;
#pragma unroll
        for (int ai = 0; ai < 2; ++ai)
#pragma unroll
            for (int m = 0; m < 4; ++m) { const int r = row0 + ai * HALF + m * 16;
#pragma unroll
                for (int bj = 0; bj < 2; ++bj) { f32x4 g0, g1; unpack8(*(const u32x4*)(G + (size_t)r * 3072 + col0 + bj * HALF), g0, g1);
                    f32x4 o0 = g0 * acc[ai][bj][m][0], o1 = g1 * acc[ai][bj][m][1];
                    bf16_t* mp = Mg + (size_t)r * 1024 + col0 + bj * HALF;
                    if (!FIRST) { f32x4 p0, p1; unpack8(*(const u32x4*)mp, p0, p1); o0 = o0 + p0; o1 = o1 + p1; }
                    *(u32x4*)mp = pack8(o0, o1); }
                EPI_FENCE(); }
    }
};
struct EpiBranchChain {
    static constexpr bool PERM = true, AFTER_DRAIN = false, CHAIN = true, RS = false;
    bf16_t* Mg; const bf16_t* G;
    __device__ __forceinline__ const float* rs_ptr() const { return nullptr; }
    __device__ __forceinline__ void operator()(f32x4 (&acc)[2][2][4][2], const Unit& u, int wr, int wc, int fr, int fq, const float (&rs8)[2][4]) const {
        const int b = u.b; const rsrc_t rg = mk_rsrc(G), rm = mk_rsrc(Mg);
        const unsigned vg = (unsigned)(fr * 3072 + 8 * fq) * 2u + (unsigned)((u.pm * BM + wr * 64) * 3072 + b * 1024 + u.pn * BM + wc * 32) * 2u;
        const unsigned vm = (unsigned)(fr * 1024 + 8 * fq) * 2u + (unsigned)((u.pm * BM + wr * 64) * 1024 + u.pn * BM + wc * 32) * 2u;
        if (b < 2) {
#pragma unroll
            for (int ai = 0; ai < 2; ++ai) { u32x4 gv[4][2], hv[4][2];
#pragma unroll
                for (int m = 0; m < 4; ++m)
#pragma unroll
                    for (int bj = 0; bj < 2; ++bj) { const unsigned o = vg + (unsigned)((ai * HALF + m * 16) * 3072 + bj * HALF) * 2u;
                        gv[m][bj] = __builtin_amdgcn_raw_buffer_load_b128(rg, o, 0, 0); hv[m][bj] = __builtin_amdgcn_raw_buffer_load_b128(rg, o + 2048u, 0, 0); }
#pragma unroll
                for (int m = 0; m < 4; ++m)
#pragma unroll
                    for (int bj = 0; bj < 2; ++bj) { f32x4 g0, g1, h0, h1; unpack8(gv[m][bj], g0, g1); unpack8(hv[m][bj], h0, h1);
#pragma unroll
                        for (int i = 0; i < 4; ++i) { g0[i] *= __builtin_amdgcn_rcpf(h0[i]); g1[i] *= __builtin_amdgcn_rcpf(h1[i]); }
                        acc[ai][bj][m][0] = acc[ai][bj][m][0] * g0; acc[ai][bj][m][1] = acc[ai][bj][m][1] * g1; }
                EPI_FENCE(); }
        } else { u32x4 gv[2][4][2];
#pragma unroll
            for (int ai = 0; ai < 2; ++ai)
#pragma unroll
                for (int m = 0; m < 4; ++m)
#pragma unroll
                    for (int bj = 0; bj < 2; ++bj) gv[ai][m][bj] = __builtin_amdgcn_raw_buffer_load_b128(rg, vg + (unsigned)((ai * HALF + m * 16) * 3072 + bj * HALF) * 2u, 0, 0);
#pragma unroll
            for (int ai = 0; ai < 2; ++ai)
#pragma unroll
                for (int m = 0; m < 4; ++m)
#pragma unroll
                    for (int bj = 0; bj < 2; ++bj) { f32x4 g0, g1; unpack8(gv[ai][m][bj], g0, g1); const f32x4 o0 = g0 * acc[ai][bj][m][0], o1 = g1 * acc[ai][bj][m][1];
                        __builtin_amdgcn_raw_buffer_store_b128(pack8(o0, o1), rm, vm + (unsigned)((ai * HALF + m * 16) * 1024 + bj * HALF) * 2u, 0, 0); }
            EPI_FENCE(); }
    }
};
struct ChainOrder : StaticOrder {
    __host__ __device__ bool next(int i, Unit& u) const { if (i >= 3) return false; if (!StaticOrder::next(0, u)) return false; u.b = i; return true; }
};
template <class Epi, class Sched, bool ALIGN_EPI = false, bool SP2 = false>
__device__ __forceinline__ void gemm_phase(PG8_LAS unsigned char* lds, const Gemm g, const Sched& S, const Epi& E) {
    const int tid = threadIdx.x, wid = __builtin_amdgcn_readfirstlane(tid >> 6), lane = tid & 63, wr = wid >> 2, wc = wid & 3, fr = lane & 15, fq = lane >> 4;
    int Kl_ = g.K; asm volatile("" : "+s"(Kl_)); const int K = Kl_, nt = K / BK;
    unsigned voffA[2], voffB[2];
#pragma unroll
    for (int i = 0; i < 2; ++i) { int R, C; stage_rc(tid * 16 + i * 8192, R, C); const int Rb = Epi::PERM ? ((R & ~31) + perm32(R & 31)) : R;
        voffA[i] = (unsigned)(R * K + C) * 2u; voffB[i] = (unsigned)(Rb * K + C) * 2u; }
    const size_t kstep = (size_t)(BK * 2);
    const size_t hstep = (size_t)HALF * K * 2;
    const size_t tstep = 2 * hstep;
    const unsigned ldsw = (unsigned)wid * 1024u;
    const int aoff = lds_byte(wr * 64 + fr, fq * 8), boff = lds_byte(wc * 32 + fr, fq * 8);
#define PG8_SA(b, h) (((b) * 2 + (h)) * HTB)
#define PG8_SB(b, h) ((4 + (b) * 2 + (h)) * HTB)
#define PG8_STAGE(bufoff, gbase, voff) do { _Pragma("unroll") for (int _i = 0; _i < 2; ++_i) \
        __builtin_amdgcn_global_load_lds((const unsigned*)((const char*)(gbase) + (voff)[_i]), (PG8_LAS unsigned*)(lds + (bufoff) + ldsw + _i * 8192), 16, 0, 0); } while (0)
#define PG8_LDA(dst, b, h) do { _Pragma("unroll") for (int m = 0; m < 4; ++m) _Pragma("unroll") for (int k = 0; k < 2; ++k) dst[m][k] = *(const PG8_LAS bf16x8*)(lds + PG8_SA(b, h) + aoff + m * 2048 + k * 1024); } while (0)
#define PG8_LDB(dst, b, h) do { _Pragma("unroll") for (int n = 0; n < 2; ++n) _Pragma("unroll") for (int k = 0; k < 2; ++k) dst[n][k] = *(const PG8_LAS bf16x8*)(lds + PG8_SB(b, h) + boff + n * 2048 + k * 1024); } while (0)
#define PG8_MMA(ai, bj, At, Bt) do { __builtin_amdgcn_s_setprio(1); _Pragma("unroll") for (int m = 0; m < 4; ++m) _Pragma("unroll") for (int n = 0; n < 2; ++n) _Pragma("unroll") for (int k = 0; k < 2; ++k) \
        acc[ai][bj][m][n] = __builtin_amdgcn_mfma_f32_16x16x32_bf16(Bt[n][k], At[m][k], acc[ai][bj][m][n], 0, 0, 0); __builtin_amdgcn_s_setprio(0); } while (0)
#define PG8_WAIT_V(n) asm volatile("s_waitcnt vmcnt(" #n ")" ::: "memory")
#define PG8_WAIT_L(n) asm volatile("s_waitcnt lgkmcnt(" #n ")" ::: "memory")
#define PG8_BAR __builtin_amdgcn_s_barrier()
#define PG8_SCHED __builtin_amdgcn_sched_barrier(0)
    Unit cur, nxt; int ui = 0;
    if (!S.next(0, cur)) return;
    f32x4 acc[2][2][4][2];
#pragma unroll
    for (int a = 0; a < 2; ++a)
#pragma unroll
        for (int b = 0; b < 2; ++b)
#pragma unroll
            for (int m = 0; m < 4; ++m)
#pragma unroll
                for (int n = 0; n < 2; ++n) acc[a][b][m][n] = (f32x4){0.f, 0.f, 0.f, 0.f};
    bf16x8 At[4][2], B0[2][2], B1[2][2];
    const char* cA = (const char*)g.A + (size_t)cur.pm * tstep + (size_t)cur.b * g.usA * 2; const char* cB = (const char*)g.Bt + (size_t)cur.pn * tstep + (size_t)cur.b * g.usB * 2;
    S.a_ready(cur);
    PG8_LAS float* RSL = (PG8_LAS float*)(lds + RS_LDS_OFF);
    if constexpr (Epi::RS) { f32x4 p0_[2];
#pragma unroll
        for (int ai = 0; ai < 2; ++ai) p0_[ai] = *(const f32x4*)(E.rs_ptr() + (size_t)(cur.pm * BM + ai * HALF + wr * 64 + wc * 16 + fr) * 16 + 4 * fq);
#pragma unroll
        for (int ai = 0; ai < 2; ++ai) { const float q_ = (p0_[ai][0] + p0_[ai][1]) + (p0_[ai][2] + p0_[ai][3]); const float r_ = __builtin_amdgcn_rsqf(xq_sum(q_) * (1.0f / 1024.0f) + 1e-6f);
            if (fq == 0) RSL[ai * HALF + wr * 64 + wc * 16 + fr] = r_; } }
    if constexpr (SP2) {
        PG8_STAGE(PG8_SB(0, 0), cB, voffB); PG8_STAGE(PG8_SB(0, 1), cB + hstep, voffB); PG8_STAGE(PG8_SA(0, 0), cA, voffA); PG8_STAGE(PG8_SA(0, 1), cA + hstep, voffA);
        if (wr == 1) PG8_BAR;
        PG8_WAIT_V(2); PG8_BAR;
        PG8_STAGE(PG8_SB(1, 0), cB + kstep, voffB); PG8_STAGE(PG8_SA(1, 0), cA + kstep, voffA); PG8_STAGE(PG8_SB(1, 1), cB + hstep + kstep, voffB);
        PG8_WAIT_V(6); PG8_BAR;
    } else {
        PG8_STAGE(PG8_SB(0, 0), cB, voffB); PG8_STAGE(PG8_SA(0, 0), cA, voffA); PG8_STAGE(PG8_SB(0, 1), cB + hstep, voffB); PG8_STAGE(PG8_SA(0, 1), cA + hstep, voffA);
        if (wr == 1) PG8_BAR;
        PG8_WAIT_V(4); PG8_BAR;
        PG8_STAGE(PG8_SB(1, 0), cB + kstep, voffB); PG8_STAGE(PG8_SA(1, 0), cA + kstep, voffA); PG8_STAGE(PG8_SB(1, 1), cB + hstep + kstep, voffB);
        PG8_WAIT_V(6); PG8_BAR;
    }
    for (;;) {
        const bool has_next = S.next(ui + 1, nxt);
        const char* nA = has_next ? (const char*)g.A + (size_t)nxt.pm * tstep + (size_t)nxt.b * g.usA * 2 : cA; const char* nB = has_next ? (const char*)g.Bt + (size_t)nxt.pn * tstep + (size_t)nxt.b * g.usB * 2 : cB;
        for (int t = 0; t < nt; t += 2) {
            const bool last = (t == nt - 2);
            const char* a1 = cA + (size_t)(t + 1) * kstep;
            const char* a2 = last ? nA : cA + (size_t)(t + 2) * kstep; const char* b2 = last ? nB : cB + (size_t)(t + 2) * kstep;
            const char* a3 = a2 + kstep; const char* b3 = b2 + kstep;
            if (last && has_next) S.a_ready(nxt);
            if constexpr (SP2) {
            PG8_LDB(B0, 0, 0); PG8_LDB(B1, 0, 1); PG8_SCHED; PG8_LDA(At, 0, 0); PG8_STAGE(PG8_SA(1, 1), a1 + hstep, voffA);
            PG8_WAIT_V(8); PG8_WAIT_L(0); PG8_BAR; PG8_MMA(0, 0, At, B0); PG8_MMA(0, 1, At, B1); PG8_BAR; PG8_SCHED;
            PG8_LDA(At, 0, 1); PG8_STAGE(PG8_SB(0, 0), b2, voffB); PG8_STAGE(PG8_SB(0, 1), b2 + hstep, voffB); PG8_STAGE(PG8_SA(0, 0), a2, voffA);
            PG8_WAIT_V(8); PG8_WAIT_L(0); PG8_BAR; PG8_MMA(1, 0, At, B0); PG8_MMA(1, 1, At, B1); PG8_BAR; PG8_SCHED;
            PG8_LDB(B0, 1, 0); PG8_LDB(B1, 1, 1); PG8_SCHED; PG8_LDA(At, 1, 0); PG8_STAGE(PG8_SA(0, 1), a2 + hstep, voffA);
            PG8_WAIT_V(8); PG8_WAIT_L(0); PG8_BAR; PG8_MMA(0, 0, At, B0); PG8_MMA(0, 1, At, B1); PG8_BAR; PG8_SCHED;
            PG8_LDA(At, 1, 1); PG8_STAGE(PG8_SB(1, 0), b3, voffB); PG8_STAGE(PG8_SB(1, 1), b3 + hstep, voffB); PG8_STAGE(PG8_SA(1, 0), a3, voffA);
            PG8_WAIT_V(8); PG8_WAIT_L(0); PG8_BAR; PG8_MMA(1, 0, At, B0); PG8_MMA(1, 1, At, B1); PG8_BAR; PG8_SCHED;
            } else {
            PG8_LDB(B0, 0, 0); PG8_SCHED; PG8_LDA(At, 0, 0); PG8_STAGE(PG8_SA(1, 1), a1 + hstep, voffA);
            PG8_WAIT_L(8); PG8_BAR; PG8_WAIT_L(0); PG8_MMA(0, 0, At, B0); PG8_BAR; PG8_SCHED;
            PG8_LDB(B1, 0, 1); PG8_STAGE(PG8_SB(0, 0), b2, voffB);
            PG8_BAR; PG8_WAIT_L(0); PG8_MMA(0, 1, At, B1); PG8_BAR;
            PG8_LDA(At, 0, 1); PG8_STAGE(PG8_SA(0, 0), a2, voffA);
            PG8_BAR; PG8_WAIT_L(0); PG8_MMA(1, 0, At, B0); PG8_BAR; PG8_SCHED;
            PG8_STAGE(PG8_SB(0, 1), b2 + hstep, voffB);
            PG8_WAIT_V(6); PG8_BAR; PG8_MMA(1, 1, At, B1); PG8_BAR;
            PG8_LDB(B0, 1, 0); PG8_SCHED; PG8_LDA(At, 1, 0); PG8_STAGE(PG8_SA(0, 1), a2 + hstep, voffA);
            PG8_WAIT_L(8); PG8_BAR; PG8_WAIT_L(0); PG8_MMA(0, 0, At, B0); PG8_BAR; PG8_SCHED;
            PG8_LDB(B1, 1, 1); PG8_STAGE(PG8_SB(1, 0), b3, voffB);
            PG8_BAR; PG8_WAIT_L(0); PG8_MMA(0, 1, At, B1); PG8_BAR;
            PG8_LDA(At, 1, 1); PG8_STAGE(PG8_SA(1, 0), a3, voffA);
            PG8_BAR; PG8_WAIT_L(0); PG8_MMA(1, 0, At, B0); PG8_BAR; PG8_SCHED;
            PG8_STAGE(PG8_SB(1, 1), b3 + hstep, voffB);
            PG8_WAIT_V(6); PG8_BAR; PG8_MMA(1, 1, At, B1); PG8_BAR;
            }
        }
        if constexpr (ALIGN_EPI) { if (wr == 0) PG8_BAR; }
        if constexpr (!Epi::AFTER_DRAIN) {
            float rsv[2][4];
            if constexpr (Epi::RS) { const PG8_LAS float* rb_ = RSL + (ui & 1) * 256 + wr * 64 + fr;
#pragma unroll
                for (int ai = 0; ai < 2; ++ai)
#pragma unroll
                    for (int m = 0; m < 4; ++m) rsv[ai][m] = rb_[ai * HALF + m * 16];
                f32x4 pn_[2];
                if (has_next) {
#pragma unroll
                    for (int ai = 0; ai < 2; ++ai) pn_[ai] = *(const f32x4*)(E.rs_ptr() + (size_t)(nxt.pm * BM + ai * HALF + wr * 64 + wc * 16 + fr) * 16 + 4 * fq); }
                E(acc, cur, wr, wc, fr, fq, rsv);
                if (has_next) {
#pragma unroll
                    for (int ai = 0; ai < 2; ++ai) { const float q_ = (pn_[ai][0] + pn_[ai][1]) + (pn_[ai][2] + pn_[ai][3]); const float r_ = __builtin_amdgcn_rsqf(xq_sum(q_) * (1.0f / 1024.0f) + 1e-6f);
                        if (fq == 0) RSL[((ui + 1) & 1) * 256 + ai * HALF + wr * 64 + wc * 16 + fr] = r_; } } }
            else { for (int ai = 0; ai < 2; ++ai) for (int m = 0; m < 4; ++m) rsv[ai][m] = 1.0f; E(acc, cur, wr, wc, fr, fq, rsv); }
            S.done(cur); }
        if (!has_next) break;
        if constexpr (!Epi::CHAIN)
#pragma unroll
        for (int a = 0; a < 2; ++a)
#pragma unroll
            for (int b = 0; b < 2; ++b)
#pragma unroll
                for (int m = 0; m < 4; ++m)
#pragma unroll
                    for (int n = 0; n < 2; ++n) acc[a][b][m][n] = (f32x4){0.f, 0.f, 0.f, 0.f};
        cur = nxt; cA = nA; cB = nB; ++ui;
        if constexpr (ALIGN_EPI) { if (wr == 1) PG8_BAR; }
    }
    PG8_WAIT_V(0);
    if constexpr (!ALIGN_EPI) { if (wr == 0) PG8_BAR; }
    PG8_BAR;
    if constexpr (Epi::AFTER_DRAIN) { E.fused(acc, cur, wr, wc, fr, fq, lds, wid, lane); S.done(cur); }
#undef PG8_SA
#undef PG8_SB
#undef PG8_STAGE
#undef PG8_LDA
#undef PG8_LDB
#undef PG8_MMA
#undef PG8_WAIT_V
#undef PG8_WAIT_L
#undef PG8_BAR
#undef PG8_SCHED
}
}
#define GAS __attribute__((address_space(1)))
#define LAS __attribute__((address_space(3)))
typedef unsigned short bf16;
typedef unsigned v4u __attribute__((ext_vector_type(4)));
typedef float f32x4 __attribute__((ext_vector_type(4)));
typedef short bf16x8 __attribute__((ext_vector_type(8)));
typedef GAS unsigned gu32;
typedef GAS unsigned long long gu64;
#define RLX_AGENT __ATOMIC_RELAXED, __HIP_MEMORY_SCOPE_AGENT
#define LDS_WAIT() asm volatile("s_waitcnt lgkmcnt(0)" ::: "memory")
#define VM_WAIT() asm volatile("s_waitcnt vmcnt(0)" ::: "memory")
__device__ __forceinline__ unsigned long long rt() { return __builtin_amdgcn_s_memrealtime(); }
__device__ __forceinline__ unsigned f2bf(float f) { unsigned u = __builtin_bit_cast(unsigned, f); return (u + 0x7fffu + ((u >> 16) & 1u)) >> 16; }
__device__ __forceinline__ unsigned pk2(float lo, float hi) { return f2bf(lo) | (f2bf(hi) << 16); }

#define XB_TMO      128
#define XB_XCNT(j)  (256  + 64 * (j))
#define XB_XSUB(j)  (1280 + 64 * (j))
#define XB_XGEN(j)  (2304 + 64 * (j))
#define XB_TOP      3328
#define XB_TOPGEN   3392
#define XCD_BAR_WORDS 3456
#define XB_SPIN_CAP (1u << 18)

__device__ __forceinline__ unsigned xb_ld(unsigned* p)              { return __hip_atomic_load(p, __ATOMIC_RELAXED, __HIP_MEMORY_SCOPE_AGENT); }
__device__ __forceinline__ unsigned xb_add(unsigned* p, unsigned v) { return __hip_atomic_fetch_add(p, v, __ATOMIC_RELAXED, __HIP_MEMORY_SCOPE_AGENT); }
__device__ __forceinline__ unsigned xb_xcc_id() { return (unsigned)__builtin_amdgcn_s_getreg((3 << 11) | 20) & 0xFu; }
#define XB_SPIN(cond, bar) do { unsigned _sp = 0; while (cond) { __builtin_amdgcn_s_sleep(1); \
    if ((++_sp & 255u) == 0u) { if (xb_ld(&(bar)[XB_TMO])) break; if (_sp > XB_SPIN_CAP) { atomicAdd(&(bar)[XB_TMO], 1u); break; } } } } while (0)

struct XcdBarrier {
    unsigned* bar; unsigned x;
    volatile LAS unsigned* st;
};

__device__ __forceinline__ XcdBarrier xcd_barrier_post(unsigned* bar, volatile LAS unsigned* st) {
    XcdBarrier b; b.bar = bar; b.x = xb_xcc_id(); b.st = st;
    if (threadIdx.x == 0) (void)xb_add(&bar[XB_XCNT(b.x)], 1u);
    return b;
}
__device__ __forceinline__ void xcd_barrier_complete(unsigned* bar, unsigned x, unsigned& nloc, unsigned& nx) {
    const unsigned G = gridDim.x * gridDim.y * gridDim.z;
    unsigned sum, cnt, mine, sp = 0u;
    for (;;) {
        sum = 0u; cnt = 0u; mine = 0u;
#pragma unroll
        for (unsigned j = 0; j < 16; ++j) { const unsigned c = xb_ld(&bar[XB_XCNT(j)]); sum += c; cnt += (c > 0u) ? 1u : 0u; mine = (j == x) ? c : mine; }
        if (sum == G) break;
        __builtin_amdgcn_s_sleep(1);
        if ((++sp & 255u) == 0u) { if (xb_ld(&bar[XB_TMO])) break; if (sp > XB_SPIN_CAP) { atomicAdd(&bar[XB_TMO], 1u); break; } }
    }
    nloc = mine > 0u ? mine : 1u; nx = cnt > 0u ? cnt : 1u;
}

__device__ __forceinline__ void xcd_barrier(const XcdBarrier& b) {
    asm volatile("s_waitcnt vmcnt(0)" ::: "memory");
    __syncthreads();
    if (threadIdx.x == 0) {
        unsigned* bar = b.bar;
        __builtin_amdgcn_s_waitcnt(0);
        unsigned nloc = b.st[0], nx = b.st[1];
        if (nloc == 0u) { xcd_barrier_complete(bar, b.x, nloc, nx); b.st[0] = nloc; b.st[1] = nx; }
        const unsigned old = xb_add(&bar[XB_XSUB(b.x)], 1u);
        const unsigned gen = old / nloc;
        if (old + 1u == (gen + 1u) * nloc) {
            __builtin_amdgcn_fence(__ATOMIC_RELEASE, "agent");
            asm volatile("s_waitcnt vmcnt(0)" ::: "memory");
            __builtin_amdgcn_fence(__ATOMIC_ACQUIRE, "agent");
            const unsigned og = xb_add(&bar[XB_TOP], 1u);
            const unsigned tg = og / nx;
            if (og + 1u == (tg + 1u) * nx) xb_add(&bar[XB_TOPGEN], 1u);
            else XB_SPIN(xb_ld(&bar[XB_TOPGEN]) == tg, bar);
            xb_add(&bar[XB_XGEN(b.x)], 1u);
            asm volatile("s_waitcnt vmcnt(0)" ::: "memory");
        } else {
            __builtin_amdgcn_fence(__ATOMIC_ACQUIRE, "agent");
            XB_SPIN(xb_ld(&bar[XB_XGEN(b.x)]) == gen, bar);
            asm volatile("s_waitcnt vmcnt(0)" ::: "memory");
        }
    }
    __syncthreads();
}
constexpr int NWAVES = 8;
constexpr int BATCH = 2, SEQ = 8192, DM = 1024, M = BATCH * SEQ, FF = 2816, DEPTH = 2;
enum { I_X = 0, I_P, I_F1N, I_F1G, I_F1U, I_F1D, I_MIXN, I_WIN, I_SINK, I_MU, I_W0, I_WUP, I_A0, I_AUP, I_GUP, I_KK, I_KA, I_RK, I_LNW, I_LNB, I_HLB, I_HNORM, I_WBR, I_WO,
       I_F2N, I_F2G, I_F2U, I_F2D, I_PLEN, I_PLEG, I_PLEP, I_FINN, N_IN };
constexpr size_t KiB = 1024, MiB = 1u << 20;
constexpr size_t WS_CTL = 0, CTL_ZERO_BYTES = 64 * KiB;
constexpr size_t WS_SS0 = 1 * MiB, WS_SS1 = 2 * MiB;
constexpr size_t WS_CBON = 3 * MiB;
constexpr size_t WS_LB = 3 * MiB + 512 * KiB;
constexpr size_t WS_W = 4 * MiB;
constexpr size_t W_F1GU = WS_W, W_F1D = W_F1GU + (size_t)5632 * 1024 * 2, W_IN = W_F1D + (size_t)1024 * 2816 * 2, W_LR = W_IN + (size_t)7680 * 1024 * 2,
                 W_BR = W_LR + (size_t)1536 * 256 * 2, W_O = W_BR + (size_t)3 * 1024 * 512 * 2, W_F2GU = W_O + (size_t)1024 * 1024 * 2, W_F2D = W_F2GU + (size_t)5632 * 1024 * 2,
                 W_PG = W_F2D + (size_t)1024 * 2816 * 2, W_PP = W_PG + (size_t)1024 * 1024 * 2, W_END = W_PP + (size_t)1024 * 256 * 2;
constexpr size_t WS_XB = 61 * MiB;
static_assert(W_END <= WS_XB, "weights fit");
constexpr size_t WS_R = 93 * MiB;
constexpr size_t R_H = WS_R;
constexpr size_t R_SIN_V = WS_R, R_SIN_R = WS_R + 16 * MiB, R_SIN_W = WS_R + 32 * MiB, R_SIN_KP = WS_R + 48 * MiB, R_SIN_KK = WS_R + 64 * MiB, R_SIN_B = WS_R + 80 * MiB;
constexpr size_t R_CV = WS_R, R_CG = WS_R + 16 * MiB, R_CH = WS_R + 32 * MiB, R_CDT = WS_R + 64 * MiB, R_CQT = WS_R + 80 * MiB, R_CS = WS_R + 200 * MiB;
constexpr size_t R_DAG_G = WS_R + 96 * MiB;
constexpr size_t R_ZR = WS_R + 112 * MiB;
constexpr size_t R_AP = WS_R + 168 * MiB;
constexpr size_t R_DAG_W = WS_R + 176 * MiB, R_DAG_A = WS_R + 192 * MiB;
constexpr size_t R_ZA = WS_R + 112 * MiB;
constexpr size_t R_YRAW = WS_R + 200 * MiB;
constexpr size_t R_Y = WS_R + 16 * MiB;
constexpr size_t R_GG = WS_R + 112 * MiB;
constexpr size_t R_MERGED = WS_R + 64 * MiB;
constexpr size_t R_PB = WS_R + 96 * MiB;
constexpr size_t R_PROJ = WS_R + 112 * MiB;
constexpr size_t R_XBALT = WS_R + 144 * MiB;
constexpr size_t R_HST = WS_R + 216 * MiB;
constexpr size_t WS_HD = 3 * MiB + 576 * KiB;
constexpr size_t WS_END = WS_R + 224 * MiB;
constexpr int CW_BAR = 4096;
constexpr int RING_OFF = 0, RING_BYTES = 131072;
constexpr int LDSCTL_OFF = 143360, MISC_OFF = LDSCTL_OFF + 320;
constexpr int LDS_BYTES = 147456;
constexpr int N_PHASES = 17 * DEPTH + 1;
#ifndef ENMASK
#define ENMASK 0x3ffff
#endif
#define EN(k) ((ENMASK >> (k)) & 1)
struct Args { const float* in[N_IN]; float* out; unsigned char* ws; int ph_lo, ph_hi; };
typedef const __attribute__((address_space(4))) unsigned char* kargp_t;
#define KP_DECL kargp_t KP_ = (kargp_t)__builtin_amdgcn_kernarg_segment_ptr(); asm volatile("" : "+s"(KP_))
#define INP(i) (*(const float* const __attribute__((address_space(4)))*)(KP_ + 8 * (i)))
typedef unsigned u32x2 __attribute__((ext_vector_type(2)));
__device__ __forceinline__ float bflo(unsigned w) { return __uint_as_float(w << 16); }
__device__ __forceinline__ float bfhi(unsigned w) { return __uint_as_float(w & 0xffff0000u); }
__device__ __forceinline__ float bf1(bf16 b) { return __uint_as_float(((unsigned)b) << 16); }
__device__ __forceinline__ float sigm(float x) { return __builtin_amdgcn_rcpf(1.0f + __builtin_amdgcn_exp2f(-1.4426950408889634f * x)); }
template <int CTRL> __device__ __forceinline__ float dppf(float x) { return __builtin_bit_cast(float, __builtin_amdgcn_mov_dpp(__builtin_bit_cast(int, x), CTRL, 0xf, 0xf, true)); }
__device__ __forceinline__ float xrow16_sum(float x) {
    auto s = __builtin_amdgcn_permlane16_swap(__float_as_uint(x), __float_as_uint(x), false, false);
    x = __uint_as_float(s[0]) + __uint_as_float(s[1]);
    auto t = __builtin_amdgcn_permlane32_swap(__float_as_uint(x), __float_as_uint(x), false, false);
    return __uint_as_float(t[0]) + __uint_as_float(t[1]);
}
__device__ __forceinline__ float wave_allsum(float x) {
    x += dppf<0xB1>(x); x += dppf<0x4E>(x); x += dppf<0x141>(x); x += dppf<0x128>(x); return xrow16_sum(x);
}
__device__ __forceinline__ float wave_allsum_slow(float v) {
#pragma unroll
    for (int o = 1; o < 64; o <<= 1) v += __shfl_xor(v, o);
    return v;
}
__device__ __forceinline__ float wave_allmax_slow(float v) {
#pragma unroll
    for (int o = 1; o < 64; o <<= 1) v = fmaxf(v, __shfl_xor(v, o));
    return v;
}

struct Frame {
    LAS unsigned char* lds;
    volatile LAS unsigned* MISC;
    gu32* ctl;
    int tid, lane, wave;
    int G;
    unsigned char* ws;
    float* x;
};
#define WSP(T, off) ((T*)(F.ws + (off)))

__device__ __forceinline__ int map_row(int map, int n0) {
    if (map == 1) return (n0 >> 7) * 256 + (n0 & 127);
    if (map == 2) return (n0 >> 7) * 256 + 128 + (n0 & 127);
    if (map == 3) return n0 < 768 ? 1792 + n0 : (n0 < 2560 ? n0 - 768 : n0);
    return n0;
}
struct CJob { const float* W; const float* g; int K, N; bf16* WT; int map, item; };
__device__ __forceinline__ void conv_load(const CJob& j, int lane, f32x4 (&v)[16], float (&sc)[16]) {
    const int nblk = j.N / 64, kb = j.item / nblk, nb = j.item % nblk, k0 = 64 * kb, n0 = 64 * nb; const int nq = (lane & 15) * 4;
#pragma unroll
    for (int i = 0; i < 16; ++i) { const int kk = 4 * i + (lane >> 4); sc[i] = j.g ? j.g[k0 + kk] : 1.0f; v[i] = __builtin_nontemporal_load((const f32x4*)(j.W + (size_t)(k0 + kk) * j.N + n0 + nq)); }
}
__device__ __forceinline__ void conv_to_lds(int lane, const f32x4 (&v)[16], const float (&sc)[16], LAS float* scr) {
    const int nq = (lane & 15) * 4;
#pragma unroll
    for (int i = 0; i < 16; ++i) { const int kk = 4 * i + (lane >> 4); LAS float* d = scr + kk * 65 + nq; d[0] = v[i].x * sc[i]; d[1] = v[i].y * sc[i]; d[2] = v[i].z * sc[i]; d[3] = v[i].w * sc[i]; }
}
__device__ __forceinline__ void conv_store(const CJob& j, int lane, const LAS float* scr) {
    const int nblk = j.N / 64, kb = j.item / nblk, nb = j.item % nblk, k0 = 64 * kb, n0 = 64 * nb; const int c = lane & 7; const int dr = map_row(j.map, n0);
#pragma unroll
    for (int q = 0; q < 8; ++q) { const int n = (lane >> 3) + 8 * q; const LAS float* s = scr + (8 * c) * 65 + n;
        v4u o; o.x = pk2(s[0 * 65], s[1 * 65]); o.y = pk2(s[2 * 65], s[3 * 65]); o.z = pk2(s[4 * 65], s[5 * 65]); o.w = pk2(s[6 * 65], s[7 * 65]);
        *(GAS v4u*)(j.WT + (size_t)(dr + n) * j.K + k0 + 8 * c) = o; }
}
template <int PART> __device__ __forceinline__ void phase_conv(Frame& F, const Args& A, int L) {
    KP_DECL;
    LAS float* scr = (LAS float*)(F.lds + RING_OFF + F.wave * 16640);
    const int gw = blockIdx.x * NWAVES + F.wave, NGW = F.G * NWAVES;
    const float* f1g = INP(I_F1G) + (size_t)L * 1024 * 2816; const float* f1u = INP(I_F1U) + (size_t)L * 1024 * 2816; const float* f1d = INP(I_F1D) + (size_t)L * 2816 * 1024;
    const float* f2g = INP(I_F2G) + (size_t)L * 1024 * 2816; const float* f2u = INP(I_F2U) + (size_t)L * 1024 * 2816; const float* f2d = INP(I_F2D) + (size_t)L * 2816 * 1024;
    const float* win = INP(I_WIN) + (size_t)L * 1024 * 7680; const float* wbr = INP(I_WBR) + (size_t)L * 3 * 512 * 1024; const float* wo = INP(I_WO) + (size_t)L * 1024 * 1024;
    const float* pg = INP(I_PLEG) + (size_t)L * 1024 * 1024; const float* pp = INP(I_PLEP) + (size_t)L * 256 * 1024;
    const float* n1 = INP(I_F1N) + L * 1024; const float* nm = INP(I_MIXN) + L * 1024; const float* n2 = INP(I_F2N) + L * 1024; const float* np = INP(I_PLEN) + L * 1024;
    constexpr int IT_FGU = 16 * 44, IT_FD = 44 * 16, IT_IN = 16 * 120, IT_BR = 8 * 16, IT_SQ = 16 * 16, IT_PP = 4 * 16;
    constexpr int NITEMS = 4 * IT_FGU + 2 * IT_FD + IT_IN + 3 * IT_BR + 2 * IT_SQ + IT_PP;
#define CONV_DECODE(it_, J) do { int r = (it_); \
        if (r < IT_FGU) { J = CJob{f1g, n1, 1024, 2816, WSP(bf16, W_F1GU), 1, r}; break; } r -= IT_FGU; \
        if (r < IT_FGU) { J = CJob{f1u, n1, 1024, 2816, WSP(bf16, W_F1GU), 2, r}; break; } r -= IT_FGU; \
        if (r < IT_FD)  { J = CJob{f1d, nullptr, 2816, 1024, WSP(bf16, W_F1D), 0, r}; break; } r -= IT_FD; \
        if (r < IT_IN)  { J = CJob{win, nm, 1024, 7680, WSP(bf16, W_IN), 3, r}; break; } r -= IT_IN; \
        if (r < 3 * IT_BR) { const int b_ = r / IT_BR; J = CJob{wbr + (size_t)b_ * 512 * 1024, nullptr, 512, 1024, WSP(bf16, W_BR) + (size_t)b_ * 1024 * 512, 0, r % IT_BR}; break; } r -= 3 * IT_BR; \
        if (r < IT_SQ)  { J = CJob{wo, nullptr, 1024, 1024, WSP(bf16, W_O), 0, r}; break; } r -= IT_SQ; \
        if (r < IT_FGU) { J = CJob{f2g, n2, 1024, 2816, WSP(bf16, W_F2GU), 1, r}; break; } r -= IT_FGU; \
        if (r < IT_FGU) { J = CJob{f2u, n2, 1024, 2816, WSP(bf16, W_F2GU), 2, r}; break; } r -= IT_FGU; \
        if (r < IT_FD)  { J = CJob{f2d, nullptr, 2816, 1024, WSP(bf16, W_F2D), 0, r}; break; } r -= IT_FD; \
        if (r < IT_SQ)  { J = CJob{pg, np, 1024, 1024, WSP(bf16, W_PG), 0, r}; break; } r -= IT_SQ; \
        J = CJob{pp, nullptr, 256, 1024, WSP(bf16, W_PP), 0, r}; } while (0)
    constexpr int NA = 2 * IT_FGU + IT_FD + IT_IN;
    const int first = (PART == 0) ? gw : NA + ((int)blockIdx.x - F.G / 2) * NWAVES + F.wave, stride = (PART == 0) ? NGW : (F.G - F.G / 2) * NWAVES, hi_ = (PART == 0) ? NA : NITEMS;
    { CJob cur{}, nxt{}; f32x4 v[16]; float scv[16];
      if (first < hi_) { CONV_DECODE(first, cur); conv_load(cur, F.lane, v, scv); }
      for (int it = first; it < hi_; it += stride) {
          conv_to_lds(F.lane, v, scv, scr);
          const bool has = it + stride < hi_;
          if (has) { CONV_DECODE(it + stride, nxt); conv_load(nxt, F.lane, v, scv); }
          LDS_WAIT(); asm volatile("" ::: "memory");
          conv_store(cur, F.lane, scr);
          LDS_WAIT(); asm volatile("" ::: "memory");
          cur = nxt; } }
#undef CONV_DECODE
    if (PART != 0) return;
    const float* wup = INP(I_WUP) + (size_t)L * 64 * 512; const float* aup = INP(I_AUP) + (size_t)L * 64 * 512; const float* gup = INP(I_GUP) + (size_t)L * 128 * 512;
    bf16* wlr = WSP(bf16, W_LR);
    const int gt = blockIdx.x * (NWAVES * 64) + F.tid, NGT = F.G * NWAVES * 64;
    for (int e = gt; e < 1536 * 256; e += NGT) { const int n = e >> 8, k = e & 255; const int grp = n >> 9, c = n & 511; float v = 0.f;
        if (grp == 0) { if (k < 64) v = wup[k * 512 + c]; } else if (grp == 1) { if (k >= 64 && k < 128) v = aup[(k - 64) * 512 + c]; } else { if (k >= 128) v = gup[(k - 128) * 512 + c]; }
        wlr[e] = (bf16)f2bf(v); }
    if (gt < 512) { const float a0 = INP(I_HLB)[gt], a1 = INP(I_HLB)[512 + gt]; const float mx = fmaxf(a0, a1); const float e0 = __expf(a0 - mx), e1 = __expf(a1 - mx);
        float lb = (L == 0) ? 0.f : e1 / (e0 + e1); lb = fminf(fmaxf(lb, 0.f), 1.0f - 1e-6f); WSP(float, WS_LB)[gt] = lb; }
    if (L == 0) {
        const float* xin = INP(I_X); bf16* xb = WSP(bf16, WS_XB); float* ss = WSP(float, WS_SS0);
        for (int m0 = gw; m0 < M; m0 += 2 * NGW) {
            f32x4 v[2][4];
#pragma unroll
            for (int k = 0; k < 2; ++k) { const int m = (m0 + k * NGW < M) ? m0 + k * NGW : m0; const GAS f32x4* xr = (const GAS f32x4*)(xin + (size_t)m * DM) + F.lane;
#pragma unroll
                for (int j = 0; j < 4; ++j) v[k][j] = __builtin_nontemporal_load((const f32x4*)(xr + 64 * j)); }
#pragma unroll
            for (int k = 0; k < 2; ++k) { const int m = m0 + k * NGW; if (m >= M) break;
                GAS unsigned long long* o8 = (GAS unsigned long long*)(xb + (size_t)m * DM) + F.lane; float s = 0.f;
#pragma unroll
                for (int j = 0; j < 4; ++j) { const f32x4 vv = v[k][j]; s += (vv.x * vv.x + vv.y * vv.y) + (vv.z * vv.z + vv.w * vv.w);
                    o8[64 * j] = (unsigned long long)pk2(vv.x, vv.y) | ((unsigned long long)pk2(vv.z, vv.w) << 32); }
                s = wave_allsum_slow(s);
                if (F.lane < 16) ss[(size_t)m * 16 + F.lane] = (F.lane == 0) ? s : 0.f; } }
    }
}
__device__ __forceinline__ void conv_p(Frame& F, const Args& A, int L) {
    KP_DECL;
    const float* p = INP(I_P) + (size_t)L * M * 256; bf16* pb = WSP(bf16, R_PB);
    const int gt = blockIdx.x * (NWAVES * 64) + F.tid, NGT = F.G * NWAVES * 64;
    for (int e0 = gt; e0 < M * 256 / 8; e0 += 4 * NGT) {
        f32x4 a[4], b[4];
#pragma unroll
        for (int k = 0; k < 4; ++k) { const int e = e0 + k * NGT; if (e < M * 256 / 8) { a[k] = __builtin_nontemporal_load((const f32x4*)(p + (size_t)e * 8)); b[k] = __builtin_nontemporal_load((const f32x4*)(p + (size_t)e * 8 + 4)); } }
#pragma unroll
        for (int k = 0; k < 4; ++k) { const int e = e0 + k * NGT; if (e < M * 256 / 8) {
            v4u o; o.x = pk2(a[k].x, a[k].y); o.y = pk2(a[k].z, a[k].w); o.z = pk2(b[k].x, b[k].y); o.w = pk2(b[k].z, b[k].w); *(v4u*)(pb + (size_t)e * 8) = o; } } }
}

__device__ __forceinline__ void phase_rprep1(Frame& F, const Args& A, int L) {
    KP_DECL;
    const bf16* zr = WSP(bf16, R_ZR); bf16* ap = WSP(bf16, R_AP); const float* mu = INP(I_MU) + L * 1792 + 1536;
    const int gt = blockIdx.x * (NWAVES * 64) + F.tid, NGT = F.G * NWAVES * 64;
    for (int e = gt; e < M * 32; e += NGT) { const int row = e >> 5, c0 = (e & 31) * 8; const int tl = row & (SEQ - 1);
        const v4u zc = *(const v4u*)(zr + (size_t)row * 1792 + 1536 + c0); v4u zp = (v4u){0u, 0u, 0u, 0u};
        if (tl != 0) zp = *(const v4u*)(zr + (size_t)(row - 1) * 1792 + 1536 + c0);
        float o[8];
#pragma unroll
        for (int i = 0; i < 4; ++i) { const unsigned wc_ = zc[i], wp_ = zp[i];
            const float c_lo = bflo(wc_), c_hi = bfhi(wc_), p_lo = bflo(wp_), p_hi = bfhi(wp_);
            const float m0 = mu[c0 + 2 * i], m1 = mu[c0 + 2 * i + 1];
            o[2 * i] = c_lo + m0 * (p_lo - c_lo); o[2 * i + 1] = c_hi + m1 * (p_hi - c_hi); }
#pragma unroll
        for (int i = 0; i < 8; ++i) { if (c0 < 64) o[i] = 2.0f * sigm(2.0f * o[i]) - 1.0f; else if (c0 >= 128) o[i] = sigm(o[i]); }
        v4u w; w.x = pk2(o[0], o[1]); w.y = pk2(o[2], o[3]); w.z = pk2(o[4], o[5]); w.w = pk2(o[6], o[7]);
        *(v4u*)(ap + (size_t)row * 256 + c0) = w; }
}
typedef float f32x16 __attribute__((ext_vector_type(16)));
__device__ __forceinline__ unsigned cvtpk(float lo, float hi) { return pg8::cvtpk_s(lo, hi); }
constexpr int LDP = 72;
__device__ __forceinline__ f32x4 mm16_k64(const LAS bf16* X, const LAS bf16* YT, int m0, int n0, int lane, f32x4 acc) {
    const int r = lane & 15, g = lane >> 4;
#pragma unroll
    for (int ks = 0; ks < 2; ++ks) { const bf16x8 a = *(const LAS bf16x8*)(X + (m0 + r) * LDP + ks * 32 + 8 * g); const bf16x8 b = *(const LAS bf16x8*)(YT + (n0 + r) * LDP + ks * 32 + 8 * g);
        acc = __builtin_amdgcn_mfma_f32_16x16x32_bf16(a, b, acc, 0, 0, 0); }
    return acc;
}
constexpr int RC_MAT = 64 * LDP * 2;
constexpr int RC_BH = 0, RC_KH = RC_MAT, RC_PC = 2 * RC_MAT, RC_RC = 3 * RC_MAT, RC_PT = 4 * RC_MAT, RC_AKP = 5 * RC_MAT, RC_RT = 6 * RC_MAT, RC_VT = 7 * RC_MAT;
constexpr int RC_XR = 8 * RC_MAT;
constexpr int RC_TI = 10 * RC_MAT;
constexpr int RC_ABP = 11 * RC_MAT;
constexpr int RC_TT = RC_ABP + 16384;
constexpr int RC_PS = RC_TT + 16384;
constexpr int RC_GC = RC_PS + 4096;
constexpr int RC_PAR = RC_GC + 256;
constexpr int RC_END = RC_PAR + 6 * 64 * 4;
static_assert(RC_END <= LDSCTL_OFF, "rwkv pre-pass LDS");
constexpr int RC_ZT = RC_PC;
constexpr int RC_KBT = RC_BH;
__device__ __forceinline__ float shx(float v, int m) { return __shfl_xor(v, m); }
__device__ __forceinline__ float sum8(float v) { v += dppf<0xB1>(v); v += dppf<0x4E>(v); v += dppf<0x141>(v); return v; }
__device__ __forceinline__ float sum16(float v) { v = sum8(v); v += dppf<0x128>(v); return v; }
__device__ __forceinline__ void phase_rchunk_pre(Frame& F, const Args& A, int L) {
    KP_DECL;
    const bf16* zr = WSP(bf16, R_ZR); const bf16* dw = WSP(bf16, R_DAG_W); const bf16* da = WSP(bf16, R_DAG_A);
    const float* mu = INP(I_MU) + L * 1792; const float* k_k = INP(I_KK) + L * 512; const float* k_a = INP(I_KA) + L * 512; const float* r_k = INP(I_RK) + L * 512;
    float* cbon = WSP(float, WS_CBON); bf16* gV = WSP(bf16, R_CV);
    LAS unsigned char* lds = F.lds;
    const int t = F.tid >> 3, cg = F.tid & 7, c0 = cg * 8;
    v4u n_cr, n_ck, n_cv, n_pr, n_pk, n_pv, n_ww, n_aa;
#define RPRE_LOAD(it_) do { const int bh_ = (it_) >> 7, ck2_ = (it_) & 127; const int row_ = (bh_ >> 3) * SEQ + ck2_ * 64 + t, ch_ = (bh_ & 7) * 64 + c0; const bf16* zc_ = zr + (size_t)row_ * 1792 + ch_; \
        n_cr = *(const v4u*)zc_; n_ck = *(const v4u*)(zc_ + 512); n_cv = *(const v4u*)(zc_ + 1024); n_pr = (v4u){0u,0u,0u,0u}; n_pk = n_pr; n_pv = n_pr; \
        if (ck2_ * 64 + t != 0) { n_pr = *(const v4u*)(zc_ - 1792); n_pk = *(const v4u*)(zc_ - 1792 + 512); n_pv = *(const v4u*)(zc_ - 1792 + 1024); } \
        n_ww = *(const v4u*)(dw + (size_t)row_ * 512 + ch_); n_aa = *(const v4u*)(da + (size_t)row_ * 512 + ch_); } while (0)
#define RPRE_ITEM(s_) (((((s_) >> 3) >> 7) * 8 + ((s_) & 7)) * 128 + (((s_) >> 3) & 127))
    if ((int)blockIdx.x < 2048) RPRE_LOAD(RPRE_ITEM((int)blockIdx.x));
    int h_par = -1; LAS float* PAR = (LAS float*)(lds + RC_PAR);
    for (int slot = blockIdx.x; slot < 2048; slot += F.G) { const int item = RPRE_ITEM(slot);
        const int bh = item >> 7, ck = item & 127, b = bh >> 3, h = bh & 7; const int row = b * SEQ + ck * 64 + t, ch = h * 64 + c0;
        if (h != h_par) { h_par = h;
            if (F.tid < 384) { const int a_ = F.tid >> 6, c_ = F.tid & 63; PAR[F.tid] = (a_ < 3) ? mu[a_ * 512 + h * 64 + c_] : (a_ == 3 ? k_k[h * 64 + c_] : (a_ == 4 ? k_a[h * 64 + c_] : r_k[h * 64 + c_])); }
            __syncthreads(); }
        float r_[8], kp_[8], kk_[8], bb_[8], lw_[8];
        { float v_[8]; const v4u cr = n_cr, ck_ = n_ck, cv = n_cv, pr = n_pr, pk = n_pk, pv = n_pv, ww = n_ww, aa = n_aa;
          float ssq = 0.f, cb = 0.f;
#pragma unroll
          for (int i = 0; i < 8; ++i) { const int q = i >> 1; const bool hi = i & 1;
              const float crf = hi ? bfhi(cr[q]) : bflo(cr[q]), ckf = hi ? bfhi(ck_[q]) : bflo(ck_[q]), cvf = hi ? bfhi(cv[q]) : bflo(cv[q]);
              const float prf = hi ? bfhi(pr[q]) : bflo(pr[q]), pkf = hi ? bfhi(pk[q]) : bflo(pk[q]), pvf = hi ? bfhi(pv[q]) : bflo(pv[q]);
              const float w = hi ? bfhi(ww[q]) : bflo(ww[q]), a = hi ? bfhi(aa[q]) : bflo(aa[q]);
              const float r = crf + PAR[c0 + i] * (prf - crf), k = ckf + PAR[64 + c0 + i] * (pkf - ckf), v = cvf + PAR[128 + c0 + i] * (pvf - cvf);
              const float kk = k * PAR[192 + c0 + i]; ssq += kk * kk; const float kp = k * (1.0f + (a - 1.0f) * PAR[256 + c0 + i]);
              r_[i] = r; kp_[i] = kp; kk_[i] = kk; bb_[i] = a; v_[i] = v; lw_[i] = __logf(w); cb += r * kp * PAR[320 + c0 + i]; }
          ssq = sum8(ssq); cb = sum8(cb);
          const float inv = __builtin_amdgcn_rsqf(fmaxf(ssq, 1e-24f));
#pragma unroll
          for (int i = 0; i < 8; ++i) { kk_[i] *= inv; bb_[i] *= kk_[i]; }
          if (cg == 0) cbon[(size_t)row * 8 + h] = cb;
          if (slot + F.G < 2048) RPRE_LOAD(RPRE_ITEM(slot + F.G));
          v4u vo; vo.x = pk2(v_[0], v_[1]); vo.y = pk2(v_[2], v_[3]); vo.z = pk2(v_[4], v_[5]); vo.w = pk2(v_[6], v_[7]); *(v4u*)(gV + (size_t)row * 512 + ch) = vo;
          { LAS bf16* VT = (LAS bf16*)(lds + RC_VT);
#pragma unroll
            for (int i = 0; i < 8; ++i) VT[(c0 + i) * LDP + t] = (bf16)f2bf(v_[i]); } }
        { LAS float* LW = (LAS float*)(lds + RC_ABP);
#pragma unroll
          for (int i = 0; i < 8; ++i) LW[t * 64 + c0 + i] = lw_[i];
          __syncthreads();
          { const int cc = F.tid & 63, sg = F.tid >> 6; float loc[8]; float run = 0.f;
            LAS float* SG = (LAS float*)(lds + RC_PS);
#pragma unroll
            for (int e = 0; e < 8; ++e) { run += LW[(8 * sg + e) * 64 + cc]; loc[e] = run; }
            SG[sg * 64 + cc] = run;
            __syncthreads();
            float pre = 0.f;
#pragma unroll
            for (int q = 0; q < 8; ++q) { const float tv = SG[q * 64 + cc]; if (q < sg) pre += tv; }
#pragma unroll
            for (int e = 0; e < 8; ++e) LW[(8 * sg + e) * 64 + cc] = pre + loc[e]; }
          __syncthreads();
          LAS bf16* Bh = (LAS bf16*)(lds + RC_BH); LAS bf16* Kh = (LAS bf16*)(lds + RC_KH); LAS bf16* Pc = (LAS bf16*)(lds + RC_PC); LAS bf16* Rc = (LAS bf16*)(lds + RC_RC);
          LAS bf16* PT = (LAS bf16*)(lds + RC_PT); LAS bf16* Rt = (LAS bf16*)(lds + RC_RT); LAS bf16* BhT = (LAS bf16*)(lds + RC_XR); LAS float* GC = (LAS float*)(lds + RC_GC);
          float bh_[8], kh_[8], pc_[8], rc_[8], rt_[8];
#pragma unroll
          for (int i = 0; i < 8; ++i) { const float Lt = LW[t * 64 + c0 + i], Lp = (t == 0) ? 0.f : LW[(t - 1) * 64 + c0 + i], LC = LW[63 * 64 + c0 + i];
              const float e1 = __expf(LC - Lt); bh_[i] = bb_[i] * e1; kh_[i] = kp_[i] * e1; pc_[i] = kk_[i] * __expf(Lp - LC); rc_[i] = r_[i] * __expf(Lt - LC); rt_[i] = r_[i] * __expf(Lt);
              PT[(c0 + i) * LDP + t] = (bf16)f2bf(kk_[i] * __expf(Lp)); BhT[(c0 + i) * LDP + t] = (bf16)f2bf(bh_[i]); if (t == 63) GC[c0 + i] = __expf(LC); }
          v4u o; o.x = pk2(bh_[0], bh_[1]); o.y = pk2(bh_[2], bh_[3]); o.z = pk2(bh_[4], bh_[5]); o.w = pk2(bh_[6], bh_[7]); *(LAS v4u*)(Bh + t * LDP + c0) = o;
          o.x = pk2(kh_[0], kh_[1]); o.y = pk2(kh_[2], kh_[3]); o.z = pk2(kh_[4], kh_[5]); o.w = pk2(kh_[6], kh_[7]); *(LAS v4u*)(Kh + t * LDP + c0) = o;
          o.x = pk2(pc_[0], pc_[1]); o.y = pk2(pc_[2], pc_[3]); o.z = pk2(pc_[4], pc_[5]); o.w = pk2(pc_[6], pc_[7]); *(LAS v4u*)(Pc + t * LDP + c0) = o;
          o.x = pk2(rc_[0], rc_[1]); o.y = pk2(rc_[2], rc_[3]); o.z = pk2(rc_[4], rc_[5]); o.w = pk2(rc_[6], rc_[7]); *(LAS v4u*)(Rc + t * LDP + c0) = o;
          o.x = pk2(rt_[0], rt_[1]); o.y = pk2(rt_[2], rt_[3]); o.z = pk2(rt_[4], rt_[5]); o.w = pk2(rt_[6], rt_[7]); *(LAS v4u*)(Rt + t * LDP + c0) = o;
          __syncthreads(); }
        f32x4 akr[4];
        { const int r16 = F.lane & 15, g4 = F.lane >> 4; const int xsel = F.wave >> 2, m0 = (F.wave & 3) * 16;
          const LAS bf16* X = (const LAS bf16*)(lds + (xsel ? RC_KH : RC_BH)) + (m0 + r16) * LDP + 8 * g4;
          const bf16x8 xa0 = *(const LAS bf16x8*)X, xa1 = *(const LAS bf16x8*)(X + 32);
          f32x4 acc[2][4];
#pragma unroll
          for (int ys = 0; ys < 2; ++ys)
#pragma unroll
              for (int nt = 0; nt < 4; ++nt) { const LAS bf16* Y = (const LAS bf16*)(lds + (ys ? RC_RC : RC_PC)) + (16 * nt + r16) * LDP + 8 * g4;
                  const bf16x8 b0 = *(const LAS bf16x8*)Y, b1 = *(const LAS bf16x8*)(Y + 32);
                  acc[ys][nt] = __builtin_amdgcn_mfma_f32_16x16x32_bf16(xa0, b0, (f32x4){0.f, 0.f, 0.f, 0.f}, 0, 0, 0); acc[ys][nt] = __builtin_amdgcn_mfma_f32_16x16x32_bf16(xa1, b1, acc[ys][nt], 0, 0, 0); }
#pragma unroll
          for (int nt = 0; nt < 4; ++nt) { const int tt = 16 * nt + r16; const int i0 = m0 + 4 * g4; float v0[4], v1[4];
#pragma unroll
              for (int rg = 0; rg < 4; ++rg) { v0[rg] = (i0 + rg < tt) ? acc[0][nt][rg] : 0.f; v1[rg] = (i0 + rg <= tt) ? acc[1][nt][rg] : 0.f; }
              if (xsel == 0) {
#pragma unroll
                  for (int rg = 0; rg < 4; ++rg) ((LAS float*)(lds + RC_ABP))[(i0 + rg) * 64 + tt] = v0[rg];
                  u32x2 o; o.x = pk2(v1[0], v1[1]); o.y = pk2(v1[2], v1[3]); *(LAS u32x2*)((LAS bf16*)(lds + RC_XR) + (64 + tt) * LDP + i0) = o; }
              else {
#pragma unroll
                  for (int rg = 0; rg < 4; ++rg) ((LAS bf16*)(lds + RC_AKP))[(i0 + rg) * LDP + tt] = (bf16)f2bf(v0[rg]);
                  akr[nt] = (f32x4){v1[0], v1[1], v1[2], v1[3]}; } }
          __syncthreads(); }
        { const LAS float* AB = (const LAS float*)(lds + RC_ABP); LAS float* TT = (LAS float*)(lds + RC_TT); LAS float* PS = (LAS float*)(lds + RC_PS);
          if (F.tid < 64) { const int a = F.tid >> 4, e = F.tid & 15; const LAS float* Aa = AB + (16 * a) * 64 + 16 * a; float x[16];
#pragma unroll
              for (int r = 15; r >= 0; --r) { float acc = (r == e) ? 1.0f : 0.f;
#pragma unroll
                  for (int j = r + 1; j < 16; ++j) acc = __builtin_fmaf(-Aa[r * 64 + j], x[j], acc);
                  x[r] = acc; }
#pragma unroll
              for (int r = 0; r < 16; ++r) TT[(16 * a + r) * 64 + 16 * a + e] = x[r]; }
          __syncthreads();
#pragma unroll 1
          for (int d = 1; d < 4; ++d) { const int nel = (4 - d) * 256;
              for (int el = F.tid; el < nel; el += NWAVES * 64) { const int a = el >> 8, r = (el >> 4) & 15, c = el & 15, b = a + d; float acc = 0.f;
                  for (int cc = a + 1; cc <= b; ++cc) { const LAS float* ar = AB + (16 * a + r) * 64 + 16 * cc; const LAS float* tc = TT + (16 * cc) * 64 + 16 * b + c;
#pragma unroll
                      for (int j = 0; j < 16; ++j) acc = __builtin_fmaf(ar[j], tc[j * 64], acc); }
                  PS[el] = acc; }
              __syncthreads();
              for (int el = F.tid; el < nel; el += NWAVES * 64) { const int a = el >> 8, r = (el >> 4) & 15, c = el & 15, b = a + d; float acc = 0.f; const LAS float* dr = TT + (16 * a + r) * 64 + 16 * a; const LAS float* sc = PS + (a << 8) + c;
#pragma unroll
                  for (int j = 0; j < 16; ++j) acc = __builtin_fmaf(-dr[j], sc[j * 16], acc);
                  TT[(16 * a + r) * 64 + 16 * b + c] = acc; }
              __syncthreads(); }
          { LAS bf16* TI = (LAS bf16*)(lds + RC_TI); float o[8];
#pragma unroll
            for (int i = 0; i < 8; ++i) o[i] = ((c0 + i) >> 4) >= (t >> 4) ? TT[t * 64 + c0 + i] : 0.f;
            v4u w; w.x = pk2(o[0], o[1]); w.y = pk2(o[2], o[3]); w.z = pk2(o[4], o[5]); w.w = pk2(o[6], o[7]); *(LAS v4u*)(TI + t * LDP + c0) = w; }
          __syncthreads();
          { const int r16 = F.lane & 15, g4 = F.lane >> 4; const int m0 = (F.wave & 3) * 16, cb0 = (F.wave >> 2) * 64;
            const LAS bf16* X = (const LAS bf16*)(lds + RC_TI) + (m0 + r16) * LDP + 8 * g4; const bf16x8 xa0 = *(const LAS bf16x8*)X, xa1 = *(const LAS bf16x8*)(X + 32);
            f32x4 zc[4];
#pragma unroll
            for (int nt = 0; nt < 4; ++nt) { const LAS bf16* Y = (const LAS bf16*)(lds + RC_XR) + (cb0 + 16 * nt + r16) * LDP + 8 * g4; const bf16x8 b0 = *(const LAS bf16x8*)Y, b1 = *(const LAS bf16x8*)(Y + 32);
                zc[nt] = __builtin_amdgcn_mfma_f32_16x16x32_bf16(xa0, b0, (f32x4){0.f, 0.f, 0.f, 0.f}, 0, 0, 0); zc[nt] = __builtin_amdgcn_mfma_f32_16x16x32_bf16(xa1, b1, zc[nt], 0, 0, 0); }
#pragma unroll
            for (int nt = 0; nt < 4; ++nt) { u32x2 o; o.x = pk2(zc[nt][0], zc[nt][1]); o.y = pk2(zc[nt][2], zc[nt][3]); *(LAS u32x2*)((LAS bf16*)(lds + RC_ZT) + (cb0 + 16 * nt + r16) * LDP + m0 + 4 * g4) = o; } } }
        __syncthreads();
        { const int r16 = F.lane & 15, g4 = F.lane >> 4; const int xsel = F.wave >> 2, m0 = (F.wave & 3) * 16, mm = m0 + 4 * g4;
          bf16* gG = WSP(bf16, R_CG) + (size_t)item * 4096; bf16* gQ = WSP(bf16, R_CQT) + (size_t)item * 4096; bf16* gD = WSP(bf16, R_CDT) + (size_t)item * 4096;
          const LAS float* GC = (const LAS float*)(lds + RC_GC);
          const LAS bf16* X = (const LAS bf16*)(lds + (xsel ? RC_AKP : RC_PT)) + (m0 + r16) * LDP + 8 * g4;
          const bf16x8 xa0 = *(const LAS bf16x8*)X, xa1 = *(const LAS bf16x8*)(X + 32);
          f32x4 acc[2][4];
#pragma unroll
          for (int ys = 0; ys < 2; ++ys)
#pragma unroll
              for (int nt = 0; nt < 4; ++nt) { const LAS bf16* Y = (const LAS bf16*)(lds + RC_ZT) + (64 * ys + 16 * nt + r16) * LDP + 8 * g4;
                  const bf16x8 b0 = *(const LAS bf16x8*)Y, b1 = *(const LAS bf16x8*)(Y + 32);
                  acc[ys][nt] = __builtin_amdgcn_mfma_f32_16x16x32_bf16(xa0, b0, (f32x4){0.f, 0.f, 0.f, 0.f}, 0, 0, 0); acc[ys][nt] = __builtin_amdgcn_mfma_f32_16x16x32_bf16(xa1, b1, acc[ys][nt], 0, 0, 0); }
#pragma unroll
          for (int nt = 0; nt < 4; ++nt) { const int nn = 16 * nt + r16;
              if (xsel == 0) {
                  { const int i2 = nn >> 5, rr = nn & 31, kt = mm >> 5, sx_ = (mm >> 4) & 1, qq = mm & 15, hh = (qq >> 2) & 1, jj0 = (qq >> 3) << 2;
                    float gv[4];
#pragma unroll
                    for (int rg = 0; rg < 4; ++rg) gv[rg] = ((mm + rg) == nn ? GC[nn] : 0.f) - acc[0][nt][rg];
                    u32x2 o; o.x = pk2(gv[0], gv[1]); o.y = pk2(gv[2], gv[3]); *(u32x2*)(gG + ((((i2 * 2 + kt) * 2 + sx_) * 64 + rr + 32 * hh) * 8 + jj0)) = o; }
                  { const LAS bf16* Rt = (const LAS bf16*)(lds + RC_RT); const u32x2 rv = *(const LAS u32x2*)(Rt + nn * LDP + mm);
                    u32x2 o; o.x = pk2(bflo(rv.x) - acc[1][nt][0], bfhi(rv.x) - acc[1][nt][1]); o.y = pk2(bflo(rv.y) - acc[1][nt][2], bfhi(rv.y) - acc[1][nt][3]); *(u32x2*)(gQ + nn * 64 + mm) = o; }
              } else {
                  { const LAS bf16* Kh = (const LAS bf16*)(lds + RC_KH); float kv[4];
#pragma unroll
                    for (int rg = 0; rg < 4; ++rg) kv[rg] = bf1(Kh[(mm + rg) * LDP + nn]) - acc[0][nt][rg];
                    u32x2 o; o.x = pk2(kv[0], kv[1]); o.y = pk2(kv[2], kv[3]); *(LAS u32x2*)((LAS bf16*)(lds + RC_KBT) + nn * LDP + mm) = o; }
                  { float dv[4];
#pragma unroll
                    for (int rg = 0; rg < 4; ++rg) dv[rg] = akr[nt][rg] - acc[1][nt][rg];
                    u32x2 o; o.x = pk2(dv[0], dv[1]); o.y = pk2(dv[2], dv[3]); *(u32x2*)(gD + nn * 64 + mm) = o; } } }
          __syncthreads();
          bf16* gH = WSP(bf16, R_CH) + (size_t)item * 4096;
#pragma unroll
          for (int q = 0; q < 2; ++q) { const int id = F.wave * 2 + q, m0 = (id >> 2) * 16, n0 = (id & 3) * 16;
              const f32x4 acc = mm16_k64((const LAS bf16*)(lds + RC_VT), (const LAS bf16*)(lds + RC_KBT), m0, n0, F.lane, (f32x4){0.f, 0.f, 0.f, 0.f});
              const int kq = n0 + r16, vv = m0 + 4 * g4;
              const int i2 = kq >> 5, kl = kq & 31, rg16 = (kl & 3) | ((kl >> 3) << 2), hh = (kl >> 2) & 1, j2 = vv >> 5;
              bf16* hq_ = gH + j2 * 2048 + ((vv & 31) + 32 * hh) * 32 + i2 * 16 + rg16;
#pragma unroll
              for (int rg = 0; rg < 4; ++rg) hq_[32 * rg] = (bf16)f2bf(acc[rg]); }
          __syncthreads(); }
    }
}
__device__ __forceinline__ void rchunk_seq(Frame& F, int wid) {
    const int bh = wid >> 1, j = wid & 1; const int r32 = F.lane & 31, hh = F.lane >> 5;
    const bf16* gG = WSP(bf16, R_CG) + (size_t)bh * 128 * 4096; const bf16* gH = WSP(bf16, R_CH) + (size_t)bh * 128 * 4096 + j * 2048 + F.lane * 32; bf16* gS = WSP(bf16, R_CS) + (size_t)bh * 128 * 4096;
    f32x16 x0, x1;
#pragma unroll
    for (int i = 0; i < 16; ++i) { x0[i] = 0.f; x1[i] = 0.f; }
    bf16x8 gA[8], gB[8]; v4u hA[4], hB[4];
#define RS_LOAD(G_, H_, cc) do { const int c_ = ((cc) < 128) ? (cc) : 127; _Pragma("unroll") for (int q = 0; q < 8; ++q) G_[q] = *(const bf16x8*)(gG + (size_t)c_ * 4096 + (q * 64 + F.lane) * 8); \
        _Pragma("unroll") for (int q = 0; q < 4; ++q) H_[q] = *(const v4u*)(gH + (size_t)c_ * 4096 + 8 * q); } while (0)
#define RS_STEP(G_, H_, cc) do { \
        f32x16 h0, h1; \
        _Pragma("unroll") for (int q = 0; q < 4; ++q) { h0[2 * q] = bflo(H_[0][q]); h0[2 * q + 1] = bfhi(H_[0][q]); h0[8 + 2 * q] = bflo(H_[1][q]); h0[8 + 2 * q + 1] = bfhi(H_[1][q]); \
                                                         h1[2 * q] = bflo(H_[2][q]); h1[2 * q + 1] = bfhi(H_[2][q]); h1[8 + 2 * q] = bflo(H_[3][q]); h1[8 + 2 * q + 1] = bfhi(H_[3][q]); } \
        unsigned xb0[8], xb1[8]; \
        _Pragma("unroll") for (int q = 0; q < 8; ++q) { xb0[q] = cvtpk(x0[2 * q], x0[2 * q + 1]); xb1[q] = cvtpk(x1[2 * q], x1[2 * q + 1]); } \
        { bf16* sp = gS + (size_t)(cc) * 4096 + (32 * j + r32) * 64 + 8 * hh;     \
          _Pragma("unroll") for (int mq = 0; mq < 2; ++mq) { \
              { auto s0 = __builtin_amdgcn_permlane32_swap(xb0[4 * mq], xb0[4 * mq + 2], false, false); auto s1 = __builtin_amdgcn_permlane32_swap(xb0[4 * mq + 1], xb0[4 * mq + 3], false, false); \
                v4u o; o.x = s0[0]; o.y = s1[0]; o.z = s0[1]; o.w = s1[1]; *(v4u*)(sp + 16 * mq) = o; } \
              { auto s0 = __builtin_amdgcn_permlane32_swap(xb1[4 * mq], xb1[4 * mq + 2], false, false); auto s1 = __builtin_amdgcn_permlane32_swap(xb1[4 * mq + 1], xb1[4 * mq + 3], false, false); \
                v4u o; o.x = s0[0]; o.y = s1[0]; o.z = s0[1]; o.w = s1[1]; *(v4u*)(sp + 32 + 16 * mq) = o; } } } \
        const bf16x8 b00 = __builtin_bit_cast(bf16x8, (v4u){xb0[0], xb0[1], xb0[2], xb0[3]}), b01 = __builtin_bit_cast(bf16x8, (v4u){xb0[4], xb0[5], xb0[6], xb0[7]}); \
        const bf16x8 b10 = __builtin_bit_cast(bf16x8, (v4u){xb1[0], xb1[1], xb1[2], xb1[3]}), b11 = __builtin_bit_cast(bf16x8, (v4u){xb1[4], xb1[5], xb1[6], xb1[7]}); \
        h0 = __builtin_amdgcn_mfma_f32_32x32x16_bf16(G_[0], b00, h0, 0, 0, 0); h1 = __builtin_amdgcn_mfma_f32_32x32x16_bf16(G_[4], b00, h1, 0, 0, 0); \
        h0 = __builtin_amdgcn_mfma_f32_32x32x16_bf16(G_[1], b01, h0, 0, 0, 0); h1 = __builtin_amdgcn_mfma_f32_32x32x16_bf16(G_[5], b01, h1, 0, 0, 0); \
        h0 = __builtin_amdgcn_mfma_f32_32x32x16_bf16(G_[2], b10, h0, 0, 0, 0); h1 = __builtin_amdgcn_mfma_f32_32x32x16_bf16(G_[6], b10, h1, 0, 0, 0); \
        h0 = __builtin_amdgcn_mfma_f32_32x32x16_bf16(G_[3], b11, h0, 0, 0, 0); h1 = __builtin_amdgcn_mfma_f32_32x32x16_bf16(G_[7], b11, h1, 0, 0, 0); \
        x0 = h0; x1 = h1; RS_LOAD(G_, H_, (cc) + 2); } while (0)
    RS_LOAD(gA, hA, 0); RS_LOAD(gB, hB, 1);
    for (int c = 0; c < 128; c += 2) { RS_STEP(gA, hA, c); RS_STEP(gB, hB, c + 1); }
#undef RS_LOAD
#undef RS_STEP
}
constexpr int RO_SX = 0, RO_QT = RC_MAT, RO_DT = 2 * RC_MAT, RO_VT = 3 * RC_MAT, RO_Y = 4 * RC_MAT, RO_HALF = RO_Y + 64 * 68 * 4;
constexpr int RO_PAR = 2 * RO_HALF;
static_assert(RO_PAR + 4096 <= LDSCTL_OFF, "rwkv output pass LDS (parameters)");
static_assert(2 * RO_HALF <= LDSCTL_OFF, "rwkv output pass LDS");
__device__ __forceinline__ void phase_rchunk_out(Frame& F, const Args& A, int L) {
    KP_DECL;
    const float* lnw = INP(I_LNW) + L * 512; const float* lnb = INP(I_LNB) + L * 512;
    const bf16* gV = WSP(bf16, R_CV); const bf16* dg = WSP(bf16, R_DAG_G); const float* cbon = WSP(float, WS_CBON); bf16* y1 = WSP(bf16, R_Y) + (size_t)M * 512;
    const int half = F.tid >> 8, ht = F.tid & 255, t = ht >> 2, c0 = (ht & 3) * 16, hw = F.wave & 3;
    LAS unsigned char* lds = F.lds + half * RO_HALF;
    { LAS float* PAR = (LAS float*)(F.lds + RO_PAR); const int pt = F.wave * 64 + (int)__builtin_amdgcn_mbcnt_hi(~0u, __builtin_amdgcn_mbcnt_lo(~0u, 0u));
      PAR[pt] = lnw[pt]; PAR[512 + pt] = lnb[pt]; }
    const LAS float* PW = (const LAS float*)(F.lds + RO_PAR); const LAS float* PB = PW + 512;
    v4u n_sx[2], n_qt[2], n_dt[2], n_vv[2], n_gg[2]; float n_cb;
#define ROUT_LOAD(it_) do { const int bh_ = (it_) >> 7, ck_ = (it_) & 127; const int row_ = (bh_ >> 3) * SEQ + ck_ * 64 + t; \
        _Pragma("unroll") for (int e = 0; e < 2; ++e) { n_sx[e] = __builtin_nontemporal_load((const v4u*)(WSP(bf16, R_CS) + (size_t)(it_) * 4096 + t * 64 + c0 + 8 * e)); n_qt[e] = __builtin_nontemporal_load((const v4u*)(WSP(bf16, R_CQT) + (size_t)(it_) * 4096 + t * 64 + c0 + 8 * e)); \
            n_dt[e] = __builtin_nontemporal_load((const v4u*)(WSP(bf16, R_CDT) + (size_t)(it_) * 4096 + t * 64 + c0 + 8 * e)); n_vv[e] = __builtin_nontemporal_load((const v4u*)(gV + (size_t)row_ * 512 + (bh_ & 7) * 64 + c0 + 8 * e)); n_gg[e] = __builtin_nontemporal_load((const v4u*)(dg + (size_t)row_ * 512 + (bh_ & 7) * 64 + c0 + 8 * e)); } \
        n_cb = cbon[(size_t)row_ * 8 + (bh_ & 7)]; } while (0)
    const int it0 = (int)blockIdx.x + half * F.G;
    if (it0 < 2048) ROUT_LOAD(it0);
    for (int base = blockIdx.x; base < 2048; base += 2 * F.G) {
        const int item = base + half * F.G; const bool valid = item < 2048;
        const int bh = item >> 7, ck = item & 127, b = bh >> 3, h = bh & 7; const int row = b * SEQ + ck * 64 + t, ch = h * 64 + c0;
        v4u vv[2], gv[2]; float cb = 0.f;
        if (valid) { cb = n_cb;
#pragma unroll
            for (int e = 0; e < 2; ++e) { vv[e] = n_vv[e]; gv[e] = n_gg[e];
                *(LAS v4u*)((LAS bf16*)(lds + RO_SX) + t * LDP + c0 + 8 * e) = n_sx[e]; *(LAS v4u*)((LAS bf16*)(lds + RO_QT) + t * LDP + c0 + 8 * e) = n_qt[e]; *(LAS v4u*)((LAS bf16*)(lds + RO_DT) + t * LDP + c0 + 8 * e) = n_dt[e];
                LAS bf16* VT = (LAS bf16*)(lds + RO_VT);
#pragma unroll
                for (int i = 0; i < 4; ++i) { VT[(c0 + 8 * e + 2 * i) * LDP + t] = (bf16)(vv[e][i] & 0xffffu); VT[(c0 + 8 * e + 2 * i + 1) * LDP + t] = (bf16)(vv[e][i] >> 16); } }
            if (item + 2 * F.G < 2048) ROUT_LOAD(item + 2 * F.G); }
        __syncthreads();
        if (valid) { const int r16 = F.lane & 15, g4 = F.lane >> 4, m0 = 16 * hw; LAS float* YL = (LAS float*)(lds + RO_Y);
            const LAS bf16* X1 = (const LAS bf16*)(lds + RO_SX) + (m0 + r16) * LDP + 8 * g4; const LAS bf16* X2 = (const LAS bf16*)(lds + RO_VT) + (m0 + r16) * LDP + 8 * g4;
            const bf16x8 a0 = *(const LAS bf16x8*)X1, a1 = *(const LAS bf16x8*)(X1 + 32), a2 = *(const LAS bf16x8*)X2, a3 = *(const LAS bf16x8*)(X2 + 32);
            f32x4 acc[4];
#pragma unroll
            for (int q = 0; q < 4; ++q) { const LAS bf16* Y1 = (const LAS bf16*)(lds + RO_QT) + (16 * q + r16) * LDP + 8 * g4; const LAS bf16* Y2 = (const LAS bf16*)(lds + RO_DT) + (16 * q + r16) * LDP + 8 * g4;
                acc[q] = __builtin_amdgcn_mfma_f32_16x16x32_bf16(a0, *(const LAS bf16x8*)Y1, (f32x4){0.f, 0.f, 0.f, 0.f}, 0, 0, 0); acc[q] = __builtin_amdgcn_mfma_f32_16x16x32_bf16(a1, *(const LAS bf16x8*)(Y1 + 32), acc[q], 0, 0, 0);
                acc[q] = __builtin_amdgcn_mfma_f32_16x16x32_bf16(a2, *(const LAS bf16x8*)Y2, acc[q], 0, 0, 0); acc[q] = __builtin_amdgcn_mfma_f32_16x16x32_bf16(a3, *(const LAS bf16x8*)(Y2 + 32), acc[q], 0, 0, 0); }
#pragma unroll
            for (int q = 0; q < 4; ++q) *(LAS f32x4*)(YL + (16 * q + r16) * 68 + m0 + 4 * g4) = acc[q]; }
        __syncthreads();
        if (valid) { const LAS float* YL = (const LAS float*)(lds + RO_Y) + t * 68 + c0; float y[16], s_ = 0.f;
#pragma unroll
            for (int i = 0; i < 16; ++i) { y[i] = YL[i]; s_ += y[i]; }
            s_ += dppf<0xB1>(s_); s_ += dppf<0x4E>(s_); const float mean = s_ * (1.0f / 64.0f); float q2 = 0.f;
#pragma unroll
            for (int i = 0; i < 16; ++i) { y[i] -= mean; q2 += y[i] * y[i]; }
            q2 += dppf<0xB1>(q2); q2 += dppf<0x4E>(q2); const float rstd = __builtin_amdgcn_rsqf(q2 * (1.0f / 64.0f) + 64e-5f);
#pragma unroll
            for (int e = 0; e < 2; ++e) { const v4u gg = gv[e]; float o[8];
#pragma unroll
                for (int i = 0; i < 8; ++i) { const int q = i >> 1; const bool hi = i & 1; const float vf = hi ? bfhi(vv[e][q]) : bflo(vv[e][q]), gf = hi ? bfhi(gg[q]) : bflo(gg[q]);
                    o[i] = (y[8 * e + i] * rstd * PW[ch + 8 * e + i] + PB[ch + 8 * e + i] + cb * vf) * gf; }
                v4u w; w.x = pk2(o[0], o[1]); w.y = pk2(o[2], o[3]); w.z = pk2(o[4], o[5]); w.w = pk2(o[6], o[7]); *(v4u*)(y1 + (size_t)row * 512 + ch + 8 * e) = w; } }
        __syncthreads();
    }
#undef ROUT_LOAD
}
template <int KS, int LDX, int LDY> __device__ __forceinline__ f32x4 mm16(const LAS bf16* X, const LAS bf16* YT, int m0, int n0, int lane, f32x4 acc) {
    const int r = lane & 15, g = lane >> 4;
#pragma unroll
    for (int ks = 0; ks < KS; ++ks) { const bf16x8 a = *(const LAS bf16x8*)(X + (m0 + r) * LDX + ks * 32 + 8 * g); const bf16x8 b = *(const LAS bf16x8*)(YT + (n0 + r) * LDY + ks * 32 + 8 * g);
        acc = __builtin_amdgcn_mfma_f32_16x16x32_bf16(a, b, acc, 0, 0, 0); }
    return acc;
}
__device__ __forceinline__ float hg_lf(float key) { return fmaxf(__logf(fmaxf(1.0f - key, 1e-30f)), -30.0f); }
constexpr int H1_LD = 136;
constexpr int H1_KT = 0, H1_VT = 128 * H1_LD * 2, H1_SEG = 2 * 128 * H1_LD * 2, H1_END = H1_SEG + 4 * 128 * 4;
__device__ __forceinline__ void phase_h1(Frame& F, int first, int stride) {
    const bf16* zh = (const bf16*)F.x; bf16* Hg = WSP(bf16, R_HST); float* Dg = WSP(float, WS_HD);
    LAS unsigned char* lds = F.lds; LAS bf16* KT = (LAS bf16*)(lds + H1_KT); LAS bf16* VT = (LAS bf16*)(lds + H1_VT); LAS float* SEG = (LAS float*)(lds + H1_SEG);
    const int k = F.tid & 127, seg = F.tid >> 7; const int r16 = F.lane & 15, g4 = F.lane >> 4;
    for (int item = first; item < 256; item += stride) { const int bh = item >> 5, m = item & 31, b = bh >> 2, h = bh & 3; const size_t row0 = (size_t)b * SEQ + m * 256;
        f32x4 acc[8];
#pragma unroll
        for (int nt = 0; nt < 8; ++nt) acc[nt] = (f32x4){0.f, 0.f, 0.f, 0.f};
        float carry = 0.f;
#pragma unroll 1
        for (int half = 1; half >= 0; --half) { const size_t rb = row0 + 128 * half;
            float key[32], lf[32]; float tot = 0.f;
#pragma unroll
            for (int j = 0; j < 32; ++j) { key[j] = bf1(zh[(rb + 32 * seg + j) * 2048 + 512 + h * 128 + k]); lf[j] = hg_lf(key[j]); tot += lf[j]; }
            SEG[seg * 128 + k] = tot;
            { const int s = F.tid >> 2, part = F.tid & 3; const bf16* vp = zh + (rb + s) * 2048 + 1024 + h * 128 + part * 32;
#pragma unroll
              for (int c = 0; c < 4; ++c) { const v4u vv = *(const v4u*)(vp + 8 * c);
#pragma unroll
                  for (int i = 0; i < 4; ++i) { VT[(part * 32 + 8 * c + 2 * i) * H1_LD + s] = (bf16)(vv[i] & 0xffffu); VT[(part * 32 + 8 * c + 2 * i + 1) * H1_LD + s] = (bf16)(vv[i] >> 16); } } }
            __syncthreads();
            float off = carry, all = 0.f;
#pragma unroll
            for (int sg = 0; sg < 4; ++sg) { const float tt = SEG[sg * 128 + k]; all += tt; if (sg > seg) off += tt; }
            carry += all;
            float e = off;
#pragma unroll
            for (int j = 31; j >= 0; --j) { KT[k * H1_LD + 32 * seg + j] = (bf16)f2bf(key[j] * __expf(e)); e += lf[j]; }
            __syncthreads();
#pragma unroll
            for (int nt = 0; nt < 8; ++nt) acc[nt] = mm16<4, H1_LD, H1_LD>(KT, VT, 16 * F.wave, 16 * nt, F.lane, acc[nt]);
            __syncthreads(); }
        if (F.tid < 128) Dg[(size_t)item * 128 + k] = __expf(carry);
        bf16* hp = Hg + (size_t)item * 16384;
#pragma unroll
        for (int nt = 0; nt < 8; ++nt) { u32x2 o; o.x = pk2(acc[nt][0], acc[nt][1]); o.y = pk2(acc[nt][2], acc[nt][3]); *(u32x2*)(hp + (16 * nt + r16) * 128 + 16 * F.wave + 4 * g4) = o; }
    }
}
__device__ __forceinline__ void phase_h2(Frame& F) {
    bf16* Hg = WSP(bf16, R_HST); const float* Dg = WSP(float, WS_HD);
    const int gt = blockIdx.x * (NWAVES * 64) + F.tid, NGT = F.G * NWAVES * 64;
    for (int idx = gt; idx < 8 * 16384; idx += NGT) { const int bh = idx >> 14, e = idx & 16383; float s = 0.f;
#pragma unroll 4
        for (int m = 0; m < 32; ++m) { const size_t o = ((size_t)(bh * 32 + m) << 14) + e; const float hv = bf1(Hg[o]); Hg[o] = (bf16)f2bf(s); s = __builtin_fmaf(Dg[(bh * 32 + m) * 128 + (e & 127)], s, hv); } }
}
constexpr int H3_LDK = 136, H3_LDS = 40;
constexpr int H3_QC = 0, H3_KH = H3_QC + 32 * H3_LDK * 2, H3_KHT = H3_KH + 32 * H3_LDK * 2, H3_VT = H3_KHT + 128 * H3_LDS * 2, H3_ST = H3_VT + 128 * H3_LDS * 2, H3_AL = H3_ST + 128 * H3_LDK * 2,
              H3_OL = H3_AL + 32 * H3_LDS * 2, H3_SEG = H3_OL + 32 * 132 * 4, H3_DD = H3_SEG + 4 * 128 * 4, H3_END = H3_DD + 128 * 4;
static_assert(H3_END <= LDSCTL_OFF && H1_END <= LDSCTL_OFF, "hgrn LDS");
__device__ __forceinline__ void phase_h3(Frame& F, const Args& A, int L) {
    KP_DECL;
    const bf16* zh = (const bf16*)F.x; const bf16* Hg = WSP(bf16, R_HST); bf16* y2 = WSP(bf16, R_Y) + (size_t)2 * M * 512; const float* ng = INP(I_HNORM) + L * 128;
    LAS unsigned char* lds = F.lds; LAS bf16* QC = (LAS bf16*)(lds + H3_QC); LAS bf16* KH = (LAS bf16*)(lds + H3_KH); LAS bf16* KHT = (LAS bf16*)(lds + H3_KHT); LAS bf16* VT = (LAS bf16*)(lds + H3_VT);
    LAS bf16* ST = (LAS bf16*)(lds + H3_ST); LAS bf16* AL = (LAS bf16*)(lds + H3_AL); LAS float* OL = (LAS float*)(lds + H3_OL); LAS float* SEG = (LAS float*)(lds + H3_SEG); LAS float* DD = (LAS float*)(lds + H3_DD);
    const int k = F.tid & 127, seg = F.tid >> 7; const int r16 = F.lane & 15, g4 = F.lane >> 4;
    float ngv[8];
#pragma unroll
    for (int i = 0; i < 8; ++i) ngv[i] = ng[(F.tid & 15) * 8 + i];
    for (int item = blockIdx.x; item < 256; item += F.G) { const int bh = item >> 5, m = item & 31, b = bh >> 2, h = bh & 3; const size_t row0 = (size_t)b * SEQ + m * 256;
        f32x4 acc[8];
        { const bf16* hp = Hg + (size_t)item * 16384;
#pragma unroll
          for (int nt = 0; nt < 8; ++nt) { const u32x2 w = *(const u32x2*)(hp + (16 * nt + r16) * 128 + 16 * F.wave + 4 * g4); acc[nt] = (f32x4){bflo(w.x), bfhi(w.x), bflo(w.y), bfhi(w.y)}; } }
        bf16 nq[8], nk[8]; v4u nvv, ngg;
#define H3_LOAD(cc) do { const size_t rb_ = row0 + 32 * (cc); _Pragma("unroll") for (int j = 0; j < 8; ++j) { const bf16* zp = zh + (rb_ + 8 * seg + j) * 2048 + h * 128 + k; nq[j] = __builtin_nontemporal_load(zp); nk[j] = __builtin_nontemporal_load(zp + 512); } \
            nvv = __builtin_nontemporal_load((const v4u*)(zh + (rb_ + (F.tid >> 4)) * 2048 + 1024 + h * 128 + (F.tid & 15) * 8)); ngg = __builtin_nontemporal_load((const v4u*)(zh + (rb_ + (F.tid >> 4)) * 2048 + 1536 + h * 128 + (F.tid & 15) * 8)); } while (0)
        H3_LOAD(0);
#pragma unroll 1
        for (int c = 0; c < 8; ++c) { const size_t rb = row0 + 32 * c;
            float key[8], qv[8], bcs[8]; float run = 0.f;
#pragma unroll
            for (int j = 0; j < 8; ++j) { qv[j] = bf1(nq[j]); key[j] = bf1(nk[j]); run += hg_lf(key[j]); bcs[j] = run; }
            const v4u vv = nvv, gg = ngg;
            if (c < 7) H3_LOAD(c + 1);
            SEG[seg * 128 + k] = run;
            { const int s = F.tid >> 4, part = F.tid & 15;
#pragma unroll
              for (int i = 0; i < 4; ++i) { VT[(part * 8 + 2 * i) * H3_LDS + s] = (bf16)(vv[i] & 0xffffu); VT[(part * 8 + 2 * i + 1) * H3_LDS + s] = (bf16)(vv[i] >> 16); } }
            __syncthreads();
            float pre = 0.f, all = 0.f;
#pragma unroll
            for (int sg = 0; sg < 4; ++sg) { const float tt = SEG[sg * 128 + k]; all += tt; if (sg < seg) pre += tt; }
#pragma unroll
            for (int j = 0; j < 8; ++j) { const float bt = pre + bcs[j]; const int t = 8 * seg + j;
                QC[t * H3_LDK + k] = (bf16)f2bf(qv[j] * __expf(bt - all)); const bf16 kh = (bf16)f2bf(key[j] * __expf(all - bt)); KH[t * H3_LDK + k] = kh; KHT[k * H3_LDS + t] = kh; }
            if (seg == 0) DD[k] = __expf(all);
            __syncthreads();
            { const f32x4 dv = *(const LAS f32x4*)(DD + 16 * F.wave + 4 * g4);
#pragma unroll
              for (int nt = 0; nt < 8; ++nt) { acc[nt] = acc[nt] * dv; u32x2 o; o.x = pk2(acc[nt][0], acc[nt][1]); o.y = pk2(acc[nt][2], acc[nt][3]); *(LAS u32x2*)(ST + (16 * nt + r16) * H3_LDK + 16 * F.wave + 4 * g4) = o; } }
            if (F.wave < 4) { const int m0 = (F.wave >> 1) * 16, n0 = (F.wave & 1) * 16; const f32x4 a = mm16<4, H3_LDK, H3_LDK>(QC, KH, m0, n0, F.lane, (f32x4){0.f, 0.f, 0.f, 0.f});
#pragma unroll
                for (int rg = 0; rg < 4; ++rg) { const int t = m0 + 4 * g4 + rg, s = n0 + r16; AL[t * H3_LDS + s] = (bf16)f2bf(s <= t ? a[rg] : 0.f); } }
            __syncthreads();
#pragma unroll
            for (int q = 0; q < 2; ++q) { const int id = 2 * F.wave + q, m0 = (id >> 3) * 16, n0 = (id & 7) * 16;
                f32x4 o = mm16<4, H3_LDK, H3_LDK>(QC, ST, m0, n0, F.lane, (f32x4){0.f, 0.f, 0.f, 0.f}); o = mm16<1, H3_LDS, H3_LDS>(AL, VT, m0, n0, F.lane, o);
#pragma unroll
                for (int rg = 0; rg < 4; ++rg) OL[(m0 + 4 * g4 + rg) * 132 + n0 + r16] = o[rg]; }
#pragma unroll
            for (int nt = 0; nt < 8; ++nt) acc[nt] = mm16<1, H3_LDS, H3_LDS>(KHT, VT, 16 * F.wave, 16 * nt, F.lane, acc[nt]);
            __syncthreads();
            { const int t = F.tid >> 4, part = F.tid & 15; const LAS float* op = OL + t * 132 + part * 8; float o[8], ss = 0.f;
#pragma unroll
              for (int i = 0; i < 8; ++i) { o[i] = op[i]; ss += o[i] * o[i]; }
              ss = sum16(ss);
              const float rs = __builtin_amdgcn_rsqf(ss * (1.0f / 128.0f) + 1e-6f); const size_t row = rb + t;
              float y[8];
#pragma unroll
              for (int i = 0; i < 8; ++i) { const int q = i >> 1; const float gf = (i & 1) ? bfhi(gg[q]) : bflo(gg[q]); y[i] = o[i] * rs * ngv[i] * gf; }
              v4u w; w.x = pk2(y[0], y[1]); w.y = pk2(y[2], y[3]); w.z = pk2(y[4], y[5]); w.w = pk2(y[6], y[7]); *(v4u*)(y2 + row * 512 + h * 128 + part * 8) = w; }
        }
        __syncthreads();
    }
}
constexpr int AT_KLD = 72, AT_VLD = 260, AT_K = 0, AT_VT = 256 * AT_KLD * 2, AT_END = AT_VT + 64 * AT_VLD * 2;
static_assert(AT_END <= LDSCTL_OFF, "attention LDS");
__device__ __forceinline__ void phase_attn_mfma(Frame& F, const Args& A, int L) {
    KP_DECL;
    const bf16* za = WSP(bf16, R_ZA); bf16* y0 = WSP(bf16, R_Y); const float* sinks = INP(I_SINK) + L * 8;
    LAS bf16* KI = (LAS bf16*)(F.lds + AT_K); LAS bf16* VT = (LAS bf16*)(F.lds + AT_VT);
    const int c32 = F.lane & 31, hh = F.lane >> 5;
    for (int item = blockIdx.x; item < 256; item += F.G) { const int b = item >> 7, kvh = (item >> 6) & 1, n = item & 63; const int rowq0 = b * SEQ + n * 128, rowk0 = rowq0 - 128;
        { const int key = F.tid >> 1, half = F.tid & 1; const bool valid = (n > 0) || key >= 128; const bf16* src = za + (size_t)(rowk0 + key) * 768 + kvh * 64 + half * 32;
#pragma unroll
          for (int c = 0; c < 4; ++c) { v4u kk = (v4u){0u, 0u, 0u, 0u}, vv = kk; if (valid) { kk = *(const v4u*)(src + 512 + 8 * c); vv = *(const v4u*)(src + 640 + 8 * c); }
              *(LAS v4u*)(KI + key * AT_KLD + half * 32 + 8 * c) = kk;
#pragma unroll
              for (int i = 0; i < 4; ++i) { VT[(half * 32 + 8 * c + 2 * i) * AT_VLD + key] = (bf16)(vv[i] & 0xffffu); VT[(half * 32 + 8 * c + 2 * i + 1) * AT_VLD + key] = (bf16)(vv[i] >> 16); } } }
        __syncthreads();
#pragma unroll 1
        for (int rep = 0; rep < 2; ++rep) { const int id = F.wave * 2 + rep, g = id >> 2, u = id & 3, hq = kvh * 4 + g; const int qrow = rowq0 + 32 * u + c32, qi = 32 * u + c32;
            bf16x8 qf[4];
#pragma unroll
            for (int s = 0; s < 4; ++s) qf[s] = *(const bf16x8*)(za + (size_t)qrow * 768 + hq * 64 + 16 * s + 8 * hh);
            f32x16 st[5];
#pragma unroll
            for (int j = 0; j < 5; ++j) { f32x16 acc;
#pragma unroll
                for (int i = 0; i < 16; ++i) acc[i] = 0.f;
#pragma unroll
                for (int s = 0; s < 4; ++s) { const bf16x8 a = *(const LAS bf16x8*)(KI + (32 * (u + j) + c32) * AT_KLD + 16 * s + 8 * hh); acc = __builtin_amdgcn_mfma_f32_32x32x16_bf16(a, qf[s], acc, 0, 0, 0); }
                st[j] = acc; }
            const float sink = sinks[hq]; float mx = sink;
#pragma unroll
            for (int j = 0; j < 5; ++j)
#pragma unroll
                for (int rg = 0; rg < 16; ++rg) { const int kj = 32 * (u + j) + (rg & 3) + 8 * (rg >> 2) + 4 * hh; const bool ok = (kj > qi) && (kj <= qi + 128) && (n > 0 || kj >= 128);
                    const float v = ok ? st[j][rg] * 0.125f : -1e30f; st[j][rg] = v; mx = fmaxf(mx, v); }
            mx = fmaxf(mx, __shfl_xor(mx, 32));
            float sum = 0.f;
#pragma unroll
            for (int j = 0; j < 5; ++j)
#pragma unroll
                for (int rg = 0; rg < 16; ++rg) { const float p = __expf(st[j][rg] - mx); st[j][rg] = p; sum += p; }
            sum += __shfl_xor(sum, 32);
            const float inv = 1.0f / (sum + __expf(sink - mx));
            f32x16 o0, o1;
#pragma unroll
            for (int i = 0; i < 16; ++i) { o0[i] = 0.f; o1[i] = 0.f; }
#pragma unroll
            for (int j = 0; j < 5; ++j)
#pragma unroll
                for (int s = 0; s < 2; ++s) { v4u pw; pw.x = pg8::cvtpk_s(st[j][8 * s], st[j][8 * s + 1]); pw.y = pg8::cvtpk_s(st[j][8 * s + 2], st[j][8 * s + 3]); pw.z = pg8::cvtpk_s(st[j][8 * s + 4], st[j][8 * s + 5]); pw.w = pg8::cvtpk_s(st[j][8 * s + 6], st[j][8 * s + 7]);
                    const bf16x8 pb = __builtin_bit_cast(bf16x8, pw); const int k0 = 32 * (u + j) + 16 * s + 4 * hh;
                    { const u32x2 lo = *(const LAS u32x2*)(VT + c32 * AT_VLD + k0), hi = *(const LAS u32x2*)(VT + c32 * AT_VLD + k0 + 8); const bf16x8 va = __builtin_bit_cast(bf16x8, (v4u){lo.x, lo.y, hi.x, hi.y});
                      o0 = __builtin_amdgcn_mfma_f32_32x32x16_bf16(va, pb, o0, 0, 0, 0); }
                    { const u32x2 lo = *(const LAS u32x2*)(VT + (32 + c32) * AT_VLD + k0), hi = *(const LAS u32x2*)(VT + (32 + c32) * AT_VLD + k0 + 8); const bf16x8 va = __builtin_bit_cast(bf16x8, (v4u){lo.x, lo.y, hi.x, hi.y});
                      o1 = __builtin_amdgcn_mfma_f32_32x32x16_bf16(va, pb, o1, 0, 0, 0); } }
            bf16* yp = y0 + (size_t)qrow * 512 + hq * 64 + 4 * hh;
#pragma unroll
            for (int q4 = 0; q4 < 4; ++q4) { u32x2 w; w.x = pk2(o0[4 * q4] * inv, o0[4 * q4 + 1] * inv); w.y = pk2(o0[4 * q4 + 2] * inv, o0[4 * q4 + 3] * inv); *(u32x2*)(yp + 8 * q4) = w;
                w.x = pk2(o1[4 * q4] * inv, o1[4 * q4 + 1] * inv); w.y = pk2(o1[4 * q4 + 2] * inv, o1[4 * q4 + 3] * inv); *(u32x2*)(yp + 32 + 8 * q4) = w; }
        }
        __syncthreads();
    }
}
__device__ __forceinline__ void phase_final(Frame& F, const Args& A) {
    KP_DECL;
    const float* g = INP(I_FINN); const bf16* xb = WSP(bf16, R_XBALT); const float* ss = WSP(float, WS_SS0);
    const int gw = blockIdx.x * NWAVES + F.wave, NGW = F.G * NWAVES;
    const int lane_ = (int)__builtin_amdgcn_mbcnt_hi(~0u, __builtin_amdgcn_mbcnt_lo(~0u, 0u));
    f32x4 gg[2][2];
#pragma unroll
    for (int j = 0; j < 2; ++j) { gg[j][0] = *(const f32x4*)(g + j * 512 + lane_ * 8); gg[j][1] = *(const f32x4*)(g + j * 512 + lane_ * 8 + 4); }
    for (int m0 = gw; m0 < M; m0 += 4 * NGW) {
        const int mr = m0 + (lane_ >> 4) * NGW; const float pq = (mr < M) ? ss[(size_t)mr * 16 + (lane_ & 15)] : 1.0f;
        v4u w[4][2];
#pragma unroll
        for (int k = 0; k < 4; ++k) { const int m = (m0 + k * NGW < M) ? m0 + k * NGW : m0;
#pragma unroll
            for (int j = 0; j < 2; ++j) w[k][j] = __builtin_nontemporal_load((const v4u*)(xb + (size_t)m * DM + j * 512 + lane_ * 8)); }
        const float rsl = __builtin_amdgcn_rsqf(sum16(pq) * (1.0f / 1024.0f) + 1e-6f);
#pragma unroll
        for (int k = 0; k < 4; ++k) { const int m = m0 + k * NGW; if (m >= M) break; const float rs = __shfl(rsl, 16 * k);
#pragma unroll
            for (int j = 0; j < 2; ++j) { const v4u ww = w[k][j]; f32x4 o0, o1;
                o0.x = bflo(ww.x) * rs; o0.y = bfhi(ww.x) * rs; o0.z = bflo(ww.y) * rs; o0.w = bfhi(ww.y) * rs; o1.x = bflo(ww.z) * rs; o1.y = bfhi(ww.z) * rs; o1.z = bflo(ww.w) * rs; o1.w = bfhi(ww.w) * rs;
                float* op = F.x + (size_t)m * DM + j * 512 + lane_ * 8; *(f32x4*)op = o0 * gg[j][0]; *(f32x4*)(op + 4) = o1 * gg[j][1]; } } }
}

template <int L> __device__ __forceinline__ void run_layer(Frame& F, const Args& args, const XcdBarrier& bar, int lo, int hi) {
    typedef pg8::bf16_t pb16;
    constexpr int base = 17 * L;
#define IN(k) (lo <= base + (k) && base + (k) < hi && EN(k))
#define SEAM(k) do { if (base + (k) + 1 < hi) xcd_barrier(bar); } while (0)
#define GEMM_RUN(EPI, g, S, E) pg8::gemm_phase<EPI, pg8::StaticOrder, true, true>(F.lds + RING_OFF, g, S, E)
    constexpr size_t SS_IN = WS_SS0, SS_A = WS_SS1, SS_B = WS_SS0, SS_C = WS_SS1, SS_OUT = WS_SS0;
    if (IN(0)) { phase_conv<0>(F, args, L); SEAM(0); }
    if (IN(1)) { pg8::Gemm g{L == 0 ? WSP(pb16, WS_XB) : WSP(pb16, R_XBALT), WSP(pb16, W_F1GU), M, 5632, 1024}; pg8::StaticOrder S; S.init(M, 5632, F.G, (int)blockIdx.x);
        pg8::EpiSwiglu E{WSP(pb16, R_H), WSP(float, SS_IN)}; GEMM_RUN(pg8::EpiSwiglu, g, S, E);
        if ((int)blockIdx.x >= F.G / 2) phase_conv<1>(F, args, L);
        SEAM(1); }
    if (IN(2)) { KP_DECL; pg8::Gemm g{WSP(pb16, R_H), WSP(pb16, W_F1D), M, 1024, FF}; pg8::StaticOrder S; S.init(M, 1024, F.G, (int)blockIdx.x);
        pg8::EpiResid<0> E{WSP(pb16, WS_XB), WSP(float, SS_A), nullptr, nullptr, 0.5f, L == 0 ? WSP(pb16, WS_XB) : WSP(pb16, R_XBALT)}; GEMM_RUN(pg8::EpiResid<0>, g, S, E); SEAM(2); }
    if (IN(3)) { pg8::Gemm g{WSP(pb16, WS_XB), WSP(pb16, W_IN), M, 1792, 1024}; pg8::StaticOrder S; S.init(M, 1792, F.G, (int)blockIdx.x);
        pg8::EpiStore<0> E{WSP(pb16, R_ZR), WSP(float, SS_A), nullptr, nullptr, nullptr, nullptr}; GEMM_RUN(pg8::EpiStore<0>, g, S, E); SEAM(3); }
    if (IN(4)) { phase_rprep1(F, args, L); SEAM(4); }
    if (IN(5)) { KP_DECL; pg8::Gemm g{WSP(pb16, R_AP), WSP(pb16, W_LR), M, 1536, 256}; pg8::StaticOrder S; S.init(M, 1536, F.G, (int)blockIdx.x);
        pg8::EpiStore<3> E{WSP(pb16, R_DAG_W), nullptr, WSP(pb16, R_DAG_A), WSP(pb16, R_DAG_G), INP(I_W0) + L * 512, INP(I_A0) + L * 512};
        GEMM_RUN(pg8::EpiStore<3>, g, S, E); SEAM(5); }
    if (IN(6)) { phase_rchunk_pre(F, args, L); SEAM(6); }
    if (IN(7)) {
        if (blockIdx.x < 32 && F.wave == 0) rchunk_seq(F, blockIdx.x);
        pg8::Gemm g{WSP(pb16, WS_XB), WSP(pb16, W_IN) + (size_t)1792 * 1024, M, 2816, 1024}; pg8::SplitOrder S; S.init(M, 2816, F.G, (int)blockIdx.x); S.ns = 32;
        pg8::EpiStore<1> E{WSP(pb16, R_ZA), WSP(float, SS_A), (pb16*)F.x, nullptr, WSP(float, WS_LB), nullptr};
        pg8::gemm_phase<pg8::EpiStore<1>, pg8::SplitOrder, true, true>(F.lds + RING_OFF, g, S, E); SEAM(7); }
    if (IN(8)) { phase_h1(F, blockIdx.x, F.G); phase_attn_mfma(F, args, L); phase_rchunk_out(F, args, L); SEAM(8); }
    if (IN(9)) { phase_h2(F); xcd_barrier(bar); phase_h3(F, args, L); }
    if (IN(10)) { pg8::Gemm g{WSP(pb16, WS_XB), WSP(pb16, W_IN) + (size_t)4608 * 1024, M, 3072, 1024}; pg8::StaticOrder S; S.init(M, 3072, F.G, (int)blockIdx.x);
        pg8::EpiStore<2> E{WSP(pb16, R_GG), WSP(float, SS_A), nullptr, nullptr, nullptr, nullptr}; GEMM_RUN(pg8::EpiStore<2>, g, S, E); SEAM(10); }
    if (IN(11)) { pg8::Gemm g{WSP(pb16, R_Y), WSP(pb16, W_BR), M, 1024, 512, (size_t)M * 512, (size_t)1024 * 512}; pg8::ChainOrder S; S.init(M, 1024, F.G, (int)blockIdx.x);
        pg8::EpiBranchChain E{WSP(pb16, R_MERGED), WSP(pb16, R_GG)}; pg8::gemm_phase<pg8::EpiBranchChain, pg8::ChainOrder, true, true>(F.lds + RING_OFF, g, S, E); SEAM(11); }
    if (IN(12)) { conv_p(F, args, L); pg8::Gemm g{WSP(pb16, R_MERGED), WSP(pb16, W_O), M, 1024, 1024}; pg8::StaticOrder S; S.init(M, 1024, F.G, (int)blockIdx.x);
        pg8::EpiResid<0> E{WSP(pb16, WS_XB), WSP(float, SS_B), nullptr, nullptr, 1.0f, WSP(pb16, WS_XB)}; GEMM_RUN(pg8::EpiResid<0>, g, S, E); SEAM(12); }
    if (IN(13)) {
        { pg8::Gemm g{WSP(pb16, WS_XB), WSP(pb16, W_F2GU), M, 5632, 1024}; pg8::StaticOrder S; S.init(M, 5632, F.G, (int)blockIdx.x);
          pg8::EpiSwiglu E{WSP(pb16, R_H), WSP(float, SS_B)}; GEMM_RUN(pg8::EpiSwiglu, g, S, E); }
        { pg8::Gemm g{WSP(pb16, R_PB), WSP(pb16, W_PP), M, 1024, 256}; pg8::TailOrder S; S.init(M, 1024, F.G, (int)blockIdx.x); S.lo = F.G / 2;
          pg8::EpiStore<4> E{WSP(pb16, R_PROJ), nullptr, nullptr, nullptr, nullptr, nullptr}; pg8::gemm_phase<pg8::EpiStore<4>, pg8::TailOrder, true, true>(F.lds + RING_OFF, g, S, E); }
        SEAM(13); }
    if (IN(14)) { pg8::Gemm g{WSP(pb16, R_H), WSP(pb16, W_F2D), M, 1024, FF}; pg8::StaticOrder S; S.init(M, 1024, F.G, (int)blockIdx.x);
        pg8::EpiResid<0> E{WSP(pb16, WS_XB), WSP(float, SS_C), nullptr, nullptr, 0.5f, WSP(pb16, WS_XB)}; GEMM_RUN(pg8::EpiResid<0>, g, S, E); SEAM(14); }
    if (IN(16)) { pg8::Gemm g{WSP(pb16, WS_XB), WSP(pb16, W_PG), M, 1024, 1024}; pg8::StaticOrder S; S.init(M, 1024, F.G, (int)blockIdx.x);
        pg8::EpiResid<1> E{WSP(pb16, R_XBALT), WSP(float, SS_OUT), WSP(float, SS_C), WSP(pb16, R_PROJ), 1.0f, WSP(pb16, WS_XB)}; GEMM_RUN(pg8::EpiResid<1>, g, S, E);
        if (L != 0) SEAM(16); }
#undef IN
#undef SEAM
#undef GEMM_RUN
}
__global__ void __launch_bounds__(NWAVES * 64, 2) mk_fwd(Args args) {
    extern __shared__ __attribute__((aligned(16))) unsigned char lds[];
    Frame F;
    F.lds = (LAS unsigned char*)lds;
    F.MISC = (volatile LAS unsigned*)(F.lds + MISC_OFF);
    F.tid = threadIdx.x; F.lane = F.tid & 63; F.wave = __builtin_amdgcn_readfirstlane(F.tid >> 6);
    F.G = gridDim.x;
    F.ws = args.ws; F.x = args.out;
    F.ctl = (gu32*)(args.ws + WS_CTL);
    for (int u = F.tid; u < (LDS_BYTES - LDSCTL_OFF) / 4; u += NWAVES * 64) ((LAS unsigned*)(F.lds + LDSCTL_OFF))[u] = 0u;
    __syncthreads();
    const int lo = args.ph_lo, hi = args.ph_hi;
    const bool multi = (hi - lo) > 1;
    XcdBarrier bar; bar.bar = (unsigned*)(F.ctl + CW_BAR); bar.x = 0; bar.st = nullptr;
    if (multi) bar = xcd_barrier_post((unsigned*)(F.ctl + CW_BAR), F.MISC + 8);
    run_layer<0>(F, args, bar, lo, hi);
    run_layer<1>(F, args, bar, lo, hi);
    if (lo <= N_PHASES - 1 && N_PHASES - 1 < hi && EN(17)) phase_final(F, args);
}

#ifndef MK_PER_PHASE
#define MK_PER_PHASE 0
#endif
extern "C" void kernel_launch(void* const* d_in, const int* in_sizes, int n_in, void* d_out, int out_size, void* d_ws, size_t ws_size, hipStream_t stream) {
    static int grid = 0;
    if (grid == 0) {
        if (n_in != N_IN || in_sizes[0] != M * DM || out_size != M * DM || ws_size < WS_END) { fprintf(stderr, "kernel_launch: unexpected shapes / workspace (n_in %d, ws %zu < %zu)\n", n_in, ws_size, (size_t)WS_END); grid = -1; return; }
        int dev = 0, cus = 0;
        if (hipGetDevice(&dev) != hipSuccess || hipDeviceGetAttribute(&cus, hipDeviceAttributeMultiprocessorCount, dev) != hipSuccess) { grid = -1; return; }
        if (hipFuncSetAttribute((const void*)mk_fwd, hipFuncAttributeMaxDynamicSharedMemorySize, LDS_BYTES) != hipSuccess) { fprintf(stderr, "kernel_launch: hipFuncSetAttribute failed\n"); grid = -1; return; }
        int per_cu = 0;
        if (hipOccupancyMaxActiveBlocksPerMultiprocessor(&per_cu, (const void*)mk_fwd, NWAVES * 64, LDS_BYTES) != hipSuccess || per_cu < 1) fprintf(stderr, "kernel_launch: occupancy query says %d\n", per_cu);
        (void)hipGetLastError();
        grid = cus;
    }
    if (grid < 0) return;
    (void)hipMemsetAsync((char*)d_ws + WS_CTL, 0, CTL_ZERO_BYTES, stream);
    Args a{};
    for (int i = 0; i < N_IN; ++i) a.in[i] = (const float*)d_in[i];
    a.out = (float*)d_out; a.ws = (unsigned char*)d_ws;
#if MK_PER_PHASE
    for (int ph = 0; ph < N_PHASES; ++ph) { a.ph_lo = ph; a.ph_hi = ph + 1; hipLaunchKernelGGL(mk_fwd, dim3(grid), dim3(NWAVES * 64), LDS_BYTES, stream, a); }
#else
    a.ph_lo = 0; a.ph_hi = N_PHASES; hipLaunchKernelGGL(mk_fwd, dim3(grid), dim3(NWAVES * 64), LDS_BYTES, stream, a);
#endif
}
```

```cpp
#include <hip/hip_runtime.h>
#include <cstdio>
#include <cstdint>
namespace pg8 {
#define PG8_LAS __attribute__((address_space(3)))
typedef unsigned short bf16_t;
typedef short bf16x8 __attribute__((ext_vector_type(8)));
typedef float f32x4 __attribute__((ext_vector_type(4)));
typedef unsigned u32x4 __attribute__((ext_vector_type(4)));
constexpr int BM = 256, BK = 64, HALF = 128, HTB = HALF * BK * 2  , STAGE_BYTES = 8 * HTB, NXCD = 8, WGM = 8;
constexpr int RS_LDS_OFF = 8 * 16640;

__host__ __device__ __forceinline__ int lds_byte(int r, int c) { const int st = (r >> 4) * 2 + (c >> 5), rr = r & 15, cc = c & 31, ob = rr * 64 + cc * 2; return st * 1024 + (ob ^ (((ob >> 9) & 1) << 5)); }
__host__ __device__ __forceinline__ void stage_rc(int b, int& R, int& C) { const int st = b / 1024, sb = b % 1024, swz = sb ^ (((sb >> 9) & 1) << 5); R = (st >> 1) * 16 + swz / 64; C = (st & 1) * 32 + (swz % 64) / 2; }
__host__ __device__ __forceinline__ int perm32(int rho) { const int n = rho >> 4, i = rho & 15; return 8 * (i >> 2) + 4 * n + (i & 3); }

struct Unit { int pm, pn; int b = 0; };
struct Gemm { const bf16_t* A; const bf16_t* Bt; int M, N, K; size_t usA = 0, usB = 0; };

struct StaticOrder {
    int nM, nN, nwg, G, c;
    __host__ __device__ void init(int M, int N, int G_, int c_) { nM = M / BM; nN = N / BM; nwg = nM * nN; G = G_; c = c_; }
    __host__ __device__ bool next(int i, Unit& u) const {
        const long L = (long)i * G + c; if (L >= nwg) return false;
        int wgid = (int)L; { const int q = nwg / NXCD, r = nwg % NXCD, xcd = wgid % NXCD, off = wgid / NXCD; wgid = (xcd < r ? xcd * (q + 1) : r * (q + 1) + (xcd - r) * q) + off; }
        const int nig = WGM * nN, gid = wgid / nig, fm = gid * WGM, gsz = (nM - fm) < WGM ? (nM - fm) : WGM;
        u.pm = fm + ((wgid % nig) % gsz); u.pn = (wgid % nig) / gsz; return true;
    }
    __device__ __forceinline__ void a_ready(const Unit&) const {}
    __device__ __forceinline__ void done(const Unit&) const {}
};

struct SplitOrder : StaticOrder {
    int ns;
    __host__ __device__ bool next(int i, Unit& u) const {
        long L;
        if (c < ns) return false;
        else { L = (long)i * (G - ns) + (c - ns); if (L >= nwg - ns) return false; }
        int wgid = (int)L; { const int q = nwg / NXCD, r = nwg % NXCD, xcd = wgid % NXCD, off = wgid / NXCD; wgid = (xcd < r ? xcd * (q + 1) : r * (q + 1) + (xcd - r) * q) + off; }
        const int nig = WGM * nN, gid = wgid / nig, fm = gid * WGM, gsz = (nM - fm) < WGM ? (nM - fm) : WGM;
        u.pm = fm + ((wgid % nig) % gsz); u.pn = (wgid % nig) / gsz; return true;
    }
};

struct EarlyOrder : StaticOrder {
    int ns;
    __host__ __device__ bool next(int i, Unit& u) const {
        if (i > 0 || c < G - ns) return false; const long L = (long)(nwg - ns) + (c - (G - ns));
        int wgid = (int)L; { const int q = nwg / NXCD, r = nwg % NXCD, xcd = wgid % NXCD, off = wgid / NXCD; wgid = (xcd < r ? xcd * (q + 1) : r * (q + 1) + (xcd - r) * q) + off; }
        const int nig = WGM * nN, gid = wgid / nig, fm = gid * WGM, gsz = (nM - fm) < WGM ? (nM - fm) : WGM;
        u.pm = fm + ((wgid % nig) % gsz); u.pn = (wgid % nig) / gsz; return true;
    }
};
struct TailOrder : StaticOrder {
    int lo;
    __host__ __device__ bool next(int i, Unit& u) const {
        if (c < lo) return false; const long L = (long)i * (G - lo) + (c - lo); if (L >= nwg) return false;
        int wgid = (int)L; { const int q = nwg / NXCD, r = nwg % NXCD, xcd = wgid % NXCD, off = wgid / NXCD; wgid = (xcd < r ? xcd * (q + 1) : r * (q + 1) + (xcd - r) * q) + off; }
        const int nig = WGM * nN, gid = wgid / nig, fm = gid * WGM, gsz = (nM - fm) < WGM ? (nM - fm) : WGM;
        u.pm = fm + ((wgid % nig) % gsz); u.pn = (wgid % nig) / gsz; return true;
    }
};

__device__ __forceinline__ unsigned cvt_pk_bf16(float lo, float hi) { unsigned r; asm volatile("v_cvt_pk_bf16_f32 %0, %1, %2" : "=v"(r) : "v"(lo), "v"(hi)); return r; }
typedef float f32x2 __attribute__((ext_vector_type(2)));
typedef unsigned u32x2 __attribute__((ext_vector_type(2)));
__device__ __forceinline__ float fsigmoid(float x) { return __builtin_amdgcn_rcpf(1.0f + __builtin_amdgcn_exp2f(-1.4426950408889634f * x)); }
__device__ __forceinline__ float fsilu(float x) { return x * fsigmoid(x); }
__device__ __forceinline__ float bf2f(unsigned short b) { return __uint_as_float(((unsigned)b) << 16); }
typedef float f32x2_t __attribute__((ext_vector_type(2))); typedef __bf16 bf16x2_t __attribute__((ext_vector_type(2)));
__device__ __forceinline__ unsigned cvtpk_s(float lo, float hi) { f32x2_t v = {lo, hi}; bf16x2_t b = __builtin_convertvector(v, bf16x2_t); return __builtin_bit_cast(unsigned, b); }
__device__ __forceinline__ u32x4 pack8(const f32x4& a, const f32x4& b) { u32x4 w; w.x = cvtpk_s(a[0], a[1]); w.y = cvtpk_s(a[2], a[3]); w.z = cvtpk_s(b[0], b[1]); w.w = cvtpk_s(b[2], b[3]); return w; }
__device__ __forceinline__ void unpack8(const u32x4& w, f32x4& a, f32x4& b) {
    a[0] = __uint_as_float(w.x << 16); a[1] = __uint_as_float(w.x & 0xffff0000u); a[2] = __uint_as_float(w.y << 16); a[3] = __uint_as_float(w.y & 0xffff0000u);
    b[0] = __uint_as_float(w.z << 16); b[1] = __uint_as_float(w.z & 0xffff0000u); b[2] = __uint_as_float(w.w << 16); b[3] = __uint_as_float(w.w & 0xffff0000u); }
__device__ __forceinline__ float row_rstd(const float* ssp, int r) {
    const f32x4* p = (const f32x4*)(ssp + (size_t)r * 16);
    const f32x4 a = p[0], b = p[1], c = p[2], d = p[3]; const f32x4 s = (a + b) + (c + d);
    return __builtin_amdgcn_rsqf(((s[0] + s[1]) + (s[2] + s[3])) * (1.0f / 1024.0f) + 1e-6f);
}
#define EPI_FENCE() asm volatile("" ::: "memory")
typedef __amdgpu_buffer_rsrc_t rsrc_t;
__device__ __forceinline__ rsrc_t mk_rsrc(const void* p) { return __builtin_amdgcn_make_buffer_rsrc((void*)p, (short)0, 0x7fffffff, 0x00020000); }
__device__ __forceinline__ float xq_sum(float x) {
    auto s = __builtin_amdgcn_permlane16_swap(__float_as_uint(x), __float_as_uint(x), false, false); x = __uint_as_float(s[0]) + __uint_as_float(s[1]);
    auto t = __builtin_amdgcn_permlane32_swap(__float_as_uint(x), __float_as_uint(x), false, false); return __uint_as_float(t[0]) + __uint_as_float(t[1]);
}
__device__ __forceinline__ void rstd8_issue(const float* ssp, int row0, int fq, f32x4 (&p)[2][4]) {
#pragma unroll
    for (int ai = 0; ai < 2; ++ai)
#pragma unroll
        for (int m = 0; m < 4; ++m) p[ai][m] = *(const f32x4*)(ssp + (size_t)(row0 + ai * HALF + m * 16) * 16 + 4 * fq);
}
__device__ __forceinline__ void rstd8_reduce(const f32x4 (&p)[2][4], float (&rs)[2][4]) {
#pragma unroll
    for (int ai = 0; ai < 2; ++ai)
#pragma unroll
        for (int m = 0; m < 4; ++m) { const float q = (p[ai][m][0] + p[ai][m][1]) + (p[ai][m][2] + p[ai][m][3]); rs[ai][m] = __builtin_amdgcn_rsqf(xq_sum(q) * (1.0f / 1024.0f) + 1e-6f); }
}
struct EpiSwiglu {
    static constexpr bool PERM = true, AFTER_DRAIN = false, CHAIN = false, RS = true;
    bf16_t* H; const float* ssp;
    __device__ __forceinline__ const float* rs_ptr() const { return ssp; }
    __device__ __forceinline__ void operator()(const f32x4 (&acc)[2][2][4][2], const Unit& u, int wr, int wc, int fr, int fq, const float (&rs8)[2][4]) const {
        const int row0 = u.pm * BM + wr * 64 + fr, col0 = u.pn * HALF + wc * 32 + 8 * fq;
#pragma unroll
        for (int ai = 0; ai < 2; ++ai)
#pragma unroll
            for (int m = 0; m < 4; ++m) { const int r = row0 + ai * HALF + m * 16; const float s = rs8[ai][m]; f32x4 o[2];
                const float sn = -1.4426950408889634f * s, s2 = s * s;
#pragma unroll
                for (int n = 0; n < 2; ++n) { const f32x4 gu = acc[ai][0][m][n] * acc[ai][1][m][n], t = acc[ai][0][m][n] * sn;
#pragma unroll
                    for (int i = 0; i < 4; ++i) o[n][i] = gu[i] * (s2 * __builtin_amdgcn_rcpf(1.0f + __builtin_amdgcn_exp2f(t[i]))); }
                *(u32x4*)(H + (size_t)r * 2816 + col0) = pack8(o[0], o[1]); EPI_FENCE(); }
    }
};
template <int MODE> struct EpiResid {
    static constexpr bool PERM = true, AFTER_DRAIN = false, CHAIN = false, RS = (MODE == 1);
    bf16_t* XB; float* sso; const float* ssi; const bf16_t* proj; float scale; const bf16_t* XBin;
    __device__ __forceinline__ const float* rs_ptr() const { return ssi; }
    static constexpr int NB = (MODE == 0) ? 8 : 2;
    __device__ __forceinline__ void operator()(const f32x4 (&acc)[2][2][4][2], const Unit& u, int wr, int wc, int fr, int fq, const float (&rs8)[2][4]) const {
        const rsrc_t rx = mk_rsrc(XBin), rp = mk_rsrc(MODE == 1 ? (const void*)proj : (const void*)XBin), ro = mk_rsrc(XB);
        const unsigned voff = (unsigned)(fr * 1024 + 8 * fq) * 2u;
        const unsigned sbase = (unsigned)((u.pm * BM + wr * 64) * 1024 + u.pn * BM + wc * 32) * 2u;
        const int row0 = u.pm * BM + wr * 64 + fr;
#pragma unroll
        for (int gp = 0; gp < 8 / NB; ++gp) {
            u32x4 xv[NB][2]; u32x4 pv[NB][2];
#pragma unroll
            for (int mm = 0; mm < NB; ++mm) { const int g = NB * gp + mm, ai = g >> 2, m = g & 3;
#pragma unroll
                for (int bj = 0; bj < 2; ++bj) { const unsigned so = sbase + (unsigned)((ai * HALF + m * 16) * 1024 + bj * HALF) * 2u;
                    xv[mm][bj] = __builtin_amdgcn_raw_buffer_load_b128(rx, voff + so, 0, 0);
                    if (MODE == 1) pv[mm][bj] = __builtin_amdgcn_raw_buffer_load_b128(rp, voff + so, 0, 0); } }
#pragma unroll
            for (int mm = 0; mm < NB; ++mm) { const int g = NB * gp + mm, ai = g >> 2, m = g & 3; const int r = row0 + ai * HALF + m * 16; float ss = 0.f;
                float s = 1.0f; if (MODE == 1) s = rs8[ai][m];
#pragma unroll
                for (int bj = 0; bj < 2; ++bj) { const unsigned so = sbase + (unsigned)((ai * HALF + m * 16) * 1024 + bj * HALF) * 2u; f32x4 x0, x1; unpack8(xv[mm][bj], x0, x1);
                    if (MODE == 0) { x0 = x0 + acc[ai][bj][m][0] * scale; x1 = x1 + acc[ai][bj][m][1] * scale; }
                    else { f32x4 p0, p1; unpack8(pv[mm][bj], p0, p1);
#pragma unroll
                        for (int i = 0; i < 4; ++i) { x0[i] += fsigmoid(acc[ai][bj][m][0][i] * s) * p0[i]; x1[i] += fsigmoid(acc[ai][bj][m][1][i] * s) * p1[i]; } }
                    __builtin_amdgcn_raw_buffer_store_b128(pack8(x0, x1), ro, voff + so, 0, 0);
                    ss += ((x0[0] * x0[0] + x0[1] * x0[1]) + (x0[2] * x0[2] + x0[3] * x0[3])) + ((x1[0] * x1[0] + x1[1] * x1[1]) + (x1[2] * x1[2] + x1[3] * x1[3])); }
                ss = xq_sum(ss);
                if (fq == 0) sso[(size_t)r * 16 + u.pn * 4 + wc] = ss; }
            EPI_FENCE(); }
    }
};
template <int ACT, bool RS, int LD> __device__ __forceinline__ void store_tile(const f32x4 (&acc)[2][2][4][2], bf16_t* base, const float (&rs8)[2][4], const float* cvp, int row0, int fq) {
    f32x4 cv[2][2];
#pragma unroll
    for (int bj = 0; bj < 2; ++bj)
#pragma unroll
        for (int n = 0; n < 2; ++n) cv[bj][n] = (ACT >= 3) ? *(const f32x4*)(cvp + bj * HALF + 4 * n) : (f32x4){0.f, 0.f, 0.f, 0.f};
#pragma unroll
    for (int ai = 0; ai < 2; ++ai)
#pragma unroll
        for (int m = 0; m < 4; ++m) { const int r = row0 + ai * HALF + m * 16; float s = 1.0f; if (RS) s = rs8[ai][m];
#pragma unroll
            for (int bj = 0; bj < 2; ++bj) { f32x4 o[2];
#pragma unroll
                for (int n = 0; n < 2; ++n) { const f32x4 z = acc[ai][bj][m][n] * ((ACT == 2) ? -1.4426950408889634f * s : s);
#pragma unroll
                    for (int i = 0; i < 4; ++i) { float v = z[i];
                        if (ACT == 1) v = fsilu(v);
                        else if (ACT == 2) v = __builtin_amdgcn_rcpf(1.0f + __builtin_amdgcn_exp2f(v));
                        else if (ACT == 3) v = (1.0f - cv[bj][n][i]) * fsigmoid(-v);
                        else if (ACT == 4) v = __builtin_amdgcn_exp2f(-0.6065306597126334f * 1.4426950408889634f * fsigmoid(v + cv[bj][n][i]));
                        else if (ACT == 5) v = fsigmoid(v + cv[bj][n][i]);
                        o[n][i] = v; } }
                *(u32x4*)(base + (size_t)r * LD + bj * HALF) = pack8(o[0], o[1]); }
            EPI_FENCE(); }
}
template <int KIND> struct EpiStore {
    static constexpr bool PERM = true, AFTER_DRAIN = false, CHAIN = false, RS = (KIND <= 2);
    bf16_t* O; const float* ssp; bf16_t* O2; bf16_t* O3; const float* c0; const float* c1;
    __device__ __forceinline__ const float* rs_ptr() const { return ssp; }
    __device__ __forceinline__ void operator()(const f32x4 (&acc)[2][2][4][2], const Unit& u, int wr, int wc, int fr, int fq, const float (&rs8)[2][4]) const {
        const int row0 = u.pm * BM + wr * 64 + fr; const int cl = wc * 32 + 8 * fq;
        if (KIND == 0) store_tile<0, true, 1792>(acc, O + u.pn * BM + cl, rs8, nullptr, row0, fq);
        if (KIND == 1) {
            if (u.pn < 3) store_tile<0, true, 768>(acc, O + u.pn * BM + cl, rs8, nullptr, row0, fq);
            else { const int t = u.pn - 3, kind = t >> 1; bf16_t* b = O2 + t * BM + cl;
                if (kind == 0 || kind == 3) store_tile<1, true, 2048>(acc, b, rs8, nullptr, row0, fq);
                else if (kind == 1) store_tile<3, true, 2048>(acc, b, rs8, c0 + (t & 1) * BM + cl, row0, fq);
                else store_tile<0, true, 2048>(acc, b, rs8, nullptr, row0, fq); } }
        if (KIND == 2) store_tile<2, true, 3072>(acc, O + u.pn * BM + cl, rs8, nullptr, row0, fq);
        if (KIND == 3) {
            if (u.pn < 2) store_tile<4, false, 512>(acc, O + u.pn * BM + cl, rs8, c0 + u.pn * BM + cl, row0, fq);
            else if (u.pn < 4) store_tile<5, false, 512>(acc, O2 + (u.pn - 2) * BM + cl, rs8, c1 + (u.pn - 2) * BM + cl, row0, fq);
            else store_tile<0, false, 512>(acc, O3 + (u.pn - 4) * BM + cl, rs8, nullptr, row0, fq); }
        if (KIND == 4) store_tile<0, false, 1024>(acc, O + u.pn * BM + cl, rs8, nullptr, row0, fq);
    }
};
template <bool FIRST> struct EpiBranch {
    static constexpr bool PERM = true, AFTER_DRAIN = false, CHAIN = false, RS = false;
    bf16_t* Mg; const bf16_t* G; const float* ssp;
    __device__ __forceinline__ const float* rs_ptr() const { return nullptr; }
    __device__ __forceinline__ void operator()(const f32x4 (&acc)[2][2][4][2], const Unit& u, int wr, int wc, int fr, int fq, const float (&rs8)[2][4]) const {
        const int row0 = u.pm * BM + wr * 64 + fr, col0 = u.pn * BM + wc * 32 + 8 * fq;
#pragma unroll
        for (int ai = 0; ai < 2; ++ai)
#pragma unroll
            for (int m = 0; m < 4; ++m) { const int r = row0 + ai * HALF + m * 16;
#pragma unroll
                for (int bj = 0; bj < 2; ++bj) { f32x4 g0, g1; unpack8(*(const u32x4*)(G + (size_t)r * 3072 + col0 + bj * HALF), g0, g1);
                    f32x4 o0 = g0 * acc[ai][bj][m][0], o1 = g1 * acc[ai][bj][m][1];
                    bf16_t* mp = Mg + (size_t)r * 1024 + col0 + bj * HALF;
                    if (!FIRST) { f32x4 p0, p1; unpack8(*(const u32x4*)mp, p0, p1); o0 = o0 + p0; o1 = o1 + p1; }
                    *(u32x4*)mp = pack8(o0, o1); }
                EPI_FENCE(); }
    }
};
struct EpiBranchChain {
    static constexpr bool PERM = true, AFTER_DRAIN = false, CHAIN = true, RS = false;
    bf16_t* Mg; const bf16_t* G;
    __device__ __forceinline__ const float* rs_ptr() const { return nullptr; }
    __device__ __forceinline__ void operator()(f32x4 (&acc)[2][2][4][2], const Unit& u, int wr, int wc, int fr, int fq, const float (&rs8)[2][4]) const {
        const int b = u.b; const rsrc_t rg = mk_rsrc(G), rm = mk_rsrc(Mg);
        const unsigned vg = (unsigned)(fr * 3072 + 8 * fq) * 2u + (unsigned)((u.pm * BM + wr * 64) * 3072 + b * 1024 + u.pn * BM + wc * 32) * 2u;
        const unsigned vm = (unsigned)(fr * 1024 + 8 * fq) * 2u + (unsigned)((u.pm * BM + wr * 64) * 1024 + u.pn * BM + wc * 32) * 2u;
        if (b < 2) {
#pragma unroll
            for (int ai = 0; ai < 2; ++ai) { u32x4 gv[4][2], hv[4][2];
#pragma unroll
                for (int m = 0; m < 4; ++m)
#pragma unroll
                    for (int bj = 0; bj < 2; ++bj) { const unsigned o = vg + (unsigned)((ai * HALF + m * 16) * 3072 + bj * HALF) * 2u;
                        gv[m][bj] = __builtin_amdgcn_raw_buffer_load_b128(rg, o, 0, 0); hv[m][bj] = __builtin_amdgcn_raw_buffer_load_b128(rg, o + 2048u, 0, 0); }
#pragma unroll
                for (int m = 0; m < 4; ++m)
#pragma unroll
                    for (int bj = 0; bj < 2; ++bj) { f32x4 g0, g1, h0, h1; unpack8(gv[m][bj], g0, g1); unpack8(hv[m][bj], h0, h1);
#pragma unroll
                        for (int i = 0; i < 4; ++i) { g0[i] *= __builtin_amdgcn_rcpf(h0[i]); g1[i] *= __builtin_amdgcn_rcpf(h1[i]); }
                        acc[ai][bj][m][0] = acc[ai][bj][m][0] * g0; acc[ai][bj][m][1] = acc[ai][bj][m][1] * g1; }
                EPI_FENCE(); }
        } else { u32x4 gv[2][4][2];
#pragma unroll
            for (int ai = 0; ai < 2; ++ai)
#pragma unroll
                for (int m = 0; m < 4; ++m)
#pragma unroll
                    for (int bj = 0; bj < 2; ++bj) gv[ai][m][bj] = __builtin_amdgcn_raw_buffer_load_b128(rg, vg + (unsigned)((ai * HALF + m * 16) * 3072 + bj * HALF) * 2u, 0, 0);
#pragma unroll
            for (int ai = 0; ai < 2; ++ai)
#pragma unroll
                for (int m = 0; m < 4; ++m)
#pragma unroll
                    for (int bj = 0; bj < 2; ++bj) { f32x4 g0, g1; unpack8(gv[ai][m][bj], g0, g1); const f32x4 o0 = g0 * acc[ai][bj][m][0], o1 = g1 * acc[ai][bj][m][1];
                        __builtin_amdgcn_raw_buffer_store_b128(pack8(o0, o1), rm, vm + (unsigned)((ai * HALF + m * 16) * 1024 + bj * HALF) * 2u, 0, 0); }
            EPI_FENCE(); }
    }
};
struct ChainOrder : StaticOrder {
    __host__ __device__ bool next(int i, Unit& u) const { if (i >= 3) return false; if (!StaticOrder::next(0, u)) return false; u.b = i; return true; }
};
template <class Epi, class Sched, bool ALIGN_EPI = false, bool SP2 = false>
__device__ __forceinline__ void gemm_phase(PG8_LAS unsigned char* lds, const Gemm g, const Sched& S, const Epi& E) {
    const int tid = threadIdx.x, wid = __builtin_amdgcn_readfirstlane(tid >> 6), lane = tid & 63, wr = wid >> 2, wc = wid & 3, fr = lane & 15, fq = lane >> 4;
    int Kl_ = g.K; asm volatile("" : "+s"(Kl_)); const int K = Kl_, nt = K / BK;
    unsigned voffA[2], voffB[2];
#pragma unroll
    for (int i = 0; i < 2; ++i) { int R, C; stage_rc(tid * 16 + i * 8192, R, C); const int Rb = Epi::PERM ? ((R & ~31) + perm32(R & 31)) : R;
        voffA[i] = (unsigned)(R * K + C) * 2u; voffB[i] = (unsigned)(Rb * K + C) * 2u; }
    const size_t kstep = (size_t)(BK * 2);
    const size_t hstep = (size_t)HALF * K * 2;
    const size_t tstep = 2 * hstep;
    const unsigned ldsw = (unsigned)wid * 1024u;
    const int aoff = lds_byte(wr * 64 + fr, fq * 8), boff = lds_byte(wc * 32 + fr, fq * 8);
#define PG8_SA(b, h) (((b) * 2 + (h)) * HTB)
#define PG8_SB(b, h) ((4 + (b) * 2 + (h)) * HTB)
#define PG8_STAGE(bufoff, gbase, voff) do { _Pragma("unroll") for (int _i = 0; _i < 2; ++_i) \
        __builtin_amdgcn_global_load_lds((const unsigned*)((const char*)(gbase) + (voff)[_i]), (PG8_LAS unsigned*)(lds + (bufoff) + ldsw + _i * 8192), 16, 0, 0); } while (0)
#define PG8_LDA(dst, b, h) do { _Pragma("unroll") for (int m = 0; m < 4; ++m) _Pragma("unroll") for (int k = 0; k < 2; ++k) dst[m][k] = *(const PG8_LAS bf16x8*)(lds + PG8_SA(b, h) + aoff + m * 2048 + k * 1024); } while (0)
#define PG8_LDB(dst, b, h) do { _Pragma("unroll") for (int n = 0; n < 2; ++n) _Pragma("unroll") for (int k = 0; k < 2; ++k) dst[n][k] = *(const PG8_LAS bf16x8*)(lds + PG8_SB(b, h) + boff + n * 2048 + k * 1024); } while (0)
#define PG8_MMA(ai, bj, At, Bt) do { __builtin_amdgcn_s_setprio(1); _Pragma("unroll") for (int m = 0; m < 4; ++m) _Pragma("unroll") for (int n = 0; n < 2; ++n) _Pragma("unroll") for (int k = 0; k < 2; ++k) \
        acc[ai][bj][m][n] = __builtin_amdgcn_mfma_f32_16x16x32_bf16(Bt[n][k], At[m][k], acc[ai][bj][m][n], 0, 0, 0); __builtin_amdgcn_s_setprio(0); } while (0)
#define PG8_WAIT_V(n) asm volatile("s_waitcnt vmcnt(" #n ")" ::: "memory")
#define PG8_WAIT_L(n) asm volatile("s_waitcnt lgkmcnt(" #n ")" ::: "memory")
#define PG8_BAR __builtin_amdgcn_s_barrier()
#define PG8_SCHED __builtin_amdgcn_sched_barrier(0)
    Unit cur, nxt; int ui = 0;
    if (!S.next(0, cur)) return;
    f32x4 acc[2][2][4][2];
#pragma unroll
    for (int a = 0; a < 2; ++a)
#pragma unroll
        for (int b = 0; b < 2; ++b)
#pragma unroll
            for (int m = 0; m < 4; ++m)
#pragma unroll
                for (int n = 0; n < 2; ++n) acc[a][b][m][n] = (f32x4){0.f, 0.f, 0.f, 0.f};
    bf16x8 At[4][2], B0[2][2], B1[2][2];
    const char* cA = (const char*)g.A + (size_t)cur.pm * tstep + (size_t)cur.b * g.usA * 2; const char* cB = (const char*)g.Bt + (size_t)cur.pn * tstep + (size_t)cur.b * g.usB * 2;
    S.a_ready(cur);
    PG8_LAS float* RSL = (PG8_LAS float*)(lds + RS_LDS_OFF);
    if constexpr (Epi::RS) { f32x4 p0_[2];
#pragma unroll
        for (int ai = 0; ai < 2; ++ai) p0_[ai] = *(const f32x4*)(E.rs_ptr() + (size_t)(cur.pm * BM + ai * HALF + wr * 64 + wc * 16 + fr) * 16 + 4 * fq);
#pragma unroll
        for (int ai = 0; ai < 2; ++ai) { const float q_ = (p0_[ai][0] + p0_[ai][1]) + (p0_[ai][2] + p0_[ai][3]); const float r_ = __builtin_amdgcn_rsqf(xq_sum(q_) * (1.0f / 1024.0f) + 1e-6f);
            if (fq == 0) RSL[ai * HALF + wr * 64 + wc * 16 + fr] = r_; } }
    if constexpr (SP2) {
        PG8_STAGE(PG8_SB(0, 0), cB, voffB); PG8_STAGE(PG8_SB(0, 1), cB + hstep, voffB); PG8_STAGE(PG8_SA(0, 0), cA, voffA); PG8_STAGE(PG8_SA(0, 1), cA + hstep, voffA);
        if (wr == 1) PG8_BAR;
        PG8_WAIT_V(2); PG8_BAR;
        PG8_STAGE(PG8_SB(1, 0), cB + kstep, voffB); PG8_STAGE(PG8_SA(1, 0), cA + kstep, voffA); PG8_STAGE(PG8_SB(1, 1), cB + hstep + kstep, voffB);
        PG8_WAIT_V(6); PG8_BAR;
    } else {
        PG8_STAGE(PG8_SB(0, 0), cB, voffB); PG8_STAGE(PG8_SA(0, 0), cA, voffA); PG8_STAGE(PG8_SB(0, 1), cB + hstep, voffB); PG8_STAGE(PG8_SA(0, 1), cA + hstep, voffA);
        if (wr == 1) PG8_BAR;
        PG8_WAIT_V(4); PG8_BAR;
        PG8_STAGE(PG8_SB(1, 0), cB + kstep, voffB); PG8_STAGE(PG8_SA(1, 0), cA + kstep, voffA); PG8_STAGE(PG8_SB(1, 1), cB + hstep + kstep, voffB);
        PG8_WAIT_V(6); PG8_BAR;
    }
    for (;;) {
        const bool has_next = S.next(ui + 1, nxt);
        const char* nA = has_next ? (const char*)g.A + (size_t)nxt.pm * tstep + (size_t)nxt.b * g.usA * 2 : cA; const char* nB = has_next ? (const char*)g.Bt + (size_t)nxt.pn * tstep + (size_t)nxt.b * g.usB * 2 : cB;
        for (int t = 0; t < nt; t += 2) {
            const bool last = (t == nt - 2);
            const char* a1 = cA + (size_t)(t + 1) * kstep;
            const char* a2 = last ? nA : cA + (size_t)(t + 2) * kstep; const char* b2 = last ? nB : cB + (size_t)(t + 2) * kstep;
            const char* a3 = a2 + kstep; const char* b3 = b2 + kstep;
            if (last && has_next) S.a_ready(nxt);
            if constexpr (SP2) {
            PG8_LDB(B0, 0, 0); PG8_LDB(B1, 0, 1); PG8_SCHED; PG8_LDA(At, 0, 0); PG8_STAGE(PG8_SA(1, 1), a1 + hstep, voffA);
            PG8_WAIT_V(8); PG8_WAIT_L(0); PG8_BAR; PG8_MMA(0, 0, At, B0); PG8_MMA(0, 1, At, B1); PG8_BAR; PG8_SCHED;
            PG8_LDA(At, 0, 1); PG8_STAGE(PG8_SB(0, 0), b2, voffB); PG8_STAGE(PG8_SB(0, 1), b2 + hstep, voffB); PG8_STAGE(PG8_SA(0, 0), a2, voffA);
            PG8_WAIT_V(8); PG8_WAIT_L(0); PG8_BAR; PG8_MMA(1, 0, At, B0); PG8_MMA(1, 1, At, B1); PG8_BAR; PG8_SCHED;
            PG8_LDB(B0, 1, 0); PG8_LDB(B1, 1, 1); PG8_SCHED; PG8_LDA(At, 1, 0); PG8_STAGE(PG8_SA(0, 1), a2 + hstep, voffA);
            PG8_WAIT_V(8); PG8_WAIT_L(0); PG8_BAR; PG8_MMA(0, 0, At, B0); PG8_MMA(0, 1, At, B1); PG8_BAR; PG8_SCHED;
            PG8_LDA(At, 1, 1); PG8_STAGE(PG8_SB(1, 0), b3, voffB); PG8_STAGE(PG8_SB(1, 1), b3 + hstep, voffB); PG8_STAGE(PG8_SA(1, 0), a3, voffA);
            PG8_WAIT_V(8); PG8_WAIT_L(0); PG8_BAR; PG8_MMA(1, 0, At, B0); PG8_MMA(1, 1, At, B1); PG8_BAR; PG8_SCHED;
            } else {
            PG8_LDB(B0, 0, 0); PG8_SCHED; PG8_LDA(At, 0, 0); PG8_STAGE(PG8_SA(1, 1), a1 + hstep, voffA);
            PG8_WAIT_L(8); PG8_BAR; PG8_WAIT_L(0); PG8_MMA(0, 0, At, B0); PG8_BAR; PG8_SCHED;
            PG8_LDB(B1, 0, 1); PG8_STAGE(PG8_SB(0, 0), b2, voffB);
            PG8_BAR; PG8_WAIT_L(0); PG8_MMA(0, 1, At, B1); PG8_BAR;
            PG8_LDA(At, 0, 1); PG8_STAGE(PG8_SA(0, 0), a2, voffA);
            PG8_BAR; PG8_WAIT_L(0); PG8_MMA(1, 0, At, B0); PG8_BAR; PG8_SCHED;
            PG8_STAGE(PG8_SB(0, 1), b2 + hstep, voffB);
            PG8_WAIT_V(6); PG8_BAR; PG8_MMA(1, 1, At, B1); PG8_BAR;
            PG8_LDB(B0, 1, 0); PG8_SCHED; PG8_LDA(At, 1, 0); PG8_STAGE(PG8_SA(0, 1), a2 + hstep, voffA);
            PG8_WAIT_L(8); PG8_BAR; PG8_WAIT_L(0); PG8_MMA(0, 0, At, B0); PG8_BAR; PG8_SCHED;
            PG8_LDB(B1, 1, 1); PG8_STAGE(PG8_SB(1, 0), b3, voffB);
            PG8_BAR; PG8_WAIT_L(0); PG8_MMA(0, 1, At, B1); PG8_BAR;
            PG8_LDA(At, 1, 1); PG8_STAGE(PG8_SA(1, 0), a3, voffA);
            PG8_BAR; PG8_WAIT_L(0); PG8_MMA(1, 0, At, B0); PG8_BAR; PG8_SCHED;
            PG8_STAGE(PG8_SB(1, 1), b3 + hstep, voffB);
            PG8_WAIT_V(6); PG8_BAR; PG8_MMA(1, 1, At, B1); PG8_BAR;
            }
        }
        if constexpr (ALIGN_EPI) { if (wr == 0) PG8_BAR; }
        if constexpr (!Epi::AFTER_DRAIN) {
            float rsv[2][4];
            if constexpr (Epi::RS) { const PG8_LAS float* rb_ = RSL + (ui & 1) * 256 + wr * 64 + fr;
#pragma unroll
                for (int ai = 0; ai < 2; ++ai)
#pragma unroll
                    for (int m = 0; m < 4; ++m) rsv[ai][m] = rb_[ai * HALF + m * 16];
                f32x4 pn_[2];
                if (has_next) {
#pragma unroll
                    for (int ai = 0; ai < 2; ++ai) pn_[ai] = *(const f32x4*)(E.rs_ptr() + (size_t)(nxt.pm * BM + ai * HALF + wr * 64 + wc * 16 + fr) * 16 + 4 * fq); }
                E(acc, cur, wr, wc, fr, fq, rsv);
                if (has_next) {
#pragma unroll
                    for (int ai = 0; ai < 2; ++ai) { const float q_ = (pn_[ai][0] + pn_[ai][1]) + (pn_[ai][2] + pn_[ai][3]); const float r_ = __builtin_amdgcn_rsqf(xq_sum(q_) * (1.0f / 1024.0f) + 1e-6f);
                        if (fq == 0) RSL[((ui + 1) & 1) * 256 + ai * HALF + wr * 64 + wc * 16 + fr] = r_; } } }
            else { for (int ai = 0; ai < 2; ++ai) for (int m = 0; m < 4; ++m) rsv[ai][m] = 1.0f; E(acc, cur, wr, wc, fr, fq, rsv); }
            S.done(cur); }
        if (!has_next) break;
        if constexpr (!Epi::CHAIN)
#pragma unroll
        for (int a = 0; a < 2; ++a)
#pragma unroll
            for (int b = 0; b < 2; ++b)
#pragma unroll
                for (int m = 0; m < 4; ++m)
#pragma unroll
                    for (int n = 0; n < 2; ++n) acc[a][b][m][n] = (f32x4){0.f, 0.f, 0.f, 0.f};
        cur = nxt; cA = nA; cB = nB; ++ui;
        if constexpr (ALIGN_EPI) { if (wr == 1) PG8_BAR; }
    }
    PG8_WAIT_V(0);
    if constexpr (!ALIGN_EPI) { if (wr == 0) PG8_BAR; }
    PG8_BAR;
    if constexpr (Epi::AFTER_DRAIN) { E.fused(acc, cur, wr, wc, fr, fq, lds, wid, lane); S.done(cur); }
#undef PG8_SA
#undef PG8_SB
#undef PG8_STAGE
#undef PG8_LDA
#undef PG8_LDB
#undef PG8_MMA
#undef PG8_WAIT_V
#undef PG8_WAIT_L
#undef PG8_BAR
#undef PG8_SCHED
}
}
#define GAS __attribute__((address_space(1)))
#define LAS __attribute__((address_space(3)))
typedef unsigned short bf16;
typedef unsigned v4u __attribute__((ext_vector_type(4)));
typedef float f32x4 __attribute__((ext_vector_type(4)));
typedef short bf16x8 __attribute__((ext_vector_type(8)));
typedef GAS unsigned gu32;
typedef GAS unsigned long long gu64;
#define RLX_AGENT __ATOMIC_RELAXED, __HIP_MEMORY_SCOPE_AGENT
#define LDS_WAIT() asm volatile("s_waitcnt lgkmcnt(0)" ::: "memory")
#define VM_WAIT() asm volatile("s_waitcnt vmcnt(0)" ::: "memory")
__device__ __forceinline__ unsigned long long rt() { return __builtin_amdgcn_s_memrealtime(); }
__device__ __forceinline__ unsigned f2bf(float f) { unsigned u = __builtin_bit_cast(unsigned, f); return (u + 0x7fffu + ((u >> 16) & 1u)) >> 16; }
__device__ __forceinline__ unsigned pk2(float lo, float hi) { return f2bf(lo) | (f2bf(hi) << 16); }

#define XB_TMO      128
#define XB_XCNT(j)  (256  + 64 * (j))
#define XB_XSUB(j)  (1280 + 64 * (j))
#define XB_XGEN(j)  (2304 + 64 * (j))
#define XB_TOP      3328
#define XB_TOPGEN   3392
#define XCD_BAR_WORDS 3456
#define XB_SPIN_CAP (1u << 18)

__device__ __forceinline__ unsigned xb_ld(unsigned* p)              { return __hip_atomic_load(p, __ATOMIC_RELAXED, __HIP_MEMORY_SCOPE_AGENT); }
__device__ __forceinline__ unsigned xb_add(unsigned* p, unsigned v) { return __hip_atomic_fetch_add(p, v, __ATOMIC_RELAXED, __HIP_MEMORY_SCOPE_AGENT); }
__device__ __forceinline__ unsigned xb_xcc_id() { return (unsigned)__builtin_amdgcn_s_getreg((3 << 11) | 20) & 0xFu; }
#define XB_SPIN(cond, bar) do { unsigned _sp = 0; while (cond) { __builtin_amdgcn_s_sleep(1); \
    if ((++_sp & 255u) == 0u) { if (xb_ld(&(bar)[XB_TMO])) break; if (_sp > XB_SPIN_CAP) { atomicAdd(&(bar)[XB_TMO], 1u); break; } } } } while (0)

struct XcdBarrier {
    unsigned* bar; unsigned x;
    volatile LAS unsigned* st;
};

__device__ __forceinline__ XcdBarrier xcd_barrier_post(unsigned* bar, volatile LAS unsigned* st) {
    XcdBarrier b; b.bar = bar; b.x = xb_xcc_id(); b.st = st;
    if (threadIdx.x == 0) (void)xb_add(&bar[XB_XCNT(b.x)], 1u);
    return b;
}
__device__ __forceinline__ void xcd_barrier_complete(unsigned* bar, unsigned x, unsigned& nloc, unsigned& nx) {
    const unsigned G = gridDim.x * gridDim.y * gridDim.z;
    unsigned sum, cnt, mine, sp = 0u;
    for (;;) {
        sum = 0u; cnt = 0u; mine = 0u;
#pragma unroll
        for (unsigned j = 0; j < 16; ++j) { const unsigned c = xb_ld(&bar[XB_XCNT(j)]); sum += c; cnt += (c > 0u) ? 1u : 0u; mine = (j == x) ? c : mine; }
        if (sum == G) break;
        __builtin_amdgcn_s_sleep(1);
        if ((++sp & 255u) == 0u) { if (xb_ld(&bar[XB_TMO])) break; if (sp > XB_SPIN_CAP) { atomicAdd(&bar[XB_TMO], 1u); break; } }
    }
    nloc = mine > 0u ? mine : 1u; nx = cnt > 0u ? cnt : 1u;
}

__device__ __forceinline__ void xcd_barrier(const XcdBarrier& b) {
    asm volatile("s_waitcnt vmcnt(0)" ::: "memory");
    __syncthreads();
    if (threadIdx.x == 0) {
        unsigned* bar = b.bar;
        __builtin_amdgcn_s_waitcnt(0);
        unsigned nloc = b.st[0], nx = b.st[1];
        if (nloc == 0u) { xcd_barrier_complete(bar, b.x, nloc, nx); b.st[0] = nloc; b.st[1] = nx; }
        const unsigned old = xb_add(&bar[XB_XSUB(b.x)], 1u);
        const unsigned gen = old / nloc;
        if (old + 1u == (gen + 1u) * nloc) {
            __builtin_amdgcn_fence(__ATOMIC_RELEASE, "agent");
            asm volatile("s_waitcnt vmcnt(0)" ::: "memory");
            __builtin_amdgcn_fence(__ATOMIC_ACQUIRE, "agent");
            const unsigned og = xb_add(&bar[XB_TOP], 1u);
            const unsigned tg = og / nx;
            if (og + 1u == (tg + 1u) * nx) xb_add(&bar[XB_TOPGEN], 1u);
            else XB_SPIN(xb_ld(&bar[XB_TOPGEN]) == tg, bar);
            xb_add(&bar[XB_XGEN(b.x)], 1u);
            asm volatile("s_waitcnt vmcnt(0)" ::: "memory");
        } else {
            __builtin_amdgcn_fence(__ATOMIC_ACQUIRE, "agent");
            XB_SPIN(xb_ld(&bar[XB_XGEN(b.x)]) == gen, bar);
            asm volatile("s_waitcnt vmcnt(0)" ::: "memory");
        }
    }
    __syncthreads();
}
constexpr int NWAVES = 8;
constexpr int BATCH = 2, SEQ = 8192, DM = 1024, M = BATCH * SEQ, FF = 2816, DEPTH = 2;
enum { I_X = 0, I_P, I_F1N, I_F1G, I_F1U, I_F1D, I_MIXN, I_WIN, I_SINK, I_MU, I_W0, I_WUP, I_A0, I_AUP, I_GUP, I_KK, I_KA, I_RK, I_LNW, I_LNB, I_HLB, I_HNORM, I_WBR, I_WO,
       I_F2N, I_F2G, I_F2U, I_F2D, I_PLEN, I_PLEG, I_PLEP, I_FINN, N_IN };
constexpr size_t KiB = 1024, MiB = 1u << 20;
constexpr size_t WS_CTL = 0, CTL_ZERO_BYTES = 64 * KiB;
constexpr size_t WS_SS0 = 1 * MiB, WS_SS1 = 2 * MiB;
constexpr size_t WS_CBON = 3 * MiB;
constexpr size_t WS_LB = 3 * MiB + 512 * KiB;
constexpr size_t WS_W = 4 * MiB;
constexpr size_t W_F1GU = WS_W, W_F1D = W_F1GU + (size_t)5632 * 1024 * 2, W_IN = W_F1D + (size_t)1024 * 2816 * 2, W_LR = W_IN + (size_t)7680 * 1024 * 2,
                 W_BR = W_LR + (size_t)1536 * 256 * 2, W_O = W_BR + (size_t)3 * 1024 * 512 * 2, W_F2GU = W_O + (size_t)1024 * 1024 * 2, W_F2D = W_F2GU + (size_t)5632 * 1024 * 2,
                 W_PG = W_F2D + (size_t)1024 * 2816 * 2, W_PP = W_PG + (size_t)1024 * 1024 * 2, W_END = W_PP + (size_t)1024 * 256 * 2;
constexpr size_t WS_XB = 61 * MiB;
static_assert(W_END <= WS_XB, "weights fit");
constexpr size_t WS_R = 93 * MiB;
constexpr size_t R_H = WS_R;
constexpr size_t R_SIN_V = WS_R, R_SIN_R = WS_R + 16 * MiB, R_SIN_W = WS_R + 32 * MiB, R_SIN_KP = WS_R + 48 * MiB, R_SIN_KK = WS_R + 64 * MiB, R_SIN_B = WS_R + 80 * MiB;
constexpr size_t R_CV = WS_R, R_CG = WS_R + 16 * MiB, R_CH = WS_R + 32 * MiB, R_CDT = WS_R + 64 * MiB, R_CQT = WS_R + 80 * MiB, R_CS = WS_R + 200 * MiB;
constexpr size_t R_DAG_G = WS_R + 96 * MiB;
constexpr size_t R_ZR = WS_R + 112 * MiB;
constexpr size_t R_AP = WS_R + 168 * MiB;
constexpr size_t R_DAG_W = WS_R + 176 * MiB, R_DAG_A = WS_R + 192 * MiB;
constexpr size_t R_ZA = WS_R + 112 * MiB;
constexpr size_t R_YRAW = WS_R + 200 * MiB;
constexpr size_t R_Y = WS_R + 16 * MiB;
constexpr size_t R_GG = WS_R + 112 * MiB;
constexpr size_t R_MERGED = WS_R + 64 * MiB;
constexpr size_t R_PB = WS_R + 96 * MiB;
constexpr size_t R_PROJ = WS_R + 112 * MiB;
constexpr size_t R_XBALT = WS_R + 144 * MiB;
constexpr size_t R_HST = WS_R + 216 * MiB;
constexpr size_t WS_HD = 3 * MiB + 576 * KiB;
constexpr size_t WS_END = WS_R + 224 * MiB;
constexpr int CW_BAR = 4096;
constexpr int RING_OFF = 0, RING_BYTES = 131072;
constexpr int LDSCTL_OFF = 143360, MISC_OFF = LDSCTL_OFF + 320;
constexpr int LDS_BYTES = 147456;
constexpr int N_PHASES = 17 * DEPTH + 1;
#ifndef ENMASK
#define ENMASK 0x3ffff
#endif
#define EN(k) ((ENMASK >> (k)) & 1)
struct Args { const float* in[N_IN]; float* out; unsigned char* ws; int ph_lo, ph_hi; };
typedef const __attribute__((address_space(4))) unsigned char* kargp_t;
#define KP_DECL kargp_t KP_ = (kargp_t)__builtin_amdgcn_kernarg_segment_ptr(); asm volatile("" : "+s"(KP_))
#define INP(i) (*(const float* const __attribute__((address_space(4)))*)(KP_ + 8 * (i)))
typedef unsigned u32x2 __attribute__((ext_vector_type(2)));
__device__ __forceinline__ float bflo(unsigned w) { return __uint_as_float(w << 16); }
__device__ __forceinline__ float bfhi(unsigned w) { return __uint_as_float(w & 0xffff0000u); }
__device__ __forceinline__ float bf1(bf16 b) { return __uint_as_float(((unsigned)b) << 16); }
__device__ __forceinline__ float sigm(float x) { return __builtin_amdgcn_rcpf(1.0f + __builtin_amdgcn_exp2f(-1.4426950408889634f * x)); }
template <int CTRL> __device__ __forceinline__ float dppf(float x) { return __builtin_bit_cast(float, __builtin_amdgcn_mov_dpp(__builtin_bit_cast(int, x), CTRL, 0xf, 0xf, true)); }
__device__ __forceinline__ float xrow16_sum(float x) {
    auto s = __builtin_amdgcn_permlane16_swap(__float_as_uint(x), __float_as_uint(x), false, false);
    x = __uint_as_float(s[0]) + __uint_as_float(s[1]);
    auto t = __builtin_amdgcn_permlane32_swap(__float_as_uint(x), __float_as_uint(x), false, false);
    return __uint_as_float(t[0]) + __uint_as_float(t[1]);
}
__device__ __forceinline__ float wave_allsum(float x) {
    x += dppf<0xB1>(x); x += dppf<0x4E>(x); x += dppf<0x141>(x); x += dppf<0x128>(x); return xrow16_sum(x);
}
__device__ __forceinline__ float wave_allsum_slow(float v) {
#pragma unroll
    for (int o = 1; o < 64; o <<= 1) v += __shfl_xor(v, o);
    return v;
}
__device__ __forceinline__ float wave_allmax_slow(float v) {
#pragma unroll
    for (int o = 1; o < 64; o <<= 1) v = fmaxf(v, __shfl_xor(v, o));
    return v;
}

struct Frame {
    LAS unsigned char* lds;
    volatile LAS unsigned* MISC;
    gu32* ctl;
    int tid, lane, wave;
    int G;
    unsigned char* ws;
    float* x;
};
#define WSP(T, off) ((T*)(F.ws + (off)))

__device__ __forceinline__ int map_row(int map, int n0) {
    if (map == 1) return (n0 >> 7) * 256 + (n0 & 127);
    if (map == 2) return (n0 >> 7) * 256 + 128 + (n0 & 127);
    if (map == 3) return n0 < 768 ? 1792 + n0 : (n0 < 2560 ? n0 - 768 : n0);
    return n0;
}
struct CJob { const float* W; const float* g; int K, N; bf16* WT; int map, item; };
__device__ __forceinline__ void conv_load(const CJob& j, int lane, f32x4 (&v)[16], float (&sc)[16]) {
    const int nblk = j.N / 64, kb = j.item / nblk, nb = j.item % nblk, k0 = 64 * kb, n0 = 64 * nb; const int nq = (lane & 15) * 4;
#pragma unroll
    for (int i = 0; i < 16; ++i) { const int kk = 4 * i + (lane >> 4); sc[i] = j.g ? j.g[k0 + kk] : 1.0f; v[i] = __builtin_nontemporal_load((const f32x4*)(j.W + (size_t)(k0 + kk) * j.N + n0 + nq)); }
}
__device__ __forceinline__ void conv_to_lds(int lane, const f32x4 (&v)[16], const float (&sc)[16], LAS float* scr) {
    const int nq = (lane & 15) * 4;
#pragma unroll
    for (int i = 0; i < 16; ++i) { const int kk = 4 * i + (lane >> 4); LAS float* d = scr + kk * 65 + nq; d[0] = v[i].x * sc[i]; d[1] = v[i].y * sc[i]; d[2] = v[i].z * sc[i]; d[3] = v[i].w * sc[i]; }
}
__device__ __forceinline__ void conv_store(const CJob& j, int lane, const LAS float* scr) {
    const int nblk = j.N / 64, kb = j.item / nblk, nb = j.item % nblk, k0 = 64 * kb, n0 = 64 * nb; const int c = lane & 7; const int dr = map_row(j.map, n0);
#pragma unroll
    for (int q = 0; q < 8; ++q) { const int n = (lane >> 3) + 8 * q; const LAS float* s = scr + (8 * c) * 65 + n;
        v4u o; o.x = pk2(s[0 * 65], s[1 * 65]); o.y = pk2(s[2 * 65], s[3 * 65]); o.z = pk2(s[4 * 65], s[5 * 65]); o.w = pk2(s[6 * 65], s[7 * 65]);
        *(GAS v4u*)(j.WT + (size_t)(dr + n) * j.K + k0 + 8 * c) = o; }
}
template <int PART> __device__ __forceinline__ void phase_conv(Frame& F, const Args& A, int L) {
    KP_DECL;
    LAS float* scr = (LAS float*)(F.lds + RING_OFF + F.wave * 16640);
    const int gw = blockIdx.x * NWAVES + F.wave, NGW = F.G * NWAVES;
    const float* f1g = INP(I_F1G) + (size_t)L * 1024 * 2816; const float* f1u = INP(I_F1U) + (size_t)L * 1024 * 2816; const float* f1d = INP(I_F1D) + (size_t)L * 2816 * 1024;
    const float* f2g = INP(I_F2G) + (size_t)L * 1024 * 2816; const float* f2u = INP(I_F2U) + (size_t)L * 1024 * 2816; const float* f2d = INP(I_F2D) + (size_t)L * 2816 * 1024;
    const float* win = INP(I_WIN) + (size_t)L * 1024 * 7680; const float* wbr = INP(I_WBR) + (size_t)L * 3 * 512 * 1024; const float* wo = INP(I_WO) + (size_t)L * 1024 * 1024;
    const float* pg = INP(I_PLEG) + (size_t)L * 1024 * 1024; const float* pp = INP(I_PLEP) + (size_t)L * 256 * 1024;
    const float* n1 = INP(I_F1N) + L * 1024; const float* nm = INP(I_MIXN) + L * 1024; const float* n2 = INP(I_F2N) + L * 1024; const float* np = INP(I_PLEN) + L * 1024;
    constexpr int IT_FGU = 16 * 44, IT_FD = 44 * 16, IT_IN = 16 * 120, IT_BR = 8 * 16, IT_SQ = 16 * 16, IT_PP = 4 * 16;
    constexpr int NITEMS = 4 * IT_FGU + 2 * IT_FD + IT_IN + 3 * IT_BR + 2 * IT_SQ + IT_PP;
#define CONV_DECODE(it_, J) do { int r = (it_); \
        if (r < IT_FGU) { J = CJob{f1g, n1, 1024, 2816, WSP(bf16, W_F1GU), 1, r}; break; } r -= IT_FGU; \
        if (r < IT_FGU) { J = CJob{f1u, n1, 1024, 2816, WSP(bf16, W_F1GU), 2, r}; break; } r -= IT_FGU; \
        if (r < IT_FD)  { J = CJob{f1d, nullptr, 2816, 1024, WSP(bf16, W_F1D), 0, r}; break; } r -= IT_FD; \
        if (r < IT_IN)  { J = CJob{win, nm, 1024, 7680, WSP(bf16, W_IN), 3, r}; break; } r -= IT_IN; \
        if (r < 3 * IT_BR) { const int b_ = r / IT_BR; J = CJob{wbr + (size_t)b_ * 512 * 1024, nullptr, 512, 1024, WSP(bf16, W_BR) + (size_t)b_ * 1024 * 512, 0, r % IT_BR}; break; } r -= 3 * IT_BR; \
        if (r < IT_SQ)  { J = CJob{wo, nullptr, 1024, 1024, WSP(bf16, W_O), 0, r}; break; } r -= IT_SQ; \
        if (r < IT_FGU) { J = CJob{f2g, n2, 1024, 2816, WSP(bf16, W_F2GU), 1, r}; break; } r -= IT_FGU; \
        if (r < IT_FGU) { J = CJob{f2u, n2, 1024, 2816, WSP(bf16, W_F2GU), 2, r}; break; } r -= IT_FGU; \
        if (r < IT_FD)  { J = CJob{f2d, nullptr, 2816, 1024, WSP(bf16, W_F2D), 0, r}; break; } r -= IT_FD; \
        if (r < IT_SQ)  { J = CJob{pg, np, 1024, 1024, WSP(bf16, W_PG), 0, r}; break; } r -= IT_SQ; \
        J = CJob{pp, nullptr, 256, 1024, WSP(bf16, W_PP), 0, r}; } while (0)
    constexpr int NA = 2 * IT_FGU + IT_FD + IT_IN;
    const int first = (PART == 0) ? gw : NA + ((int)blockIdx.x - F.G / 2) * NWAVES + F.wave, stride = (PART == 0) ? NGW : (F.G - F.G / 2) * NWAVES, hi_ = (PART == 0) ? NA : NITEMS;
    { CJob cur{}, nxt{}; f32x4 v[16]; float scv[16];
      if (first < hi_) { CONV_DECODE(first, cur); conv_load(cur, F.lane, v, scv); }
      for (int it = first; it < hi_; it += stride) {
          conv_to_lds(F.lane, v, scv, scr);
          const bool has = it + stride < hi_;
          if (has) { CONV_DECODE(it + stride, nxt); conv_load(nxt, F.lane, v, scv); }
          LDS_WAIT(); asm volatile("" ::: "memory");
          conv_store(cur, F.lane, scr);
          LDS_WAIT(); asm volatile("" ::: "memory");
          cur = nxt; } }
#undef CONV_DECODE
    if (PART != 0) return;
    const float* wup = INP(I_WUP) + (size_t)L * 64 * 512; const float* aup = INP(I_AUP) + (size_t)L * 64 * 512; const float* gup = INP(I_GUP) + (size_t)L * 128 * 512;
    bf16* wlr = WSP(bf16, W_LR);
    const int gt = blockIdx.x * (NWAVES * 64) + F.tid, NGT = F.G * NWAVES * 64;
    for (int e = gt; e < 1536 * 256; e += NGT) { const int n = e >> 8, k = e & 255; const int grp = n >> 9, c = n & 511; float v = 0.f;
        if (grp == 0) { if (k < 64) v = wup[k * 512 + c]; } else if (grp == 1) { if (k >= 64 && k < 128) v = aup[(k - 64) * 512 + c]; } else { if (k >= 128) v = gup[(k - 128) * 512 + c]; }
        wlr[e] = (bf16)f2bf(v); }
    if (gt < 512) { const float a0 = INP(I_HLB)[gt], a1 = INP(I_HLB)[512 + gt]; const float mx = fmaxf(a0, a1); const float e0 = __expf(a0 - mx), e1 = __expf(a1 - mx);
        float lb = (L == 0) ? 0.f : e1 / (e0 + e1); lb = fminf(fmaxf(lb, 0.f), 1.0f - 1e-6f); WSP(float, WS_LB)[gt] = lb; }
    if (L == 0) {
        const float* xin = INP(I_X); bf16* xb = WSP(bf16, WS_XB); float* ss = WSP(float, WS_SS0);
        for (int m0 = gw; m0 < M; m0 += 2 * NGW) {
            f32x4 v[2][4];
#pragma unroll
            for (int k = 0; k < 2; ++k) { const int m = (m0 + k * NGW < M) ? m0 + k * NGW : m0; const GAS f32x4* xr = (const GAS f32x4*)(xin + (size_t)m * DM) + F.lane;
#pragma unroll
                for (int j = 0; j < 4; ++j) v[k][j] = __builtin_nontemporal_load((const f32x4*)(xr + 64 * j)); }
#pragma unroll
            for (int k = 0; k < 2; ++k) { const int m = m0 + k * NGW; if (m >= M) break;
                GAS unsigned long long* o8 = (GAS unsigned long long*)(xb + (size_t)m * DM) + F.lane; float s = 0.f;
#pragma unroll
                for (int j = 0; j < 4; ++j) { const f32x4 vv = v[k][j]; s += (vv.x * vv.x + vv.y * vv.y) + (vv.z * vv.z + vv.w * vv.w);
                    o8[64 * j] = (unsigned long long)pk2(vv.x, vv.y) | ((unsigned long long)pk2(vv.z, vv.w) << 32); }
                s = wave_allsum_slow(s);
                if (F.lane < 16) ss[(size_t)m * 16 + F.lane] = (F.lane == 0) ? s : 0.f; } }
    }
}
__device__ __forceinline__ void conv_p(Frame& F, const Args& A, int L) {
    KP_DECL;
    const float* p = INP(I_P) + (size_t)L * M * 256; bf16* pb = WSP(bf16, R_PB);
    const int gt = blockIdx.x * (NWAVES * 64) + F.tid, NGT = F.G * NWAVES * 64;
    for (int e0 = gt; e0 < M * 256 / 8; e0 += 4 * NGT) {
        f32x4 a[4], b[4];
#pragma unroll
        for (int k = 0; k < 4; ++k) { const int e = e0 + k * NGT; if (e < M * 256 / 8) { a[k] = __builtin_nontemporal_load((const f32x4*)(p + (size_t)e * 8)); b[k] = __builtin_nontemporal_load((const f32x4*)(p + (size_t)e * 8 + 4)); } }
#pragma unroll
        for (int k = 0; k < 4; ++k) { const int e = e0 + k * NGT; if (e < M * 256 / 8) {
            v4u o; o.x = pk2(a[k].x, a[k].y); o.y = pk2(a[k].z, a[k].w); o.z = pk2(b[k].x, b[k].y); o.w = pk2(b[k].z, b[k].w); *(v4u*)(pb + (size_t)e * 8) = o; } } }
}

__device__ __forceinline__ void phase_rprep1(Frame& F, const Args& A, int L) {
    KP_DECL;
    const bf16* zr = WSP(bf16, R_ZR); bf16* ap = WSP(bf16, R_AP); const float* mu = INP(I_MU) + L * 1792 + 1536;
    const int gt = blockIdx.x * (NWAVES * 64) + F.tid, NGT = F.G * NWAVES * 64;
    for (int e = gt; e < M * 32; e += NGT) { const int row = e >> 5, c0 = (e & 31) * 8; const int tl = row & (SEQ - 1);
        const v4u zc = *(const v4u*)(zr + (size_t)row * 1792 + 1536 + c0); v4u zp = (v4u){0u, 0u, 0u, 0u};
        if (tl != 0) zp = *(const v4u*)(zr + (size_t)(row - 1) * 1792 + 1536 + c0);
        float o[8];
#pragma unroll
        for (int i = 0; i < 4; ++i) { const unsigned wc_ = zc[i], wp_ = zp[i];
            const float c_lo = bflo(wc_), c_hi = bfhi(wc_), p_lo = bflo(wp_), p_hi = bfhi(wp_);
            const float m0 = mu[c0 + 2 * i], m1 = mu[c0 + 2 * i + 1];
            o[2 * i] = c_lo + m0 * (p_lo - c_lo); o[2 * i + 1] = c_hi + m1 * (p_hi - c_hi); }
#pragma unroll
        for (int i = 0; i < 8; ++i) { if (c0 < 64) o[i] = 2.0f * sigm(2.0f * o[i]) - 1.0f; else if (c0 >= 128) o[i] = sigm(o[i]); }
        v4u w; w.x = pk2(o[0], o[1]); w.y = pk2(o[2], o[3]); w.z = pk2(o[4], o[5]); w.w = pk2(o[6], o[7]);
        *(v4u*)(ap + (size_t)row * 256 + c0) = w; }
}
typedef float f32x16 __attribute__((ext_vector_type(16)));
__device__ __forceinline__ unsigned cvtpk(float lo, float hi) { return pg8::cvtpk_s(lo, hi); }
constexpr int LDP = 72;
__device__ __forceinline__ f32x4 mm16_k64(const LAS bf16* X, const LAS bf16* YT, int m0, int n0, int lane, f32x4 acc) {
    const int r = lane & 15, g = lane >> 4;
#pragma unroll
    for (int ks = 0; ks < 2; ++ks) { const bf16x8 a = *(const LAS bf16x8*)(X + (m0 + r) * LDP + ks * 32 + 8 * g); const bf16x8 b = *(const LAS bf16x8*)(YT + (n0 + r) * LDP + ks * 32 + 8 * g);
        acc = __builtin_amdgcn_mfma_f32_16x16x32_bf16(a, b, acc, 0, 0, 0); }
    return acc;
}
constexpr int RC_MAT = 64 * LDP * 2;
constexpr int RC_BH = 0, RC_KH = RC_MAT, RC_PC = 2 * RC_MAT, RC_RC = 3 * RC_MAT, RC_PT = 4 * RC_MAT, RC_AKP = 5 * RC_MAT, RC_RT = 6 * RC_MAT, RC_VT = 7 * RC_MAT;
constexpr int RC_XR = 8 * RC_MAT;
constexpr int RC_TI = 10 * RC_MAT;
constexpr int RC_ABP = 11 * RC_MAT;
constexpr int RC_TT = RC_ABP + 16384;
constexpr int RC_PS = RC_TT + 16384;
constexpr int RC_GC = RC_PS + 4096;
constexpr int RC_PAR = RC_GC + 256;
constexpr int RC_END = RC_PAR + 6 * 64 * 4;
static_assert(RC_END <= LDSCTL_OFF, "rwkv pre-pass LDS");
constexpr int RC_ZT = RC_PC;
constexpr int RC_KBT = RC_BH;
__device__ __forceinline__ float shx(float v, int m) { return __shfl_xor(v, m); }
__device__ __forceinline__ float sum8(float v) { v += dppf<0xB1>(v); v += dppf<0x4E>(v); v += dppf<0x141>(v); return v; }
__device__ __forceinline__ float sum16(float v) { v = sum8(v); v += dppf<0x128>(v); return v; }
__device__ __forceinline__ void phase_rchunk_pre(Frame& F, const Args& A, int L) {
    KP_DECL;
    const bf16* zr = WSP(bf16, R_ZR); const bf16* dw = WSP(bf16, R_DAG_W); const bf16* da = WSP(bf16, R_DAG_A);
    const float* mu = INP(I_MU) + L * 1792; const float* k_k = INP(I_KK) + L * 512; const float* k_a = INP(I_KA) + L * 512; const float* r_k = INP(I_RK) + L * 512;
    float* cbon = WSP(float, WS_CBON); bf16* gV = WSP(bf16, R_CV);
    LAS unsigned char* lds = F.lds;
    const int t = F.tid >> 3, cg = F.tid & 7, c0 = cg * 8;
    v4u n_cr, n_ck, n_cv, n_pr, n_pk, n_pv, n_ww, n_aa;
#define RPRE_LOAD(it_) do { const int bh_ = (it_) >> 7, ck2_ = (it_) & 127; const int row_ = (bh_ >> 3) * SEQ + ck2_ * 64 + t, ch_ = (bh_ & 7) * 64 + c0; const bf16* zc_ = zr + (size_t)row_ * 1792 + ch_; \
        n_cr = *(const v4u*)zc_; n_ck = *(const v4u*)(zc_ + 512); n_cv = *(const v4u*)(zc_ + 1024); n_pr = (v4u){0u,0u,0u,0u}; n_pk = n_pr; n_pv = n_pr; \
        if (ck2_ * 64 + t != 0) { n_pr = *(const v4u*)(zc_ - 1792); n_pk = *(const v4u*)(zc_ - 1792 + 512); n_pv = *(const v4u*)(zc_ - 1792 + 1024); } \
        n_ww = *(const v4u*)(dw + (size_t)row_ * 512 + ch_); n_aa = *(const v4u*)(da + (size_t)row_ * 512 + ch_); } while (0)
#define RPRE_ITEM(s_) (((((s_) >> 3) >> 7) * 8 + ((s_) & 7)) * 128 + (((s_) >> 3) & 127))
    if ((int)blockIdx.x < 2048) RPRE_LOAD(RPRE_ITEM((int)blockIdx.x));
    int h_par = -1; LAS float* PAR = (LAS float*)(lds + RC_PAR);
    for (int slot = blockIdx.x; slot < 2048; slot += F.G) { const int item = RPRE_ITEM(slot);
        const int bh = item >> 7, ck = item & 127, b = bh >> 3, h = bh & 7; const int row = b * SEQ + ck * 64 + t, ch = h * 64 + c0;
        if (h != h_par) { h_par = h;
            if (F.tid < 384) { const int a_ = F.tid >> 6, c_ = F.tid & 63; PAR[F.tid] = (a_ < 3) ? mu[a_ * 512 + h * 64 + c_] : (a_ == 3 ? k_k[h * 64 + c_] : (a_ == 4 ? k_a[h * 64 + c_] : r_k[h * 64 + c_])); }
            __syncthreads(); }
        float r_[8], kp_[8], kk_[8], bb_[8], lw_[8];
        { float v_[8]; const v4u cr = n_cr, ck_ = n_ck, cv = n_cv, pr = n_pr, pk = n_pk, pv = n_pv, ww = n_ww, aa = n_aa;
          float ssq = 0.f, cb = 0.f;
#pragma unroll
          for (int i = 0; i < 8; ++i) { const int q = i >> 1; const bool hi = i & 1;
              const float crf = hi ? bfhi(cr[q]) : bflo(cr[q]), ckf = hi ? bfhi(ck_[q]) : bflo(ck_[q]), cvf = hi ? bfhi(cv[q]) : bflo(cv[q]);
              const float prf = hi ? bfhi(pr[q]) : bflo(pr[q]), pkf = hi ? bfhi(pk[q]) : bflo(pk[q]), pvf = hi ? bfhi(pv[q]) : bflo(pv[q]);
              const float w = hi ? bfhi(ww[q]) : bflo(ww[q]), a = hi ? bfhi(aa[q]) : bflo(aa[q]);
              const float r = crf + PAR[c0 + i] * (prf - crf), k = ckf + PAR[64 + c0 + i] * (pkf - ckf), v = cvf + PAR[128 + c0 + i] * (pvf - cvf);
              const float kk = k * PAR[192 + c0 + i]; ssq += kk * kk; const float kp = k * (1.0f + (a - 1.0f) * PAR[256 + c0 + i]);
              r_[i] = r; kp_[i] = kp; kk_[i] = kk; bb_[i] = a; v_[i] = v; lw_[i] = __logf(w); cb += r * kp * PAR[320 + c0 + i]; }
          ssq = sum8(ssq); cb = sum8(cb);
          const float inv = __builtin_amdgcn_rsqf(fmaxf(ssq, 1e-24f));
#pragma unroll
          for (int i = 0; i < 8; ++i) { kk_[i] *= inv; bb_[i] *= kk_[i]; }
          if (cg == 0) cbon[(size_t)row * 8 + h] = cb;
          if (slot + F.G < 2048) RPRE_LOAD(RPRE_ITEM(slot + F.G));
          v4u vo; vo.x = pk2(v_[0], v_[1]); vo.y = pk2(v_[2], v_[3]); vo.z = pk2(v_[4], v_[5]); vo.w = pk2(v_[6], v_[7]); *(v4u*)(gV + (size_t)row * 512 + ch) = vo;
          { LAS bf16* VT = (LAS bf16*)(lds + RC_VT);
#pragma unroll
            for (int i = 0; i < 8; ++i) VT[(c0 + i) * LDP + t] = (bf16)f2bf(v_[i]); } }
        { LAS float* LW = (LAS float*)(lds + RC_ABP);
#pragma unroll
          for (int i = 0; i < 8; ++i) LW[t * 64 + c0 + i] = lw_[i];
          __syncthreads();
          { const int cc = F.tid & 63, sg = F.tid >> 6; float loc[8]; float run = 0.f;
            LAS float* SG = (LAS float*)(lds + RC_PS);
#pragma unroll
            for (int e = 0; e < 8; ++e) { run += LW[(8 * sg + e) * 64 + cc]; loc[e] = run; }
            SG[sg * 64 + cc] = run;
            __syncthreads();
            float pre = 0.f;
#pragma unroll
            for (int q = 0; q < 8; ++q) { const float tv = SG[q * 64 + cc]; if (q < sg) pre += tv; }
#pragma unroll
            for (int e = 0; e < 8; ++e) LW[(8 * sg + e) * 64 + cc] = pre + loc[e]; }
          __syncthreads();
          LAS bf16* Bh = (LAS bf16*)(lds + RC_BH); LAS bf16* Kh = (LAS bf16*)(lds + RC_KH); LAS bf16* Pc = (LAS bf16*)(lds + RC_PC); LAS bf16* Rc = (LAS bf16*)(lds + RC_RC);
          LAS bf16* PT = (LAS bf16*)(lds + RC_PT); LAS bf16* Rt = (LAS bf16*)(lds + RC_RT); LAS bf16* BhT = (LAS bf16*)(lds + RC_XR); LAS float* GC = (LAS float*)(lds + RC_GC);
          float bh_[8], kh_[8], pc_[8], rc_[8], rt_[8];
#pragma unroll
          for (int i = 0; i < 8; ++i) { const float Lt = LW[t * 64 + c0 + i], Lp = (t == 0) ? 0.f : LW[(t - 1) * 64 + c0 + i], LC = LW[63 * 64 + c0 + i];
              const float e1 = __expf(LC - Lt); bh_[i] = bb_[i] * e1; kh_[i] = kp_[i] * e1; pc_[i] = kk_[i] * __expf(Lp - LC); rc_[i] = r_[i] * __expf(Lt - LC); rt_[i] = r_[i] * __expf(Lt);
              PT[(c0 + i) * LDP + t] = (bf16)f2bf(kk_[i] * __expf(Lp)); BhT[(c0 + i) * LDP + t] = (bf16)f2bf(bh_[i]); if (t == 63) GC[c0 + i] = __expf(LC); }
          v4u o; o.x = pk2(bh_[0], bh_[1]); o.y = pk2(bh_[2], bh_[3]); o.z = pk2(bh_[4], bh_[5]); o.w = pk2(bh_[6], bh_[7]); *(LAS v4u*)(Bh + t * LDP + c0) = o;
          o.x = pk2(kh_[0], kh_[1]); o.y = pk2(kh_[2], kh_[3]); o.z = pk2(kh_[4], kh_[5]); o.w = pk2(kh_[6], kh_[7]); *(LAS v4u*)(Kh + t * LDP + c0) = o;
          o.x = pk2(pc_[0], pc_[1]); o.y = pk2(pc_[2], pc_[3]); o.z = pk2(pc_[4], pc_[5]); o.w = pk2(pc_[6], pc_[7]); *(LAS v4u*)(Pc + t * LDP + c0) = o;
          o.x = pk2(rc_[0], rc_[1]); o.y = pk2(rc_[2], rc_[3]); o.z = pk2(rc_[4], rc_[5]); o.w = pk2(rc_[6], rc_[7]); *(LAS v4u*)(Rc + t * LDP + c0) = o;
          o.x = pk2(rt_[0], rt_[1]); o.y = pk2(rt_[2], rt_[3]); o.z = pk2(rt_[4], rt_[5]); o.w = pk2(rt_[6], rt_[7]); *(LAS v4u*)(Rt + t * LDP + c0) = o;
          __syncthreads(); }
        f32x4 akr[4];
        { const int r16 = F.lane & 15, g4 = F.lane >> 4; const int xsel = F.wave >> 2, m0 = (F.wave & 3) * 16;
          const LAS bf16* X = (const LAS bf16*)(lds + (xsel ? RC_KH : RC_BH)) + (m0 + r16) * LDP + 8 * g4;
          const bf16x8 xa0 = *(const LAS bf16x8*)X, xa1 = *(const LAS bf16x8*)(X + 32);
          f32x4 acc[2][4];
#pragma unroll
          for (int ys = 0; ys < 2; ++ys)
#pragma unroll
              for (int nt = 0; nt < 4; ++nt) { const LAS bf16* Y = (const LAS bf16*)(lds + (ys ? RC_RC : RC_PC)) + (16 * nt + r16) * LDP + 8 * g4;
                  const bf16x8 b0 = *(const LAS bf16x8*)Y, b1 = *(const LAS bf16x8*)(Y + 32);
                  acc[ys][nt] = __builtin_amdgcn_mfma_f32_16x16x32_bf16(xa0, b0, (f32x4){0.f, 0.f, 0.f, 0.f}, 0, 0, 0); acc[ys][nt] = __builtin_amdgcn_mfma_f32_16x16x32_bf16(xa1, b1, acc[ys][nt], 0, 0, 0); }
#pragma unroll
          for (int nt = 0; nt < 4; ++nt) { const int tt = 16 * nt + r16; const int i0 = m0 + 4 * g4; float v0[4], v1[4];
#pragma unroll
              for (int rg = 0; rg < 4; ++rg) { v0[rg] = (i0 + rg < tt) ? acc[0][nt][rg] : 0.f; v1[rg] = (i0 + rg <= tt) ? acc[1][nt][rg] : 0.f; }
              if (xsel == 0) {
#pragma unroll
                  for (int rg = 0; rg < 4; ++rg) ((LAS float*)(lds + RC_ABP))[(i0 + rg) * 64 + tt] = v0[rg];
                  u32x2 o; o.x = pk2(v1[0], v1[1]); o.y = pk2(v1[2], v1[3]); *(LAS u32x2*)((LAS bf16*)(lds + RC_XR) + (64 + tt) * LDP + i0) = o; }
              else {
#pragma unroll
                  for (int rg = 0; rg < 4; ++rg) ((LAS bf16*)(lds + RC_AKP))[(i0 + rg) * LDP + tt] = (bf16)f2bf(v0[rg]);
                  akr[nt] = (f32x4){v1[0], v1[1], v1[2], v1[3]}; } }
          __syncthreads(); }
        { const LAS float* AB = (const LAS float*)(lds + RC_ABP); LAS float* TT = (LAS float*)(lds + RC_TT); LAS float* PS = (LAS float*)(lds + RC_PS);
          if (F.tid < 64) { const int a = F.tid >> 4, e = F.tid & 15; const LAS float* Aa = AB + (16 * a) * 64 + 16 * a; float x[16];
#pragma unroll
              for (int r = 15; r >= 0; --r) { float acc = (r == e) ? 1.0f : 0.f;
#pragma unroll
                  for (int j = r + 1; j < 16; ++j) acc = __builtin_fmaf(-Aa[r * 64 + j], x[j], acc);
                  x[r] = acc; }
#pragma unroll
              for (int r = 0; r < 16; ++r) TT[(16 * a + r) * 64 + 16 * a + e] = x[r]; }
          __syncthreads();
#pragma unroll 1
          for (int d = 1; d < 4; ++d) { const int nel = (4 - d) * 256;
              for (int el = F.tid; el < nel; el += NWAVES * 64) { const int a = el >> 8, r = (el >> 4) & 15, c = el & 15, b = a + d; float acc = 0.f;
                  for (int cc = a + 1; cc <= b; ++cc) { const LAS float* ar = AB + (16 * a + r) * 64 + 16 * cc; const LAS float* tc = TT + (16 * cc) * 64 + 16 * b + c;
#pragma unroll
                      for (int j = 0; j < 16; ++j) acc = __builtin_fmaf(ar[j], tc[j * 64], acc); }
                  PS[el] = acc; }
              __syncthreads();
              for (int el = F.tid; el < nel; el += NWAVES * 64) { const int a = el >> 8, r = (el >> 4) & 15, c = el & 15, b = a + d; float acc = 0.f; const LAS float* dr = TT + (16 * a + r) * 64 + 16 * a; const LAS float* sc = PS + (a << 8) + c;
#pragma unroll
                  for (int j = 0; j < 16; ++j) acc = __builtin_fmaf(-dr[j], sc[j * 16], acc);
                  TT[(16 * a + r) * 64 + 16 * b + c] = acc; }
              __syncthreads(); }
          { LAS bf16* TI = (LAS bf16*)(lds + RC_TI); float o[8];
#pragma unroll
            for (int i = 0; i < 8; ++i) o[i] = ((c0 + i) >> 4) >= (t >> 4) ? TT[t * 64 + c0 + i] : 0.f;
            v4u w; w.x = pk2(o[0], o[1]); w.y = pk2(o[2], o[3]); w.z = pk2(o[4], o[5]); w.w = pk2(o[6], o[7]); *(LAS v4u*)(TI + t * LDP + c0) = w; }
          __syncthreads();
          { const int r16 = F.lane & 15, g4 = F.lane >> 4; const int m0 = (F.wave & 3) * 16, cb0 = (F.wave >> 2) * 64;
            const LAS bf16* X = (const LAS bf16*)(lds + RC_TI) + (m0 + r16) * LDP + 8 * g4; const bf16x8 xa0 = *(const LAS bf16x8*)X, xa1 = *(const LAS bf16x8*)(X + 32);
            f32x4 zc[4];
#pragma unroll
            for (int nt = 0; nt < 4; ++nt) { const LAS bf16* Y = (const LAS bf16*)(lds + RC_XR) + (cb0 + 16 * nt + r16) * LDP + 8 * g4; const bf16x8 b0 = *(const LAS bf16x8*)Y, b1 = *(const LAS bf16x8*)(Y + 32);
                zc[nt] = __builtin_amdgcn_mfma_f32_16x16x32_bf16(xa0, b0, (f32x4){0.f, 0.f, 0.f, 0.f}, 0, 0, 0); zc[nt] = __builtin_amdgcn_mfma_f32_16x16x32_bf16(xa1, b1, zc[nt], 0, 0, 0); }
#pragma unroll
            for (int nt = 0; nt < 4; ++nt) { u32x2 o; o.x = pk2(zc[nt][0], zc[nt][1]); o.y = pk2(zc[nt][2], zc[nt][3]); *(LAS u32x2*)((LAS bf16*)(lds + RC_ZT) + (cb0 + 16 * nt + r16) * LDP + m0 + 4 * g4) = o; } } }
        __syncthreads();
        { const int r16 = F.lane & 15, g4 = F.lane >> 4; const int xsel = F.wave >> 2, m0 = (F.wave & 3) * 16, mm = m0 + 4 * g4;
          bf16* gG = WSP(bf16, R_CG) + (size_t)item * 4096; bf16* gQ = WSP(bf16, R_CQT) + (size_t)item * 4096; bf16* gD = WSP(bf16, R_CDT) + (size_t)item * 4096;
          const LAS float* GC = (const LAS float*)(lds + RC_GC);
          const LAS bf16* X = (const LAS bf16*)(lds + (xsel ? RC_AKP : RC_PT)) + (m0 + r16) * LDP + 8 * g4;
          const bf16x8 xa0 = *(const LAS bf16x8*)X, xa1 = *(const LAS bf16x8*)(X + 32);
          f32x4 acc[2][4];
#pragma unroll
          for (int ys = 0; ys < 2; ++ys)
#pragma unroll
              for (int nt = 0; nt < 4; ++nt) { const LAS bf16* Y = (const LAS bf16*)(lds + RC_ZT) + (64 * ys + 16 * nt + r16) * LDP + 8 * g4;
                  const bf16x8 b0 = *(const LAS bf16x8*)Y, b1 = *(const LAS bf16x8*)(Y + 32);
                  acc[ys][nt] = __builtin_amdgcn_mfma_f32_16x16x32_bf16(xa0, b0, (f32x4){0.f, 0.f, 0.f, 0.f}, 0, 0, 0); acc[ys][nt] = __builtin_amdgcn_mfma_f32_16x16x32_bf16(xa1, b1, acc[ys][nt], 0, 0, 0); }
#pragma unroll
          for (int nt = 0; nt < 4; ++nt) { const int nn = 16 * nt + r16;
              if (xsel == 0) {
                  { const int i2 = nn >> 5, rr = nn & 31, kt = mm >> 5, sx_ = (mm >> 4) & 1, qq = mm & 15, hh = (qq >> 2) & 1, jj0 = (qq >> 3) << 2;
                    float gv[4];
#pragma unroll
                    for (int rg = 0; rg < 4; ++rg) gv[rg] = ((mm + rg) == nn ? GC[nn] : 0.f) - acc[0][nt][rg];
                    u32x2 o; o.x = pk2(gv[0], gv[1]); o.y = pk2(gv[2], gv[3]); *(u32x2*)(gG + ((((i2 * 2 + kt) * 2 + sx_) * 64 + rr + 32 * hh) * 8 + jj0)) = o; }
                  { const LAS bf16* Rt = (const LAS bf16*)(lds + RC_RT); const u32x2 rv = *(const LAS u32x2*)(Rt + nn * LDP + mm);
                    u32x2 o; o.x = pk2(bflo(rv.x) - acc[1][nt][0], bfhi(rv.x) - acc[1][nt][1]); o.y = pk2(bflo(rv.y) - acc[1][nt][2], bfhi(rv.y) - acc[1][nt][3]); *(u32x2*)(gQ + nn * 64 + mm) = o; }
              } else {
                  { const LAS bf16* Kh = (const LAS bf16*)(lds + RC_KH); float kv[4];
#pragma unroll
                    for (int rg = 0; rg < 4; ++rg) kv[rg] = bf1(Kh[(mm + rg) * LDP + nn]) - acc[0][nt][rg];
                    u32x2 o; o.x = pk2(kv[0], kv[1]); o.y = pk2(kv[2], kv[3]); *(LAS u32x2*)((LAS bf16*)(lds + RC_KBT) + nn * LDP + mm) = o; }
                  { float dv[4];
#pragma unroll
                    for (int rg = 0; rg < 4; ++rg) dv[rg] = akr[nt][rg] - acc[1][nt][rg];
                    u32x2 o; o.x = pk2(dv[0], dv[1]); o.y = pk2(dv[2], dv[3]); *(u32x2*)(gD + nn * 64 + mm) = o; } } }
          __syncthreads();
          bf16* gH = WSP(bf16, R_CH) + (size_t)item * 4096;
#pragma unroll
          for (int q = 0; q < 2; ++q) { const int id = F.wave * 2 + q, m0 = (id >> 2) * 16, n0 = (id & 3) * 16;
              const f32x4 acc = mm16_k64((const LAS bf16*)(lds + RC_VT), (const LAS bf16*)(lds + RC_KBT), m0, n0, F.lane, (f32x4){0.f, 0.f, 0.f, 0.f});
              const int kq = n0 + r16, vv = m0 + 4 * g4;
              const int i2 = kq >> 5, kl = kq & 31, rg16 = (kl & 3) | ((kl >> 3) << 2), hh = (kl >> 2) & 1, j2 = vv >> 5;
              bf16* hq_ = gH + j2 * 2048 + ((vv & 31) + 32 * hh) * 32 + i2 * 16 + rg16;
#pragma unroll
              for (int rg = 0; rg < 4; ++rg) hq_[32 * rg] = (bf16)f2bf(acc[rg]); }
          __syncthreads(); }
    }
}
__device__ __forceinline__ void rchunk_seq(Frame& F, int wid) {
    const int bh = wid >> 1, j = wid & 1; const int r32 = F.lane & 31, hh = F.lane >> 5;
    const bf16* gG = WSP(bf16, R_CG) + (size_t)bh * 128 * 4096; const bf16* gH = WSP(bf16, R_CH) + (size_t)bh * 128 * 4096 + j * 2048 + F.lane * 32; bf16* gS = WSP(bf16, R_CS) + (size_t)bh * 128 * 4096;
    f32x16 x0, x1;
#pragma unroll
    for (int i = 0; i < 16; ++i) { x0[i] = 0.f; x1[i] = 0.f; }
    bf16x8 gA[8], gB[8]; v4u hA[4], hB[4];
#define RS_LOAD(G_, H_, cc) do { const int c_ = ((cc) < 128) ? (cc) : 127; _Pragma("unroll") for (int q = 0; q < 8; ++q) G_[q] = *(const bf16x8*)(gG + (size_t)c_ * 4096 + (q * 64 + F.lane) * 8); \
        _Pragma("unroll") for (int q = 0; q < 4; ++q) H_[q] = *(const v4u*)(gH + (size_t)c_ * 4096 + 8 * q); } while (0)
#define RS_STEP(G_, H_, cc) do { \
        f32x16 h0, h1; \
        _Pragma("unroll") for (int q = 0; q < 4; ++q) { h0[2 * q] = bflo(H_[0][q]); h0[2 * q + 1] = bfhi(H_[0][q]); h0[8 + 2 * q] = bflo(H_[1][q]); h0[8 + 2 * q + 1] = bfhi(H_[1][q]); \
                                                         h1[2 * q] = bflo(H_[2][q]); h1[2 * q + 1] = bfhi(H_[2][q]); h1[8 + 2 * q] = bflo(H_[3][q]); h1[8 + 2 * q + 1] = bfhi(H_[3][q]); } \
        unsigned xb0[8], xb1[8]; \
        _Pragma("unroll") for (int q = 0; q < 8; ++q) { xb0[q] = cvtpk(x0[2 * q], x0[2 * q + 1]); xb1[q] = cvtpk(x1[2 * q], x1[2 * q + 1]); } \
        { bf16* sp = gS + (size_t)(cc) * 4096 + (32 * j + r32) * 64 + 8 * hh;     \
          _Pragma("unroll") for (int mq = 0; mq < 2; ++mq) { \
              { auto s0 = __builtin_amdgcn_permlane32_swap(xb0[4 * mq], xb0[4 * mq + 2], false, false); auto s1 = __builtin_amdgcn_permlane32_swap(xb0[4 * mq + 1], xb0[4 * mq + 3], false, false); \
                v4u o; o.x = s0[0]; o.y = s1[0]; o.z = s0[1]; o.w = s1[1]; *(v4u*)(sp + 16 * mq) = o; } \
              { auto s0 = __builtin_amdgcn_permlane32_swap(xb1[4 * mq], xb1[4 * mq + 2], false, false); auto s1 = __builtin_amdgcn_permlane32_swap(xb1[4 * mq + 1], xb1[4 * mq + 3], false, false); \
                v4u o; o.x = s0[0]; o.y = s1[0]; o.z = s0[1]; o.w = s1[1]; *(v4u*)(sp + 32 + 16 * mq) = o; } } } \
        const bf16x8 b00 = __builtin_bit_cast(bf16x8, (v4u){xb0[0], xb0[1], xb0[2], xb0[3]}), b01 = __builtin_bit_cast(bf16x8, (v4u){xb0[4], xb0[5], xb0[6], xb0[7]}); \
        const bf16x8 b10 = __builtin_bit_cast(bf16x8, (v4u){xb1[0], xb1[1], xb1[2], xb1[3]}), b11 = __builtin_bit_cast(bf16x8, (v4u){xb1[4], xb1[5], xb1[6], xb1[7]}); \
        h0 = __builtin_amdgcn_mfma_f32_32x32x16_bf16(G_[0], b00, h0, 0, 0, 0); h1 = __builtin_amdgcn_mfma_f32_32x32x16_bf16(G_[4], b00, h1, 0, 0, 0); \
        h0 = __builtin_amdgcn_mfma_f32_32x32x16_bf16(G_[1], b01, h0, 0, 0, 0); h1 = __builtin_amdgcn_mfma_f32_32x32x16_bf16(G_[5], b01, h1, 0, 0, 0); \
        h0 = __builtin_amdgcn_mfma_f32_32x32x16_bf16(G_[2], b10, h0, 0, 0, 0); h1 = __builtin_amdgcn_mfma_f32_32x32x16_bf16(G_[6], b10, h1, 0, 0, 0); \
        h0 = __builtin_amdgcn_mfma_f32_32x32x16_bf16(G_[3], b11, h0, 0, 0, 0); h1 = __builtin_amdgcn_mfma_f32_32x32x16_bf16(G_[7], b11, h1, 0, 0, 0); \
        x0 = h0; x1 = h1; RS_LOAD(G_, H_, (cc) + 2); } while (0)
    RS_LOAD(gA, hA, 0); RS_LOAD(gB, hB, 1);
    for (int c = 0; c < 128; c += 2) { RS_STEP(gA, hA, c); RS_STEP(gB, hB, c + 1); }
#undef RS_LOAD
#undef RS_STEP
}
constexpr int RO_SX = 0, RO_QT = RC_MAT, RO_DT = 2 * RC_MAT, RO_VT = 3 * RC_MAT, RO_Y = 4 * RC_MAT, RO_HALF = RO_Y + 64 * 68 * 4;
constexpr int RO_PAR = 2 * RO_HALF;
static_assert(RO_PAR + 4096 <= LDSCTL_OFF, "rwkv output pass LDS (parameters)");
static_assert(2 * RO_HALF <= LDSCTL_OFF, "rwkv output pass LDS");
__device__ __forceinline__ void phase_rchunk_out(Frame& F, const Args& A, int L) {
    KP_DECL;
    const float* lnw = INP(I_LNW) + L * 512; const float* lnb = INP(I_LNB) + L * 512;
    const bf16* gV = WSP(bf16, R_CV); const bf16* dg = WSP(bf16, R_DAG_G); const float* cbon = WSP(float, WS_CBON); bf16* y1 = WSP(bf16, R_Y) + (size_t)M * 512;
    const int half = F.tid >> 8, ht = F.tid & 255, t = ht >> 2, c0 = (ht & 3) * 16, hw = F.wave & 3;
    LAS unsigned char* lds = F.lds + half * RO_HALF;
    { LAS float* PAR = (LAS float*)(F.lds + RO_PAR); const int pt = F.wave * 64 + (int)__builtin_amdgcn_mbcnt_hi(~0u, __builtin_amdgcn_mbcnt_lo(~0u, 0u));
      PAR[pt] = lnw[pt]; PAR[512 + pt] = lnb[pt]; }
    const LAS float* PW = (const LAS float*)(F.lds + RO_PAR); const LAS float* PB = PW + 512;
    v4u n_sx[2], n_qt[2], n_dt[2], n_vv[2], n_gg[2]; float n_cb;
#define ROUT_LOAD(it_) do { const int bh_ = (it_) >> 7, ck_ = (it_) & 127; const int row_ = (bh_ >> 3) * SEQ + ck_ * 64 + t; \
        _Pragma("unroll") for (int e = 0; e < 2; ++e) { n_sx[e] = __builtin_nontemporal_load((const v4u*)(WSP(bf16, R_CS) + (size_t)(it_) * 4096 + t * 64 + c0 + 8 * e)); n_qt[e] = __builtin_nontemporal_load((const v4u*)(WSP(bf16, R_CQT) + (size_t)(it_) * 4096 + t * 64 + c0 + 8 * e)); \
            n_dt[e] = __builtin_nontemporal_load((const v4u*)(WSP(bf16, R_CDT) + (size_t)(it_) * 4096 + t * 64 + c0 + 8 * e)); n_vv[e] = __builtin_nontemporal_load((const v4u*)(gV + (size_t)row_ * 512 + (bh_ & 7) * 64 + c0 + 8 * e)); n_gg[e] = __builtin_nontemporal_load((const v4u*)(dg + (size_t)row_ * 512 + (bh_ & 7) * 64 + c0 + 8 * e)); } \
        n_cb = cbon[(size_t)row_ * 8 + (bh_ & 7)]; } while (0)
    const int it0 = (int)blockIdx.x + half * F.G;
    if (it0 < 2048) ROUT_LOAD(it0);
    for (int base = blockIdx.x; base < 2048; base += 2 * F.G) {
        const int item = base + half * F.G; const bool valid = item < 2048;
        const int bh = item >> 7, ck = item & 127, b = bh >> 3, h = bh & 7; const int row = b * SEQ + ck * 64 + t, ch = h * 64 + c0;
        v4u vv[2], gv[2]; float cb = 0.f;
        if (valid) { cb = n_cb;
#pragma unroll
            for (int e = 0; e < 2; ++e) { vv[e] = n_vv[e]; gv[e] = n_gg[e];
                *(LAS v4u*)((LAS bf16*)(lds + RO_SX) + t * LDP + c0 + 8 * e) = n_sx[e]; *(LAS v4u*)((LAS bf16*)(lds + RO_QT) + t * LDP + c0 + 8 * e) = n_qt[e]; *(LAS v4u*)((LAS bf16*)(lds + RO_DT) + t * LDP + c0 + 8 * e) = n_dt[e];
                LAS bf16* VT = (LAS bf16*)(lds + RO_VT);
#pragma unroll
                for (int i = 0; i < 4; ++i) { VT[(c0 + 8 * e + 2 * i) * LDP + t] = (bf16)(vv[e][i] & 0xffffu); VT[(c0 + 8 * e + 2 * i + 1) * LDP + t] = (bf16)(vv[e][i] >> 16); } }
            if (item + 2 * F.G < 2048) ROUT_LOAD(item + 2 * F.G); }
        __syncthreads();
        if (valid) { const int r16 = F.lane & 15, g4 = F.lane >> 4, m0 = 16 * hw; LAS float* YL = (LAS float*)(lds + RO_Y);
            const LAS bf16* X1 = (const LAS bf16*)(lds + RO_SX) + (m0 + r16) * LDP + 8 * g4; const LAS bf16* X2 = (const LAS bf16*)(lds + RO_VT) + (m0 + r16) * LDP + 8 * g4;
            const bf16x8 a0 = *(const LAS bf16x8*)X1, a1 = *(const LAS bf16x8*)(X1 + 32), a2 = *(const LAS bf16x8*)X2, a3 = *(const LAS bf16x8*)(X2 + 32);
            f32x4 acc[4];
#pragma unroll
            for (int q = 0; q < 4; ++q) { const LAS bf16* Y1 = (const LAS bf16*)(lds + RO_QT) + (16 * q + r16) * LDP + 8 * g4; const LAS bf16* Y2 = (const LAS bf16*)(lds + RO_DT) + (16 * q + r16) * LDP + 8 * g4;
                acc[q] = __builtin_amdgcn_mfma_f32_16x16x32_bf16(a0, *(const LAS bf16x8*)Y1, (f32x4){0.f, 0.f, 0.f, 0.f}, 0, 0, 0); acc[q] = __builtin_amdgcn_mfma_f32_16x16x32_bf16(a1, *(const LAS bf16x8*)(Y1 + 32), acc[q], 0, 0, 0);
                acc[q] = __builtin_amdgcn_mfma_f32_16x16x32_bf16(a2, *(const LAS bf16x8*)Y2, acc[q], 0, 0, 0); acc[q] = __builtin_amdgcn_mfma_f32_16x16x32_bf16(a3, *(const LAS bf16x8*)(Y2 + 32), acc[q], 0, 0, 0); }
#pragma unroll
            for (int q = 0; q < 4; ++q) *(LAS f32x4*)(YL + (16 * q + r16) * 68 + m0 + 4 * g4) = acc[q]; }
        __syncthreads();
        if (valid) { const LAS float* YL = (const LAS float*)(lds + RO_Y) + t * 68 + c0; float y[16], s_ = 0.f;
#pragma unroll
            for (int i = 0; i < 16; ++i) { y[i] = YL[i]; s_ += y[i]; }
            s_ += dppf<0xB1>(s_); s_ += dppf<0x4E>(s_); const float mean = s_ * (1.0f / 64.0f); float q2 = 0.f;
#pragma unroll
            for (int i = 0; i < 16; ++i) { y[i] -= mean; q2 += y[i] * y[i]; }
            q2 += dppf<0xB1>(q2); q2 += dppf<0x4E>(q2); const float rstd = __builtin_amdgcn_rsqf(q2 * (1.0f / 64.0f) + 64e-5f);
#pragma unroll
            for (int e = 0; e < 2; ++e) { const v4u gg = gv[e]; float o[8];
#pragma unroll
                for (int i = 0; i < 8; ++i) { const int q = i >> 1; const bool hi = i & 1; const float vf = hi ? bfhi(vv[e][q]) : bflo(vv[e][q]), gf = hi ? bfhi(gg[q]) : bflo(gg[q]);
                    o[i] = (y[8 * e + i] * rstd * PW[ch + 8 * e + i] + PB[ch + 8 * e + i] + cb * vf) * gf; }
                v4u w; w.x = pk2(o[0], o[1]); w.y = pk2(o[2], o[3]); w.z = pk2(o[4], o[5]); w.w = pk2(o[6], o[7]); *(v4u*)(y1 + (size_t)row * 512 + ch + 8 * e) = w; } }
        __syncthreads();
    }
#undef ROUT_LOAD
}
template <int KS, int LDX, int LDY> __device__ __forceinline__ f32x4 mm16(const LAS bf16* X, const LAS bf16* YT, int m0, int n0, int lane, f32x4 acc) {
    const int r = lane & 15, g = lane >> 4;
#pragma unroll
    for (int ks = 0; ks < KS; ++ks) { const bf16x8 a = *(const LAS bf16x8*)(X + (m0 + r) * LDX + ks * 32 + 8 * g); const bf16x8 b = *(const LAS bf16x8*)(YT + (n0 + r) * LDY + ks * 32 + 8 * g);
        acc = __builtin_amdgcn_mfma_f32_16x16x32_bf16(a, b, acc, 0, 0, 0); }
    return acc;
}
__device__ __forceinline__ float hg_lf(float key) { return fmaxf(__logf(fmaxf(1.0f - key, 1e-30f)), -30.0f); }
constexpr int H1_LD = 136;
constexpr int H1_KT = 0, H1_VT = 128 * H1_LD * 2, H1_SEG = 2 * 128 * H1_LD * 2, H1_END = H1_SEG + 4 * 128 * 4;
__device__ __forceinline__ void phase_h1(Frame& F, int first, int stride) {
    const bf16* zh = (const bf16*)F.x; bf16* Hg = WSP(bf16, R_HST); float* Dg = WSP(float, WS_HD);
    LAS unsigned char* lds = F.lds; LAS bf16* KT = (LAS bf16*)(lds + H1_KT); LAS bf16* VT = (LAS bf16*)(lds + H1_VT); LAS float* SEG = (LAS float*)(lds + H1_SEG);
    const int k = F.tid & 127, seg = F.tid >> 7; const int r16 = F.lane & 15, g4 = F.lane >> 4;
    for (int item = first; item < 256; item += stride) { const int bh = item >> 5, m = item & 31, b = bh >> 2, h = bh & 3; const size_t row0 = (size_t)b * SEQ + m * 256;
        f32x4 acc[8];
#pragma unroll
        for (int nt = 0; nt < 8; ++nt) acc[nt] = (f32x4){0.f, 0.f, 0.f, 0.f};
        float carry = 0.f;
#pragma unroll 1
        for (int half = 1; half >= 0; --half) { const size_t rb = row0 + 128 * half;
            float key[32], lf[32]; float tot = 0.f;
#pragma unroll
            for (int j = 0; j < 32; ++j) { key[j] = bf1(zh[(rb + 32 * seg + j) * 2048 + 512 + h * 128 + k]); lf[j] = hg_lf(key[j]); tot += lf[j]; }
            SEG[seg * 128 + k] = tot;
            { const int s = F.tid >> 2, part = F.tid & 3; const bf16* vp = zh + (rb + s) * 2048 + 1024 + h * 128 + part * 32;
#pragma unroll
              for (int c = 0; c < 4; ++c) { const v4u vv = *(const v4u*)(vp + 8 * c);
#pragma unroll
                  for (int i = 0; i < 4; ++i) { VT[(part * 32 + 8 * c + 2 * i) * H1_LD + s] = (bf16)(vv[i] & 0xffffu); VT[(part * 32 + 8 * c + 2 * i + 1) * H1_LD + s] = (bf16)(vv[i] >> 16); } } }
            __syncthreads();
            float off = carry, all = 0.f;
#pragma unroll
            for (int sg = 0; sg < 4; ++sg) { const float tt = SEG[sg * 128 + k]; all += tt; if (sg > seg) off += tt; }
            carry += all;
            float e = off;
#pragma unroll
            for (int j = 31; j >= 0; --j) { KT[k * H1_LD + 32 * seg + j] = (bf16)f2bf(key[j] * __expf(e)); e += lf[j]; }
            __syncthreads();
#pragma unroll
            for (int nt = 0; nt < 8; ++nt) acc[nt] = mm16<4, H1_LD, H1_LD>(KT, VT, 16 * F.wave, 16 * nt, F.lane, acc[nt]);
            __syncthreads(); }
        if (F.tid < 128) Dg[(size_t)item * 128 + k] = __expf(carry);
        bf16* hp = Hg + (size_t)item * 16384;
#pragma unroll
        for (int nt = 0; nt < 8; ++nt) { u32x2 o; o.x = pk2(acc[nt][0], acc[nt][1]); o.y = pk2(acc[nt][2], acc[nt][3]); *(u32x2*)(hp + (16 * nt + r16) * 128 + 16 * F.wave + 4 * g4) = o; }
    }
}
__device__ __forceinline__ void phase_h2(Frame& F) {
    bf16* Hg = WSP(bf16, R_HST); const float* Dg = WSP(float, WS_HD);
    const int gt = blockIdx.x * (NWAVES * 64) + F.tid, NGT = F.G * NWAVES * 64;
    for (int idx = gt; idx < 8 * 16384; idx += NGT) { const int bh = idx >> 14, e = idx & 16383; float s = 0.f;
#pragma unroll 4
        for (int m = 0; m < 32; ++m) { const size_t o = ((size_t)(bh * 32 + m) << 14) + e; const float hv = bf1(Hg[o]); Hg[o] = (bf16)f2bf(s); s = __builtin_fmaf(Dg[(bh * 32 + m) * 128 + (e & 127)], s, hv); } }
}
constexpr int H3_LDK = 136, H3_LDS = 40;
constexpr int H3_QC = 0, H3_KH = H3_QC + 32 * H3_LDK * 2, H3_KHT = H3_KH + 32 * H3_LDK * 2, H3_VT = H3_KHT + 128 * H3_LDS * 2, H3_ST = H3_VT + 128 * H3_LDS * 2, H3_AL = H3_ST + 128 * H3_LDK * 2,
              H3_OL = H3_AL + 32 * H3_LDS * 2, H3_SEG = H3_OL + 32 * 132 * 4, H3_DD = H3_SEG + 4 * 128 * 4, H3_END = H3_DD + 128 * 4;
static_assert(H3_END <= LDSCTL_OFF && H1_END <= LDSCTL_OFF, "hgrn LDS");
__device__ __forceinline__ void phase_h3(Frame& F, const Args& A, int L) {
    KP_DECL;
    const bf16* zh = (const bf16*)F.x; const bf16* Hg = WSP(bf16, R_HST); bf16* y2 = WSP(bf16, R_Y) + (size_t)2 * M * 512; const float* ng = INP(I_HNORM) + L * 128;
    LAS unsigned char* lds = F.lds; LAS bf16* QC = (LAS bf16*)(lds + H3_QC); LAS bf16* KH = (LAS bf16*)(lds + H3_KH); LAS bf16* KHT = (LAS bf16*)(lds + H3_KHT); LAS bf16* VT = (LAS bf16*)(lds + H3_VT);
    LAS bf16* ST = (LAS bf16*)(lds + H3_ST); LAS bf16* AL = (LAS bf16*)(lds + H3_AL); LAS float* OL = (LAS float*)(lds + H3_OL); LAS float* SEG = (LAS float*)(lds + H3_SEG); LAS float* DD = (LAS float*)(lds + H3_DD);
    const int k = F.tid & 127, seg = F.tid >> 7; const int r16 = F.lane & 15, g4 = F.lane >> 4;
    float ngv[8];
#pragma unroll
    for (int i = 0; i < 8; ++i) ngv[i] = ng[(F.tid & 15) * 8 + i];
    for (int item = blockIdx.x; item < 256; item += F.G) { const int bh = item >> 5, m = item & 31, b = bh >> 2, h = bh & 3; const size_t row0 = (size_t)b * SEQ + m * 256;
        f32x4 acc[8];
        { const bf16* hp = Hg + (size_t)item * 16384;
#pragma unroll
          for (int nt = 0; nt < 8; ++nt) { const u32x2 w = *(const u32x2*)(hp + (16 * nt + r16) * 128 + 16 * F.wave + 4 * g4); acc[nt] = (f32x4){bflo(w.x), bfhi(w.x), bflo(w.y), bfhi(w.y)}; } }
        bf16 nq[8], nk[8]; v4u nvv, ngg;
#define H3_LOAD(cc) do { const size_t rb_ = row0 + 32 * (cc); _Pragma("unroll") for (int j = 0; j < 8; ++j) { const bf16* zp = zh + (rb_ + 8 * seg + j) * 2048 + h * 128 + k; nq[j] = __builtin_nontemporal_load(zp); nk[j] = __builtin_nontemporal_load(zp + 512); } \
            nvv = __builtin_nontemporal_load((const v4u*)(zh + (rb_ + (F.tid >> 4)) * 2048 + 1024 + h * 128 + (F.tid & 15) * 8)); ngg = __builtin_nontemporal_load((const v4u*)(zh + (rb_ + (F.tid >> 4)) * 2048 + 1536 + h * 128 + (F.tid & 15) * 8)); } while (0)
        H3_LOAD(0);
#pragma unroll 1
        for (int c = 0; c < 8; ++c) { const size_t rb = row0 + 32 * c;
            float key[8], qv[8], bcs[8]; float run = 0.f;
#pragma unroll
            for (int j = 0; j < 8; ++j) { qv[j] = bf1(nq[j]); key[j] = bf1(nk[j]); run += hg_lf(key[j]); bcs[j] = run; }
            const v4u vv = nvv, gg = ngg;
            if (c < 7) H3_LOAD(c + 1);
            SEG[seg * 128 + k] = run;
            { const int s = F.tid >> 4, part = F.tid & 15;
#pragma unroll
              for (int i = 0; i < 4; ++i) { VT[(part * 8 + 2 * i) * H3_LDS + s] = (bf16)(vv[i] & 0xffffu); VT[(part * 8 + 2 * i + 1) * H3_LDS + s] = (bf16)(vv[i] >> 16); } }
            __syncthreads();
            float pre = 0.f, all = 0.f;
#pragma unroll
            for (int sg = 0; sg < 4; ++sg) { const float tt = SEG[sg * 128 + k]; all += tt; if (sg < seg) pre += tt; }
#pragma unroll
            for (int j = 0; j < 8; ++j) { const float bt = pre + bcs[j]; const int t = 8 * seg + j;
                QC[t * H3_LDK + k] = (bf16)f2bf(qv[j] * __expf(bt - all)); const bf16 kh = (bf16)f2bf(key[j] * __expf(all - bt)); KH[t * H3_LDK + k] = kh; KHT[k * H3_LDS + t] = kh; }
            if (seg == 0) DD[k] = __expf(all);
            __syncthreads();
            { const f32x4 dv = *(const LAS f32x4*)(DD + 16 * F.wave + 4 * g4);
#pragma unroll
              for (int nt = 0; nt < 8; ++nt) { acc[nt] = acc[nt] * dv; u32x2 o; o.x = pk2(acc[nt][0], acc[nt][1]); o.y = pk2(acc[nt][2], acc[nt][3]); *(LAS u32x2*)(ST + (16 * nt + r16) * H3_LDK + 16 * F.wave + 4 * g4) = o; } }
            if (F.wave < 4) { const int m0 = (F.wave >> 1) * 16, n0 = (F.wave & 1) * 16; const f32x4 a = mm16<4, H3_LDK, H3_LDK>(QC, KH, m0, n0, F.lane, (f32x4){0.f, 0.f, 0.f, 0.f});
#pragma unroll
                for (int rg = 0; rg < 4; ++rg) { const int t = m0 + 4 * g4 + rg, s = n0 + r16; AL[t * H3_LDS + s] = (bf16)f2bf(s <= t ? a[rg] : 0.f); } }
            __syncthreads();
#pragma unroll
            for (int q = 0; q < 2; ++q) { const int id = 2 * F.wave + q, m0 = (id >> 3) * 16, n0 = (id & 7) * 16;
                f32x4 o = mm16<4, H3_LDK, H3_LDK>(QC, ST, m0, n0, F.lane, (f32x4){0.f, 0.f, 0.f, 0.f}); o = mm16<1, H3_LDS, H3_LDS>(AL, VT, m0, n0, F.lane, o);
#pragma unroll
                for (int rg = 0; rg < 4; ++rg) OL[(m0 + 4 * g4 + rg) * 132 + n0 + r16] = o[rg]; }
#pragma unroll
            for (int nt = 0; nt < 8; ++nt) acc[nt] = mm16<1, H3_LDS, H3_LDS>(KHT, VT, 16 * F.wave, 16 * nt, F.lane, acc[nt]);
            __syncthreads();
            { const int t = F.tid >> 4, part = F.tid & 15; const LAS float* op = OL + t * 132 + part * 8; float o[8], ss = 0.f;
#pragma unroll
              for (int i = 0; i < 8; ++i) { o[i] = op[i]; ss += o[i] * o[i]; }
              ss = sum16(ss);
              const float rs = __builtin_amdgcn_rsqf(ss * (1.0f / 128.0f) + 1e-6f); const size_t row = rb + t;
              float y[8];
#pragma unroll
              for (int i = 0; i < 8; ++i) { const int q = i >> 1; const float gf = (i & 1) ? bfhi(gg[q]) : bflo(gg[q]); y[i] = o[i] * rs * ngv[i] * gf; }
              v4u w; w.x = pk2(y[0], y[1]); w.y = pk2(y[2], y[3]); w.z = pk2(y[4], y[5]); w.w = pk2(y[6], y[7]); *(v4u*)(y2 + row * 512 + h * 128 + part * 8) = w; }
        }
        __syncthreads();
    }
}
constexpr int AT_KLD = 72, AT_VLD = 260, AT_K = 0, AT_VT = 256 * AT_KLD * 2, AT_END = AT_VT + 64 * AT_VLD * 2;
static_assert(AT_END <= LDSCTL_OFF, "attention LDS");
__device__ __forceinline__ void phase_attn_mfma(Frame& F, const Args& A, int L) {
    KP_DECL;
    const bf16* za = WSP(bf16, R_ZA); bf16* y0 = WSP(bf16, R_Y); const float* sinks = INP(I_SINK) + L * 8;
    LAS bf16* KI = (LAS bf16*)(F.lds + AT_K); LAS bf16* VT = (LAS bf16*)(F.lds + AT_VT);
    const int c32 = F.lane & 31, hh = F.lane >> 5;
    for (int item = blockIdx.x; item < 256; item += F.G) { const int b = item >> 7, kvh = (item >> 6) & 1, n = item & 63; const int rowq0 = b * SEQ + n * 128, rowk0 = rowq0 - 128;
        { const int key = F.tid >> 1, half = F.tid & 1; const bool valid = (n > 0) || key >= 128; const bf16* src = za + (size_t)(rowk0 + key) * 768 + kvh * 64 + half * 32;
#pragma unroll
          for (int c = 0; c < 4; ++c) { v4u kk = (v4u){0u, 0u, 0u, 0u}, vv = kk; if (valid) { kk = *(const v4u*)(src + 512 + 8 * c); vv = *(const v4u*)(src + 640 + 8 * c); }
              *(LAS v4u*)(KI + key * AT_KLD + half * 32 + 8 * c) = kk;
#pragma unroll
              for (int i = 0; i < 4; ++i) { VT[(half * 32 + 8 * c + 2 * i) * AT_VLD + key] = (bf16)(vv[i] & 0xffffu); VT[(half * 32 + 8 * c + 2 * i + 1) * AT_VLD + key] = (bf16)(vv[i] >> 16); } } }
        __syncthreads();
#pragma unroll 1
        for (int rep = 0; rep < 2; ++rep) { const int id = F.wave * 2 + rep, g = id >> 2, u = id & 3, hq = kvh * 4 + g; const int qrow = rowq0 + 32 * u + c32, qi = 32 * u + c32;
            bf16x8 qf[4];
#pragma unroll
            for (int s = 0; s < 4; ++s) qf[s] = *(const bf16x8*)(za + (size_t)qrow * 768 + hq * 64 + 16 * s + 8 * hh);
            f32x16 st[5];
#pragma unroll
            for (int j = 0; j < 5; ++j) { f32x16 acc;
#pragma unroll
                for (int i = 0; i < 16; ++i) acc[i] = 0.f;
#pragma unroll
                for (int s = 0; s < 4; ++s) { const bf16x8 a = *(const LAS bf16x8*)(KI + (32 * (u + j) + c32) * AT_KLD + 16 * s + 8 * hh); acc = __builtin_amdgcn_mfma_f32_32x32x16_bf16(a, qf[s], acc, 0, 0, 0); }
                st[j] = acc; }
            const float sink = sinks[hq]; float mx = sink;
#pragma unroll
            for (int j = 0; j < 5; ++j)
#pragma unroll
                for (int rg = 0; rg < 16; ++rg) { const int kj = 32 * (u + j) + (rg & 3) + 8 * (rg >> 2) + 4 * hh; const bool ok = (kj > qi) && (kj <= qi + 128) && (n > 0 || kj >= 128);
                    const float v = ok ? st[j][rg] * 0.125f : -1e30f; st[j][rg] = v; mx = fmaxf(mx, v); }
            mx = fmaxf(mx, __shfl_xor(mx, 32));
            float sum = 0.f;
#pragma unroll
            for (int j = 0; j < 5; ++j)
#pragma unroll
                for (int rg = 0; rg < 16; ++rg) { const float p = __expf(st[j][rg] - mx); st[j][rg] = p; sum += p; }
            sum += __shfl_xor(sum, 32);
            const float inv = 1.0f / (sum + __expf(sink - mx));
            f32x16 o0, o1;
#pragma unroll
            for (int i = 0; i < 16; ++i) { o0[i] = 0.f; o1[i] = 0.f; }
#pragma unroll
            for (int j = 0; j < 5; ++j)
#pragma unroll
                for (int s = 0; s < 2; ++s) { v4u pw; pw.x = pg8::cvtpk_s(st[j][8 * s], st[j][8 * s + 1]); pw.y = pg8::cvtpk_s(st[j][8 * s + 2], st[j][8 * s + 3]); pw.z = pg8::cvtpk_s(st[j][8 * s + 4], st[j][8 * s + 5]); pw.w = pg8::cvtpk_s(st[j][8 * s + 6], st[j][8 * s + 7]);
                    const bf16x8 pb = __builtin_bit_cast(bf16x8, pw); const int k0 = 32 * (u + j) + 16 * s + 4 * hh;
                    { const u32x2 lo = *(const LAS u32x2*)(VT + c32 * AT_VLD + k0), hi = *(const LAS u32x2*)(VT + c32 * AT_VLD + k0 + 8); const bf16x8 va = __builtin_bit_cast(bf16x8, (v4u){lo.x, lo.y, hi.x, hi.y});
                      o0 = __builtin_amdgcn_mfma_f32_32x32x16_bf16(va, pb, o0, 0, 0, 0); }
                    { const u32x2 lo = *(const LAS u32x2*)(VT + (32 + c32) * AT_VLD + k0), hi = *(const LAS u32x2*)(VT + (32 + c32) * AT_VLD + k0 + 8); const bf16x8 va = __builtin_bit_cast(bf16x8, (v4u){lo.x, lo.y, hi.x, hi.y});
                      o1 = __builtin_amdgcn_mfma_f32_32x32x16_bf16(va, pb, o1, 0, 0, 0); } }
            bf16* yp = y0 + (size_t)qrow * 512 + hq * 64 + 4 * hh;
#pragma unroll
            for (int q4 = 0; q4 < 4; ++q4) { u32x2 w; w.x = pk2(o0[4 * q4] * inv, o0[4 * q4 + 1] * inv); w.y = pk2(o0[4 * q4 + 2] * inv, o0[4 * q4 + 3] * inv); *(u32x2*)(yp + 8 * q4) = w;
                w.x = pk2(o1[4 * q4] * inv, o1[4 * q4 + 1] * inv); w.y = pk2(o1[4 * q4 + 2] * inv, o1[4 * q4 + 3] * inv); *(u32x2*)(yp + 32 + 8 * q4) = w; }
        }
        __syncthreads();
    }
}
__device__ __forceinline__ void phase_final(Frame& F, const Args& A) {
    KP_DECL;
    const float* g = INP(I_FINN); const bf16* xb = WSP(bf16, R_XBALT); const float* ss = WSP(float, WS_SS0);
    const int gw = blockIdx.x * NWAVES + F.wave, NGW = F.G * NWAVES;
    const int lane_ = (int)__builtin_amdgcn_mbcnt_hi(~0u, __builtin_amdgcn_mbcnt_lo(~0u, 0u));
    f32x4 gg[2][2];
#pragma unroll
    for (int j = 0; j < 2; ++j) { gg[j][0] = *(const f32x4*)(g + j * 512 + lane_ * 8); gg[j][1] = *(const f32x4*)(g + j * 512 + lane_ * 8 + 4); }
    for (int m0 = gw; m0 < M; m0 += 4 * NGW) {
        const int mr = m0 + (lane_ >> 4) * NGW; const float pq = (mr < M) ? ss[(size_t)mr * 16 + (lane_ & 15)] : 1.0f;
        v4u w[4][2];
#pragma unroll
        for (int k = 0; k < 4; ++k) { const int m = (m0 + k * NGW < M) ? m0 + k * NGW : m0;
#pragma unroll
            for (int j = 0; j < 2; ++j) w[k][j] = __builtin_nontemporal_load((const v4u*)(xb + (size_t)m * DM + j * 512 + lane_ * 8)); }
        const float rsl = __builtin_amdgcn_rsqf(sum16(pq) * (1.0f / 1024.0f) + 1e-6f);
#pragma unroll
        for (int k = 0; k < 4; ++k) { const int m = m0 + k * NGW; if (m >= M) break; const float rs = __shfl(rsl, 16 * k);
#pragma unroll
            for (int j = 0; j < 2; ++j) { const v4u ww = w[k][j]; f32x4 o0, o1;
                o0.x = bflo(ww.x) * rs; o0.y = bfhi(ww.x) * rs; o0.z = bflo(ww.y) * rs; o0.w = bfhi(ww.y) * rs; o1.x = bflo(ww.z) * rs; o1.y = bfhi(ww.z) * rs; o1.z = bflo(ww.w) * rs; o1.w = bfhi(ww.w) * rs;
                float* op = F.x + (size_t)m * DM + j * 512 + lane_ * 8; *(f32x4*)op = o0 * gg[j][0]; *(f32x4*)(op + 4) = o1 * gg[j][1]; } } }
}

template <int L> __device__ __forceinline__ void run_layer(Frame& F, const Args& args, const XcdBarrier& bar, int lo, int hi) {
    typedef pg8::bf16_t pb16;
    constexpr int base = 17 * L;
#define IN(k) (lo <= base + (k) && base + (k) < hi && EN(k))
#define SEAM(k) do { if (base + (k) + 1 < hi) xcd_barrier(bar); } while (0)
#define GEMM_RUN(EPI, g, S, E) pg8::gemm_phase<EPI, pg8::StaticOrder, true, true>(F.lds + RING_OFF, g, S, E)
    constexpr size_t SS_IN = WS_SS0, SS_A = WS_SS1, SS_B = WS_SS0, SS_C = WS_SS1, SS_OUT = WS_SS0;
    if (IN(0)) { phase_conv<0>(F, args, L); SEAM(0); }
    if (IN(1)) { pg8::Gemm g{L == 0 ? WSP(pb16, WS_XB) : WSP(pb16, R_XBALT), WSP(pb16, W_F1GU), M, 5632, 1024}; pg8::StaticOrder S; S.init(M, 5632, F.G, (int)blockIdx.x);
        pg8::EpiSwiglu E{WSP(pb16, R_H), WSP(float, SS_IN)}; GEMM_RUN(pg8::EpiSwiglu, g, S, E);
        if ((int)blockIdx.x >= F.G / 2) phase_conv<1>(F, args, L);
        SEAM(1); }
    if (IN(2)) { KP_DECL; pg8::Gemm g{WSP(pb16, R_H), WSP(pb16, W_F1D), M, 1024, FF}; pg8::StaticOrder S; S.init(M, 1024, F.G, (int)blockIdx.x);
        pg8::EpiResid<0> E{WSP(pb16, WS_XB), WSP(float, SS_A), nullptr, nullptr, 0.5f, L == 0 ? WSP(pb16, WS_XB) : WSP(pb16, R_XBALT)}; GEMM_RUN(pg8::EpiResid<0>, g, S, E); SEAM(2); }
    if (IN(3)) { pg8::Gemm g{WSP(pb16, WS_XB), WSP(pb16, W_IN), M, 1792, 1024}; pg8::StaticOrder S; S.init(M, 1792, F.G, (int)blockIdx.x);
        pg8::EpiStore<0> E{WSP(pb16, R_ZR), WSP(float, SS_A), nullptr, nullptr, nullptr, nullptr}; GEMM_RUN(pg8::EpiStore<0>, g, S, E);
        { pg8::Gemm g3{WSP(pb16, WS_XB), WSP(pb16, W_IN) + (size_t)1792 * 1024, M, 2816, 1024}; pg8::EarlyOrder S3; S3.init(M, 2816, F.G, (int)blockIdx.x); S3.ns = 32;
          pg8::EpiStore<1> E3{WSP(pb16, R_ZA), WSP(float, SS_A), (pb16*)F.x, nullptr, WSP(float, WS_LB), nullptr}; pg8::gemm_phase<pg8::EpiStore<1>, pg8::EarlyOrder, true, true>(F.lds + RING_OFF, g3, S3, E3); }
        SEAM(3); }
    if (IN(4)) { phase_rprep1(F, args, L); SEAM(4); }
    if (IN(5)) { KP_DECL; pg8::Gemm g{WSP(pb16, R_AP), WSP(pb16, W_LR), M, 1536, 256}; pg8::StaticOrder S; S.init(M, 1536, F.G, (int)blockIdx.x);
        pg8::EpiStore<3> E{WSP(pb16, R_DAG_W), nullptr, WSP(pb16, R_DAG_A), WSP(pb16, R_DAG_G), INP(I_W0) + L * 512, INP(I_A0) + L * 512};
        GEMM_RUN(pg8::EpiStore<3>, g, S, E); SEAM(5); }
    if (IN(6)) { phase_rchunk_pre(F, args, L); SEAM(6); }
    if (IN(7)) {
        if (blockIdx.x < 32 && F.wave == 0) rchunk_seq(F, blockIdx.x);
        pg8::Gemm g{WSP(pb16, WS_XB), WSP(pb16, W_IN) + (size_t)1792 * 1024, M, 2816, 1024}; pg8::SplitOrder S; S.init(M, 2816, F.G, (int)blockIdx.x); S.ns = 32;
        pg8::EpiStore<1> E{WSP(pb16, R_ZA), WSP(float, SS_A), (pb16*)F.x, nullptr, WSP(float, WS_LB), nullptr};
        pg8::gemm_phase<pg8::EpiStore<1>, pg8::SplitOrder, true, true>(F.lds + RING_OFF, g, S, E); SEAM(7); }
    if (IN(8)) { phase_h1(F, blockIdx.x, F.G); phase_attn_mfma(F, args, L); phase_rchunk_out(F, args, L); SEAM(8); }
    if (IN(9)) { phase_h2(F); xcd_barrier(bar); phase_h3(F, args, L); }
    if (IN(10)) { pg8::Gemm g{WSP(pb16, WS_XB), WSP(pb16, W_IN) + (size_t)4608 * 1024, M, 3072, 1024}; pg8::StaticOrder S; S.init(M, 3072, F.G, (int)blockIdx.x);
        pg8::EpiStore<2> E{WSP(pb16, R_GG), WSP(float, SS_A), nullptr, nullptr, nullptr, nullptr}; GEMM_RUN(pg8::EpiStore<2>, g, S, E); SEAM(10); }
    if (IN(11)) { pg8::Gemm g{WSP(pb16, R_Y), WSP(pb16, W_BR), M, 1024, 512, (size_t)M * 512, (size_t)1024 * 512}; pg8::ChainOrder S; S.init(M, 1024, F.G, (int)blockIdx.x);
        pg8::EpiBranchChain E{WSP(pb16, R_MERGED), WSP(pb16, R_GG)}; pg8::gemm_phase<pg8::EpiBranchChain, pg8::ChainOrder, true, true>(F.lds + RING_OFF, g, S, E); SEAM(11); }
    if (IN(12)) { conv_p(F, args, L); pg8::Gemm g{WSP(pb16, R_MERGED), WSP(pb16, W_O), M, 1024, 1024}; pg8::StaticOrder S; S.init(M, 1024, F.G, (int)blockIdx.x);
        pg8::EpiResid<0> E{WSP(pb16, WS_XB), WSP(float, SS_B), nullptr, nullptr, 1.0f, WSP(pb16, WS_XB)}; GEMM_RUN(pg8::EpiResid<0>, g, S, E); SEAM(12); }
    if (IN(13)) {
        { pg8::Gemm g{WSP(pb16, WS_XB), WSP(pb16, W_F2GU), M, 5632, 1024}; pg8::StaticOrder S; S.init(M, 5632, F.G, (int)blockIdx.x);
          pg8::EpiSwiglu E{WSP(pb16, R_H), WSP(float, SS_B)}; GEMM_RUN(pg8::EpiSwiglu, g, S, E); }
        { pg8::Gemm g{WSP(pb16, R_PB), WSP(pb16, W_PP), M, 1024, 256}; pg8::TailOrder S; S.init(M, 1024, F.G, (int)blockIdx.x); S.lo = F.G / 2;
          pg8::EpiStore<4> E{WSP(pb16, R_PROJ), nullptr, nullptr, nullptr, nullptr, nullptr}; pg8::gemm_phase<pg8::EpiStore<4>, pg8::TailOrder, true, true>(F.lds + RING_OFF, g, S, E); }
        SEAM(13); }
    if (IN(14)) { pg8::Gemm g{WSP(pb16, R_H), WSP(pb16, W_F2D), M, 1024, FF}; pg8::StaticOrder S; S.init(M, 1024, F.G, (int)blockIdx.x);
        pg8::EpiResid<0> E{WSP(pb16, WS_XB), WSP(float, SS_C), nullptr, nullptr, 0.5f, WSP(pb16, WS_XB)}; GEMM_RUN(pg8::EpiResid<0>, g, S, E); SEAM(14); }
    if (IN(16)) { pg8::Gemm g{WSP(pb16, WS_XB), WSP(pb16, W_PG), M, 1024, 1024}; pg8::StaticOrder S; S.init(M, 1024, F.G, (int)blockIdx.x);
        pg8::EpiResid<1> E{WSP(pb16, R_XBALT), WSP(float, SS_OUT), WSP(float, SS_C), WSP(pb16, R_PROJ), 1.0f, WSP(pb16, WS_XB)}; GEMM_RUN(pg8::EpiResid<1>, g, S, E);
        if (L != 0) SEAM(16); }
#undef IN
#undef SEAM
#undef GEMM_RUN
}
__global__ void __launch_bounds__(NWAVES * 64, 2) mk_fwd(Args args) {
    extern __shared__ __attribute__((aligned(16))) unsigned char lds[];
    Frame F;
    F.lds = (LAS unsigned char*)lds;
    F.MISC = (volatile LAS unsigned*)(F.lds + MISC_OFF);
    F.tid = threadIdx.x; F.lane = F.tid & 63; F.wave = __builtin_amdgcn_readfirstlane(F.tid >> 6);
    F.G = gridDim.x;
    F.ws = args.ws; F.x = args.out;
    F.ctl = (gu32*)(args.ws + WS_CTL);
    for (int u = F.tid; u < (LDS_BYTES - LDSCTL_OFF) / 4; u += NWAVES * 64) ((LAS unsigned*)(F.lds + LDSCTL_OFF))[u] = 0u;
    __syncthreads();
    const int lo = args.ph_lo, hi = args.ph_hi;
    const bool multi = (hi - lo) > 1;
    XcdBarrier bar; bar.bar = (unsigned*)(F.ctl + CW_BAR); bar.x = 0; bar.st = nullptr;
    if (multi) bar = xcd_barrier_post((unsigned*)(F.ctl + CW_BAR), F.MISC + 8);
    run_layer<0>(F, args, bar, lo, hi);
    run_layer<1>(F, args, bar, lo, hi);
    if (lo <= N_PHASES - 1 && N_PHASES - 1 < hi && EN(17)) phase_final(F, args);
}

#ifndef MK_PER_PHASE
#define MK_PER_PHASE 0
#endif
extern "C" void kernel_launch(void* const* d_in, const int* in_sizes, int n_in, void* d_out, int out_size, void* d_ws, size_t ws_size, hipStream_t stream) {
    static int grid = 0;
    if (grid == 0) {
        if (n_in != N_IN || in_sizes[0] != M * DM || out_size != M * DM || ws_size < WS_END) { fprintf(stderr, "kernel_launch: unexpected shapes / workspace (n_in %d, ws %zu < %zu)\n", n_in, ws_size, (size_t)WS_END); grid = -1; return; }
        int dev = 0, cus = 0;
        if (hipGetDevice(&dev) != hipSuccess || hipDeviceGetAttribute(&cus, hipDeviceAttributeMultiprocessorCount, dev) != hipSuccess) { grid = -1; return; }
        if (hipFuncSetAttribute((const void*)mk_fwd, hipFuncAttributeMaxDynamicSharedMemorySize, LDS_BYTES) != hipSuccess) { fprintf(stderr, "kernel_launch: hipFuncSetAttribute failed\n"); grid = -1; return; }
        int per_cu = 0;
        if (hipOccupancyMaxActiveBlocksPerMultiprocessor(&per_cu, (const void*)mk_fwd, NWAVES * 64, LDS_BYTES) != hipSuccess || per_cu < 1) fprintf(stderr, "kernel_launch: occupancy query says %d\n", per_cu);
        (void)hipGetLastError();
        grid = cus;
    }
    if (grid < 0) return;
    (void)hipMemsetAsync((char*)d_ws + WS_CTL, 0, CTL_ZERO_BYTES, stream);
    Args a{};
    for (int i = 0; i < N_IN; ++i) a.in[i] = (const float*)d_in[i];
    a.out = (float*)d_out; a.ws = (unsigned char*)d_ws;
#if MK_PER_PHASE
    for (int ph = 0; ph < N_PHASES; ++ph) { a.ph_lo = ph; a.ph_hi = ph + 1; hipLaunchKernelGGL(mk_fwd, dim3(grid), dim3(NWAVES * 64), LDS_BYTES, stream, a); }
#else
    a.ph_lo = 0; a.ph_hi = N_PHASES; hipLaunchKernelGGL(mk_fwd, dim3(grid), dim3(NWAVES * 64), LDS_BYTES, stream, a);
#endif
}
```

```cpp
#include <hip/hip_runtime.h>
#include <cstdio>
#include <cstdint>
namespace pg8 {
#define PG8_LAS __attribute__((address_space(3)))
typedef unsigned short bf16_t;
typedef short bf16x8 __attribute__((ext_vector_type(8)));
typedef float f32x4 __attribute__((ext_vector_type(4)));
typedef unsigned u32x4 __attribute__((ext_vector_type(4)));
constexpr int BM = 256, BK = 64, HALF = 128, HTB = HALF * BK * 2  , STAGE_BYTES = 8 * HTB, NXCD = 8, WGM = 8;
constexpr int RS_LDS_OFF = 8 * 16640;

__host__ __device__ __forceinline__ int lds_byte(int r, int c) { const int st = (r >> 4) * 2 + (c >> 5), rr = r & 15, cc = c & 31, ob = rr * 64 + cc * 2; return st * 1024 + (ob ^ (((ob >> 9) & 1) << 5)); }
__host__ __device__ __forceinline__ void stage_rc(int b, int& R, int& C) { const int st = b / 1024, sb = b % 1024, swz = sb ^ (((sb >> 9) & 1) << 5); R = (st >> 1) * 16 + swz / 64; C = (st & 1) * 32 + (swz % 64) / 2; }
__host__ __device__ __forceinline__ int perm32(int rho) { const int n = rho >> 4, i = rho & 15; return 8 * (i >> 2) + 4 * n + (i & 3); }

struct Unit { int pm, pn; int b = 0; };
struct Gemm { const bf16_t* A; const bf16_t* Bt; int M, N, K; size_t usA = 0, usB = 0; };

struct StaticOrder {
    int nM, nN, nwg, G, c;
    __host__ __device__ void init(int M, int N, int G_, int c_) { nM = M / BM; nN = N / BM; nwg = nM * nN; G = G_; c = c_; }
    __host__ __device__ bool next(int i, Unit& u) const {
        const long L = (long)i * G + c; if (L >= nwg) return false;
        int wgid = (int)L; { const int q = nwg / NXCD, r = nwg % NXCD, xcd = wgid % NXCD, off = wgid / NXCD; wgid = (xcd < r ? xcd * (q + 1) : r * (q + 1) + (xcd - r) * q) + off; }
        const int nig = WGM * nN, gid = wgid / nig, fm = gid * WGM, gsz = (nM - fm) < WGM ? (nM - fm) : WGM;
        u.pm = fm + ((wgid % nig) % gsz); u.pn = (wgid % nig) / gsz; return true;
    }
    __device__ __forceinline__ void a_ready(const Unit&) const {}
    __device__ __forceinline__ void done(const Unit&) const {}
};

struct SplitOrder : StaticOrder {
    int ns;
    __host__ __device__ bool next(int i, Unit& u) const {
        long L;
        if (c < ns) return false;
        else { L = (long)i * (G - ns) + (c - ns); if (L >= nwg - ns) return false; }
        int wgid = (int)L; { const int q = nwg / NXCD, r = nwg % NXCD, xcd = wgid % NXCD, off = wgid / NXCD; wgid = (xcd < r ? xcd * (q + 1) : r * (q + 1) + (xcd - r) * q) + off; }
        const int nig = WGM * nN, gid = wgid / nig, fm = gid * WGM, gsz = (nM - fm) < WGM ? (nM - fm) : WGM;
        u.pm = fm + ((wgid % nig) % gsz); u.pn = (wgid % nig) / gsz; return true;
    }
};

struct EarlyOrder : StaticOrder {
    int ns;
    __host__ __device__ bool next(int i, Unit& u) const {
        if (i > 0 || c < G - ns) return false; const long L = (long)(nwg - ns) + (c - (G - ns));
        int wgid = (int)L; { const int q = nwg / NXCD, r = nwg % NXCD, xcd = wgid % NXCD, off = wgid / NXCD; wgid = (xcd < r ? xcd * (q + 1) : r * (q + 1) + (xcd - r) * q) + off; }
        const int nig = WGM * nN, gid = wgid / nig, fm = gid * WGM, gsz = (nM - fm) < WGM ? (nM - fm) : WGM;
        u.pm = fm + ((wgid % nig) % gsz); u.pn = (wgid % nig) / gsz; return true;
    }
};
struct TailOrder : StaticOrder {
    int lo;
    __host__ __device__ bool next(int i, Unit& u) const {
        if (c < lo) return false; const long L = (long)i * (G - lo) + (c - lo); if (L >= nwg) return false;
        int wgid = (int)L; { const int q = nwg / NXCD, r = nwg % NXCD, xcd = wgid % NXCD, off = wgid / NXCD; wgid = (xcd < r ? xcd * (q + 1) : r * (q + 1) + (xcd - r) * q) + off; }
        const int nig = WGM * nN, gid = wgid / nig, fm = gid * WGM, gsz = (nM - fm) < WGM ? (nM - fm) : WGM;
        u.pm = fm + ((wgid % nig) % gsz); u.pn = (wgid % nig) / gsz; return true;
    }
};

__device__ __forceinline__ unsigned cvt_pk_bf16(float lo, float hi) { unsigned r; asm volatile("v_cvt_pk_bf16_f32 %0, %1, %2" : "=v"(r) : "v"(lo), "v"(hi)); return r; }
typedef float f32x2 __attribute__((ext_vector_type(2)));
typedef unsigned u32x2 __attribute__((ext_vector_type(2)));
__device__ __forceinline__ float fsigmoid(float x) { return __builtin_amdgcn_rcpf(1.0f + __builtin_amdgcn_exp2f(-1.4426950408889634f * x)); }
__device__ __forceinline__ float fsilu(float x) { return x * fsigmoid(x); }
__device__ __forceinline__ float bf2f(unsigned short b) { return __uint_as_float(((unsigned)b) << 16); }
typedef float f32x2_t __attribute__((ext_vector_type(2))); typedef __bf16 bf16x2_t __attribute__((ext_vector_type(2)));
__device__ __forceinline__ unsigned cvtpk_s(float lo, float hi) { f32x2_t v = {lo, hi}; bf16x2_t b = __builtin_convertvector(v, bf16x2_t); return __builtin_bit_cast(unsigned, b); }
__device__ __forceinline__ u32x4 pack8(const f32x4& a, const f32x4& b) { u32x4 w; w.x = cvtpk_s(a[0], a[1]); w.y = cvtpk_s(a[2], a[3]); w.z = cvtpk_s(b[0], b[1]); w.w = cvtpk_s(b[2], b[3]); return w; }
__device__ __forceinline__ void unpack8(const u32x4& w, f32x4& a, f32x4& b) {
    a[0] = __uint_as_float(w.x << 16); a[1] = __uint_as_float(w.x & 0xffff0000u); a[2] = __uint_as_float(w.y << 16); a[3] = __uint_as_float(w.y & 0xffff0000u);
    b[0] = __uint_as_float(w.z << 16); b[1] = __uint_as_float(w.z & 0xffff0000u); b[2] = __uint_as_float(w.w << 16); b[3] = __uint_as_float(w.w & 0xffff0000u); }
__device__ __forceinline__ float row_rstd(const float* ssp, int r) {
    const f32x4* p = (const f32x4*)(ssp + (size_t)r * 16);
    const f32x4 a = p[0], b = p[1], c = p[2], d = p[3]; const f32x4 s = (a + b) + (c + d);
    return __builtin_amdgcn_rsqf(((s[0] + s[1]) + (s[2] + s[3])) * (1.0f / 1024.0f) + 1e-6f);
}
#define EPI_FENCE() asm volatile("" ::: "memory")
typedef __amdgpu_buffer_rsrc_t rsrc_t;
__device__ __forceinline__ rsrc_t mk_rsrc(const void* p) { return __builtin_amdgcn_make_buffer_rsrc((void*)p, (short)0, 0x7fffffff, 0x00020000); }
__device__ __forceinline__ float xq_sum(float x) {
    auto s = __builtin_amdgcn_permlane16_swap(__float_as_uint(x), __float_as_uint(x), false, false); x = __uint_as_float(s[0]) + __uint_as_float(s[1]);
    auto t = __builtin_amdgcn_permlane32_swap(__float_as_uint(x), __float_as_uint(x), false, false); return __uint_as_float(t[0]) + __uint_as_float(t[1]);
}
__device__ __forceinline__ void rstd8_issue(const float* ssp, int row0, int fq, f32x4 (&p)[2][4]) {
#pragma unroll
    for (int ai = 0; ai < 2; ++ai)
#pragma unroll
        for (int m = 0; m < 4; ++m) p[ai][m] = *(const f32x4*)(ssp + (size_t)(row0 + ai * HALF + m * 16) * 16 + 4 * fq);
}
__device__ __forceinline__ void rstd8_reduce(const f32x4 (&p)[2][4], float (&rs)[2][4]) {
#pragma unroll
    for (int ai = 0; ai < 2; ++ai)
#pragma unroll
        for (int m = 0; m < 4; ++m) { const float q = (p[ai][m][0] + p[ai][m][1]) + (p[ai][m][2] + p[ai][m][3]); rs[ai][m] = __builtin_amdgcn_rsqf(xq_sum(q) * (1.0f / 1024.0f) + 1e-6f); }
}
struct EpiSwiglu {
    static constexpr bool PERM = true, AFTER_DRAIN = false, CHAIN = false, RS = true;
    bf16_t* H; const float* ssp;
    __device__ __forceinline__ const float* rs_ptr() const { return ssp; }
    __device__ __forceinline__ void operator()(const f32x4 (&acc)[2][2][4][2], const Unit& u, int wr, int wc, int fr, int fq, const float (&rs8)[2][4]) const {
        const int row0 = u.pm * BM + wr * 64 + fr, col0 = u.pn * HALF + wc * 32 + 8 * fq;
#pragma unroll
        for (int ai = 0; ai < 2; ++ai)
#pragma unroll
            for (int m = 0; m < 4; ++m) { const int r = row0 + ai * HALF + m * 16; const float s = rs8[ai][m]; f32x4 o[2];
                const float sn = -1.4426950408889634f * s, s2 = s * s;
#pragma unroll
                for (int n = 0; n < 2; ++n) { const f32x4 gu = acc[ai][0][m][n] * acc[ai][1][m][n], t = acc[ai][0][m][n] * sn;
#pragma unroll
                    for (int i = 0; i < 4; ++i) o[n][i] = gu[i] * (s2 * __builtin_amdgcn_rcpf(1.0f + __builtin_amdgcn_exp2f(t[i]))); }
                *(u32x4*)(H + (size_t)r * 2816 + col0) = pack8(o[0], o[1]); EPI_FENCE(); }
    }
};
template <int MODE> struct EpiResid {
    static constexpr bool PERM = true, AFTER_DRAIN = false, CHAIN = false, RS = (MODE == 1);
    bf16_t* XB; float* sso; const float* ssi; const bf16_t* proj; float scale; const bf16_t* XBin;
    __device__ __forceinline__ const float* rs_ptr() const { return ssi; }
    static constexpr int NB = (MODE == 0) ? 8 : 2;
    __device__ __forceinline__ void operator()(const f32x4 (&acc)[2][2][4][2], const Unit& u, int wr, int wc, int fr, int fq, const float (&rs8)[2][4]) const {
        const rsrc_t rx = mk_rsrc(XBin), rp = mk_rsrc(MODE == 1 ? (const void*)proj : (const void*)XBin), ro = mk_rsrc(XB);
        const unsigned voff = (unsigned)(fr * 1024 + 8 * fq) * 2u;
        const unsigned sbase = (unsigned)((u.pm * BM + wr * 64) * 1024 + u.pn * BM + wc * 32) * 2u;
        const int row0 = u.pm * BM + wr * 64 + fr;
#pragma unroll
        for (int gp = 0; gp < 8 / NB; ++gp) {
            u32x4 xv[NB][2]; u32x4 pv[NB][2];
#pragma unroll
            for (int mm = 0; mm < NB; ++mm) { const int g = NB * gp + mm, ai = g >> 2, m = g & 3;
#pragma unroll
                for (int bj = 0; bj < 2; ++bj) { const unsigned so = sbase + (unsigned)((ai * HALF + m * 16) * 1024 + bj * HALF) * 2u;
                    xv[mm][bj] = __builtin_amdgcn_raw_buffer_load_b128(rx, voff + so, 0, 0);
                    if (MODE == 1) pv[mm][bj] = __builtin_amdgcn_raw_buffer_load_b128(rp, voff + so, 0, 0); } }
#pragma unroll
            for (int mm = 0; mm < NB; ++mm) { const int g = NB * gp + mm, ai = g >> 2, m = g & 3; const int r = row0 + ai * HALF + m * 16; float ss = 0.f;
                float s = 1.0f; if (MODE == 1) s = rs8[ai][m];
#pragma unroll
                for (int bj = 0; bj < 2; ++bj) { const unsigned so = sbase + (unsigned)((ai * HALF + m * 16) * 1024 + bj * HALF) * 2u; f32x4 x0, x1; unpack8(xv[mm][bj], x0, x1);
                    if (MODE == 0) { x0 = x0 + acc[ai][bj][m][0] * scale; x1 = x1 + acc[ai][bj][m][1] * scale; }
                    else { f32x4 p0, p1; unpack8(pv[mm][bj], p0, p1);
#pragma unroll
                        for (int i = 0; i < 4; ++i) { x0[i] += fsigmoid(acc[ai][bj][m][0][i] * s) * p0[i]; x1[i] += fsigmoid(acc[ai][bj][m][1][i] * s) * p1[i]; } }
                    __builtin_amdgcn_raw_buffer_store_b128(pack8(x0, x1), ro, voff + so, 0, 0);
                    ss += ((x0[0] * x0[0] + x0[1] * x0[1]) + (x0[2] * x0[2] + x0[3] * x0[3])) + ((x1[0] * x1[0] + x1[1] * x1[1]) + (x1[2] * x1[2] + x1[3] * x1[3])); }
                ss = xq_sum(ss);
                if (fq == 0) sso[(size_t)r * 16 + u.pn * 4 + wc] = ss; }
            EPI_FENCE(); }
    }
};
template <int ACT, bool RS, int LD> __device__ __forceinline__ void store_tile(const f32x4 (&acc)[2][2][4][2], bf16_t* base, const float (&rs8)[2][4], const float* cvp, int row0, int fq) {
    f32x4 cv[2][2];
#pragma unroll
    for (int bj = 0; bj < 2; ++bj)
#pragma unroll
        for (int n = 0; n < 2; ++n) cv[bj][n] = (ACT >= 3) ? *(const f32x4*)(cvp + bj * HALF + 4 * n) : (f32x4){0.f, 0.f, 0.f, 0.f};
#pragma unroll
    for (int ai = 0; ai < 2; ++ai)
#pragma unroll
        for (int m = 0; m < 4; ++m) { const int r = row0 + ai * HALF + m * 16; float s = 1.0f; if (RS) s = rs8[ai][m];
#pragma unroll
            for (int bj = 0; bj < 2; ++bj) { f32x4 o[2];
#pragma unroll
                for (int n = 0; n < 2; ++n) { const f32x4 z = acc[ai][bj][m][n] * ((ACT == 2) ? -1.4426950408889634f * s : s);
#pragma unroll
                    for (int i = 0; i < 4; ++i) { float v = z[i];
                        if (ACT == 1) v = fsilu(v);
                        else if (ACT == 2) v = __builtin_amdgcn_rcpf(1.0f + __builtin_amdgcn_exp2f(v));
                        else if (ACT == 3) v = (1.0f - cv[bj][n][i]) * fsigmoid(-v);
                        else if (ACT == 4) v = __builtin_amdgcn_exp2f(-0.6065306597126334f * 1.4426950408889634f * fsigmoid(v + cv[bj][n][i]));
                        else if (ACT == 5) v = fsigmoid(v + cv[bj][n][i]);
                        o[n][i] = v; } }
                *(u32x4*)(base + (size_t)r * LD + bj * HALF) = pack8(o[0], o[1]); }
            EPI_FENCE(); }
}
template <int KIND> struct EpiStore {
    static constexpr bool PERM = true, AFTER_DRAIN = false, CHAIN = false, RS = (KIND <= 2);
    bf16_t* O; const float* ssp; bf16_t* O2; bf16_t* O3; const float* c0; const float* c1;
    __device__ __forceinline__ const float* rs_ptr() const { return ssp; }
    __device__ __forceinline__ void operator()(const f32x4 (&acc)[2][2][4][2], const Unit& u, int wr, int wc, int fr, int fq, const float (&rs8)[2][4]) const {
        const int row0 = u.pm * BM + wr * 64 + fr; const int cl = wc * 32 + 8 * fq;
        if (KIND == 0) store_tile<0, true, 1792>(acc, O + u.pn * BM + cl, rs8, nullptr, row0, fq);
        if (KIND == 1) {
            if (u.pn < 3) store_tile<0, true, 768>(acc, O + u.pn * BM + cl, rs8, nullptr, row0, fq);
            else { const int t = u.pn - 3, kind = t >> 1; bf16_t* b = O2 + t * BM + cl;
                if (kind == 0 || kind == 3) store_tile<1, true, 2048>(acc, b, rs8, nullptr, row0, fq);
                else if (kind == 1) store_tile<3, true, 2048>(acc, b, rs8, c0 + (t & 1) * BM + cl, row0, fq);
                else store_tile<0, true, 2048>(acc, b, rs8, nullptr, row0, fq); } }
        if (KIND == 2) store_tile<2, true, 3072>(acc, O + u.pn * BM + cl, rs8, nullptr, row0, fq);
        if (KIND == 3) {
            if (u.pn < 2) store_tile<4, false, 512>(acc, O + u.pn * BM + cl, rs8, c0 + u.pn * BM + cl, row0, fq);
            else if (u.pn < 4) store_tile<5, false, 512>(acc, O2 + (u.pn - 2) * BM + cl, rs8, c1 + (u.pn - 2) * BM + cl, row0, fq);
            else store_tile<0, false, 512>(acc, O3 + (u.pn - 4) * BM + cl, rs8, nullptr, row0, fq); }
        if (KIND == 4) store_tile<0, false, 1024>(acc, O + u.pn * BM + cl, rs8, nullptr, row0, fq);
    }
};
template <bool FIRST> struct EpiBranch {
    static constexpr bool PERM = true, AFTER_DRAIN = false, CHAIN = false, RS = false;
    bf16_t* Mg; const bf16_t* G; const float* ssp;
    __device__ __forceinline__ const float* rs_ptr() const { return nullptr; }
    __device__ __forceinline__ void operator()(const f32x4 (&acc)[2][2][4][2], const Unit& u, int wr, int wc, int fr, int fq, const float (&rs8)[2][4]) const {
        const int row0 = u.pm * BM + wr * 64 + fr, col0 = u.pn * BM + wc * 32 + 8 * fq;
#pragma unroll
        for (int ai = 0; ai < 2; ++ai)
#pragma unroll
            for (int m = 0; m < 4; ++m) { const int r = row0 + ai * HALF + m * 16;
#pragma unroll
                for (int bj = 0; bj < 2; ++bj) { f32x4 g0, g1; unpack8(*(const u32x4*)(G + (size_t)r * 3072 + col0 + bj * HALF), g0, g1);
                    f32x4 o0 = g0 * acc[ai][bj][m][0], o1 = g1 * acc[ai][bj][m][1];
                    bf16_t* mp = Mg + (size_t)r * 1024 + col0 + bj * HALF;
                    if (!FIRST) { f32x4 p0, p1; unpack8(*(const u32x4*)mp, p0, p1); o0 = o0 + p0; o1 = o1 + p1; }
                    *(u32x4*)mp = pack8(o0, o1); }
                EPI_FENCE(); }
    }
};
struct EpiBranchChain {
    static constexpr bool PERM = true, AFTER_DRAIN = false, CHAIN = true, RS = false;
    bf16_t* Mg; const bf16_t* G;
    __device__ __forceinline__ const float* rs_ptr() const { return nullptr; }
    __device__ __forceinline__ void operator()(f32x4 (&acc)[2][2][4][2], const Unit& u, int wr, int wc, int fr, int fq, const float (&rs8)[2][4]) const {
        const int b = u.b; const rsrc_t rg = mk_rsrc(G), rm = mk_rsrc(Mg);
        const unsigned vg = (unsigned)(fr * 3072 + 8 * fq) * 2u + (unsigned)((u.pm * BM + wr * 64) * 3072 + b * 1024 + u.pn * BM + wc * 32) * 2u;
        const unsigned vm = (unsigned)(fr * 1024 + 8 * fq) * 2u + (unsigned)((u.pm * BM + wr * 64) * 1024 + u.pn * BM + wc * 32) * 2u;
        if (b < 2) {
#pragma unroll
            for (int ai = 0; ai < 2; ++ai) { u32x4 gv[4][2], hv[4][2];
#pragma unroll
                for (int m = 0; m < 4; ++m)
#pragma unroll
                    for (int bj = 0; bj < 2; ++bj) { const unsigned o = vg + (unsigned)((ai * HALF + m * 16) * 3072 + bj * HALF) * 2u;
                        gv[m][bj] = __builtin_amdgcn_raw_buffer_load_b128(rg, o, 0, 0); hv[m][bj] = __builtin_amdgcn_raw_buffer_load_b128(rg, o + 2048u, 0, 0); }
#pragma unroll
                for (int m = 0; m < 4; ++m)
#pragma unroll
                    for (int bj = 0; bj < 2; ++bj) { f32x4 g0, g1, h0, h1; unpack8(gv[m][bj], g0, g1); unpack8(hv[m][bj], h0, h1);
#pragma unroll
                        for (int i = 0; i < 4; ++i) { g0[i] *= __builtin_amdgcn_rcpf(h0[i]); g1[i] *= __builtin_amdgcn_rcpf(h1[i]); }
                        acc[ai][bj][m][0] = acc[ai][bj][m][0] * g0; acc[ai][bj][m][1] = acc[ai][bj][m][1] * g1; }
                EPI_FENCE(); }
        } else { u32x4 gv[2][4][2];
#pragma unroll
            for (int ai = 0; ai < 2; ++ai)
#pragma unroll
                for (int m = 0; m < 4; ++m)
#pragma unroll
                    for (int bj = 0; bj < 2; ++bj) gv[ai][m][bj] = __builtin_amdgcn_raw_buffer_load_b128(rg, vg + (unsigned)((ai * HALF + m * 16) * 3072 + bj * HALF) * 2u, 0, 0);
#pragma unroll
            for (int ai = 0; ai < 2; ++ai)
#pragma unroll
                for (int m = 0; m < 4; ++m)
#pragma unroll
                    for (int bj = 0; bj < 2; ++bj) { f32x4 g0, g1; unpack8(gv[ai][m][bj], g0, g1); const f32x4 o0 = g0 * acc[ai][bj][m][0], o1 = g1 * acc[ai][bj][m][1];
                        __builtin_amdgcn_raw_buffer_store_b128(pack8(o0, o1), rm, vm + (unsigned)((ai * HALF + m * 16) * 1024 + bj * HALF) * 2u, 0, 0); }
            EPI_FENCE(); }
    }
};
struct ChainOrder : StaticOrder {
    __host__ __device__ bool next(int i, Unit& u) const { if (i >= 3) return false; if (!StaticOrder::next(0, u)) return false; u.b = i; return true; }
};
template <class Epi, class Sched, bool ALIGN_EPI = false, bool SP2 = false>
__device__ __forceinline__ void gemm_phase(PG8_LAS unsigned char* lds, const Gemm g, const Sched& S, const Epi& E) {
    const int tid = threadIdx.x, wid = __builtin_amdgcn_readfirstlane(tid >> 6), lane = tid & 63, wr = wid >> 2, wc = wid & 3, fr = lane & 15, fq = lane >> 4;
    int Kl_ = g.K; asm volatile("" : "+s"(Kl_)); const int K = Kl_, nt = K / BK;
    unsigned voffA[2], voffB[2];
#pragma unroll
    for (int i = 0; i < 2; ++i) { int R, C; stage_rc(tid * 16 + i * 8192, R, C); const int Rb = Epi::PERM ? ((R & ~31) + perm32(R & 31)) : R;
        voffA[i] = (unsigned)(R * K + C) * 2u; voffB[i] = (unsigned)(Rb * K + C) * 2u; }
    const size_t kstep = (size_t)(BK * 2);
    const size_t hstep = (size_t)HALF * K * 2;
    const size_t tstep = 2 * hstep;
    const unsigned ldsw = (unsigned)wid * 1024u;
    const int aoff = lds_byte(wr * 64 + fr, fq * 8), boff = lds_byte(wc * 32 + fr, fq * 8);
#define PG8_SA(b, h) (((b) * 2 + (h)) * HTB)
#define PG8_SB(b, h) ((4 + (b) * 2 + (h)) * HTB)
#define PG8_STAGE(bufoff, gbase, voff) do { _Pragma("unroll") for (int _i = 0; _i < 2; ++_i) \
        __builtin_amdgcn_global_load_lds((const unsigned*)((const char*)(gbase) + (voff)[_i]), (PG8_LAS unsigned*)(lds + (bufoff) + ldsw + _i * 8192), 16, 0, 0); } while (0)
#define PG8_LDA(dst, b, h) do { _Pragma("unroll") for (int m = 0; m < 4; ++m) _Pragma("unroll") for (int k = 0; k < 2; ++k) dst[m][k] = *(const PG8_LAS bf16x8*)(lds + PG8_SA(b, h) + aoff + m * 2048 + k * 1024); } while (0)
#define PG8_LDB(dst, b, h) do { _Pragma("unroll") for (int n = 0; n < 2; ++n) _Pragma("unroll") for (int k = 0; k < 2; ++k) dst[n][k] = *(const PG8_LAS bf16x8*)(lds + PG8_SB(b, h) + boff + n * 2048 + k * 1024); } while (0)
#define PG8_MMA(ai, bj, At, Bt) do { __builtin_amdgcn_s_setprio(1); _Pragma("unroll") for (int m = 0; m < 4; ++m) _Pragma("unroll") for (int n = 0; n < 2; ++n) _Pragma("unroll") for (int k = 0; k < 2; ++k) \
        acc[ai][bj][m][n] = __builtin_amdgcn_mfma_f32_16x16x32_bf16(Bt[n][k], At[m][k], acc[ai][bj][m][n], 0, 0, 0); __builtin_amdgcn_s_setprio(0); } while (0)
#define PG8_WAIT_V(n) asm volatile("s_waitcnt vmcnt(" #n ")" ::: "memory")
#define PG8_WAIT_L(n) asm volatile("s_waitcnt lgkmcnt(" #n ")" ::: "memory")
#define PG8_BAR __builtin_amdgcn_s_barrier()
#define PG8_SCHED __builtin_amdgcn_sched_barrier(0)
    Unit cur, nxt; int ui = 0;
    if (!S.next(0, cur)) return;
    f32x4 acc[2][2][4][2];
#pragma unroll
    for (int a = 0; a < 2; ++a)
#pragma unroll
        for (int b = 0; b < 2; ++b)
#pragma unroll
            for (int m = 0; m < 4; ++m)
#pragma unroll
                for (int n = 0; n < 2; ++n) acc[a][b][m][n] = (f32x4){0.f, 0.f, 0.f, 0.f};
    bf16x8 At[4][2], B0[2][2], B1[2][2];
    const char* cA = (const char*)g.A + (size_t)cur.pm * tstep + (size_t)cur.b * g.usA * 2; const char* cB = (const char*)g.Bt + (size_t)cur.pn * tstep + (size_t)cur.b * g.usB * 2;
    S.a_ready(cur);
    PG8_LAS float* RSL = (PG8_LAS float*)(lds + RS_LDS_OFF);
    if constexpr (Epi::RS) { f32x4 p0_[2];
#pragma unroll
        for (int ai = 0; ai < 2; ++ai) p0_[ai] = *(const f32x4*)(E.rs_ptr() + (size_t)(cur.pm * BM + ai * HALF + wr * 64 + wc * 16 + fr) * 16 + 4 * fq);
#pragma unroll
        for (int ai = 0; ai < 2; ++ai) { const float q_ = (p0_[ai][0] + p0_[ai][1]) + (p0_[ai][2] + p0_[ai][3]); const float r_ = __builtin_amdgcn_rsqf(xq_sum(q_) * (1.0f / 1024.0f) + 1e-6f);
            if (fq == 0) RSL[ai * HALF + wr * 64 + wc * 16 + fr] = r_; } }
    if constexpr (SP2) {
        PG8_STAGE(PG8_SB(0, 0), cB, voffB); PG8_STAGE(PG8_SB(0, 1), cB + hstep, voffB); PG8_STAGE(PG8_SA(0, 0), cA, voffA); PG8_STAGE(PG8_SA(0, 1), cA + hstep, voffA);
        if (wr == 1) PG8_BAR;
        PG8_WAIT_V(2); PG8_BAR;
        PG8_STAGE(PG8_SB(1, 0), cB + kstep, voffB); PG8_STAGE(PG8_SA(1, 0), cA + kstep, voffA); PG8_STAGE(PG8_SB(1, 1), cB + hstep + kstep, voffB);
        PG8_WAIT_V(6); PG8_BAR;
    } else {
        PG8_STAGE(PG8_SB(0, 0), cB, voffB); PG8_STAGE(PG8_SA(0, 0), cA, voffA); PG8_STAGE(PG8_SB(0, 1), cB + hstep, voffB); PG8_STAGE(PG8_SA(0, 1), cA + hstep, voffA);
        if (wr == 1) PG8_BAR;
        PG8_WAIT_V(4); PG8_BAR;
        PG8_STAGE(PG8_SB(1, 0), cB + kstep, voffB); PG8_STAGE(PG8_SA(1, 0), cA + kstep, voffA); PG8_STAGE(PG8_SB(1, 1), cB + hstep + kstep, voffB);
        PG8_WAIT_V(6); PG8_BAR;
    }
    for (;;) {
        const bool has_next = S.next(ui + 1, nxt);
        const char* nA = has_next ? (const char*)g.A + (size_t)nxt.pm * tstep + (size_t)nxt.b * g.usA * 2 : cA; const char* nB = has_next ? (const char*)g.Bt + (size_t)nxt.pn * tstep + (size_t)nxt.b * g.usB * 2 : cB;
        for (int t = 0; t < nt; t += 2) {
            const bool last = (t == nt - 2);
            const char* a1 = cA + (size_t)(t + 1) * kstep;
            const char* a2 = last ? nA : cA + (size_t)(t + 2) * kstep; const char* b2 = last ? nB : cB + (size_t)(t + 2) * kstep;
            const char* a3 = a2 + kstep; const char* b3 = b2 + kstep;
            if (last && has_next) S.a_ready(nxt);
            if constexpr (SP2) {
            PG8_LDB(B0, 0, 0); PG8_LDB(B1, 0, 1); PG8_SCHED; PG8_LDA(At, 0, 0); PG8_STAGE(PG8_SA(1, 1), a1 + hstep, voffA);
            PG8_WAIT_V(8); PG8_WAIT_L(0); PG8_BAR; PG8_MMA(0, 0, At, B0); PG8_MMA(0, 1, At, B1); PG8_BAR; PG8_SCHED;
            PG8_LDA(At, 0, 1); PG8_STAGE(PG8_SB(0, 0), b2, voffB); PG8_STAGE(PG8_SB(0, 1), b2 + hstep, voffB); PG8_STAGE(PG8_SA(0, 0), a2, voffA);
            PG8_WAIT_V(8); PG8_WAIT_L(0); PG8_BAR; PG8_MMA(1, 0, At, B0); PG8_MMA(1, 1, At, B1); PG8_BAR; PG8_SCHED;
            PG8_LDB(B0, 1, 0); PG8_LDB(B1, 1, 1); PG8_SCHED; PG8_LDA(At, 1, 0); PG8_STAGE(PG8_SA(0, 1), a2 + hstep, voffA);
            PG8_WAIT_V(8); PG8_WAIT_L(0); PG8_BAR; PG8_MMA(0, 0, At, B0); PG8_MMA(0, 1, At, B1); PG8_BAR; PG8_SCHED;
            PG8_LDA(At, 1, 1); PG8_STAGE(PG8_SB(1, 0), b3, voffB); PG8_STAGE(PG8_SB(1, 1), b3 + hstep, voffB); PG8_STAGE(PG8_SA(1, 0), a3, voffA);
            PG8_WAIT_V(8); PG8_WAIT_L(0); PG8_BAR; PG8_MMA(1, 0, At, B0); PG8_MMA(1, 1, At, B1); PG8_BAR; PG8_SCHED;
            } else {
            PG8_LDB(B0, 0, 0); PG8_SCHED; PG8_LDA(At, 0, 0); PG8_STAGE(PG8_SA(1, 1), a1 + hstep, voffA);
            PG8_WAIT_L(8); PG8_BAR; PG8_WAIT_L(0); PG8_MMA(0, 0, At, B0); PG8_BAR; PG8_SCHED;
            PG8_LDB(B1, 0, 1); PG8_STAGE(PG8_SB(0, 0), b2, voffB);
            PG8_BAR; PG8_WAIT_L(0); PG8_MMA(0, 1, At, B1); PG8_BAR;
            PG8_LDA(At, 0, 1); PG8_STAGE(PG8_SA(0, 0), a2, voffA);
            PG8_BAR; PG8_WAIT_L(0); PG8_MMA(1, 0, At, B0); PG8_BAR; PG8_SCHED;
            PG8_STAGE(PG8_SB(0, 1), b2 + hstep, voffB);
            PG8_WAIT_V(6); PG8_BAR; PG8_MMA(1, 1, At, B1); PG8_BAR;
            PG8_LDB(B0, 1, 0); PG8_SCHED; PG8_LDA(At, 1, 0); PG8_STAGE(PG8_SA(0, 1), a2 + hstep, voffA);
            PG8_WAIT_L(8); PG8_BAR; PG8_WAIT_L(0); PG8_MMA(0, 0, At, B0); PG8_BAR; PG8_SCHED;
            PG8_LDB(B1, 1, 1); PG8_STAGE(PG8_SB(1, 0), b3, voffB);
            PG8_BAR; PG8_WAIT_L(0); PG8_MMA(0, 1, At, B1); PG8_BAR;
            PG8_LDA(At, 1, 1); PG8_STAGE(PG8_SA(1, 0), a3, voffA);
            PG8_BAR; PG8_WAIT_L(0); PG8_MMA(1, 0, At, B0); PG8_BAR; PG8_SCHED;
            PG8_STAGE(PG8_SB(1, 1), b3 + hstep, voffB);
            PG8_WAIT_V(6); PG8_BAR; PG8_MMA(1, 1, At, B1); PG8_BAR;
            }
        }
        if constexpr (ALIGN_EPI) { if (wr == 0) PG8_BAR; }
        if constexpr (!Epi::AFTER_DRAIN) {
            float rsv[2][4];
            if constexpr (Epi::RS) { const PG8_LAS float* rb_ = RSL + (ui & 1) * 256 + wr * 64 + fr;
#pragma unroll
                for (int ai = 0; ai < 2; ++ai)
#pragma unroll
                    for (int m = 0; m < 4; ++m) rsv[ai][m] = rb_[ai * HALF + m * 16];
                f32x4 pn_[2];
                if (has_next) {
#pragma unroll
                    for (int ai = 0; ai < 2; ++ai) pn_[ai] = *(const f32x4*)(E.rs_ptr() + (size_t)(nxt.pm * BM + ai * HALF + wr * 64 + wc * 16 + fr) * 16 + 4 * fq); }
                E(acc, cur, wr, wc, fr, fq, rsv);
                if (has_next) {
#pragma unroll
                    for (int ai = 0; ai < 2; ++ai) { const float q_ = (pn_[ai][0] + pn_[ai][1]) + (pn_[ai][2] + pn_[ai][3]); const float r_ = __builtin_amdgcn_rsqf(xq_sum(q_) * (1.0f / 1024.0f) + 1e-6f);
                        if (fq == 0) RSL[((ui + 1) & 1) * 256 + ai * HALF + wr * 64 + wc * 16 + fr] = r_; } } }
            else { for (int ai = 0; ai < 2; ++ai) for (int m = 0; m < 4; ++m) rsv[ai][m] = 1.0f; E(acc, cur, wr, wc, fr, fq, rsv); }
            S.done(cur); }
        if (!has_next) break;
        if constexpr (!Epi::CHAIN)
#pragma unroll
        for (int a = 0; a < 2; ++a)
#pragma unroll
            for (int b = 0; b < 2; ++b)
#pragma unroll
                for (int m = 0; m < 4; ++m)
#pragma unroll
                    for (int n = 0; n < 2; ++n) acc[a][b][m][n] = (f32x4){0.f, 0.f, 0.f, 0.f};
        cur = nxt; cA = nA; cB = nB; ++ui;
        if constexpr (ALIGN_EPI) { if (wr == 1) PG8_BAR; }
    }
    PG8_WAIT_V(0);
    if constexpr (!ALIGN_EPI) { if (wr == 0) PG8_BAR; }
    PG8_BAR;
    if constexpr (Epi::AFTER_DRAIN) { E.fused(acc, cur, wr, wc, fr, fq, lds, wid, lane); S.done(cur); }
#undef PG8_SA
#undef PG8_SB
#undef PG8_STAGE
#undef PG8_LDA
#undef PG8_LDB
#undef PG8_MMA
#undef PG8_WAIT_V
#undef PG8_WAIT_L
#undef PG8_BAR
#undef PG8_SCHED
}
}
#define GAS __attribute__((address_space(1)))
#define LAS __attribute__((address_space(3)))
typedef unsigned short bf16;
typedef unsigned v4u __attribute__((ext_vector_type(4)));
typedef float f32x4 __attribute__((ext_vector_type(4)));
typedef short bf16x8 __attribute__((ext_vector_type(8)));
typedef GAS unsigned gu32;
typedef GAS unsigned long long gu64;
#define RLX_AGENT __ATOMIC_RELAXED, __HIP_MEMORY_SCOPE_AGENT
#define LDS_WAIT() asm volatile("s_waitcnt lgkmcnt(0)" ::: "memory")
#define VM_WAIT() asm volatile("s_waitcnt vmcnt(0)" ::: "memory")
__device__ __forceinline__ unsigned long long rt() { return __builtin_amdgcn_s_memrealtime(); }
__device__ __forceinline__ unsigned f2bf(float f) { unsigned u = __builtin_bit_cast(unsigned, f); return (u + 0x7fffu + ((u >> 16) & 1u)) >> 16; }
__device__ __forceinline__ unsigned pk2(float lo, float hi) { return f2bf(lo) | (f2bf(hi) << 16); }

#define XB_TMO      128
#define XB_XCNT(j)  (256  + 64 * (j))
#define XB_XSUB(j)  (1280 + 64 * (j))
#define XB_XGEN(j)  (2304 + 64 * (j))
#define XB_TOP      3328
#define XB_TOPGEN   3392
#define XCD_BAR_WORDS 3456
#define XB_SPIN_CAP (1u << 18)

__device__ __forceinline__ unsigned xb_ld(unsigned* p)              { return __hip_atomic_load(p, __ATOMIC_RELAXED, __HIP_MEMORY_SCOPE_AGENT); }
__device__ __forceinline__ unsigned xb_add(unsigned* p, unsigned v) { return __hip_atomic_fetch_add(p, v, __ATOMIC_RELAXED, __HIP_MEMORY_SCOPE_AGENT); }
__device__ __forceinline__ unsigned xb_xcc_id() { return (unsigned)__builtin_amdgcn_s_getreg((3 << 11) | 20) & 0xFu; }
#define XB_SPIN(cond, bar) do { unsigned _sp = 0; while (cond) { __builtin_amdgcn_s_sleep(1); \
    if ((++_sp & 255u) == 0u) { if (xb_ld(&(bar)[XB_TMO])) break; if (_sp > XB_SPIN_CAP) { atomicAdd(&(bar)[XB_TMO], 1u); break; } } } } while (0)

struct XcdBarrier {
    unsigned* bar; unsigned x;
    volatile LAS unsigned* st;
};

__device__ __forceinline__ XcdBarrier xcd_barrier_post(unsigned* bar, volatile LAS unsigned* st) {
    XcdBarrier b; b.bar = bar; b.x = xb_xcc_id(); b.st = st;
    if (threadIdx.x == 0) (void)xb_add(&bar[XB_XCNT(b.x)], 1u);
    return b;
}
__device__ __forceinline__ void xcd_barrier_complete(unsigned* bar, unsigned x, unsigned& nloc, unsigned& nx) {
    const unsigned G = gridDim.x * gridDim.y * gridDim.z;
    unsigned sum, cnt, mine, sp = 0u;
    for (;;) {
        sum = 0u; cnt = 0u; mine = 0u;
#pragma unroll
        for (unsigned j = 0; j < 16; ++j) { const unsigned c = xb_ld(&bar[XB_XCNT(j)]); sum += c; cnt += (c > 0u) ? 1u : 0u; mine = (j == x) ? c : mine; }
        if (sum == G) break;
        __builtin_amdgcn_s_sleep(1);
        if ((++sp & 255u) == 0u) { if (xb_ld(&bar[XB_TMO])) break; if (sp > XB_SPIN_CAP) { atomicAdd(&bar[XB_TMO], 1u); break; } }
    }
    nloc = mine > 0u ? mine : 1u; nx = cnt > 0u ? cnt : 1u;
}

__device__ __forceinline__ void xcd_barrier(const XcdBarrier& b) {
    asm volatile("s_waitcnt vmcnt(0)" ::: "memory");
    __syncthreads();
    if (threadIdx.x == 0) {
        unsigned* bar = b.bar;
        __builtin_amdgcn_s_waitcnt(0);
        unsigned nloc = b.st[0], nx = b.st[1];
        if (nloc == 0u) { xcd_barrier_complete(bar, b.x, nloc, nx); b.st[0] = nloc; b.st[1] = nx; }
        const unsigned old = xb_add(&bar[XB_XSUB(b.x)], 1u);
        const unsigned gen = old / nloc;
        if (old + 1u == (gen + 1u) * nloc) {
            __builtin_amdgcn_fence(__ATOMIC_RELEASE, "agent");
            asm volatile("s_waitcnt vmcnt(0)" ::: "memory");
            __builtin_amdgcn_fence(__ATOMIC_ACQUIRE, "agent");
            const unsigned og = xb_add(&bar[XB_TOP], 1u);
            const unsigned tg = og / nx;
            if (og + 1u == (tg + 1u) * nx) xb_add(&bar[XB_TOPGEN], 1u);
            else XB_SPIN(xb_ld(&bar[XB_TOPGEN]) == tg, bar);
            xb_add(&bar[XB_XGEN(b.x)], 1u);
            asm volatile("s_waitcnt vmcnt(0)" ::: "memory");
        } else {
            __builtin_amdgcn_fence(__ATOMIC_ACQUIRE, "agent");
            XB_SPIN(xb_ld(&bar[XB_XGEN(b.x)]) == gen, bar);
            asm volatile("s_waitcnt vmcnt(0)" ::: "memory");
        }
    }
    __syncthreads();
}
constexpr int NWAVES = 8;
constexpr int BATCH = 2, SEQ = 8192, DM = 1024, M = BATCH * SEQ, FF = 2816, DEPTH = 2;
enum { I_X = 0, I_P, I_F1N, I_F1G, I_F1U, I_F1D, I_MIXN, I_WIN, I_SINK, I_MU, I_W0, I_WUP, I_A0, I_AUP, I_GUP, I_KK, I_KA, I_RK, I_LNW, I_LNB, I_HLB, I_HNORM, I_WBR, I_WO,
       I_F2N, I_F2G, I_F2U, I_F2D, I_PLEN, I_PLEG, I_PLEP, I_FINN, N_IN };
constexpr size_t KiB = 1024, MiB = 1u << 20;
constexpr size_t WS_CTL = 0, CTL_ZERO_BYTES = 64 * KiB;
constexpr size_t WS_SS0 = 1 * MiB, WS_SS1 = 2 * MiB;
constexpr size_t WS_CBON = 3 * MiB;
constexpr size_t WS_LB = 3 * MiB + 512 * KiB;
constexpr size_t WS_W = 4 * MiB;
constexpr size_t W_F1GU = WS_W, W_F1D = W_F1GU + (size_t)5632 * 1024 * 2, W_IN = W_F1D + (size_t)1024 * 2816 * 2, W_LR = W_IN + (size_t)7680 * 1024 * 2,
                 W_BR = W_LR + (size_t)1536 * 256 * 2, W_O = W_BR + (size_t)3 * 1024 * 512 * 2, W_F2GU = W_O + (size_t)1024 * 1024 * 2, W_F2D = W_F2GU + (size_t)5632 * 1024 * 2,
                 W_PG = W_F2D + (size_t)1024 * 2816 * 2, W_PP = W_PG + (size_t)1024 * 1024 * 2, W_END = W_PP + (size_t)1024 * 256 * 2;
constexpr size_t WS_XB = 61 * MiB;
static_assert(W_END <= WS_XB, "weights fit");
constexpr size_t WS_R = 93 * MiB;
constexpr size_t R_H = WS_R;
constexpr size_t R_SIN_V = WS_R, R_SIN_R = WS_R + 16 * MiB, R_SIN_W = WS_R + 32 * MiB, R_SIN_KP = WS_R + 48 * MiB, R_SIN_KK = WS_R + 64 * MiB, R_SIN_B = WS_R + 80 * MiB;
constexpr size_t R_CV = WS_R, R_CG = WS_R + 16 * MiB, R_CH = WS_R + 32 * MiB, R_CDT = WS_R + 64 * MiB, R_CQT = WS_R + 80 * MiB, R_CS = WS_R + 200 * MiB;
constexpr size_t R_DAG_G = WS_R + 96 * MiB;
constexpr size_t R_ZR = WS_R + 112 * MiB;
constexpr size_t R_AP = WS_R + 168 * MiB;
constexpr size_t R_DAG_W = WS_R + 176 * MiB, R_DAG_A = WS_R + 192 * MiB;
constexpr size_t R_ZA = WS_R + 112 * MiB;
constexpr size_t R_YRAW = WS_R + 200 * MiB;
constexpr size_t R_Y = WS_R + 16 * MiB;
constexpr size_t R_GG = WS_R + 112 * MiB;
constexpr size_t R_MERGED = WS_R + 64 * MiB;
constexpr size_t R_PB = WS_R + 96 * MiB;
constexpr size_t R_PROJ = WS_R + 112 * MiB;
constexpr size_t R_XBALT = WS_R + 144 * MiB;
constexpr size_t R_HST = WS_R + 216 * MiB;
constexpr size_t WS_HD = 3 * MiB + 576 * KiB;
constexpr size_t WS_END = WS_R + 224 * MiB;
constexpr int CW_BAR = 4096;
constexpr int RING_OFF = 0, RING_BYTES = 131072;
constexpr int LDSCTL_OFF = 143360, MISC_OFF = LDSCTL_OFF + 320;
constexpr int LDS_BYTES = 147456;
constexpr int N_PHASES = 17 * DEPTH + 1;
#ifndef ENMASK
#define ENMASK 0x3ffff
#endif
#define EN(k) ((ENMASK >> (k)) & 1)
struct Args { const float* in[N_IN]; float* out; unsigned char* ws; int ph_lo, ph_hi; };
typedef const __attribute__((address_space(4))) unsigned char* kargp_t;
#define KP_DECL kargp_t KP_ = (kargp_t)__builtin_amdgcn_kernarg_segment_ptr(); asm volatile("" : "+s"(KP_))
#define INP(i) (*(const float* const __attribute__((address_space(4)))*)(KP_ + 8 * (i)))
typedef unsigned u32x2 __attribute__((ext_vector_type(2)));
__device__ __forceinline__ float bflo(unsigned w) { return __uint_as_float(w << 16); }
__device__ __forceinline__ float bfhi(unsigned w) { return __uint_as_float(w & 0xffff0000u); }
__device__ __forceinline__ float bf1(bf16 b) { return __uint_as_float(((unsigned)b) << 16); }
__device__ __forceinline__ float sigm(float x) { return __builtin_amdgcn_rcpf(1.0f + __builtin_amdgcn_exp2f(-1.4426950408889634f * x)); }
template <int CTRL> __device__ __forceinline__ float dppf(float x) { return __builtin_bit_cast(float, __builtin_amdgcn_mov_dpp(__builtin_bit_cast(int, x), CTRL, 0xf, 0xf, true)); }
__device__ __forceinline__ float xrow16_sum(float x) {
    auto s = __builtin_amdgcn_permlane16_swap(__float_as_uint(x), __float_as_uint(x), false, false);
    x = __uint_as_float(s[0]) + __uint_as_float(s[1]);
    auto t = __builtin_amdgcn_permlane32_swap(__float_as_uint(x), __float_as_uint(x), false, false);
    return __uint_as_float(t[0]) + __uint_as_float(t[1]);
}
__device__ __forceinline__ float wave_allsum(float x) {
    x += dppf<0xB1>(x); x += dppf<0x4E>(x); x += dppf<0x141>(x); x += dppf<0x128>(x); return xrow16_sum(x);
}
__device__ __forceinline__ float wave_allsum_slow(float v) {
#pragma unroll
    for (int o = 1; o < 64; o <<= 1) v += __shfl_xor(v, o);
    return v;
}
__device__ __forceinline__ float wave_allmax_slow(float v) {
#pragma unroll
    for (int o = 1; o < 64; o <<= 1) v = fmaxf(v, __shfl_xor(v, o));
    return v;
}

struct Frame {
    LAS unsigned char* lds;
    volatile LAS unsigned* MISC;
    gu32* ctl;
    int tid, lane, wave;
    int G;
    unsigned char* ws;
    float* x;
};
#define WSP(T, off) ((T*)(F.ws + (off)))

__device__ __forceinline__ int map_row(int map, int n0) {
    if (map == 1) return (n0 >> 7) * 256 + (n0 & 127);
    if (map == 2) return (n0 >> 7) * 256 + 128 + (n0 & 127);
    if (map == 3) return n0 < 768 ? 1792 + n0 : (n0 < 2560 ? n0 - 768 : n0);
    return n0;
}
struct CJob { const float* W; const float* g; int K, N; bf16* WT; int map, item; };
__device__ __forceinline__ void conv_load(const CJob& j, int lane, f32x4 (&v)[16], float (&sc)[16]) {
    const int nblk = j.N / 64, kb = j.item / nblk, nb = j.item % nblk, k0 = 64 * kb, n0 = 64 * nb; const int nq = (lane & 15) * 4;
#pragma unroll
    for (int i = 0; i < 16; ++i) { const int kk = 4 * i + (lane >> 4); sc[i] = j.g ? j.g[k0 + kk] : 1.0f; v[i] = __builtin_nontemporal_load((const f32x4*)(j.W + (size_t)(k0 + kk) * j.N + n0 + nq)); }
}
__device__ __forceinline__ void conv_to_lds(int lane, const f32x4 (&v)[16], const float (&sc)[16], LAS float* scr) {
    const int nq = (lane & 15) * 4;
#pragma unroll
    for (int i = 0; i < 16; ++i) { const int kk = 4 * i + (lane >> 4); LAS float* d = scr + kk * 65 + nq; d[0] = v[i].x * sc[i]; d[1] = v[i].y * sc[i]; d[2] = v[i].z * sc[i]; d[3] = v[i].w * sc[i]; }
}
__device__ __forceinline__ void conv_store(const CJob& j, int lane, const LAS float* scr) {
    const int nblk = j.N / 64, kb = j.item / nblk, nb = j.item % nblk, k0 = 64 * kb, n0 = 64 * nb; const int c = lane & 7; const int dr = map_row(j.map, n0);
#pragma unroll
    for (int q = 0; q < 8; ++q) { const int n = (lane >> 3) + 8 * q; const LAS float* s = scr + (8 * c) * 65 + n;
        v4u o; o.x = pk2(s[0 * 65], s[1 * 65]); o.y = pk2(s[2 * 65], s[3 * 65]); o.z = pk2(s[4 * 65], s[5 * 65]); o.w = pk2(s[6 * 65], s[7 * 65]);
        *(GAS v4u*)(j.WT + (size_t)(dr + n) * j.K + k0 + 8 * c) = o; }
}
template <int PART> __device__ __forceinline__ void phase_conv(Frame& F, const Args& A, int L) {
    KP_DECL;
    LAS float* scr = (LAS float*)(F.lds + RING_OFF + F.wave * 16640);
    const int gw = blockIdx.x * NWAVES + F.wave, NGW = F.G * NWAVES;
    const float* f1g = INP(I_F1G) + (size_t)L * 1024 * 2816; const float* f1u = INP(I_F1U) + (size_t)L * 1024 * 2816; const float* f1d = INP(I_F1D) + (size_t)L * 2816 * 1024;
    const float* f2g = INP(I_F2G) + (size_t)L * 1024 * 2816; const float* f2u = INP(I_F2U) + (size_t)L * 1024 * 2816; const float* f2d = INP(I_F2D) + (size_t)L * 2816 * 1024;
    const float* win = INP(I_WIN) + (size_t)L * 1024 * 7680; const float* wbr = INP(I_WBR) + (size_t)L * 3 * 512 * 1024; const float* wo = INP(I_WO) + (size_t)L * 1024 * 1024;
    const float* pg = INP(I_PLEG) + (size_t)L * 1024 * 1024; const float* pp = INP(I_PLEP) + (size_t)L * 256 * 1024;
    const float* n1 = INP(I_F1N) + L * 1024; const float* nm = INP(I_MIXN) + L * 1024; const float* n2 = INP(I_F2N) + L * 1024; const float* np = INP(I_PLEN) + L * 1024;
    constexpr int IT_FGU = 16 * 44, IT_FD = 44 * 16, IT_IN = 16 * 120, IT_BR = 8 * 16, IT_SQ = 16 * 16, IT_PP = 4 * 16;
    constexpr int NITEMS = 4 * IT_FGU + 2 * IT_FD + IT_IN + 3 * IT_BR + 2 * IT_SQ + IT_PP;
#define CONV_DECODE(it_, J) do { int r = (it_); \
        if (r < IT_FGU) { J = CJob{f1g, n1, 1024, 2816, WSP(bf16, W_F1GU), 1, r}; break; } r -= IT_FGU; \
        if (r < IT_FGU) { J = CJob{f1u, n1, 1024, 2816, WSP(bf16, W_F1GU), 2, r}; break; } r -= IT_FGU; \
        if (r < IT_FD)  { J = CJob{f1d, nullptr, 2816, 1024, WSP(bf16, W_F1D), 0, r}; break; } r -= IT_FD; \
        if (r < IT_IN)  { J = CJob{win, nm, 1024, 7680, WSP(bf16, W_IN), 3, r}; break; } r -= IT_IN; \
        if (r < 3 * IT_BR) { const int b_ = r / IT_BR; J = CJob{wbr + (size_t)b_ * 512 * 1024, nullptr, 512, 1024, WSP(bf16, W_BR) + (size_t)b_ * 1024 * 512, 0, r % IT_BR}; break; } r -= 3 * IT_BR; \
        if (r < IT_SQ)  { J = CJob{wo, nullptr, 1024, 1024, WSP(bf16, W_O), 0, r}; break; } r -= IT_SQ; \
        if (r < IT_FGU) { J = CJob{f2g, n2, 1024, 2816, WSP(bf16, W_F2GU), 1, r}; break; } r -= IT_FGU; \
        if (r < IT_FGU) { J = CJob{f2u, n2, 1024, 2816, WSP(bf16, W_F2GU), 2, r}; break; } r -= IT_FGU; \
        if (r < IT_FD)  { J = CJob{f2d, nullptr, 2816, 1024, WSP(bf16, W_F2D), 0, r}; break; } r -= IT_FD; \
        if (r < IT_SQ)  { J = CJob{pg, np, 1024, 1024, WSP(bf16, W_PG), 0, r}; break; } r -= IT_SQ; \
        J = CJob{pp, nullptr, 256, 1024, WSP(bf16, W_PP), 0, r}; } while (0)
    constexpr int NA = 2 * IT_FGU + IT_FD + IT_IN;
    const int first = (PART == 0) ? gw : NA + ((int)blockIdx.x - F.G / 2) * NWAVES + F.wave, stride = (PART == 0) ? NGW : (F.G - F.G / 2) * NWAVES, hi_ = (PART == 0) ? NA : NITEMS;
    { CJob cur{}, nxt{}; f32x4 v[16]; float scv[16];
      if (first < hi_) { CONV_DECODE(first, cur); conv_load(cur, F.lane, v, scv); }
      for (int it = first; it < hi_; it += stride) {
          conv_to_lds(F.lane, v, scv, scr);
          const bool has = it + stride < hi_;
          if (has) { CONV_DECODE(it + stride, nxt); conv_load(nxt, F.lane, v, scv); }
          LDS_WAIT(); asm volatile("" ::: "memory");
          conv_store(cur, F.lane, scr);
          LDS_WAIT(); asm volatile("" ::: "memory");
          cur = nxt; } }
#undef CONV_DECODE
    if (PART != 0) return;
    const float* wup = INP(I_WUP) + (size_t)L * 64 * 512; const float* aup = INP(I_AUP) + (size_t)L * 64 * 512; const float* gup = INP(I_GUP) + (size_t)L * 128 * 512;
    bf16* wlr = WSP(bf16, W_LR);
    const int gt = blockIdx.x * (NWAVES * 64) + F.tid, NGT = F.G * NWAVES * 64;
    for (int e = gt; e < 1536 * 256; e += NGT) { const int n = e >> 8, k = e & 255; const int grp = n >> 9, c = n & 511; float v = 0.f;
        if (grp == 0) { if (k < 64) v = wup[k * 512 + c]; } else if (grp == 1) { if (k >= 64 && k < 128) v = aup[(k - 64) * 512 + c]; } else { if (k >= 128) v = gup[(k - 128) * 512 + c]; }
        wlr[e] = (bf16)f2bf(v); }
    if (gt < 512) { const float a0 = INP(I_HLB)[gt], a1 = INP(I_HLB)[512 + gt]; const float mx = fmaxf(a0, a1); const float e0 = __expf(a0 - mx), e1 = __expf(a1 - mx);
        float lb = (L == 0) ? 0.f : e1 / (e0 + e1); lb = fminf(fmaxf(lb, 0.f), 1.0f - 1e-6f); WSP(float, WS_LB)[gt] = lb; }
    if (L == 0) {
        const float* xin = INP(I_X); bf16* xb = WSP(bf16, WS_XB); float* ss = WSP(float, WS_SS0);
        for (int m0 = gw; m0 < M; m0 += 2 * NGW) {
            f32x4 v[2][4];
#pragma unroll
            for (int k = 0; k < 2; ++k) { const int m = (m0 + k * NGW < M) ? m0 + k * NGW : m0; const GAS f32x4* xr = (const GAS f32x4*)(xin + (size_t)m * DM) + F.lane;
#pragma unroll
                for (int j = 0; j < 4; ++j) v[k][j] = __builtin_nontemporal_load((const f32x4*)(xr + 64 * j)); }
#pragma unroll
            for (int k = 0; k < 2; ++k) { const int m = m0 + k * NGW; if (m >= M) break;
                GAS unsigned long long* o8 = (GAS unsigned long long*)(xb + (size_t)m * DM) + F.lane; float s = 0.f;
#pragma unroll
                for (int j = 0; j < 4; ++j) { const f32x4 vv = v[k][j]; s += (vv.x * vv.x + vv.y * vv.y) + (vv.z * vv.z + vv.w * vv.w);
                    o8[64 * j] = (unsigned long long)pk2(vv.x, vv.y) | ((unsigned long long)pk2(vv.z, vv.w) << 32); }
                s = wave_allsum_slow(s);
                if (F.lane < 16) ss[(size_t)m * 16 + F.lane] = (F.lane == 0) ? s : 0.f; } }
    }
}
__device__ __forceinline__ void conv_p(Frame& F, const Args& A, int L) {
    KP_DECL;
    const float* p = INP(I_P) + (size_t)L * M * 256; bf16* pb = WSP(bf16, R_PB);
    const int gt = blockIdx.x * (NWAVES * 64) + F.tid, NGT = F.G * NWAVES * 64;
    for (int e0 = gt; e0 < M * 256 / 8; e0 += 4 * NGT) {
        f32x4 a[4], b[4];
#pragma unroll
        for (int k = 0; k < 4; ++k) { const int e = e0 + k * NGT; if (e < M * 256 / 8) { a[k] = __builtin_nontemporal_load((const f32x4*)(p + (size_t)e * 8)); b[k] = __builtin_nontemporal_load((const f32x4*)(p + (size_t)e * 8 + 4)); } }
#pragma unroll
        for (int k = 0; k < 4; ++k) { const int e = e0 + k * NGT; if (e < M * 256 / 8) {
            v4u o; o.x = pk2(a[k].x, a[k].y); o.y = pk2(a[k].z, a[k].w); o.z = pk2(b[k].x, b[k].y); o.w = pk2(b[k].z, b[k].w); *(v4u*)(pb + (size_t)e * 8) = o; } } }
}

__device__ __forceinline__ void phase_rprep1(Frame& F, const Args& A, int L) {
    KP_DECL;
    const bf16* zr = WSP(bf16, R_ZR); bf16* ap = WSP(bf16, R_AP); const float* mu = INP(I_MU) + L * 1792 + 1536;
    const int gt = blockIdx.x * (NWAVES * 64) + F.tid, NGT = F.G * NWAVES * 64;
    for (int e = gt; e < M * 32; e += NGT) { const int row = e >> 5, c0 = (e & 31) * 8; const int tl = row & (SEQ - 1);
        const v4u zc = *(const v4u*)(zr + (size_t)row * 1792 + 1536 + c0); v4u zp = (v4u){0u, 0u, 0u, 0u};
        if (tl != 0) zp = *(const v4u*)(zr + (size_t)(row - 1) * 1792 + 1536 + c0);
        float o[8];
#pragma unroll
        for (int i = 0; i < 4; ++i) { const unsigned wc_ = zc[i], wp_ = zp[i];
            const float c_lo = bflo(wc_), c_hi = bfhi(wc_), p_lo = bflo(wp_), p_hi = bfhi(wp_);
            const float m0 = mu[c0 + 2 * i], m1 = mu[c0 + 2 * i + 1];
            o[2 * i] = c_lo + m0 * (p_lo - c_lo); o[2 * i + 1] = c_hi + m1 * (p_hi - c_hi); }
#pragma unroll
        for (int i = 0; i < 8; ++i) { if (c0 < 64) o[i] = 2.0f * sigm(2.0f * o[i]) - 1.0f; else if (c0 >= 128) o[i] = sigm(o[i]); }
        v4u w; w.x = pk2(o[0], o[1]); w.y = pk2(o[2], o[3]); w.z = pk2(o[4], o[5]); w.w = pk2(o[6], o[7]);
        *(v4u*)(ap + (size_t)row * 256 + c0) = w; }
}
typedef float f32x16 __attribute__((ext_vector_type(16)));
__device__ __forceinline__ unsigned cvtpk(float lo, float hi) { return pg8::cvtpk_s(lo, hi); }
constexpr int LDP = 72;
__device__ __forceinline__ f32x4 mm16_k64(const LAS bf16* X, const LAS bf16* YT, int m0, int n0, int lane, f32x4 acc) {
    const int r = lane & 15, g = lane >> 4;
#pragma unroll
    for (int ks = 0; ks < 2; ++ks) { const bf16x8 a = *(const LAS bf16x8*)(X + (m0 + r) * LDP + ks * 32 + 8 * g); const bf16x8 b = *(const LAS bf16x8*)(YT + (n0 + r) * LDP + ks * 32 + 8 * g);
        acc = __builtin_amdgcn_mfma_f32_16x16x32_bf16(a, b, acc, 0, 0, 0); }
    return acc;
}
constexpr int RC_MAT = 64 * LDP * 2;
constexpr int RC_BH = 0, RC_KH = RC_MAT, RC_PC = 2 * RC_MAT, RC_RC = 3 * RC_MAT, RC_PT = 4 * RC_MAT, RC_AKP = 5 * RC_MAT, RC_RT = 6 * RC_MAT, RC_VT = 7 * RC_MAT;
constexpr int RC_XR = 8 * RC_MAT;
constexpr int RC_TI = 10 * RC_MAT;
constexpr int SP = 68;
constexpr int RC_ABP = 11 * RC_MAT;
constexpr int RC_TT = RC_ABP + 64 * SP * 4;
constexpr int RC_PS = RC_TT + 64 * SP * 4;
constexpr int RC_GC = RC_PS + 4096;
constexpr int RC_PAR = RC_GC + 256;
constexpr int RC_END = RC_PAR + 6 * 64 * 4;
static_assert(RC_END <= LDSCTL_OFF, "rwkv pre-pass LDS");
constexpr int RC_ZT = RC_PC;
constexpr int RC_KBT = RC_BH;
__device__ __forceinline__ float shx(float v, int m) { return __shfl_xor(v, m); }
__device__ __forceinline__ float sum8(float v) { v += dppf<0xB1>(v); v += dppf<0x4E>(v); v += dppf<0x141>(v); return v; }
__device__ __forceinline__ float sum16(float v) { v = sum8(v); v += dppf<0x128>(v); return v; }
__device__ __forceinline__ void phase_rchunk_pre(Frame& F, const Args& A, int L) {
    KP_DECL;
    const bf16* zr = WSP(bf16, R_ZR); const bf16* dw = WSP(bf16, R_DAG_W); const bf16* da = WSP(bf16, R_DAG_A);
    const float* mu = INP(I_MU) + L * 1792; const float* k_k = INP(I_KK) + L * 512; const float* k_a = INP(I_KA) + L * 512; const float* r_k = INP(I_RK) + L * 512;
    float* cbon = WSP(float, WS_CBON); bf16* gV = WSP(bf16, R_CV);
    LAS unsigned char* lds = F.lds;
    const int t = F.tid >> 3, cg = F.tid & 7, c0 = cg * 8;
    v4u n_cr, n_ck, n_cv, n_pr, n_pk, n_pv, n_ww, n_aa;
#define RPRE_LOAD(it_) do { const int bh_ = (it_) >> 7, ck2_ = (it_) & 127; const int row_ = (bh_ >> 3) * SEQ + ck2_ * 64 + t, ch_ = (bh_ & 7) * 64 + c0; const bf16* zc_ = zr + (size_t)row_ * 1792 + ch_; \
        n_cr = *(const v4u*)zc_; n_ck = *(const v4u*)(zc_ + 512); n_cv = *(const v4u*)(zc_ + 1024); n_pr = (v4u){0u,0u,0u,0u}; n_pk = n_pr; n_pv = n_pr; \
        if (ck2_ * 64 + t != 0) { n_pr = *(const v4u*)(zc_ - 1792); n_pk = *(const v4u*)(zc_ - 1792 + 512); n_pv = *(const v4u*)(zc_ - 1792 + 1024); } \
        n_ww = *(const v4u*)(dw + (size_t)row_ * 512 + ch_); n_aa = *(const v4u*)(da + (size_t)row_ * 512 + ch_); } while (0)
#define RPRE_ITEM(s_) (((((s_) >> 3) >> 7) * 8 + ((s_) & 7)) * 128 + (((s_) >> 3) & 127))
    if ((int)blockIdx.x < 2048) RPRE_LOAD(RPRE_ITEM((int)blockIdx.x));
    int h_par = -1; LAS float* PAR = (LAS float*)(lds + RC_PAR);
    for (int slot = blockIdx.x; slot < 2048; slot += F.G) { const int item = RPRE_ITEM(slot);
        const int bh = item >> 7, ck = item & 127, b = bh >> 3, h = bh & 7; const int row = b * SEQ + ck * 64 + t, ch = h * 64 + c0;
        if (h != h_par) { h_par = h;
            if (F.tid < 384) { const int a_ = F.tid >> 6, c_ = F.tid & 63; PAR[F.tid] = (a_ < 3) ? mu[a_ * 512 + h * 64 + c_] : (a_ == 3 ? k_k[h * 64 + c_] : (a_ == 4 ? k_a[h * 64 + c_] : r_k[h * 64 + c_])); }
            __syncthreads(); }
        float r_[8], kp_[8], kk_[8], bb_[8], lw_[8];
        { float v_[8]; const v4u cr = n_cr, ck_ = n_ck, cv = n_cv, pr = n_pr, pk = n_pk, pv = n_pv, ww = n_ww, aa = n_aa;
          float ssq = 0.f, cb = 0.f;
#pragma unroll
          for (int i = 0; i < 8; ++i) { const int q = i >> 1; const bool hi = i & 1;
              const float crf = hi ? bfhi(cr[q]) : bflo(cr[q]), ckf = hi ? bfhi(ck_[q]) : bflo(ck_[q]), cvf = hi ? bfhi(cv[q]) : bflo(cv[q]);
              const float prf = hi ? bfhi(pr[q]) : bflo(pr[q]), pkf = hi ? bfhi(pk[q]) : bflo(pk[q]), pvf = hi ? bfhi(pv[q]) : bflo(pv[q]);
              const float w = hi ? bfhi(ww[q]) : bflo(ww[q]), a = hi ? bfhi(aa[q]) : bflo(aa[q]);
              const float r = crf + PAR[c0 + i] * (prf - crf), k = ckf + PAR[64 + c0 + i] * (pkf - ckf), v = cvf + PAR[128 + c0 + i] * (pvf - cvf);
              const float kk = k * PAR[192 + c0 + i]; ssq += kk * kk; const float kp = k * (1.0f + (a - 1.0f) * PAR[256 + c0 + i]);
              r_[i] = r; kp_[i] = kp; kk_[i] = kk; bb_[i] = a; v_[i] = v; lw_[i] = __logf(w); cb += r * kp * PAR[320 + c0 + i]; }
          ssq = sum8(ssq); cb = sum8(cb);
          const float inv = __builtin_amdgcn_rsqf(fmaxf(ssq, 1e-24f));
#pragma unroll
          for (int i = 0; i < 8; ++i) { kk_[i] *= inv; bb_[i] *= kk_[i]; }
          if (cg == 0) cbon[(size_t)row * 8 + h] = cb;
          if (slot + F.G < 2048) RPRE_LOAD(RPRE_ITEM(slot + F.G));
          v4u vo; vo.x = pk2(v_[0], v_[1]); vo.y = pk2(v_[2], v_[3]); vo.z = pk2(v_[4], v_[5]); vo.w = pk2(v_[6], v_[7]); *(v4u*)(gV + (size_t)row * 512 + ch) = vo;
          { LAS bf16* VT = (LAS bf16*)(lds + RC_VT);
#pragma unroll
            for (int i = 0; i < 8; ++i) VT[(c0 + i) * LDP + t] = (bf16)f2bf(v_[i]); } }
        { LAS float* LW = (LAS float*)(lds + RC_ABP);
#pragma unroll
          for (int i = 0; i < 8; ++i) LW[t * 64 + c0 + i] = lw_[i];
          __syncthreads();
          { const int cc = F.tid & 63, sg = F.tid >> 6; float loc[8]; float run = 0.f;
            LAS float* SG = (LAS float*)(lds + RC_PS);
#pragma unroll
            for (int e = 0; e < 8; ++e) { run += LW[(8 * sg + e) * 64 + cc]; loc[e] = run; }
            SG[sg * 64 + cc] = run;
            __syncthreads();
            float pre = 0.f;
#pragma unroll
            for (int q = 0; q < 8; ++q) { const float tv = SG[q * 64 + cc]; if (q < sg) pre += tv; }
#pragma unroll
            for (int e = 0; e < 8; ++e) LW[(8 * sg + e) * 64 + cc] = pre + loc[e]; }
          __syncthreads();
          LAS bf16* Bh = (LAS bf16*)(lds + RC_BH); LAS bf16* Kh = (LAS bf16*)(lds + RC_KH); LAS bf16* Pc = (LAS bf16*)(lds + RC_PC); LAS bf16* Rc = (LAS bf16*)(lds + RC_RC);
          LAS bf16* PT = (LAS bf16*)(lds + RC_PT); LAS bf16* Rt = (LAS bf16*)(lds + RC_RT); LAS bf16* BhT = (LAS bf16*)(lds + RC_XR); LAS float* GC = (LAS float*)(lds + RC_GC);
          float bh_[8], kh_[8], pc_[8], rc_[8], rt_[8];
          f32x4 lt4[2], lp4[2], lc4[2];
#pragma unroll
          for (int q = 0; q < 2; ++q) { lt4[q] = *(const LAS f32x4*)(LW + t * 64 + c0 + 4 * q); lp4[q] = *(const LAS f32x4*)(LW + (t == 0 ? 0 : t - 1) * 64 + c0 + 4 * q); lc4[q] = *(const LAS f32x4*)(LW + 63 * 64 + c0 + 4 * q); }
          __builtin_amdgcn_sched_barrier(0);
#pragma unroll
          for (int i = 0; i < 8; ++i) { const float Lt = lt4[i >> 2][i & 3], Lp = (t == 0) ? 0.f : lp4[i >> 2][i & 3], LC = lc4[i >> 2][i & 3];
              const float e1 = __expf(LC - Lt); bh_[i] = bb_[i] * e1; kh_[i] = kp_[i] * e1; pc_[i] = kk_[i] * __expf(Lp - LC); rc_[i] = r_[i] * __expf(Lt - LC); rt_[i] = r_[i] * __expf(Lt);
              PT[(c0 + i) * LDP + t] = (bf16)f2bf(kk_[i] * __expf(Lp)); BhT[(c0 + i) * LDP + t] = (bf16)f2bf(bh_[i]); if (t == 63) GC[c0 + i] = __expf(LC); }
          v4u o; o.x = pk2(bh_[0], bh_[1]); o.y = pk2(bh_[2], bh_[3]); o.z = pk2(bh_[4], bh_[5]); o.w = pk2(bh_[6], bh_[7]); *(LAS v4u*)(Bh + t * LDP + c0) = o;
          o.x = pk2(kh_[0], kh_[1]); o.y = pk2(kh_[2], kh_[3]); o.z = pk2(kh_[4], kh_[5]); o.w = pk2(kh_[6], kh_[7]); *(LAS v4u*)(Kh + t * LDP + c0) = o;
          o.x = pk2(pc_[0], pc_[1]); o.y = pk2(pc_[2], pc_[3]); o.z = pk2(pc_[4], pc_[5]); o.w = pk2(pc_[6], pc_[7]); *(LAS v4u*)(Pc + t * LDP + c0) = o;
          o.x = pk2(rc_[0], rc_[1]); o.y = pk2(rc_[2], rc_[3]); o.z = pk2(rc_[4], rc_[5]); o.w = pk2(rc_[6], rc_[7]); *(LAS v4u*)(Rc + t * LDP + c0) = o;
          o.x = pk2(rt_[0], rt_[1]); o.y = pk2(rt_[2], rt_[3]); o.z = pk2(rt_[4], rt_[5]); o.w = pk2(rt_[6], rt_[7]); *(LAS v4u*)(Rt + t * LDP + c0) = o;
          __syncthreads(); }
        f32x4 akr[4];
        { const int r16 = F.lane & 15, g4 = F.lane >> 4; const int xsel = F.wave >> 2, m0 = (F.wave & 3) * 16;
          const LAS bf16* X = (const LAS bf16*)(lds + (xsel ? RC_KH : RC_BH)) + (m0 + r16) * LDP + 8 * g4;
          const bf16x8 xa0 = *(const LAS bf16x8*)X, xa1 = *(const LAS bf16x8*)(X + 32);
          f32x4 acc[2][4];
#pragma unroll
          for (int ys = 0; ys < 2; ++ys) { bf16x8 yb[4][2];
#pragma unroll
              for (int nt = 0; nt < 4; ++nt) { const LAS bf16* Y = (const LAS bf16*)(lds + (ys ? RC_RC : RC_PC)) + (16 * nt + r16) * LDP + 8 * g4; yb[nt][0] = *(const LAS bf16x8*)Y; yb[nt][1] = *(const LAS bf16x8*)(Y + 32); }
              __builtin_amdgcn_sched_barrier(0);
#pragma unroll
              for (int nt = 0; nt < 4; ++nt) acc[ys][nt] = __builtin_amdgcn_mfma_f32_16x16x32_bf16(xa0, yb[nt][0], (f32x4){0.f, 0.f, 0.f, 0.f}, 0, 0, 0);
#pragma unroll
              for (int nt = 0; nt < 4; ++nt) acc[ys][nt] = __builtin_amdgcn_mfma_f32_16x16x32_bf16(xa1, yb[nt][1], acc[ys][nt], 0, 0, 0);
              __builtin_amdgcn_sched_barrier(0); }
#pragma unroll
          for (int nt = 0; nt < 4; ++nt) { const int tt = 16 * nt + r16; const int i0 = m0 + 4 * g4; float v0[4], v1[4];
#pragma unroll
              for (int rg = 0; rg < 4; ++rg) { v0[rg] = (i0 + rg < tt) ? acc[0][nt][rg] : 0.f; v1[rg] = (i0 + rg <= tt) ? acc[1][nt][rg] : 0.f; }
              if (xsel == 0) {
#pragma unroll
                  for (int rg = 0; rg < 4; ++rg) ((LAS float*)(lds + RC_ABP))[(i0 + rg) * SP + tt] = v0[rg];
                  u32x2 o; o.x = pk2(v1[0], v1[1]); o.y = pk2(v1[2], v1[3]); *(LAS u32x2*)((LAS bf16*)(lds + RC_XR) + (64 + tt) * LDP + i0) = o; }
              else {
#pragma unroll
                  for (int rg = 0; rg < 4; ++rg) ((LAS bf16*)(lds + RC_AKP))[(i0 + rg) * LDP + tt] = (bf16)f2bf(v0[rg]);
                  akr[nt] = (f32x4){v1[0], v1[1], v1[2], v1[3]}; } }
          __syncthreads(); }
        { const LAS float* AB = (const LAS float*)(lds + RC_ABP); LAS float* TT = (LAS float*)(lds + RC_TT); LAS float* PS = (LAS float*)(lds + RC_PS);
          if (F.tid < 64) { const int a = F.tid >> 4, e = F.tid & 15; const LAS float* Aa = AB + (16 * a) * SP + 16 * a; float x[16];
#pragma unroll
              for (int r = 15; r >= 0; --r) { float acc = (r == e) ? 1.0f : 0.f;
#pragma unroll
                  for (int j = r + 1; j < 16; ++j) acc = __builtin_fmaf(-Aa[r * SP + j], x[j], acc);
                  x[r] = acc; }
#pragma unroll
              for (int r = 0; r < 16; ++r) TT[(16 * a + r) * SP + 16 * a + e] = x[r]; }
          __syncthreads();
#pragma unroll 1
          for (int d = 1; d < 4; ++d) { const int nel = (4 - d) * 256;
              for (int el = F.tid; el < nel; el += NWAVES * 64) { const int a = el >> 8, r = (el >> 4) & 15, c = el & 15, b = a + d; float acc = 0.f;
                  for (int cc = a + 1; cc <= b; ++cc) { const LAS float* ar = AB + (16 * a + r) * SP + 16 * cc; const LAS float* tc = TT + (16 * cc) * SP + 16 * b + c;
                      f32x4 av[4]; float tv[16];
#pragma unroll
                      for (int q = 0; q < 4; ++q) av[q] = *(const LAS f32x4*)(ar + 4 * q);
#pragma unroll
                      for (int j = 0; j < 16; ++j) tv[j] = tc[j * SP];
                      __builtin_amdgcn_sched_barrier(0);
#pragma unroll
                      for (int j = 0; j < 16; ++j) acc = __builtin_fmaf(av[j >> 2][j & 3], tv[j], acc);
                      __builtin_amdgcn_sched_barrier(0); }
                  PS[el] = acc; }
              __syncthreads();
              for (int el = F.tid; el < nel; el += NWAVES * 64) { const int a = el >> 8, r = (el >> 4) & 15, c = el & 15, b = a + d; float acc = 0.f; const LAS float* dr = TT + (16 * a + r) * SP + 16 * a; const LAS float* sc = PS + (a << 8) + c;
                  f32x4 dv[4]; float sv[16];
#pragma unroll
                  for (int q = 0; q < 4; ++q) dv[q] = *(const LAS f32x4*)(dr + 4 * q);
#pragma unroll
                  for (int j = 0; j < 16; ++j) sv[j] = sc[j * 16];
                  __builtin_amdgcn_sched_barrier(0);
#pragma unroll
                  for (int j = 0; j < 16; ++j) acc = __builtin_fmaf(-dv[j >> 2][j & 3], sv[j], acc);
                  __builtin_amdgcn_sched_barrier(0);
                  TT[(16 * a + r) * SP + 16 * b + c] = acc; }
              __syncthreads(); }
          { LAS bf16* TI = (LAS bf16*)(lds + RC_TI); float o[8];
#pragma unroll
            for (int i = 0; i < 8; ++i) o[i] = ((c0 + i) >> 4) >= (t >> 4) ? TT[t * SP + c0 + i] : 0.f;
            v4u w; w.x = pk2(o[0], o[1]); w.y = pk2(o[2], o[3]); w.z = pk2(o[4], o[5]); w.w = pk2(o[6], o[7]); *(LAS v4u*)(TI + t * LDP + c0) = w; }
          __syncthreads();
          { const int r16 = F.lane & 15, g4 = F.lane >> 4; const int m0 = (F.wave & 3) * 16, cb0 = (F.wave >> 2) * 64;
            const LAS bf16* X = (const LAS bf16*)(lds + RC_TI) + (m0 + r16) * LDP + 8 * g4; const bf16x8 xa0 = *(const LAS bf16x8*)X, xa1 = *(const LAS bf16x8*)(X + 32);
            f32x4 zc[4]; bf16x8 yz[4][2];
#pragma unroll
            for (int nt = 0; nt < 4; ++nt) { const LAS bf16* Y = (const LAS bf16*)(lds + RC_XR) + (cb0 + 16 * nt + r16) * LDP + 8 * g4; yz[nt][0] = *(const LAS bf16x8*)Y; yz[nt][1] = *(const LAS bf16x8*)(Y + 32); }
            __builtin_amdgcn_sched_barrier(0);
#pragma unroll
            for (int nt = 0; nt < 4; ++nt) zc[nt] = __builtin_amdgcn_mfma_f32_16x16x32_bf16(xa0, yz[nt][0], (f32x4){0.f, 0.f, 0.f, 0.f}, 0, 0, 0);
#pragma unroll
            for (int nt = 0; nt < 4; ++nt) zc[nt] = __builtin_amdgcn_mfma_f32_16x16x32_bf16(xa1, yz[nt][1], zc[nt], 0, 0, 0);
            __builtin_amdgcn_sched_barrier(0);
#pragma unroll
            for (int nt = 0; nt < 4; ++nt) { u32x2 o; o.x = pk2(zc[nt][0], zc[nt][1]); o.y = pk2(zc[nt][2], zc[nt][3]); *(LAS u32x2*)((LAS bf16*)(lds + RC_ZT) + (cb0 + 16 * nt + r16) * LDP + m0 + 4 * g4) = o; } } }
        __syncthreads();
        { const int r16 = F.lane & 15, g4 = F.lane >> 4; const int xsel = F.wave >> 2, m0 = (F.wave & 3) * 16, mm = m0 + 4 * g4;
          bf16* gG = WSP(bf16, R_CG) + (size_t)item * 4096; bf16* gQ = WSP(bf16, R_CQT) + (size_t)item * 4096; bf16* gD = WSP(bf16, R_CDT) + (size_t)item * 4096;
          const LAS float* GC = (const LAS float*)(lds + RC_GC);
          const LAS bf16* X = (const LAS bf16*)(lds + (xsel ? RC_AKP : RC_PT)) + (m0 + r16) * LDP + 8 * g4;
          const bf16x8 xa0 = *(const LAS bf16x8*)X, xa1 = *(const LAS bf16x8*)(X + 32);
          f32x4 acc[2][4];
#pragma unroll
          for (int ys = 0; ys < 2; ++ys) { bf16x8 yb[4][2];
#pragma unroll
              for (int nt = 0; nt < 4; ++nt) { const LAS bf16* Y = (const LAS bf16*)(lds + RC_ZT) + (64 * ys + 16 * nt + r16) * LDP + 8 * g4; yb[nt][0] = *(const LAS bf16x8*)Y; yb[nt][1] = *(const LAS bf16x8*)(Y + 32); }
              __builtin_amdgcn_sched_barrier(0);
#pragma unroll
              for (int nt = 0; nt < 4; ++nt) acc[ys][nt] = __builtin_amdgcn_mfma_f32_16x16x32_bf16(xa0, yb[nt][0], (f32x4){0.f, 0.f, 0.f, 0.f}, 0, 0, 0);
#pragma unroll
              for (int nt = 0; nt < 4; ++nt) acc[ys][nt] = __builtin_amdgcn_mfma_f32_16x16x32_bf16(xa1, yb[nt][1], acc[ys][nt], 0, 0, 0);
              __builtin_amdgcn_sched_barrier(0); }
#pragma unroll
          for (int nt = 0; nt < 4; ++nt) { const int nn = 16 * nt + r16;
              if (xsel == 0) {
                  { const int i2 = nn >> 5, rr = nn & 31, kt = mm >> 5, sx_ = (mm >> 4) & 1, qq = mm & 15, hh = (qq >> 2) & 1, jj0 = (qq >> 3) << 2;
                    float gv[4];
#pragma unroll
                    for (int rg = 0; rg < 4; ++rg) gv[rg] = ((mm + rg) == nn ? GC[nn] : 0.f) - acc[0][nt][rg];
                    u32x2 o; o.x = pk2(gv[0], gv[1]); o.y = pk2(gv[2], gv[3]); *(u32x2*)(gG + ((((i2 * 2 + kt) * 2 + sx_) * 64 + rr + 32 * hh) * 8 + jj0)) = o; }
                  { const LAS bf16* Rt = (const LAS bf16*)(lds + RC_RT); const u32x2 rv = *(const LAS u32x2*)(Rt + nn * LDP + mm);
                    u32x2 o; o.x = pk2(bflo(rv.x) - acc[1][nt][0], bfhi(rv.x) - acc[1][nt][1]); o.y = pk2(bflo(rv.y) - acc[1][nt][2], bfhi(rv.y) - acc[1][nt][3]); *(u32x2*)(gQ + nn * 64 + mm) = o; }
              } else {
                  { const LAS bf16* Kh = (const LAS bf16*)(lds + RC_KH); float kv[4];
#pragma unroll
                    for (int rg = 0; rg < 4; ++rg) kv[rg] = bf1(Kh[(mm + rg) * LDP + nn]) - acc[0][nt][rg];
                    u32x2 o; o.x = pk2(kv[0], kv[1]); o.y = pk2(kv[2], kv[3]); *(LAS u32x2*)((LAS bf16*)(lds + RC_KBT) + nn * LDP + mm) = o; }
                  { float dv[4];
#pragma unroll
                    for (int rg = 0; rg < 4; ++rg) dv[rg] = akr[nt][rg] - acc[1][nt][rg];
                    u32x2 o; o.x = pk2(dv[0], dv[1]); o.y = pk2(dv[2], dv[3]); *(u32x2*)(gD + nn * 64 + mm) = o; } } }
          __syncthreads();
          bf16* gH = WSP(bf16, R_CH) + (size_t)item * 4096;
#pragma unroll
          for (int q = 0; q < 2; ++q) { const int id = F.wave * 2 + q, m0 = (id >> 2) * 16, n0 = (id & 3) * 16;
              const f32x4 acc = mm16_k64((const LAS bf16*)(lds + RC_VT), (const LAS bf16*)(lds + RC_KBT), m0, n0, F.lane, (f32x4){0.f, 0.f, 0.f, 0.f});
              const int kq = n0 + r16, vv = m0 + 4 * g4;
              const int i2 = kq >> 5, kl = kq & 31, rg16 = (kl & 3) | ((kl >> 3) << 2), hh = (kl >> 2) & 1, j2 = vv >> 5;
              bf16* hq_ = gH + j2 * 2048 + ((vv & 31) + 32 * hh) * 32 + i2 * 16 + rg16;
#pragma unroll
              for (int rg = 0; rg < 4; ++rg) hq_[32 * rg] = (bf16)f2bf(acc[rg]); }
          __syncthreads(); }
    }
}
__device__ __forceinline__ void rchunk_seq(Frame& F, int wid) {
    const int bh = wid >> 1, j = wid & 1; const int r32 = F.lane & 31, hh = F.lane >> 5;
    const bf16* gG = WSP(bf16, R_CG) + (size_t)bh * 128 * 4096; const bf16* gH = WSP(bf16, R_CH) + (size_t)bh * 128 * 4096 + j * 2048 + F.lane * 32; bf16* gS = WSP(bf16, R_CS) + (size_t)bh * 128 * 4096;
    f32x16 x0, x1;
#pragma unroll
    for (int i = 0; i < 16; ++i) { x0[i] = 0.f; x1[i] = 0.f; }
    bf16x8 gA[8], gB[8]; v4u hA[4], hB[4];
#define RS_LOAD(G_, H_, cc) do { const int c_ = ((cc) < 128) ? (cc) : 127; _Pragma("unroll") for (int q = 0; q < 8; ++q) G_[q] = *(const bf16x8*)(gG + (size_t)c_ * 4096 + (q * 64 + F.lane) * 8); \
        _Pragma("unroll") for (int q = 0; q < 4; ++q) H_[q] = *(const v4u*)(gH + (size_t)c_ * 4096 + 8 * q); } while (0)
#define RS_STEP(G_, H_, cc) do { \
        f32x16 h0, h1; \
        _Pragma("unroll") for (int q = 0; q < 4; ++q) { h0[2 * q] = bflo(H_[0][q]); h0[2 * q + 1] = bfhi(H_[0][q]); h0[8 + 2 * q] = bflo(H_[1][q]); h0[8 + 2 * q + 1] = bfhi(H_[1][q]); \
                                                         h1[2 * q] = bflo(H_[2][q]); h1[2 * q + 1] = bfhi(H_[2][q]); h1[8 + 2 * q] = bflo(H_[3][q]); h1[8 + 2 * q + 1] = bfhi(H_[3][q]); } \
        unsigned xb0[8], xb1[8]; \
        _Pragma("unroll") for (int q = 0; q < 8; ++q) { xb0[q] = cvtpk(x0[2 * q], x0[2 * q + 1]); xb1[q] = cvtpk(x1[2 * q], x1[2 * q + 1]); } \
        { bf16* sp = gS + (size_t)(cc) * 4096 + (32 * j + r32) * 64 + 8 * hh;     \
          _Pragma("unroll") for (int mq = 0; mq < 2; ++mq) { \
              { auto s0 = __builtin_amdgcn_permlane32_swap(xb0[4 * mq], xb0[4 * mq + 2], false, false); auto s1 = __builtin_amdgcn_permlane32_swap(xb0[4 * mq + 1], xb0[4 * mq + 3], false, false); \
                v4u o; o.x = s0[0]; o.y = s1[0]; o.z = s0[1]; o.w = s1[1]; *(v4u*)(sp + 16 * mq) = o; } \
              { auto s0 = __builtin_amdgcn_permlane32_swap(xb1[4 * mq], xb1[4 * mq + 2], false, false); auto s1 = __builtin_amdgcn_permlane32_swap(xb1[4 * mq + 1], xb1[4 * mq + 3], false, false); \
                v4u o; o.x = s0[0]; o.y = s1[0]; o.z = s0[1]; o.w = s1[1]; *(v4u*)(sp + 32 + 16 * mq) = o; } } } \
        const bf16x8 b00 = __builtin_bit_cast(bf16x8, (v4u){xb0[0], xb0[1], xb0[2], xb0[3]}), b01 = __builtin_bit_cast(bf16x8, (v4u){xb0[4], xb0[5], xb0[6], xb0[7]}); \
        const bf16x8 b10 = __builtin_bit_cast(bf16x8, (v4u){xb1[0], xb1[1], xb1[2], xb1[3]}), b11 = __builtin_bit_cast(bf16x8, (v4u){xb1[4], xb1[5], xb1[6], xb1[7]}); \
        h0 = __builtin_amdgcn_mfma_f32_32x32x16_bf16(G_[0], b00, h0, 0, 0, 0); h1 = __builtin_amdgcn_mfma_f32_32x32x16_bf16(G_[4], b00, h1, 0, 0, 0); \
        h0 = __builtin_amdgcn_mfma_f32_32x32x16_bf16(G_[1], b01, h0, 0, 0, 0); h1 = __builtin_amdgcn_mfma_f32_32x32x16_bf16(G_[5], b01, h1, 0, 0, 0); \
        h0 = __builtin_amdgcn_mfma_f32_32x32x16_bf16(G_[2], b10, h0, 0, 0, 0); h1 = __builtin_amdgcn_mfma_f32_32x32x16_bf16(G_[6], b10, h1, 0, 0, 0); \
        h0 = __builtin_amdgcn_mfma_f32_32x32x16_bf16(G_[3], b11, h0, 0, 0, 0); h1 = __builtin_amdgcn_mfma_f32_32x32x16_bf16(G_[7], b11, h1, 0, 0, 0); \
        x0 = h0; x1 = h1; RS_LOAD(G_, H_, (cc) + 2); } while (0)
    RS_LOAD(gA, hA, 0); RS_LOAD(gB, hB, 1);
    for (int c = 0; c < 128; c += 2) { RS_STEP(gA, hA, c); RS_STEP(gB, hB, c + 1); }
#undef RS_LOAD
#undef RS_STEP
}
constexpr int RO_SX = 0, RO_QT = RC_MAT, RO_DT = 2 * RC_MAT, RO_VT = 3 * RC_MAT, RO_Y = 4 * RC_MAT, RO_HALF = RO_Y + 64 * 68 * 4;
constexpr int RO_PAR = 2 * RO_HALF;
static_assert(RO_PAR + 4096 <= LDSCTL_OFF, "rwkv output pass LDS (parameters)");
static_assert(2 * RO_HALF <= LDSCTL_OFF, "rwkv output pass LDS");
__device__ __forceinline__ void phase_rchunk_out(Frame& F, const Args& A, int L) {
    KP_DECL;
    const float* lnw = INP(I_LNW) + L * 512; const float* lnb = INP(I_LNB) + L * 512;
    const bf16* gV = WSP(bf16, R_CV); const bf16* dg = WSP(bf16, R_DAG_G); const float* cbon = WSP(float, WS_CBON); bf16* y1 = WSP(bf16, R_Y) + (size_t)M * 512;
    const int half = F.tid >> 8, ht = F.tid & 255, t = ht >> 2, c0 = (ht & 3) * 16, hw = F.wave & 3;
    LAS unsigned char* lds = F.lds + half * RO_HALF;
    { LAS float* PAR = (LAS float*)(F.lds + RO_PAR); const int pt = F.wave * 64 + (int)__builtin_amdgcn_mbcnt_hi(~0u, __builtin_amdgcn_mbcnt_lo(~0u, 0u));
      PAR[pt] = lnw[pt]; PAR[512 + pt] = lnb[pt]; }
    const LAS float* PW = (const LAS float*)(F.lds + RO_PAR); const LAS float* PB = PW + 512;
    v4u n_sx[2], n_qt[2], n_dt[2], n_vv[2], n_gg[2]; float n_cb;
#define ROUT_LOAD(it_) do { const int bh_ = (it_) >> 7, ck_ = (it_) & 127; const int row_ = (bh_ >> 3) * SEQ + ck_ * 64 + t; \
        _Pragma("unroll") for (int e = 0; e < 2; ++e) { n_sx[e] = __builtin_nontemporal_load((const v4u*)(WSP(bf16, R_CS) + (size_t)(it_) * 4096 + t * 64 + c0 + 8 * e)); n_qt[e] = __builtin_nontemporal_load((const v4u*)(WSP(bf16, R_CQT) + (size_t)(it_) * 4096 + t * 64 + c0 + 8 * e)); \
            n_dt[e] = __builtin_nontemporal_load((const v4u*)(WSP(bf16, R_CDT) + (size_t)(it_) * 4096 + t * 64 + c0 + 8 * e)); n_vv[e] = __builtin_nontemporal_load((const v4u*)(gV + (size_t)row_ * 512 + (bh_ & 7) * 64 + c0 + 8 * e)); n_gg[e] = __builtin_nontemporal_load((const v4u*)(dg + (size_t)row_ * 512 + (bh_ & 7) * 64 + c0 + 8 * e)); } \
        n_cb = cbon[(size_t)row_ * 8 + (bh_ & 7)]; } while (0)
    const int it0 = (int)blockIdx.x + half * F.G;
    if (it0 < 2048) ROUT_LOAD(it0);
    for (int base = blockIdx.x; base < 2048; base += 2 * F.G) {
        const int item = base + half * F.G; const bool valid = item < 2048;
        const int bh = item >> 7, ck = item & 127, b = bh >> 3, h = bh & 7; const int row = b * SEQ + ck * 64 + t, ch = h * 64 + c0;
        v4u vv[2], gv[2]; float cb = 0.f;
        if (valid) { cb = n_cb;
#pragma unroll
            for (int e = 0; e < 2; ++e) { vv[e] = n_vv[e]; gv[e] = n_gg[e];
                *(LAS v4u*)((LAS bf16*)(lds + RO_SX) + t * LDP + c0 + 8 * e) = n_sx[e]; *(LAS v4u*)((LAS bf16*)(lds + RO_QT) + t * LDP + c0 + 8 * e) = n_qt[e]; *(LAS v4u*)((LAS bf16*)(lds + RO_DT) + t * LDP + c0 + 8 * e) = n_dt[e];
                LAS bf16* VT = (LAS bf16*)(lds + RO_VT);
#pragma unroll
                for (int i = 0; i < 4; ++i) { VT[(c0 + 8 * e + 2 * i) * LDP + t] = (bf16)(vv[e][i] & 0xffffu); VT[(c0 + 8 * e + 2 * i + 1) * LDP + t] = (bf16)(vv[e][i] >> 16); } }
            if (item + 2 * F.G < 2048) ROUT_LOAD(item + 2 * F.G); }
        __syncthreads();
        if (valid) { const int r16 = F.lane & 15, g4 = F.lane >> 4, m0 = 16 * hw; LAS float* YL = (LAS float*)(lds + RO_Y);
            const LAS bf16* X1 = (const LAS bf16*)(lds + RO_SX) + (m0 + r16) * LDP + 8 * g4; const LAS bf16* X2 = (const LAS bf16*)(lds + RO_VT) + (m0 + r16) * LDP + 8 * g4;
            const bf16x8 a0 = *(const LAS bf16x8*)X1, a1 = *(const LAS bf16x8*)(X1 + 32), a2 = *(const LAS bf16x8*)X2, a3 = *(const LAS bf16x8*)(X2 + 32);
            f32x4 acc[4];
#pragma unroll
            for (int q0 = 0; q0 < 4; q0 += 2) { bf16x8 yf[2][4];
#pragma unroll
                for (int qq = 0; qq < 2; ++qq) { const LAS bf16* Y1 = (const LAS bf16*)(lds + RO_QT) + (16 * (q0 + qq) + r16) * LDP + 8 * g4; const LAS bf16* Y2 = (const LAS bf16*)(lds + RO_DT) + (16 * (q0 + qq) + r16) * LDP + 8 * g4;
                    yf[qq][0] = *(const LAS bf16x8*)Y1; yf[qq][1] = *(const LAS bf16x8*)(Y1 + 32); yf[qq][2] = *(const LAS bf16x8*)Y2; yf[qq][3] = *(const LAS bf16x8*)(Y2 + 32); }
                __builtin_amdgcn_sched_barrier(0);
#pragma unroll
                for (int qq = 0; qq < 2; ++qq) acc[q0 + qq] = __builtin_amdgcn_mfma_f32_16x16x32_bf16(a0, yf[qq][0], (f32x4){0.f, 0.f, 0.f, 0.f}, 0, 0, 0);
#pragma unroll
                for (int qq = 0; qq < 2; ++qq) acc[q0 + qq] = __builtin_amdgcn_mfma_f32_16x16x32_bf16(a1, yf[qq][1], acc[q0 + qq], 0, 0, 0);
#pragma unroll
                for (int qq = 0; qq < 2; ++qq) acc[q0 + qq] = __builtin_amdgcn_mfma_f32_16x16x32_bf16(a2, yf[qq][2], acc[q0 + qq], 0, 0, 0);
#pragma unroll
                for (int qq = 0; qq < 2; ++qq) acc[q0 + qq] = __builtin_amdgcn_mfma_f32_16x16x32_bf16(a3, yf[qq][3], acc[q0 + qq], 0, 0, 0);
                __builtin_amdgcn_sched_barrier(0); }
#pragma unroll
            for (int q = 0; q < 4; ++q) *(LAS f32x4*)(YL + (16 * q + r16) * 68 + m0 + 4 * g4) = acc[q]; }
        __syncthreads();
        if (valid) { const LAS float* YL = (const LAS float*)(lds + RO_Y) + t * 68 + c0; float y[16], s_ = 0.f;
#pragma unroll
            for (int i = 0; i < 16; ++i) { y[i] = YL[i]; s_ += y[i]; }
            s_ += dppf<0xB1>(s_); s_ += dppf<0x4E>(s_); const float mean = s_ * (1.0f / 64.0f); float q2 = 0.f;
#pragma unroll
            for (int i = 0; i < 16; ++i) { y[i] -= mean; q2 += y[i] * y[i]; }
            q2 += dppf<0xB1>(q2); q2 += dppf<0x4E>(q2); const float rstd = __builtin_amdgcn_rsqf(q2 * (1.0f / 64.0f) + 64e-5f);
#pragma unroll
            for (int e = 0; e < 2; ++e) { const v4u gg = gv[e]; float o[8];
#pragma unroll
                for (int i = 0; i < 8; ++i) { const int q = i >> 1; const bool hi = i & 1; const float vf = hi ? bfhi(vv[e][q]) : bflo(vv[e][q]), gf = hi ? bfhi(gg[q]) : bflo(gg[q]);
                    o[i] = (y[8 * e + i] * rstd * PW[ch + 8 * e + i] + PB[ch + 8 * e + i] + cb * vf) * gf; }
                v4u w; w.x = pk2(o[0], o[1]); w.y = pk2(o[2], o[3]); w.z = pk2(o[4], o[5]); w.w = pk2(o[6], o[7]); *(v4u*)(y1 + (size_t)row * 512 + ch + 8 * e) = w; } }
        __syncthreads();
    }
#undef ROUT_LOAD
}
template <int KS, int LDX, int LDY> __device__ __forceinline__ f32x4 mm16(const LAS bf16* X, const LAS bf16* YT, int m0, int n0, int lane, f32x4 acc) {
    const int r = lane & 15, g = lane >> 4;
#pragma unroll
    for (int ks = 0; ks < KS; ++ks) { const bf16x8 a = *(const LAS bf16x8*)(X + (m0 + r) * LDX + ks * 32 + 8 * g); const bf16x8 b = *(const LAS bf16x8*)(YT + (n0 + r) * LDY + ks * 32 + 8 * g);
        acc = __builtin_amdgcn_mfma_f32_16x16x32_bf16(a, b, acc, 0, 0, 0); }
    return acc;
}
__device__ __forceinline__ float hg_lf(float key) { return fmaxf(__logf(fmaxf(1.0f - key, 1e-30f)), -30.0f); }
constexpr int H1_LD = 136;
constexpr int H1_KT = 0, H1_VT = 128 * H1_LD * 2, H1_SEG = 2 * 128 * H1_LD * 2, H1_END = H1_SEG + 4 * 128 * 4;
__device__ __forceinline__ void phase_h1(Frame& F, int first, int stride) {
    const bf16* zh = (const bf16*)F.x; bf16* Hg = WSP(bf16, R_HST); float* Dg = WSP(float, WS_HD);
    LAS unsigned char* lds = F.lds; LAS bf16* KT = (LAS bf16*)(lds + H1_KT); LAS bf16* VT = (LAS bf16*)(lds + H1_VT); LAS float* SEG = (LAS float*)(lds + H1_SEG);
    const int k = F.tid & 127, seg = F.tid >> 7; const int r16 = F.lane & 15, g4 = F.lane >> 4;
    for (int item = first; item < 256; item += stride) { const int bh = item >> 5, m = item & 31, b = bh >> 2, h = bh & 3; const size_t row0 = (size_t)b * SEQ + m * 256;
        f32x4 acc[8];
#pragma unroll
        for (int nt = 0; nt < 8; ++nt) acc[nt] = (f32x4){0.f, 0.f, 0.f, 0.f};
        float carry = 0.f;
#pragma unroll 1
        for (int half = 1; half >= 0; --half) { const size_t rb = row0 + 128 * half;
            float key[32], lf[32]; float tot = 0.f;
#pragma unroll
            for (int j = 0; j < 32; ++j) { key[j] = bf1(zh[(rb + 32 * seg + j) * 2048 + 512 + h * 128 + k]); lf[j] = hg_lf(key[j]); tot += lf[j]; }
            SEG[seg * 128 + k] = tot;
            { const int s = F.tid >> 2, part = F.tid & 3; const bf16* vp = zh + (rb + s) * 2048 + 1024 + h * 128 + part * 32;
#pragma unroll
              for (int c = 0; c < 4; ++c) { const v4u vv = *(const v4u*)(vp + 8 * c);
#pragma unroll
                  for (int i = 0; i < 4; ++i) { VT[(part * 32 + 8 * c + 2 * i) * H1_LD + s] = (bf16)(vv[i] & 0xffffu); VT[(part * 32 + 8 * c + 2 * i + 1) * H1_LD + s] = (bf16)(vv[i] >> 16); } } }
            __syncthreads();
            float off = carry, all = 0.f;
#pragma unroll
            for (int sg = 0; sg < 4; ++sg) { const float tt = SEG[sg * 128 + k]; all += tt; if (sg > seg) off += tt; }
            carry += all;
            float e = off;
#pragma unroll
            for (int j = 31; j >= 0; --j) { KT[k * H1_LD + 32 * seg + j] = (bf16)f2bf(key[j] * __expf(e)); e += lf[j]; }
            __syncthreads();
            { bf16x8 af[4];
#pragma unroll
              for (int ks = 0; ks < 4; ++ks) af[ks] = *(const LAS bf16x8*)(KT + (16 * F.wave + r16) * H1_LD + ks * 32 + 8 * g4);
#pragma unroll
              for (int nt0 = 0; nt0 < 8; nt0 += 2) { bf16x8 bfr[2][4];
#pragma unroll
                  for (int q = 0; q < 2; ++q)
#pragma unroll
                      for (int ks = 0; ks < 4; ++ks) bfr[q][ks] = *(const LAS bf16x8*)(VT + (16 * (nt0 + q) + r16) * H1_LD + ks * 32 + 8 * g4);
                  __builtin_amdgcn_sched_barrier(0);
#pragma unroll
                  for (int ks = 0; ks < 4; ++ks)
#pragma unroll
                      for (int q = 0; q < 2; ++q) acc[nt0 + q] = __builtin_amdgcn_mfma_f32_16x16x32_bf16(af[ks], bfr[q][ks], acc[nt0 + q], 0, 0, 0);
                  __builtin_amdgcn_sched_barrier(0); } }
            __syncthreads(); }
        if (F.tid < 128) Dg[(size_t)item * 128 + k] = __expf(carry);
        bf16* hp = Hg + (size_t)item * 16384;
#pragma unroll
        for (int nt = 0; nt < 8; ++nt) { u32x2 o; o.x = pk2(acc[nt][0], acc[nt][1]); o.y = pk2(acc[nt][2], acc[nt][3]); *(u32x2*)(hp + (16 * nt + r16) * 128 + 16 * F.wave + 4 * g4) = o; }
    }
}
__device__ __forceinline__ void phase_h2(Frame& F) {
    bf16* Hg = WSP(bf16, R_HST); const float* Dg = WSP(float, WS_HD);
    const int gt = blockIdx.x * (NWAVES * 64) + F.tid, NGT = F.G * NWAVES * 64;
    for (int idx = gt; idx < 8 * 16384; idx += NGT) { const int bh = idx >> 14, e = idx & 16383; float s = 0.f;
#pragma unroll 4
        for (int m = 0; m < 32; ++m) { const size_t o = ((size_t)(bh * 32 + m) << 14) + e; const float hv = bf1(Hg[o]); Hg[o] = (bf16)f2bf(s); s = __builtin_fmaf(Dg[(bh * 32 + m) * 128 + (e & 127)], s, hv); } }
}
constexpr int H3_LDK = 136, H3_LDS = 40;
constexpr int H3_QC = 0, H3_KH = H3_QC + 32 * H3_LDK * 2, H3_KHT = H3_KH + 32 * H3_LDK * 2, H3_VT = H3_KHT + 128 * H3_LDS * 2, H3_ST = H3_VT + 128 * H3_LDS * 2, H3_AL = H3_ST + 128 * H3_LDK * 2,
              H3_OL = H3_AL + 32 * H3_LDS * 2, H3_SEG = H3_OL + 32 * 132 * 4, H3_DD = H3_SEG + 4 * 128 * 4, H3_END = H3_DD + 128 * 4;
static_assert(H3_END <= LDSCTL_OFF && H1_END <= LDSCTL_OFF, "hgrn LDS");
__device__ __forceinline__ void phase_h3(Frame& F, const Args& A, int L) {
    KP_DECL;
    const bf16* zh = (const bf16*)F.x; const bf16* Hg = WSP(bf16, R_HST); bf16* y2 = WSP(bf16, R_Y) + (size_t)2 * M * 512; const float* ng = INP(I_HNORM) + L * 128;
    LAS unsigned char* lds = F.lds; LAS bf16* QC = (LAS bf16*)(lds + H3_QC); LAS bf16* KH = (LAS bf16*)(lds + H3_KH); LAS bf16* KHT = (LAS bf16*)(lds + H3_KHT); LAS bf16* VT = (LAS bf16*)(lds + H3_VT);
    LAS bf16* ST = (LAS bf16*)(lds + H3_ST); LAS bf16* AL = (LAS bf16*)(lds + H3_AL); LAS float* OL = (LAS float*)(lds + H3_OL); LAS float* SEG = (LAS float*)(lds + H3_SEG); LAS float* DD = (LAS float*)(lds + H3_DD);
    const int k = F.tid & 127, seg = F.tid >> 7; const int r16 = F.lane & 15, g4 = F.lane >> 4;
    float ngv[8];
#pragma unroll
    for (int i = 0; i < 8; ++i) ngv[i] = ng[(F.tid & 15) * 8 + i];
    for (int item = blockIdx.x; item < 256; item += F.G) { const int bh = item >> 5, m = item & 31, b = bh >> 2, h = bh & 3; const size_t row0 = (size_t)b * SEQ + m * 256;
        f32x4 acc[8];
        { const bf16* hp = Hg + (size_t)item * 16384;
#pragma unroll
          for (int nt = 0; nt < 8; ++nt) { const u32x2 w = *(const u32x2*)(hp + (16 * nt + r16) * 128 + 16 * F.wave + 4 * g4); acc[nt] = (f32x4){bflo(w.x), bfhi(w.x), bflo(w.y), bfhi(w.y)}; } }
        bf16 nq[8], nk[8]; v4u nvv, ngg;
#define H3_LOAD(cc) do { const size_t rb_ = row0 + 32 * (cc); _Pragma("unroll") for (int j = 0; j < 8; ++j) { const bf16* zp = zh + (rb_ + 8 * seg + j) * 2048 + h * 128 + k; nq[j] = __builtin_nontemporal_load(zp); nk[j] = __builtin_nontemporal_load(zp + 512); } \
            nvv = __builtin_nontemporal_load((const v4u*)(zh + (rb_ + (F.tid >> 4)) * 2048 + 1024 + h * 128 + (F.tid & 15) * 8)); ngg = __builtin_nontemporal_load((const v4u*)(zh + (rb_ + (F.tid >> 4)) * 2048 + 1536 + h * 128 + (F.tid & 15) * 8)); } while (0)
        H3_LOAD(0);
#pragma unroll 1
        for (int c = 0; c < 8; ++c) { const size_t rb = row0 + 32 * c;
            float key[8], qv[8], bcs[8]; float run = 0.f;
#pragma unroll
            for (int j = 0; j < 8; ++j) { qv[j] = bf1(nq[j]); key[j] = bf1(nk[j]); run += hg_lf(key[j]); bcs[j] = run; }
            const v4u vv = nvv, gg = ngg;
            if (c < 7) H3_LOAD(c + 1);
            SEG[seg * 128 + k] = run;
            { const int s = F.tid >> 4, part = F.tid & 15;
#pragma unroll
              for (int i = 0; i < 4; ++i) { VT[(part * 8 + 2 * i) * H3_LDS + s] = (bf16)(vv[i] & 0xffffu); VT[(part * 8 + 2 * i + 1) * H3_LDS + s] = (bf16)(vv[i] >> 16); } }
            __syncthreads();
            float pre = 0.f, all = 0.f;
#pragma unroll
            for (int sg = 0; sg < 4; ++sg) { const float tt = SEG[sg * 128 + k]; all += tt; if (sg < seg) pre += tt; }
#pragma unroll
            for (int j = 0; j < 8; ++j) { const float bt = pre + bcs[j]; const int t = 8 * seg + j;
                QC[t * H3_LDK + k] = (bf16)f2bf(qv[j] * __expf(bt - all)); const bf16 kh = (bf16)f2bf(key[j] * __expf(all - bt)); KH[t * H3_LDK + k] = kh; KHT[k * H3_LDS + t] = kh; }
            if (seg == 0) DD[k] = __expf(all);
            __syncthreads();
            { const f32x4 dv = *(const LAS f32x4*)(DD + 16 * F.wave + 4 * g4);
#pragma unroll
              for (int nt = 0; nt < 8; ++nt) { acc[nt] = acc[nt] * dv; u32x2 o; o.x = pk2(acc[nt][0], acc[nt][1]); o.y = pk2(acc[nt][2], acc[nt][3]); *(LAS u32x2*)(ST + (16 * nt + r16) * H3_LDK + 16 * F.wave + 4 * g4) = o; } }
            if (F.wave < 4) { const int m0 = (F.wave >> 1) * 16, n0 = (F.wave & 1) * 16; const f32x4 a = mm16<4, H3_LDK, H3_LDK>(QC, KH, m0, n0, F.lane, (f32x4){0.f, 0.f, 0.f, 0.f});
#pragma unroll
                for (int rg = 0; rg < 4; ++rg) { const int t = m0 + 4 * g4 + rg, s = n0 + r16; AL[t * H3_LDS + s] = (bf16)f2bf(s <= t ? a[rg] : 0.f); } }
            __syncthreads();
#pragma unroll
            for (int q = 0; q < 2; ++q) { const int id = 2 * F.wave + q, m0 = (id >> 3) * 16, n0 = (id & 7) * 16;
                f32x4 o = mm16<4, H3_LDK, H3_LDK>(QC, ST, m0, n0, F.lane, (f32x4){0.f, 0.f, 0.f, 0.f}); o = mm16<1, H3_LDS, H3_LDS>(AL, VT, m0, n0, F.lane, o);
#pragma unroll
                for (int rg = 0; rg < 4; ++rg) OL[(m0 + 4 * g4 + rg) * 132 + n0 + r16] = o[rg]; }
#pragma unroll
            for (int nt = 0; nt < 8; ++nt) acc[nt] = mm16<1, H3_LDS, H3_LDS>(KHT, VT, 16 * F.wave, 16 * nt, F.lane, acc[nt]);
            __syncthreads();
            { const int t = F.tid >> 4, part = F.tid & 15; const LAS float* op = OL + t * 132 + part * 8; float o[8], ss = 0.f;
#pragma unroll
              for (int i = 0; i < 8; ++i) { o[i] = op[i]; ss += o[i] * o[i]; }
              ss = sum16(ss);
              const float rs = __builtin_amdgcn_rsqf(ss * (1.0f / 128.0f) + 1e-6f); const size_t row = rb + t;
              float y[8];
#pragma unroll
              for (int i = 0; i < 8; ++i) { const int q = i >> 1; const float gf = (i & 1) ? bfhi(gg[q]) : bflo(gg[q]); y[i] = o[i] * rs * ngv[i] * gf; }
              v4u w; w.x = pk2(y[0], y[1]); w.y = pk2(y[2], y[3]); w.z = pk2(y[4], y[5]); w.w = pk2(y[6], y[7]); *(v4u*)(y2 + row * 512 + h * 128 + part * 8) = w; }
        }
        __syncthreads();
    }
}
constexpr int AT_KLD = 72, AT_VLD = 260, AT_K = 0, AT_VT = 256 * AT_KLD * 2, AT_END = AT_VT + 64 * AT_VLD * 2;
static_assert(AT_END <= LDSCTL_OFF, "attention LDS");
__device__ __forceinline__ void phase_attn_mfma(Frame& F, const Args& A, int L) {
    KP_DECL;
    const bf16* za = WSP(bf16, R_ZA); bf16* y0 = WSP(bf16, R_Y); const float* sinks = INP(I_SINK) + L * 8;
    LAS bf16* KI = (LAS bf16*)(F.lds + AT_K); LAS bf16* VT = (LAS bf16*)(F.lds + AT_VT);
    const int c32 = F.lane & 31, hh = F.lane >> 5;
    for (int item = blockIdx.x; item < 256; item += F.G) { const int b = item >> 7, kvh = (item >> 6) & 1, n = item & 63; const int rowq0 = b * SEQ + n * 128, rowk0 = rowq0 - 128;
        { const int key = F.tid >> 1, half = F.tid & 1; const bool valid = (n > 0) || key >= 128; const bf16* src = za + (size_t)(rowk0 + key) * 768 + kvh * 64 + half * 32;
#pragma unroll
          for (int c = 0; c < 4; ++c) { v4u kk = (v4u){0u, 0u, 0u, 0u}, vv = kk; if (valid) { kk = *(const v4u*)(src + 512 + 8 * c); vv = *(const v4u*)(src + 640 + 8 * c); }
              *(LAS v4u*)(KI + key * AT_KLD + half * 32 + 8 * c) = kk;
#pragma unroll
              for (int i = 0; i < 4; ++i) { VT[(half * 32 + 8 * c + 2 * i) * AT_VLD + key] = (bf16)(vv[i] & 0xffffu); VT[(half * 32 + 8 * c + 2 * i + 1) * AT_VLD + key] = (bf16)(vv[i] >> 16); } } }
        __syncthreads();
#pragma unroll 1
        for (int rep = 0; rep < 2; ++rep) { const int id = F.wave * 2 + rep, g = id >> 2, u = id & 3, hq = kvh * 4 + g; const int qrow = rowq0 + 32 * u + c32, qi = 32 * u + c32;
            bf16x8 qf[4];
#pragma unroll
            for (int s = 0; s < 4; ++s) qf[s] = *(const bf16x8*)(za + (size_t)qrow * 768 + hq * 64 + 16 * s + 8 * hh);
            f32x16 st[5];
            { bf16x8 ka[2][4];
#pragma unroll
              for (int s = 0; s < 4; ++s) ka[0][s] = *(const LAS bf16x8*)(KI + (32 * u + c32) * AT_KLD + 16 * s + 8 * hh);
#pragma unroll
              for (int j = 0; j < 5; ++j) { f32x16 acc;
#pragma unroll
                  for (int i = 0; i < 16; ++i) acc[i] = 0.f;
                  if (j < 4) {
#pragma unroll
                      for (int s = 0; s < 4; ++s) ka[(j + 1) & 1][s] = *(const LAS bf16x8*)(KI + (32 * (u + j + 1) + c32) * AT_KLD + 16 * s + 8 * hh); }
                  __builtin_amdgcn_sched_barrier(0);
#pragma unroll
                  for (int s = 0; s < 4; ++s) acc = __builtin_amdgcn_mfma_f32_32x32x16_bf16(ka[j & 1][s], qf[s], acc, 0, 0, 0);
                  __builtin_amdgcn_sched_barrier(0);
                  st[j] = acc; } }
            const float sink = sinks[hq]; float mx = sink;
#pragma unroll
            for (int j = 0; j < 5; ++j)
#pragma unroll
                for (int rg = 0; rg < 16; ++rg) { const int kj = 32 * (u + j) + (rg & 3) + 8 * (rg >> 2) + 4 * hh; const bool ok = (kj > qi) && (kj <= qi + 128) && (n > 0 || kj >= 128);
                    const float v = ok ? st[j][rg] * 0.125f : -1e30f; st[j][rg] = v; mx = fmaxf(mx, v); }
            mx = fmaxf(mx, __shfl_xor(mx, 32));
            float sum = 0.f;
#pragma unroll
            for (int j = 0; j < 5; ++j)
#pragma unroll
                for (int rg = 0; rg < 16; ++rg) { const float p = __expf(st[j][rg] - mx); st[j][rg] = p; sum += p; }
            sum += __shfl_xor(sum, 32);
            const float inv = 1.0f / (sum + __expf(sink - mx));
            f32x16 o0, o1;
#pragma unroll
            for (int i = 0; i < 16; ++i) { o0[i] = 0.f; o1[i] = 0.f; }
#pragma unroll
            for (int j = 0; j < 5; ++j) { u32x2 vl[2][2][2];
#pragma unroll
                for (int s = 0; s < 2; ++s)
#pragma unroll
                    for (int dt = 0; dt < 2; ++dt) { const int k0 = 32 * (u + j) + 16 * s + 4 * hh; vl[s][dt][0] = *(const LAS u32x2*)(VT + (32 * dt + c32) * AT_VLD + k0); vl[s][dt][1] = *(const LAS u32x2*)(VT + (32 * dt + c32) * AT_VLD + k0 + 8); }
                __builtin_amdgcn_sched_barrier(0);
#pragma unroll
                for (int s = 0; s < 2; ++s) { v4u pw; pw.x = pg8::cvtpk_s(st[j][8 * s], st[j][8 * s + 1]); pw.y = pg8::cvtpk_s(st[j][8 * s + 2], st[j][8 * s + 3]); pw.z = pg8::cvtpk_s(st[j][8 * s + 4], st[j][8 * s + 5]); pw.w = pg8::cvtpk_s(st[j][8 * s + 6], st[j][8 * s + 7]);
                    const bf16x8 pb = __builtin_bit_cast(bf16x8, pw);
                    o0 = __builtin_amdgcn_mfma_f32_32x32x16_bf16(__builtin_bit_cast(bf16x8, (v4u){vl[s][0][0].x, vl[s][0][0].y, vl[s][0][1].x, vl[s][0][1].y}), pb, o0, 0, 0, 0);
                    o1 = __builtin_amdgcn_mfma_f32_32x32x16_bf16(__builtin_bit_cast(bf16x8, (v4u){vl[s][1][0].x, vl[s][1][0].y, vl[s][1][1].x, vl[s][1][1].y}), pb, o1, 0, 0, 0); }
                __builtin_amdgcn_sched_barrier(0); }
            bf16* yp = y0 + (size_t)qrow * 512 + hq * 64 + 4 * hh;
#pragma unroll
            for (int q4 = 0; q4 < 4; ++q4) { u32x2 w; w.x = pk2(o0[4 * q4] * inv, o0[4 * q4 + 1] * inv); w.y = pk2(o0[4 * q4 + 2] * inv, o0[4 * q4 + 3] * inv); *(u32x2*)(yp + 8 * q4) = w;
                w.x = pk2(o1[4 * q4] * inv, o1[4 * q4 + 1] * inv); w.y = pk2(o1[4 * q4 + 2] * inv, o1[4 * q4 + 3] * inv); *(u32x2*)(yp + 32 + 8 * q4) = w; }
        }
        __syncthreads();
    }
}
__device__ __forceinline__ void phase_final(Frame& F, const Args& A) {
    KP_DECL;
    const float* g = INP(I_FINN); const bf16* xb = WSP(bf16, R_XBALT); const float* ss = WSP(float, WS_SS0);
    const int gw = blockIdx.x * NWAVES + F.wave, NGW = F.G * NWAVES;
    const int lane_ = (int)__builtin_amdgcn_mbcnt_hi(~0u, __builtin_amdgcn_mbcnt_lo(~0u, 0u));
    f32x4 gg[2][2];
#pragma unroll
    for (int j = 0; j < 2; ++j) { gg[j][0] = *(const f32x4*)(g + j * 512 + lane_ * 8); gg[j][1] = *(const f32x4*)(g + j * 512 + lane_ * 8 + 4); }
    for (int m0 = gw; m0 < M; m0 += 4 * NGW) {
        const int mr = m0 + (lane_ >> 4) * NGW; const float pq = (mr < M) ? ss[(size_t)mr * 16 + (lane_ & 15)] : 1.0f;
        v4u w[4][2];
#pragma unroll
        for (int k = 0; k < 4; ++k) { const int m = (m0 + k * NGW < M) ? m0 + k * NGW : m0;
#pragma unroll
            for (int j = 0; j < 2; ++j) w[k][j] = __builtin_nontemporal_load((const v4u*)(xb + (size_t)m * DM + j * 512 + lane_ * 8)); }
        const float rsl = __builtin_amdgcn_rsqf(sum16(pq) * (1.0f / 1024.0f) + 1e-6f);
#pragma unroll
        for (int k = 0; k < 4; ++k) { const int m = m0 + k * NGW; if (m >= M) break; const float rs = __shfl(rsl, 16 * k);
#pragma unroll
            for (int j = 0; j < 2; ++j) { const v4u ww = w[k][j]; f32x4 o0, o1;
                o0.x = bflo(ww.x) * rs; o0.y = bfhi(ww.x) * rs; o0.z = bflo(ww.y) * rs; o0.w = bfhi(ww.y) * rs; o1.x = bflo(ww.z) * rs; o1.y = bfhi(ww.z) * rs; o1.z = bflo(ww.w) * rs; o1.w = bfhi(ww.w) * rs;
                float* op = F.x + (size_t)m * DM + j * 512 + lane_ * 8; *(f32x4*)op = o0 * gg[j][0]; *(f32x4*)(op + 4) = o1 * gg[j][1]; } } }
}

template <int L> __device__ __forceinline__ void run_layer(Frame& F, const Args& args, const XcdBarrier& bar, int lo, int hi) {
    typedef pg8::bf16_t pb16;
    constexpr int base = 17 * L;
#define IN(k) (lo <= base + (k) && base + (k) < hi && EN(k))
#define SEAM(k) do { if (base + (k) + 1 < hi) xcd_barrier(bar); } while (0)
#define GEMM_RUN(EPI, g, S, E) pg8::gemm_phase<EPI, pg8::StaticOrder, true, true>(F.lds + RING_OFF, g, S, E)
    constexpr size_t SS_IN = WS_SS0, SS_A = WS_SS1, SS_B = WS_SS0, SS_C = WS_SS1, SS_OUT = WS_SS0;
    if (IN(0)) { phase_conv<0>(F, args, L); SEAM(0); }
    if (IN(1)) { pg8::Gemm g{L == 0 ? WSP(pb16, WS_XB) : WSP(pb16, R_XBALT), WSP(pb16, W_F1GU), M, 5632, 1024}; pg8::StaticOrder S; S.init(M, 5632, F.G, (int)blockIdx.x);
        pg8::EpiSwiglu E{WSP(pb16, R_H), WSP(float, SS_IN)}; GEMM_RUN(pg8::EpiSwiglu, g, S, E);
        if ((int)blockIdx.x >= F.G / 2) phase_conv<1>(F, args, L);
        SEAM(1); }
    if (IN(2)) { KP_DECL; pg8::Gemm g{WSP(pb16, R_H), WSP(pb16, W_F1D), M, 1024, FF}; pg8::StaticOrder S; S.init(M, 1024, F.G, (int)blockIdx.x);
        pg8::EpiResid<0> E{WSP(pb16, WS_XB), WSP(float, SS_A), nullptr, nullptr, 0.5f, L == 0 ? WSP(pb16, WS_XB) : WSP(pb16, R_XBALT)}; GEMM_RUN(pg8::EpiResid<0>, g, S, E); SEAM(2); }
    if (IN(3)) { pg8::Gemm g{WSP(pb16, WS_XB), WSP(pb16, W_IN), M, 1792, 1024}; pg8::StaticOrder S; S.init(M, 1792, F.G, (int)blockIdx.x);
        pg8::EpiStore<0> E{WSP(pb16, R_ZR), WSP(float, SS_A), nullptr, nullptr, nullptr, nullptr}; GEMM_RUN(pg8::EpiStore<0>, g, S, E);
        { pg8::Gemm g3{WSP(pb16, WS_XB), WSP(pb16, W_IN) + (size_t)1792 * 1024, M, 2816, 1024}; pg8::EarlyOrder S3; S3.init(M, 2816, F.G, (int)blockIdx.x); S3.ns = 32;
          pg8::EpiStore<1> E3{WSP(pb16, R_ZA), WSP(float, SS_A), (pb16*)F.x, nullptr, WSP(float, WS_LB), nullptr}; pg8::gemm_phase<pg8::EpiStore<1>, pg8::EarlyOrder, true, true>(F.lds + RING_OFF, g3, S3, E3); }
        SEAM(3); }
    if (IN(4)) { phase_rprep1(F, args, L); SEAM(4); }
    if (IN(5)) { KP_DECL; pg8::Gemm g{WSP(pb16, R_AP), WSP(pb16, W_LR), M, 1536, 256}; pg8::StaticOrder S; S.init(M, 1536, F.G, (int)blockIdx.x);
        pg8::EpiStore<3> E{WSP(pb16, R_DAG_W), nullptr, WSP(pb16, R_DAG_A), WSP(pb16, R_DAG_G), INP(I_W0) + L * 512, INP(I_A0) + L * 512};
        GEMM_RUN(pg8::EpiStore<3>, g, S, E); SEAM(5); }
    if (IN(6)) { phase_rchunk_pre(F, args, L); SEAM(6); }
    if (IN(7)) {
        if (blockIdx.x < 32 && F.wave == 0) rchunk_seq(F, blockIdx.x);
        pg8::Gemm g{WSP(pb16, WS_XB), WSP(pb16, W_IN) + (size_t)1792 * 1024, M, 2816, 1024}; pg8::SplitOrder S; S.init(M, 2816, F.G, (int)blockIdx.x); S.ns = 32;
        pg8::EpiStore<1> E{WSP(pb16, R_ZA), WSP(float, SS_A), (pb16*)F.x, nullptr, WSP(float, WS_LB), nullptr};
        pg8::gemm_phase<pg8::EpiStore<1>, pg8::SplitOrder, true, true>(F.lds + RING_OFF, g, S, E); SEAM(7); }
    if (IN(8)) { phase_h1(F, blockIdx.x, F.G); phase_attn_mfma(F, args, L); phase_rchunk_out(F, args, L); SEAM(8); }
    if (IN(9)) { phase_h2(F); xcd_barrier(bar); phase_h3(F, args, L); }
    if (IN(10)) { pg8::Gemm g{WSP(pb16, WS_XB), WSP(pb16, W_IN) + (size_t)4608 * 1024, M, 3072, 1024}; pg8::StaticOrder S; S.init(M, 3072, F.G, (int)blockIdx.x);
        pg8::EpiStore<2> E{WSP(pb16, R_GG), WSP(float, SS_A), nullptr, nullptr, nullptr, nullptr}; GEMM_RUN(pg8::EpiStore<2>, g, S, E); SEAM(10); }
    if (IN(11)) { pg8::Gemm g{WSP(pb16, R_Y), WSP(pb16, W_BR), M, 1024, 512, (size_t)M * 512, (size_t)1024 * 512}; pg8::ChainOrder S; S.init(M, 1024, F.G, (int)blockIdx.x);
        pg8::EpiBranchChain E{WSP(pb16, R_MERGED), WSP(pb16, R_GG)}; pg8::gemm_phase<pg8::EpiBranchChain, pg8::ChainOrder, true, true>(F.lds + RING_OFF, g, S, E); SEAM(11); }
    if (IN(12)) { conv_p(F, args, L); pg8::Gemm g{WSP(pb16, R_MERGED), WSP(pb16, W_O), M, 1024, 1024}; pg8::StaticOrder S; S.init(M, 1024, F.G, (int)blockIdx.x);
        pg8::EpiResid<0> E{WSP(pb16, WS_XB), WSP(float, SS_B), nullptr, nullptr, 1.0f, WSP(pb16, WS_XB)}; GEMM_RUN(pg8::EpiResid<0>, g, S, E); SEAM(12); }
    if (IN(13)) {
        { pg8::Gemm g{WSP(pb16, WS_XB), WSP(pb16, W_F2GU), M, 5632, 1024}; pg8::StaticOrder S; S.init(M, 5632, F.G, (int)blockIdx.x);
          pg8::EpiSwiglu E{WSP(pb16, R_H), WSP(float, SS_B)}; GEMM_RUN(pg8::EpiSwiglu, g, S, E); }
        { pg8::Gemm g{WSP(pb16, R_PB), WSP(pb16, W_PP), M, 1024, 256}; pg8::TailOrder S; S.init(M, 1024, F.G, (int)blockIdx.x); S.lo = F.G / 2;
          pg8::EpiStore<4> E{WSP(pb16, R_PROJ), nullptr, nullptr, nullptr, nullptr, nullptr}; pg8::gemm_phase<pg8::EpiStore<4>, pg8::TailOrder, true, true>(F.lds + RING_OFF, g, S, E); }
        SEAM(13); }
    if (IN(14)) { pg8::Gemm g{WSP(pb16, R_H), WSP(pb16, W_F2D), M, 1024, FF}; pg8::StaticOrder S; S.init(M, 1024, F.G, (int)blockIdx.x);
        pg8::EpiResid<0> E{WSP(pb16, WS_XB), WSP(float, SS_C), nullptr, nullptr, 0.5f, WSP(pb16, WS_XB)}; GEMM_RUN(pg8::EpiResid<0>, g, S, E); SEAM(14); }
    if (IN(16)) { pg8::Gemm g{WSP(pb16, WS_XB), WSP(pb16, W_PG), M, 1024, 1024}; pg8::StaticOrder S; S.init(M, 1024, F.G, (int)blockIdx.x);
        pg8::EpiResid<1> E{WSP(pb16, R_XBALT), WSP(float, SS_OUT), WSP(float, SS_C), WSP(pb16, R_PROJ), 1.0f, WSP(pb16, WS_XB)}; GEMM_RUN(pg8::EpiResid<1>, g, S, E);
        if (L != 0) SEAM(16); }
#undef IN
#undef SEAM
#undef GEMM_RUN
}
__global__ void __launch_bounds__(NWAVES * 64, 2) mk_fwd(Args args) {
    extern __shared__ __attribute__((aligned(16))) unsigned char lds[];
    Frame F;
    F.lds = (LAS unsigned char*)lds;
    F.MISC = (volatile LAS unsigned*)(F.lds + MISC_OFF);
    F.tid = threadIdx.x; F.lane = F.tid & 63; F.wave = __builtin_amdgcn_readfirstlane(F.tid >> 6);
    F.G = gridDim.x;
    F.ws = args.ws; F.x = args.out;
    F.ctl = (gu32*)(args.ws + WS_CTL);
    for (int u = F.tid; u < (LDS_BYTES - LDSCTL_OFF) / 4; u += NWAVES * 64) ((LAS unsigned*)(F.lds + LDSCTL_OFF))[u] = 0u;
    __syncthreads();
    const int lo = args.ph_lo, hi = args.ph_hi;
    const bool multi = (hi - lo) > 1;
    XcdBarrier bar; bar.bar = (unsigned*)(F.ctl + CW_BAR); bar.x = 0; bar.st = nullptr;
    if (multi) bar = xcd_barrier_post((unsigned*)(F.ctl + CW_BAR), F.MISC + 8);
    run_layer<0>(F, args, bar, lo, hi);
    run_layer<1>(F, args, bar, lo, hi);
    if (lo <= N_PHASES - 1 && N_PHASES - 1 < hi && EN(17)) phase_final(F, args);
}

#ifndef MK_PER_PHASE
#define MK_PER_PHASE 0
#endif
extern "C" void kernel_launch(void* const* d_in, const int* in_sizes, int n_in, void* d_out, int out_size, void* d_ws, size_t ws_size, hipStream_t stream) {
    static int grid = 0;
    if (grid == 0) {
        if (n_in != N_IN || in_sizes[0] != M * DM || out_size != M * DM || ws_size < WS_END) { fprintf(stderr, "kernel_launch: unexpected shapes / workspace (n_in %d, ws %zu < %zu)\n", n_in, ws_size, (size_t)WS_END); grid = -1; return; }
        int dev = 0, cus = 0;
        if (hipGetDevice(&dev) != hipSuccess || hipDeviceGetAttribute(&cus, hipDeviceAttributeMultiprocessorCount, dev) != hipSuccess) { grid = -1; return; }
        if (hipFuncSetAttribute((const void*)mk_fwd, hipFuncAttributeMaxDynamicSharedMemorySize, LDS_BYTES) != hipSuccess) { fprintf(stderr, "kernel_launch: hipFuncSetAttribute failed\n"); grid = -1; return; }
        int per_cu = 0;
        if (hipOccupancyMaxActiveBlocksPerMultiprocessor(&per_cu, (const void*)mk_fwd, NWAVES * 64, LDS_BYTES) != hipSuccess || per_cu < 1) fprintf(stderr, "kernel_launch: occupancy query says %d\n", per_cu);
        (void)hipGetLastError();
        grid = cus;
    }
    if (grid < 0) return;
    (void)hipMemsetAsync((char*)d_ws + WS_CTL, 0, CTL_ZERO_BYTES, stream);
    Args a{};
    for (int i = 0; i < N_IN; ++i) a.in[i] = (const float*)d_in[i];
    a.out = (float*)d_out; a.ws = (unsigned char*)d_ws;
#if MK_PER_PHASE
    for (int ph = 0; ph < N_PHASES; ++ph) { a.ph_lo = ph; a.ph_hi = ph + 1; hipLaunchKernelGGL(mk_fwd, dim3(grid), dim3(NWAVES * 64), LDS_BYTES, stream, a); }
#else
    a.ph_lo = 0; a.ph_hi = N_PHASES; hipLaunchKernelGGL(mk_fwd, dim3(grid), dim3(NWAVES * 64), LDS_BYTES, stream, a);
#endif
}
```
